# Optimizing an MI355X kernel written in HIP

```python
import math
import jax, jax.numpy as jnp
from jax import lax
import numpy as np


D_MODEL = 1024
BATCH = 2
SEQ = 8192
DEPTH = 4

N_MIXERS = 3
HEAD_DIM = 128
MIX_HEADS = D_MODEL // HEAD_DIM
MIX_WIDTH = MIX_HEADS * HEAD_DIM
MEM_HEADS = 4
MEM_WIDTH = MEM_HEADS * HEAD_DIM
MEM_TOKENS = 256
OUT_IN = MIX_WIDTH + MEM_WIDTH

HGRN_CHUNK = 64
HGRN_IN = 4 * MIX_WIDTH + MEM_WIDTH
FOX_QBLOCK = 128
FOX_IN = 3 * MIX_WIDTH + MIX_HEADS + MEM_WIDTH
MOBA_BLOCK = 256
MOBA_TOPK = 3
MOBA_QCHUNK = 32
MOBA_IN = 3 * MIX_WIDTH + MEM_WIDTH
REL_BUCKETS = 32
REL_MAX_DIST = 128

N_EXPERTS = 32
TOP_K = 4
D_FF_EXPERT = D_MODEL
SWIGLU_LIMIT = 7.0
SWIGLU_ALPHA = 1.702
MOE_BLOCK = 256

DEEPNORM_ALPHA = (2 * DEPTH) ** 0.25
DEEPNORM_BETA = (8 * DEPTH) ** -0.25
LN_EPS = 1e-5
RMS_EPS = 1e-6
N_HGRN = (DEPTH + 2) // 3
N_FOX = (DEPTH + 1) // 3
N_MOBA = DEPTH // 3

kernel_name = 'hybrid_hgrn2_fox_moba_memory_moe'


def layer_norm(x, g, b):
    xf = x.astype(jnp.float32)
    mu = xf.mean(-1, keepdims=True)
    var = jnp.square(xf - mu).mean(-1, keepdims=True)
    return ((xf - mu) * lax.rsqrt(var + LN_EPS) * g + b).astype(x.dtype)


def split_heads(t, n):
    B, S, _ = t.shape
    return t.reshape(B, S, n, -1).transpose(0, 2, 1, 3)


def merge_heads(t):
    B, n, S, dh = t.shape
    return t.transpose(0, 2, 1, 3).reshape(B, S, n * dh)


def hgrn_lower_bounds(lb_param):
    p = jax.nn.softmax(lb_param.astype(jnp.float32), axis=0)
    c = jnp.cumsum(p, axis=0)
    return c - c[0:1]


def hgrn2_chunk_scan(q, k, v, log_f):
    B, H, S, dk = q.shape
    dv = v.shape[-1]
    nc = S // HGRN_CHUNK

    def to_chunks(t):
        return t.reshape(B, H, nc, HGRN_CHUNK, t.shape[-1]).transpose(2, 0, 1, 3, 4)

    causal = jnp.tril(jnp.ones((HGRN_CHUNK, HGRN_CHUNK), bool))

    def step(state, inp):
        qc, kc, vc, gc = inp
        b = jnp.cumsum(gc, axis=2)
        o_inter = jnp.einsum('bhtd,bhde->bhte', qc * jnp.exp(b), state)
        rel = jnp.where(causal[:, :, None], b[:, :, :, None, :] - b[:, :, None, :, :], -jnp.inf)
        scores = jnp.einsum('bhtd,bhsd,bhtsd->bhts', qc, kc, jnp.exp(rel))
        o = o_inter + jnp.einsum('bhts,bhse->bhte', scores, vc)
        b_last = b[:, :, -1:, :]
        k_dec = kc * jnp.exp(b_last - b)
        state = jnp.exp(b_last[:, :, 0, :])[..., None] * state + jnp.einsum('bhsd,bhse->bhde', k_dec, vc)
        return state, o

    state0 = jnp.zeros((B, H, dk, dv), jnp.float32)
    _, o = lax.scan(step, state0, (to_chunks(q), to_chunks(k), to_chunks(v), to_chunks(log_f)))
    return o.transpose(1, 2, 0, 3, 4).reshape(B, H, S, dv)


def hgrn2_mixer(p, lb, norm_g):
    B, S, _ = p.shape
    q, z, i, g = jnp.split(p, 4, axis=-1)
    zf = z.astype(jnp.float32)
    log_f = jnp.logaddexp(jnp.log(lb), jnp.log1p(-lb) + jax.nn.log_sigmoid(zf))
    k = (1.0 - lb) * jax.nn.sigmoid(-zf)
    qf = jax.nn.silu(q.astype(jnp.float32))
    o = hgrn2_chunk_scan(split_heads(qf, MIX_HEADS), split_heads(k, MIX_HEADS),
                         split_heads(i.astype(jnp.float32), MIX_HEADS), split_heads(log_f, MIX_HEADS))
    o = o * lax.rsqrt(jnp.mean(jnp.square(o), axis=-1, keepdims=True) + RMS_EPS)
    o = merge_heads(o) * norm_g * jax.nn.silu(g.astype(jnp.float32))
    return o.astype(p.dtype)


def fox_attention(q, k, v, c):
    B, H, S, dh = q.shape
    nq = S // FOX_QBLOCK
    q_blocks = q.reshape(B, H, nq, FOX_QBLOCK, dh).transpose(2, 0, 1, 3, 4)
    c_blocks = c.reshape(B, H, nq, FOX_QBLOCK).transpose(2, 0, 1, 3)
    key_pos = jnp.arange(S)
    scale = dh ** -0.5

    def block(args):
        bi, qb, cb = args
        q_pos = bi * FOX_QBLOCK + jnp.arange(FOX_QBLOCK)
        s = jnp.einsum('bhqd,bhkd->bhqk', qb, k).astype(jnp.float32) * scale
        s = s + (cb[..., :, None] - c[:, :, None, :])
        s = jnp.where(key_pos[None, :] <= q_pos[:, None], s, -jnp.inf)
        pr = jax.nn.softmax(s, axis=-1).astype(v.dtype)
        return jnp.einsum('bhqk,bhkd->bhqd', pr, v)

    o = lax.map(block, (jnp.arange(nq), q_blocks, c_blocks))
    return o.transpose(1, 2, 0, 3, 4).reshape(B, H, S, dh)


def fox_mixer(p, b_f):
    q, k, v, zf = jnp.split(p, [MIX_WIDTH, 2 * MIX_WIDTH, 3 * MIX_WIDTH], axis=-1)
    log_f = jax.nn.log_sigmoid(zf.astype(jnp.float32) + b_f)
    c = jnp.cumsum(log_f, axis=1).transpose(0, 2, 1)
    o = fox_attention(split_heads(q, MIX_HEADS), split_heads(k, MIX_HEADS), split_heads(v, MIX_HEADS), c)
    return merge_heads(o)


def t5_bucket(dist):
    n = jnp.maximum(dist, 0)
    max_exact = REL_BUCKETS // 2
    log_ratio = jnp.log(jnp.maximum(n, 1).astype(jnp.float32) / max_exact) / math.log(REL_MAX_DIST / max_exact)
    large = jnp.minimum(max_exact + (log_ratio * (REL_BUCKETS - max_exact)).astype(jnp.int32), REL_BUCKETS - 1)
    return jnp.where(n < max_exact, n, large)


def moba_attention(q, k, v, rel_bias):
    B, H, S, dh = q.shape
    nb = -(-S // MOBA_BLOCK)
    Sp = nb * MOBA_BLOCK
    topk = min(MOBA_TOPK, nb)
    pad = ((0, 0), (0, 0), (0, Sp - S), (0, 0))
    q, k, v = jnp.pad(q, pad), jnp.pad(k, pad), jnp.pad(v, pad)
    k_blk = k.reshape(B, H, nb, MOBA_BLOCK, dh)
    v_blk = v.reshape(B, H, nb, MOBA_BLOCK, dh)
    k_mean = k_blk.astype(jnp.float32).mean(axis=3)
    nq = Sp // MOBA_QCHUNK
    q_chunks = q.reshape(B, H, nq, MOBA_QCHUNK, dh).transpose(2, 0, 1, 3, 4)
    bias_table = rel_bias.T
    b_idx = jnp.arange(B)[:, None, None, None]
    h_idx = jnp.arange(H)[None, :, None, None]
    offs = jnp.arange(MOBA_BLOCK)
    scale = dh ** -0.5
    n_past = topk * MOBA_BLOCK

    def chunk(args):
        ci, qc = args
        q_pos = ci * MOBA_QCHUNK + jnp.arange(MOBA_QCHUNK)
        own = (ci * MOBA_QCHUNK) // MOBA_BLOCK
        gate = jnp.einsum('bhqd,bhnd->bhqn', qc.astype(jnp.float32), k_mean)
        gate = jnp.where(jnp.arange(nb) < own, gate, -jnp.inf)
        _, sel = lax.top_k(gate, topk)
        sel_valid = sel < own
        k_sel = k_blk[b_idx, h_idx, sel]
        v_sel = v_blk[b_idx, h_idx, sel]
        s_past = jnp.einsum('bhqd,bhqnkd->bhqnk', qc, k_sel).astype(jnp.float32) * scale
        pos_past = sel[..., None] * MOBA_BLOCK + offs
        s_past = s_past + bias_table[h_idx[..., None], t5_bucket(q_pos[:, None, None] - pos_past)]
        s_past = jnp.where(sel_valid[..., None], s_past, -jnp.inf)
        k_own = lax.dynamic_index_in_dim(k_blk, own, axis=2, keepdims=False)
        v_own = lax.dynamic_index_in_dim(v_blk, own, axis=2, keepdims=False)
        s_own = jnp.einsum('bhqd,bhkd->bhqk', qc, k_own).astype(jnp.float32) * scale
        dist = q_pos[:, None] - (own * MOBA_BLOCK + offs)[None, :]
        s_own = s_own + bias_table[:, t5_bucket(dist)]
        s_own = jnp.where(dist >= 0, s_own, -jnp.inf)
        logits = jnp.concatenate([s_past.reshape(B, H, MOBA_QCHUNK, n_past), s_own], axis=-1)
        probs = jax.nn.softmax(logits, axis=-1).astype(v.dtype)
        p_past = probs[..., :n_past].reshape(B, H, MOBA_QCHUNK, topk, MOBA_BLOCK)
        p_own = probs[..., n_past:]
        return (jnp.einsum('bhqnk,bhqnkd->bhqd', p_past, v_sel)
                + jnp.einsum('bhqk,bhkd->bhqd', p_own, v_own))

    o = lax.map(chunk, (jnp.arange(nq), q_chunks))
    return o.transpose(1, 2, 0, 3, 4).reshape(B, H, Sp, dh)[:, :, :S]


def moba_mixer(p, rel_bias):
    q, k, v = jnp.split(p, 3, axis=-1)
    o = moba_attention(split_heads(q, MIX_HEADS), split_heads(k, MIX_HEADS), split_heads(v, MIX_HEADS), rel_bias)
    return merge_heads(o)


def memory_attention(q, mem, w_mem_kv):
    k, v = jnp.split(mem @ w_mem_kv, 2, axis=-1)
    qh, kh, vh = split_heads(q, MEM_HEADS), split_heads(k, MEM_HEADS), split_heads(v, MEM_HEADS)
    s = jnp.einsum('bhqd,bhkd->bhqk', qh, kh).astype(jnp.float32) * (HEAD_DIM ** -0.5)
    pr = jax.nn.softmax(s, axis=-1).astype(vh.dtype)
    return merge_heads(jnp.einsum('bhqk,bhkd->bhqd', pr, vh))


def moe_ffn(x, router_w, router_b, w_up, b_up, w_down, b_down):
    B, S, D = x.shape
    T = B * S
    xt = x.reshape(T, D)
    logits = (xt @ router_w + router_b).astype(jnp.float32)
    top_v, top_i = lax.top_k(logits, TOP_K)
    gates = jax.nn.softmax(top_v, axis=-1)
    A = T * TOP_K
    flat_e = top_i.reshape(A)
    flat_tok = jnp.repeat(jnp.arange(T, dtype=jnp.int32), TOP_K)
    flat_g = gates.reshape(A)
    order = jnp.argsort(flat_e)
    e_sorted = flat_e[order]
    counts = jnp.bincount(flat_e, length=N_EXPERTS)
    starts = jnp.cumsum(counts) - counts
    padded = ((counts + MOE_BLOCK - 1) // MOE_BLOCK) * MOE_BLOCK
    p_ends = jnp.cumsum(padded)
    p_starts = p_ends - padded
    dest = p_starts[e_sorted] + (jnp.arange(A) - starts[e_sorted])
    P = ((A + MOE_BLOCK - 1) // MOE_BLOCK + N_EXPERTS) * MOE_BLOCK
    tok_buf = jnp.full((P,), T, jnp.int32).at[dest].set(flat_tok[order])
    gate_buf = jnp.zeros((P,), jnp.float32).at[dest].set(flat_g[order])
    n_blk = P // MOE_BLOCK
    blk_expert = jnp.clip(jnp.searchsorted(p_ends, jnp.arange(n_blk) * MOE_BLOCK, side='right'), 0, N_EXPERTS - 1)
    x_pad = jnp.concatenate([xt, jnp.zeros((1, D), xt.dtype)], axis=0)
    x_blocks = x_pad[tok_buf].reshape(n_blk, MOE_BLOCK, D)

    def expert_block(args):
        xb, e = args
        h = xb @ w_up[e] + b_up[e]
        glu = jnp.minimum(h[..., ::2], SWIGLU_LIMIT)
        lin = jnp.clip(h[..., 1::2], -SWIGLU_LIMIT, SWIGLU_LIMIT)
        act = glu * jax.nn.sigmoid(SWIGLU_ALPHA * glu) * (lin + 1.0)
        return act @ w_down[e] + b_down[e]

    y = lax.map(expert_block, (x_blocks, blk_expert)).reshape(P, D)
    y = y * gate_buf[:, None].astype(y.dtype)
    out = jax.ops.segment_sum(y, tok_buf, num_segments=T + 1)[:T]
    return out.astype(x.dtype).reshape(B, S, D)


def setup_inputs(seed: int = 0) -> dict:
    key = jax.random.key(seed)
    ks = jax.random.split(key, 22)
    f32 = jnp.float32

    def nrm(k, shape, s):
        return jax.random.normal(k, shape, f32) * s

    return {
        'x': nrm(ks[0], (BATCH, SEQ, D_MODEL), 1.0),
        'mem': nrm(ks[1], (BATCH, MEM_TOKENS, D_MODEL), 1.0),
        'hgrn_w_in': nrm(ks[2], (N_HGRN, D_MODEL, HGRN_IN), D_MODEL ** -0.5),
        'hgrn_lb': nrm(ks[3], (N_HGRN, MIX_WIDTH), 0.5),
        'hgrn_norm_g': 1.0 + nrm(ks[4], (N_HGRN, MIX_WIDTH), 0.02),
        'fox_w_in': nrm(ks[5], (N_FOX, D_MODEL, FOX_IN), D_MODEL ** -0.5),
        'fox_b_f': jax.random.uniform(ks[6], (N_FOX, MIX_HEADS), f32, 1.0, 4.0),
        'moba_w_in': nrm(ks[7], (N_MOBA, D_MODEL, MOBA_IN), D_MODEL ** -0.5),
        'rel_bias': nrm(ks[8], (REL_BUCKETS, MIX_HEADS), 0.5),
        'w_mem_kv': nrm(ks[9], (DEPTH, D_MODEL, 2 * MEM_WIDTH), D_MODEL ** -0.5),
        'w_out': nrm(ks[10], (DEPTH, OUT_IN, D_MODEL), OUT_IN ** -0.5 * DEEPNORM_BETA),
        'ln1_g': 1.0 + nrm(ks[11], (DEPTH, D_MODEL), 0.02),
        'ln1_b': nrm(ks[12], (DEPTH, D_MODEL), 0.02),
        'router_w': nrm(ks[13], (DEPTH, D_MODEL, N_EXPERTS), D_MODEL ** -0.5),
        'router_b': nrm(ks[14], (DEPTH, N_EXPERTS), 0.01),
        'w_up': nrm(ks[15], (DEPTH, N_EXPERTS, D_MODEL, 2 * D_FF_EXPERT), D_MODEL ** -0.5),
        'b_up': nrm(ks[16], (DEPTH, N_EXPERTS, 2 * D_FF_EXPERT), 0.01),
        'w_down': nrm(ks[17], (DEPTH, N_EXPERTS, D_FF_EXPERT, D_MODEL), D_FF_EXPERT ** -0.5 * DEEPNORM_BETA),
        'b_down': nrm(ks[18], (DEPTH, N_EXPERTS, D_MODEL), 0.01),
        'ln2_g': 1.0 + nrm(ks[19], (DEPTH, D_MODEL), 0.02),
        'ln2_b': nrm(ks[20], (DEPTH, D_MODEL), 0.02),
    }


def reference(x, mem, hgrn_w_in, hgrn_lb, hgrn_norm_g, fox_w_in, fox_b_f, moba_w_in, rel_bias,
              w_mem_kv, w_out, ln1_g, ln1_b, router_w, router_b, w_up, b_up, w_down, b_down,
              ln2_g, ln2_b):
    lower_bounds = hgrn_lower_bounds(hgrn_lb)
    for i in range(DEPTH):
        kind, j = i % N_MIXERS, i // N_MIXERS
        if kind == 0:
            proj = x @ hgrn_w_in[j]
            mix = hgrn2_mixer(proj[..., :4 * MIX_WIDTH], lower_bounds[j], hgrn_norm_g[j])
        elif kind == 1:
            proj = x @ fox_w_in[j]
            mix = fox_mixer(proj[..., :3 * MIX_WIDTH + MIX_HEADS], fox_b_f[j])
        else:
            proj = x @ moba_w_in[j]
            mix = moba_mixer(proj[..., :3 * MIX_WIDTH], rel_bias)
        mem_out = memory_attention(proj[..., -MEM_WIDTH:], mem, w_mem_kv[i])
        h = jnp.concatenate([mix, mem_out], axis=-1) @ w_out[i]
        x = layer_norm(DEEPNORM_ALPHA * x + h, ln1_g[i], ln1_b[i])
        f = moe_ffn(x, router_w[i], router_b[i], w_up[i], b_up[i], w_down[i], b_down[i])
        x = layer_norm(DEEPNORM_ALPHA * x + f, ln2_g[i], ln2_b[i])
    return x
```

```cpp
#include <hip/hip_runtime.h>
#include <cstdio>
#include <cstdint>

#ifndef MEGA
#define MEGA 0
#endif

#define LAS __attribute__((address_space(3)))
#define GAS __attribute__((address_space(1)))
typedef unsigned short bf16_t;
typedef short bf16x8 __attribute__((ext_vector_type(8)));
typedef float f32x4 __attribute__((ext_vector_type(4)));
typedef float f32x2 __attribute__((ext_vector_type(2)));
typedef float f32x16 __attribute__((ext_vector_type(16)));
typedef unsigned u32x4 __attribute__((ext_vector_type(4)));
typedef unsigned u32x2 __attribute__((ext_vector_type(2)));

constexpr int BATCH = 2, SEQ = 8192, T = BATCH * SEQ, DM = 1024, NH = 8, HD = 128, MH = 4, MEMT = 256, MEMW = 512;
constexpr int NEXP = 32, TOPK = 4, DFF = 1024, OUT_IN = 1536;
constexpr int HGRN_IN = 4608, FOX_IN = 3592, MOBA_IN = 3584;
constexpr float DN_ALPHA = 1.681792830507429f;
constexpr float LN_EPS = 1e-5f, RMS_EPS = 1e-6f;
constexpr float LOG2E = 1.4426950408889634f;
constexpr float QK_SCALE = 0.08838834764831845f;
constexpr int NTHR = 512, NWAVES = 8;

__device__ __forceinline__ unsigned cvt_pk_bf16(float lo, float hi) { unsigned r; asm volatile("v_cvt_pk_bf16_f32 %0, %1, %2" : "=v"(r) : "v"(lo), "v"(hi)); return r; }
__device__ __forceinline__ float bf2f(bf16_t b) { return __uint_as_float(((unsigned)b) << 16); }
__device__ __forceinline__ float bflo(unsigned w) { return __uint_as_float(w << 16); }
__device__ __forceinline__ float bfhi(unsigned w) { return __uint_as_float(w & 0xffff0000u); }
__device__ __forceinline__ bf16_t f2bf(float f) { return (bf16_t)(cvt_pk_bf16(f, 0.f) & 0xffffu); }
__device__ __forceinline__ float fast_exp2(float x) { return __builtin_amdgcn_exp2f(x); }
__device__ __forceinline__ float fast_rcp(float x) { return __builtin_amdgcn_rcpf(x); }
__device__ __forceinline__ float sigmoidf_(float x) { return 1.0f / (1.0f + __expf(-x)); }
__device__ __forceinline__ float siluf_(float x) { return x / (1.0f + __expf(-x)); }
__device__ __forceinline__ float logsigmoidf_(float z) { return fminf(z, 0.f) - log1pf(__expf(-fabsf(z))); }
__device__ __forceinline__ float wave_sum(float v) {
#pragma unroll
    for (int o = 1; o < 64; o <<= 1) v += __shfl_xor(v, o);
    return v;
}
__device__ __forceinline__ float swap_max(float x) { auto rr = __builtin_amdgcn_permlane32_swap(__float_as_uint(x), __float_as_uint(x), false, false); return fmaxf(__uint_as_float(rr[0]), __uint_as_float(rr[1])); }
__device__ __forceinline__ float swap_sum(float x) { auto rr = __builtin_amdgcn_permlane32_swap(__float_as_uint(x), __float_as_uint(x), false, false); return __uint_as_float(rr[0]) + __uint_as_float(rr[1]); }

#define XB_TMO      128
#define XB_XCNT(j)  (256  + 64 * (j))
#define XB_XSUB(j)  (1280 + 64 * (j))
#define XB_XGEN(j)  (2304 + 64 * (j))
#define XB_TOP      3328
#define XB_TOPGEN   3392
#define XCD_BAR_WORDS 3456
#define XB_SPIN_CAP (1u << 18)
__device__ __forceinline__ unsigned xb_ld(unsigned* p)              { return __hip_atomic_load(p, __ATOMIC_RELAXED, __HIP_MEMORY_SCOPE_AGENT); }
__device__ __forceinline__ unsigned xb_add(unsigned* p, unsigned v) { return __hip_atomic_fetch_add(p, v, __ATOMIC_RELAXED, __HIP_MEMORY_SCOPE_AGENT); }
__device__ __forceinline__ unsigned xb_xcc_id() { return (unsigned)__builtin_amdgcn_s_getreg((3 << 11) | 20) & 0xFu; }
#define XB_SPIN(cond, bar) do { unsigned _sp = 0; while (cond) { __builtin_amdgcn_s_sleep(1); \
    if ((++_sp & 255u) == 0u) { if (xb_ld(&(bar)[XB_TMO])) break; if (_sp > XB_SPIN_CAP) { atomicAdd(&(bar)[XB_TMO], 1u); break; } } } } while (0)
struct XcdBarrier { unsigned* bar; unsigned x; volatile LAS unsigned* st; };
__device__ __forceinline__ XcdBarrier xcd_barrier_post(unsigned* bar, volatile LAS unsigned* st) {
    XcdBarrier b; b.bar = bar; b.x = xb_xcc_id(); b.st = st;
    if (threadIdx.x == 0) (void)xb_add(&bar[XB_XCNT(b.x)], 1u);
    return b;
}
__device__ __forceinline__ void xcd_barrier_complete(unsigned* bar, unsigned x, unsigned& nloc, unsigned& nx) {
    const unsigned G = gridDim.x * gridDim.y * gridDim.z;
    unsigned sum, cnt, mine, sp = 0u;
    for (;;) {
        sum = 0u; cnt = 0u; mine = 0u;
#pragma unroll
        for (unsigned j = 0; j < 16; ++j) { const unsigned c = xb_ld(&bar[XB_XCNT(j)]); sum += c; cnt += (c > 0u) ? 1u : 0u; mine = (j == x) ? c : mine; }
        if (sum == G) break;
        __builtin_amdgcn_s_sleep(1);
        if ((++sp & 255u) == 0u) { if (xb_ld(&bar[XB_TMO])) break; if (sp > XB_SPIN_CAP) { atomicAdd(&bar[XB_TMO], 1u); break; } }
    }
    nloc = mine > 0u ? mine : 1u; nx = cnt > 0u ? cnt : 1u;
}
__device__ __forceinline__ void xcd_barrier(const XcdBarrier& b) {
    asm volatile("s_waitcnt vmcnt(0)" ::: "memory");
    __syncthreads();
    if (threadIdx.x == 0) {
        unsigned* bar = b.bar;
        __builtin_amdgcn_s_waitcnt(0);
        unsigned nloc = b.st[0], nx = b.st[1];
        if (nloc == 0u) { xcd_barrier_complete(bar, b.x, nloc, nx); b.st[0] = nloc; b.st[1] = nx; }
        const unsigned old = xb_add(&bar[XB_XSUB(b.x)], 1u);
        const unsigned gen = old / nloc;
        if (old + 1u == (gen + 1u) * nloc) {
            __builtin_amdgcn_fence(__ATOMIC_RELEASE, "agent");
            asm volatile("s_waitcnt vmcnt(0)" ::: "memory");
            const unsigned og = xb_add(&bar[XB_TOP], 1u);
            const unsigned tg = og / nx;
            if (og + 1u == (tg + 1u) * nx) xb_add(&bar[XB_TOPGEN], 1u);
            else XB_SPIN(xb_ld(&bar[XB_TOPGEN]) == tg, bar);
            __builtin_amdgcn_fence(__ATOMIC_ACQUIRE, "agent");
            xb_add(&bar[XB_XGEN(b.x)], 1u);
            asm volatile("s_waitcnt vmcnt(0)" ::: "memory");
        } else {
            XB_SPIN(xb_ld(&bar[XB_XGEN(b.x)]) == gen, bar);
            __builtin_amdgcn_fence(__ATOMIC_ACQUIRE, "agent");
            asm volatile("s_waitcnt vmcnt(0)" ::: "memory");
        }
    }
    __syncthreads();
}

namespace pg8 {
constexpr int BM = 256, BK = 64, HALF = 128, HTB = HALF * BK * 2, STAGE_BYTES = 8 * HTB;
__host__ __device__ __forceinline__ int lds_byte(int r, int c) { const int st = (r >> 4) * 2 + (c >> 5), rr = r & 15, cc = c & 31, ob = rr * 64 + cc * 2; return st * 1024 + (ob ^ (((ob >> 9) & 1) << 5)); }
__host__ __device__ __forceinline__ void stage_rc(int b, int& R, int& C) { const int st = b / 1024, sb = b % 1024, swz = sb ^ (((sb >> 9) & 1) << 5); R = (st >> 1) * 16 + swz / 64; C = (st & 1) * 32 + (swz % 64) / 2; }
__host__ __device__ __forceinline__ int perm32(int rho) { const int n = rho >> 4, i = rho & 15; return 8 * (i >> 2) + 4 * n + (i & 3); }
struct Unit { const char* a; const char* b; char* c; int ldc, mode, x0, x1, x2, x3; };

template <class Epi, class Sched, bool GATHER>
__device__ __forceinline__ void gemm_phase(LAS unsigned char* lds, const int K, const Sched& S, const Epi& E, const LAS unsigned* gtab) {
    const int tid = threadIdx.x, wid = __builtin_amdgcn_readfirstlane(tid >> 6), lane = tid & 63, wr = wid >> 2, wc = wid & 3, fr = lane & 15, fq = lane >> 4;
    const int nt = K / BK;
    int Rr[2], Cc[2]; unsigned voffB[2], vA[2][2], nvA[2][2];
#pragma unroll
    for (int i = 0; i < 2; ++i) { stage_rc(tid * 16 + i * 8192, Rr[i], Cc[i]); const int Rb = (Rr[i] & ~31) + perm32(Rr[i] & 31); voffB[i] = (unsigned)(Rb * K + Cc[i]) * 2u; }
    const size_t kstep = (size_t)(BK * 2);
    const unsigned hstep = (unsigned)HALF * K * 2;
    const unsigned ldsw = (unsigned)wid * 1024u;
    const int aoff = lds_byte(wr * 64 + fr, fq * 8), boff = lds_byte(wc * 32 + fr, fq * 8);
#define PG8_SA(b, h) (((b) * 2 + (h)) * HTB)
#define PG8_SB(b, h) ((4 + (b) * 2 + (h)) * HTB)
#define PG8_GLDS(src, dstoff) __builtin_amdgcn_global_load_lds((const unsigned*)(src), (LAS unsigned*)(lds + (dstoff)), 16, 0, 0)
#define PG8_STGB(b, h, gbase) do { _Pragma("unroll") for (int _i = 0; _i < 2; ++_i) PG8_GLDS((gbase) + (h) * hstep + voffB[_i], PG8_SB(b, h) + ldsw + _i * 8192); } while (0)
#define PG8_STGA(b, h, gbase, V) do { _Pragma("unroll") for (int _i = 0; _i < 2; ++_i) PG8_GLDS((gbase) + (V)[h][_i], PG8_SA(b, h) + ldsw + _i * 8192); } while (0)
#define PG8_LOADV(V, slot) do { _Pragma("unroll") for (int _h = 0; _h < 2; ++_h) _Pragma("unroll") for (int _i = 0; _i < 2; ++_i) \
        (V)[_h][_i] = GATHER ? (gtab[(slot) * 256 + _h * 128 + Rr[_i]] + (unsigned)Cc[_i] * 2u) : ((unsigned)((_h * 128 + Rr[_i]) * K + Cc[_i]) * 2u); } while (0)
#define PG8_LDA(dst, b, h) do { _Pragma("unroll") for (int m = 0; m < 4; ++m) _Pragma("unroll") for (int k = 0; k < 2; ++k) dst[m][k] = *(const LAS bf16x8*)(lds + PG8_SA(b, h) + aoff + m * 2048 + k * 1024); } while (0)
#define PG8_LDB(dst, b, h) do { _Pragma("unroll") for (int n = 0; n < 2; ++n) _Pragma("unroll") for (int k = 0; k < 2; ++k) dst[n][k] = *(const LAS bf16x8*)(lds + PG8_SB(b, h) + boff + n * 2048 + k * 1024); } while (0)
#define PG8_MMA(ai, bj, At, Bt) do { __builtin_amdgcn_s_setprio(1); _Pragma("unroll") for (int m = 0; m < 4; ++m) _Pragma("unroll") for (int n = 0; n < 2; ++n) _Pragma("unroll") for (int k = 0; k < 2; ++k) \
        acc[ai][bj][m][n] = __builtin_amdgcn_mfma_f32_16x16x32_bf16(Bt[n][k], At[m][k], acc[ai][bj][m][n], 0, 0, 0); __builtin_amdgcn_s_setprio(0); } while (0)
#define PG8_WAIT_V(n) asm volatile("s_waitcnt vmcnt(" #n ")" ::: "memory")
#define PG8_WAIT_L(n) asm volatile("s_waitcnt lgkmcnt(" #n ")" ::: "memory")
#define PG8_BAR __builtin_amdgcn_s_barrier()
#define PG8_SCHED __builtin_amdgcn_sched_barrier(0)
    Unit cur, nxt; int ui = 0;
    if (!S.next(0, cur)) return;
    f32x4 acc[2][2][4][2];
#pragma unroll
    for (int a = 0; a < 2; ++a)
#pragma unroll
        for (int b = 0; b < 2; ++b)
#pragma unroll
            for (int m = 0; m < 4; ++m)
#pragma unroll
                for (int n = 0; n < 2; ++n) acc[a][b][m][n] = (f32x4){0.f, 0.f, 0.f, 0.f};
    bf16x8 At[4][2], B0[2][2], B1[2][2];
    const char* cA = cur.a; const char* cB = cur.b;
    PG8_LOADV(vA, 0);
    PG8_STGB(0, 0, cB); PG8_STGB(0, 1, cB); PG8_STGA(0, 0, cA, vA); PG8_STGA(0, 1, cA, vA);
    if (wr == 1) PG8_BAR;
    PG8_WAIT_V(2); PG8_BAR;
    PG8_STGB(1, 0, cB + kstep); PG8_STGA(1, 0, cA + kstep, vA); PG8_STGB(1, 1, cB + kstep);
    PG8_WAIT_V(6); PG8_BAR;
    for (;;) {
        const bool has_next = S.next(ui + 1, nxt);
        const char* nA = has_next ? nxt.a : cA; const char* nB = has_next ? nxt.b : cB;
        for (int t = 0; t < nt; t += 2) {
            const bool last = (t == nt - 2);
            const char* a1 = cA + (size_t)(t + 1) * kstep;
            const char* a2 = last ? nA : cA + (size_t)(t + 2) * kstep; const char* b2 = last ? nB : cB + (size_t)(t + 2) * kstep;
            const char* a3 = a2 + kstep; const char* b3 = b2 + kstep;
            if (last) { if (has_next) { PG8_LOADV(nvA, ui + 1); } else {
#pragma unroll
                for (int _h = 0; _h < 2; ++_h)
#pragma unroll
                    for (int _i = 0; _i < 2; ++_i) nvA[_h][_i] = vA[_h][_i]; } }
            else {
#pragma unroll
                for (int _h = 0; _h < 2; ++_h)
#pragma unroll
                    for (int _i = 0; _i < 2; ++_i) nvA[_h][_i] = vA[_h][_i]; }
            PG8_LDB(B0, 0, 0); PG8_LDB(B1, 0, 1); PG8_SCHED; PG8_LDA(At, 0, 0); PG8_STGA(1, 1, a1, vA);
            PG8_WAIT_V(8); PG8_WAIT_L(0); PG8_BAR; PG8_MMA(0, 0, At, B0); PG8_MMA(0, 1, At, B1); PG8_BAR; PG8_SCHED;
            PG8_LDA(At, 0, 1); PG8_STGB(0, 0, b2); PG8_STGB(0, 1, b2); PG8_STGA(0, 0, a2, nvA);
            PG8_WAIT_V(8); PG8_WAIT_L(0); PG8_BAR; PG8_MMA(1, 0, At, B0); PG8_MMA(1, 1, At, B1); PG8_BAR; PG8_SCHED;
            PG8_LDB(B0, 1, 0); PG8_LDB(B1, 1, 1); PG8_SCHED; PG8_LDA(At, 1, 0); PG8_STGA(0, 1, a2, nvA);
            PG8_WAIT_V(8); PG8_WAIT_L(0); PG8_BAR; PG8_MMA(0, 0, At, B0); PG8_MMA(0, 1, At, B1); PG8_BAR; PG8_SCHED;
            PG8_LDA(At, 1, 1); PG8_STGB(1, 0, b3); PG8_STGB(1, 1, b3); PG8_STGA(1, 0, a3, nvA);
            PG8_WAIT_V(8); PG8_WAIT_L(0); PG8_BAR; PG8_MMA(1, 0, At, B0); PG8_MMA(1, 1, At, B1); PG8_BAR; PG8_SCHED;
        }
        if (wr == 0) PG8_BAR;
        E(acc, cur, wr, wc, fr, fq);
        if (!has_next) break;
#pragma unroll
        for (int a = 0; a < 2; ++a)
#pragma unroll
            for (int b = 0; b < 2; ++b)
#pragma unroll
                for (int m = 0; m < 4; ++m)
#pragma unroll
                    for (int n = 0; n < 2; ++n) acc[a][b][m][n] = (f32x4){0.f, 0.f, 0.f, 0.f};
        cur = nxt; cA = nA; cB = nB; ++ui;
#pragma unroll
        for (int _h = 0; _h < 2; ++_h)
#pragma unroll
            for (int _i = 0; _i < 2; ++_i) vA[_h][_i] = nvA[_h][_i];
        if (wr == 1) PG8_BAR;
    }
    PG8_WAIT_V(0);
    PG8_BAR;
#undef PG8_SA
#undef PG8_SB
#undef PG8_GLDS
#undef PG8_STGB
#undef PG8_STGA
#undef PG8_LOADV
#undef PG8_LDA
#undef PG8_LDB
#undef PG8_MMA
#undef PG8_WAIT_V
#undef PG8_WAIT_L
#undef PG8_BAR
#undef PG8_SCHED
}
}

constexpr size_t MiB = 1u << 20;
constexpr size_t WS_CTL = 0, CTL_BYTES = 1 * MiB;
constexpr size_t WS_WIN = 1 * MiB;
constexpr size_t WS_WKV = WS_WIN + 40 * MiB;
constexpr size_t WS_WOUT = WS_WKV + 8 * MiB;
constexpr size_t WS_WUP = WS_WOUT + 12 * MiB;
constexpr size_t WS_WDN = WS_WUP + 512 * MiB;
constexpr size_t WS_XB = WS_WDN + 256 * MiB;
constexpr size_t WS_MEMB = WS_XB + 32 * MiB;
constexpr size_t WS_XF = WS_MEMB + 1 * MiB;
constexpr size_t WS_PA = WS_XF + 64 * MiB;
constexpr size_t WS_PB = WS_PA + 32 * MiB;
constexpr size_t WS_PVT = WS_PB + 32 * MiB;
constexpr size_t WS_PZ = WS_PVT + 32 * MiB;
constexpr size_t WS_PMQ = WS_PZ + 64 * MiB;
constexpr size_t WS_MEMK = WS_PMQ + 16 * MiB;
constexpr size_t WS_MEMVT = WS_MEMK + MiB / 2;
constexpr size_t WS_LOGF = WS_MEMVT + MiB / 2;
constexpr size_t WS_HQB = WS_LOGF + 1 * MiB;
constexpr size_t WS_HQR = WS_HQB + 32 * MiB;
constexpr size_t WS_HKR = WS_HQR + 32 * MiB;
constexpr size_t WS_HKDT = WS_HKR + 32 * MiB;
constexpr size_t WS_HG = WS_HKDT + 32 * MiB;
constexpr size_t WS_HST = WS_HG + 1 * MiB;
constexpr size_t WS_KMEAN = WS_HST + 128 * MiB;
constexpr size_t WS_SEL = WS_KMEAN + 1 * MiB;
constexpr size_t WS_LISTS = WS_SEL + 2 * MiB;
constexpr size_t WS_PARTO = WS_LISTS + 16 * MiB;
constexpr size_t WS_PARTL = WS_PARTO + 96 * MiB;
constexpr size_t WS_MIX = WS_PARTL + 2 * MiB;
constexpr size_t WS_Y1 = WS_MIX + 48 * MiB;
constexpr size_t WS_X1F = WS_Y1 + 64 * MiB;
constexpr size_t WS_X1B = WS_X1F + 64 * MiB;
constexpr size_t WS_ETOK = WS_X1B + 32 * MiB;
constexpr size_t WS_GATE = WS_ETOK + 2 * MiB;
constexpr size_t WS_ACT = WS_GATE + 1 * MiB;
constexpr size_t WS_YE = WS_ACT + 144 * MiB;
constexpr size_t WS_END = WS_YE + 128 * MiB;
constexpr int CW_BAR = 1024;
constexpr int CW_ECNT = 8192;
constexpr int CW_LCNT = 8192 + 256;
constexpr int CW_CHK = 16384;

struct Params {
    const float* in[21];
    float* out; unsigned char* ws;
};
#define WSP(T_, off) ((T_*)(p.ws + (off)))
__device__ __forceinline__ unsigned* ctl(const Params& p) { return (unsigned*)(p.ws + WS_CTL); }

__device__ __forceinline__ void transpose_item(const float* W, int K, int N, bf16_t* WT, int k0, int n_src0, int n_dst0, LAS float* scr, int lane) {
#pragma unroll 8
    for (int i = 0; i < 32; ++i) { const int kk = 2 * i + (lane >> 5); scr[kk * 33 + (lane & 31)] = W[(size_t)(k0 + kk) * N + n_src0 + (lane & 31)]; }
    asm volatile("s_waitcnt lgkmcnt(0)" ::: "memory");
    const int c = lane & 7;
#pragma unroll
    for (int j = 0; j < 4; ++j) { const int n = (lane >> 3) + 8 * j; const LAS float* s = scr + (8 * c) * 33 + n;
        u32x4 o; o.x = cvt_pk_bf16(s[0 * 33], s[1 * 33]); o.y = cvt_pk_bf16(s[2 * 33], s[3 * 33]); o.z = cvt_pk_bf16(s[4 * 33], s[5 * 33]); o.w = cvt_pk_bf16(s[6 * 33], s[7 * 33]);
        *(u32x4*)(WT + (size_t)(n_dst0 + n) * K + k0 + 8 * c) = o; }
    asm volatile("s_waitcnt lgkmcnt(0)" ::: "memory");
}
struct TJob { const float* W; bf16_t* WT; int K, N, src0, dst0, ncb, nmat; size_t sstride, dstride; };
__device__ __forceinline__ void run_tjob(const TJob& j, int gw, int ngw, LAS float* scr, int lane) {
    const int nkb = j.K / 64, per = nkb * j.ncb, nit = per * j.nmat;
    for (int it = gw; it < nit; it += ngw) { const int mt = it / per, r = it % per, kb = r / j.ncb, cb = r % j.ncb;
        transpose_item(j.W + (size_t)mt * j.sstride, j.K, j.N, j.WT + (size_t)mt * j.dstride, 64 * kb, j.src0 + 32 * cb, j.dst0 + 32 * cb, scr, lane); }
}
__device__ __forceinline__ void cvt_rows_bf16(const float* src, bf16_t* dst, size_t n8, int gtid, int ngt) {
    for (size_t i = gtid; i < n8; i += ngt) { const f32x4 a = *(const f32x4*)(src + i * 8), b = *(const f32x4*)(src + i * 8 + 4);
        u32x4 o; o.x = cvt_pk_bf16(a[0], a[1]); o.y = cvt_pk_bf16(a[2], a[3]); o.z = cvt_pk_bf16(b[0], b[1]); o.w = cvt_pk_bf16(b[2], b[3]); *(u32x4*)(dst + i * 8) = o; }
}
enum { I_X = 0, I_MEM, I_HGRN_W, I_HGRN_LB, I_HGRN_NG, I_FOX_W, I_FOX_BF, I_MOBA_W, I_RELB, I_WKV, I_WOUT, I_LN1G, I_LN1B, I_RW, I_RB, I_WUP, I_BUP, I_WDN, I_BDN, I_LN2G, I_LN2B };

__device__ __forceinline__ void phase_prologue(const Params& p, LAS unsigned char* lds, int bid, int nb) {
    const int tid = threadIdx.x, lane = tid & 63, wave = tid >> 6;
    LAS float* scr = (LAS float*)(lds + wave * 16384);
    const int gw = bid * NWAVES + wave, ngw = nb * NWAVES;
    for (int l = 0; l < 4; ++l) {
        TJob ju{p.in[I_WUP] + (size_t)l * NEXP * DM * 2 * DFF, WSP(bf16_t, WS_WUP) + (size_t)l * NEXP * 2 * DFF * DM, DM, 2 * DFF, 0, 0, 2 * DFF / 32, NEXP, (size_t)DM * 2 * DFF, (size_t)2 * DFF * DM};
        run_tjob(ju, gw, ngw, scr, lane);
        TJob jd{p.in[I_WDN] + (size_t)l * NEXP * DFF * DM, WSP(bf16_t, WS_WDN) + (size_t)l * NEXP * DM * DFF, DFF, DM, 0, 0, DM / 32, NEXP, (size_t)DFF * DM, (size_t)DM * DFF};
        run_tjob(jd, gw, ngw, scr, lane);
        TJob jk{p.in[I_WKV] + (size_t)l * DM * 1024, WSP(bf16_t, WS_WKV) + (size_t)l * 1024 * DM, DM, 1024, 0, 0, 32, 1, 0, 0};
        run_tjob(jk, gw, ngw, scr, lane);
        TJob jo{p.in[I_WOUT] + (size_t)l * OUT_IN * DM, WSP(bf16_t, WS_WOUT) + (size_t)l * DM * OUT_IN, OUT_IN, DM, 0, 0, 32, 1, 0, 0};
        run_tjob(jo, gw, ngw, scr, lane);
        const int kind = l % 3, jj = l / 3;
        bf16_t* wt = WSP(bf16_t, WS_WIN) + (size_t)l * (10 * MiB / 2);
        if (kind == 0) { TJob ji{p.in[I_HGRN_W] + (size_t)jj * DM * HGRN_IN, wt, DM, HGRN_IN, 0, 0, HGRN_IN / 32, 1, 0, 0}; run_tjob(ji, gw, ngw, scr, lane); }
        else if (kind == 1) { TJob ja{p.in[I_FOX_W], wt, DM, FOX_IN, 0, 0, 3072 / 32, 1, 0, 0}; run_tjob(ja, gw, ngw, scr, lane);
                              TJob jb{p.in[I_FOX_W], wt, DM, FOX_IN, 3080, 3072, 512 / 32, 1, 0, 0}; run_tjob(jb, gw, ngw, scr, lane); }
        else { TJob ji{p.in[I_MOBA_W], wt, DM, MOBA_IN, 0, 0, MOBA_IN / 32, 1, 0, 0}; run_tjob(ji, gw, ngw, scr, lane); }
    }
    const int gtid = bid * NTHR + tid, ngt = nb * NTHR;
    cvt_rows_bf16(p.in[I_X], WSP(bf16_t, WS_XB), (size_t)T * DM / 8, gtid, ngt);
    cvt_rows_bf16(p.in[I_MEM], WSP(bf16_t, WS_MEMB), (size_t)BATCH * MEMT * DM / 8, gtid, ngt);
}

constexpr int LDS_STAGE = 0, LDS_GTAB = 131072, LDS_MISC = 147456, LDS_BYTES = 153600;

__device__ __forceinline__ void static_order(int L, int nM, int nN, int& pm, int& pn) {
    const int nwg = nM * nN; int wgid = L; { const int q = nwg / 8, r = nwg % 8, xcd = wgid % 8, off = wgid / 8; wgid = (xcd < r ? xcd * (q + 1) : r * (q + 1) + (xcd - r) * q) + off; }
    const int nig = 8 * nN, gid = wgid / nig, fm = gid * 8, gsz = (nM - fm) < 8 ? (nM - fm) : 8;
    pm = fm + ((wgid % nig) % gsz); pn = (wgid % nig) / gsz;
}
struct ProjSched {
    int G, c, kind; const char *xb, *win, *memb, *wkv; char *pa, *pb, *pvt, *pz, *pmq, *memk, *memvt;
    __device__ __forceinline__ bool next(int i, pg8::Unit& u) const {
        const int nmc = (kind == 0) ? 14 : 10, nmain = 64 * nmc; const int L = i * G + c;
        u.x0 = 0; u.x1 = 0; u.x2 = 0; u.x3 = 0;
        if (L < nmain) { int pm, j; static_order(L, 64, nmc, pm, j);
            int pn, dc; char* dst; int ldc = DM, mode = 0, esz = 2;
            if (kind == 0) { if (j < 4) { pn = j; dst = pa; dc = j; mode = 1; } else if (j < 8) { pn = j; dst = pz; dc = j - 4; mode = 2; esz = 4; } else if (j < 12) { pn = j + 4; dst = pb; dc = j - 8; mode = 1; } else { pn = j + 4; dst = pmq; dc = j - 12; ldc = MEMW; } }
            else { if (j < 4) { pn = j; dst = pa; dc = j; } else if (j < 8) { pn = j; dst = pb; dc = j - 4; } else { pn = j + 4; dst = pmq; dc = j - 8; ldc = MEMW; } }
            u.a = xb + (size_t)pm * 256 * DM * 2; u.b = win + (size_t)pn * 256 * DM * 2; u.c = dst + ((size_t)pm * 256 * ldc + dc * 256) * esz; u.ldc = ldc; u.mode = mode; return true; }
        int idx = L - nmain;
        if (idx < 256) { const int x = idx & 7, off = idx >> 3, tn = 8 * x + (off & 7), vm = off >> 3;
            u.a = win + (size_t)(2048 + 256 * vm) * DM * 2; u.b = xb + (size_t)tn * 256 * DM * 2; u.c = pvt + ((size_t)256 * vm * T + 256 * tn) * 2; u.ldc = T; u.mode = 0; return true; }
        idx -= 256;
        if (idx < 4) { const int mm = idx & 1, kn = idx >> 1;
            u.a = memb + (size_t)mm * 256 * DM * 2; u.b = wkv + (size_t)kn * 256 * DM * 2; u.c = memk + ((size_t)256 * mm * MEMW + 256 * kn) * 2; u.ldc = MEMW; u.mode = 0; return true; }
        idx -= 4;
        if (idx < 4) { const int mm = idx & 1, vn = idx >> 1;
            u.a = wkv + (size_t)(512 + 256 * vn) * DM * 2; u.b = memb + (size_t)mm * 256 * DM * 2; u.c = memvt + ((size_t)256 * vn * 512 + 256 * mm) * 2; u.ldc = 512; u.mode = 0; return true; }
        return false;
    }
};
struct EpiStore {
    __device__ __forceinline__ void operator()(const f32x4 (&acc)[2][2][4][2], const pg8::Unit& u, int wr, int wc, int fr, int fq) const {
        const int r0 = wr * 64 + fr, c0 = wc * 32 + 8 * fq;
#pragma unroll
        for (int ai = 0; ai < 2; ++ai)
#pragma unroll
            for (int m = 0; m < 4; ++m) { const size_t ro = (size_t)(r0 + ai * 128 + m * 16) * u.ldc + c0;
#pragma unroll
                for (int bj = 0; bj < 2; ++bj) { f32x4 v0 = acc[ai][bj][m][0], v1 = acc[ai][bj][m][1];
                    if (u.mode == 2) { float* o = (float*)u.c + ro + bj * 128; *(f32x4*)o = v0; *(f32x4*)(o + 4) = v1; }
                    else { if (u.mode == 1) {
#pragma unroll
                            for (int j = 0; j < 4; ++j) { v0[j] = siluf_(v0[j]); v1[j] = siluf_(v1[j]); } }
                        u32x4 w; w.x = cvt_pk_bf16(v0[0], v0[1]); w.y = cvt_pk_bf16(v0[2], v0[3]); w.z = cvt_pk_bf16(v1[0], v1[1]); w.w = cvt_pk_bf16(v1[2], v1[3]);
                        *(u32x4*)((bf16_t*)u.c + ro + bj * 128) = w; } } }
    }
};
struct OutSched { int G, c; const char *mix, *wout;
    __device__ __forceinline__ bool next(int i, pg8::Unit& u) const { const int L = i * G + c; if (L >= 256) return false; int pm, pn; static_order(L, 64, 4, pm, pn);
        u.a = mix + (size_t)pm * 256 * OUT_IN * 2; u.b = wout + (size_t)pn * 256 * OUT_IN * 2; u.c = nullptr; u.ldc = DM; u.mode = 0; u.x0 = pm; u.x1 = pn; u.x2 = 0; u.x3 = 0; return true; }
};
struct EpiResid {
    const float* res; float* out;
    __device__ __forceinline__ void operator()(const f32x4 (&acc)[2][2][4][2], const pg8::Unit& u, int wr, int wc, int fr, int fq) const {
        const int r0 = u.x0 * 256 + wr * 64 + fr, c0 = u.x1 * 256 + wc * 32 + 8 * fq;
#pragma unroll
        for (int ai = 0; ai < 2; ++ai)
#pragma unroll
            for (int m = 0; m < 4; ++m) { const size_t ro = (size_t)(r0 + ai * 128 + m * 16) * DM + c0;
#pragma unroll
                for (int bj = 0; bj < 2; ++bj) { const float* rp = res + ro + bj * 128; float* o = out + ro + bj * 128;
                    const f32x4 a = *(const f32x4*)rp, b = *(const f32x4*)(rp + 4);
                    *(f32x4*)o = a * DN_ALPHA + acc[ai][bj][m][0]; *(f32x4*)(o + 4) = b * DN_ALPHA + acc[ai][bj][m][1]; } }
    }
};
struct MoeSched { const LAS int* ut; const char *abase, *wbase; int up;
    __device__ __forceinline__ bool next(int i, pg8::Unit& u) const {
        if (i >= 16) return false; const LAS int* t = ut + i * 8; if (!t[0]) return false;
        const int e = t[1], rbl = t[2], rbc = t[3], pn = t[4], cnt = t[5];
        if (up) { u.a = abase; u.b = wbase + ((size_t)e * 2 * DFF + pn * 256) * DM * 2; }
        else { u.a = abase + (size_t)rbc * 256 * DFF * 2; u.b = wbase + ((size_t)e * DM + pn * 256) * DFF * 2; }
        u.c = nullptr; u.ldc = pn; u.mode = e; u.x0 = rbl; u.x1 = rbc; u.x2 = cnt; u.x3 = 0; return true; }
};
struct EpiUp {
    const float* bup; bf16_t* act;
    __device__ __forceinline__ void operator()(const f32x4 (&acc)[2][2][4][2], const pg8::Unit& u, int wr, int wc, int fr, int fq) const {
        const int e = u.mode, pn = u.ldc, r0 = u.x1 * 256 + wr * 64 + fr, c0 = pn * 256 + wc * 32 + 8 * fq;
        f32x4 bv[2][2];
#pragma unroll
        for (int bj = 0; bj < 2; ++bj) { const float* bp = bup + (size_t)e * 2 * DFF + c0 + bj * 128; bv[bj][0] = *(const f32x4*)bp; bv[bj][1] = *(const f32x4*)(bp + 4); }
#pragma unroll
        for (int ai = 0; ai < 2; ++ai)
#pragma unroll
            for (int m = 0; m < 4; ++m) { bf16_t* rowp = act + (size_t)(r0 + ai * 128 + m * 16) * DFF + (c0 >> 1);
#pragma unroll
                for (int bj = 0; bj < 2; ++bj) { const f32x4 v0 = acc[ai][bj][m][0] + bv[bj][0], v1 = acc[ai][bj][m][1] + bv[bj][1];
                    float o[4];
#pragma unroll
                    for (int j = 0; j < 4; ++j) { const float hg = (j < 2) ? v0[2 * j] : v1[2 * j - 4], hl = (j < 2) ? v0[2 * j + 1] : v1[2 * j - 3];
                        const float glu = fminf(hg, 7.0f), lin = fminf(fmaxf(hl, -7.0f), 7.0f); o[j] = glu * sigmoidf_(1.702f * glu) * (lin + 1.0f); }
                    u32x2 w; w.x = cvt_pk_bf16(o[0], o[1]); w.y = cvt_pk_bf16(o[2], o[3]); *(u32x2*)(rowp + bj * 64) = w; } }
    }
};
struct EpiDown {
    const float* bdn; const unsigned* etok; bf16_t* ye;
    __device__ __forceinline__ void operator()(const f32x4 (&acc)[2][2][4][2], const pg8::Unit& u, int wr, int wc, int fr, int fq) const {
        const int e = u.mode, pn = u.ldc, rl0 = u.x0 * 256 + wr * 64 + fr, cnt = u.x2, c0 = pn * 256 + wc * 32 + 8 * fq;
        f32x4 bv[2][2];
#pragma unroll
        for (int bj = 0; bj < 2; ++bj) { const float* bp = bdn + (size_t)e * DM + c0 + bj * 128; bv[bj][0] = *(const f32x4*)bp; bv[bj][1] = *(const f32x4*)(bp + 4); }
        unsigned dest[2][4];
#pragma unroll
        for (int ai = 0; ai < 2; ++ai)
#pragma unroll
            for (int m = 0; m < 4; ++m) { const int rl = rl0 + ai * 128 + m * 16; dest[ai][m] = (rl < cnt) ? etok[(size_t)e * T + rl] : 0xffffffffu; }
#pragma unroll
        for (int ai = 0; ai < 2; ++ai)
#pragma unroll
            for (int m = 0; m < 4; ++m) { if (dest[ai][m] != 0xffffffffu) { bf16_t* rowp = ye + (size_t)dest[ai][m] * DM + c0;
#pragma unroll
                for (int bj = 0; bj < 2; ++bj) { const f32x4 v0 = acc[ai][bj][m][0] + bv[bj][0], v1 = acc[ai][bj][m][1] + bv[bj][1];
                    u32x4 w; w.x = cvt_pk_bf16(v0[0], v0[1]); w.y = cvt_pk_bf16(v0[2], v0[3]); w.z = cvt_pk_bf16(v1[0], v1[1]); w.w = cvt_pk_bf16(v1[2], v1[3]);
                    *(u32x4*)(rowp + bj * 128) = w; } } }
    }
};

__device__ __forceinline__ void phase_proj(const Params& p, LAS unsigned char* lds, int layer, int bid, int nb) {
    ProjSched S; S.G = nb; S.c = bid; S.kind = layer % 3;
    S.xb = (const char*)WSP(bf16_t, WS_XB); S.win = (const char*)(WSP(bf16_t, WS_WIN) + (size_t)layer * (10 * MiB / 2)); S.memb = (const char*)WSP(bf16_t, WS_MEMB);
    S.wkv = (const char*)(WSP(bf16_t, WS_WKV) + (size_t)layer * 1024 * DM);
    S.pa = (char*)WSP(bf16_t, WS_PA); S.pb = (char*)WSP(bf16_t, WS_PB); S.pvt = (char*)WSP(bf16_t, WS_PVT); S.pz = (char*)WSP(float, WS_PZ); S.pmq = (char*)WSP(bf16_t, WS_PMQ);
    S.memk = (char*)WSP(bf16_t, WS_MEMK); S.memvt = (char*)WSP(bf16_t, WS_MEMVT);
    EpiStore E;
    pg8::gemm_phase<EpiStore, ProjSched, false>(lds + LDS_STAGE, DM, S, E, nullptr);
}
__device__ __forceinline__ void phase_outproj(const Params& p, LAS unsigned char* lds, int layer, int bid, int nb) {
    OutSched S{nb, bid, (const char*)WSP(bf16_t, WS_MIX), (const char*)(WSP(bf16_t, WS_WOUT) + (size_t)layer * DM * OUT_IN)};
    EpiResid E{layer == 0 ? p.in[I_X] : WSP(float, WS_XF), WSP(float, WS_Y1)};
    pg8::gemm_phase<EpiResid, OutSched, false>(lds + LDS_STAGE, OUT_IN, S, E, nullptr);
}
__device__ __forceinline__ void moe_build_units(const Params& p, LAS unsigned char* lds, int layer, int bid, int nb, int npn, bool up) {
    LAS int* misc = (LAS int*)(lds + LDS_MISC); LAS int* ut = misc + 16; LAS int* pre = misc + 160; LAS int* cnts = misc + 200;
    LAS unsigned* gtab = (LAS unsigned*)(lds + LDS_GTAB);
    const int tid = threadIdx.x;
    const unsigned* ecnt = ctl(p) + CW_ECNT + layer * 32;
    if (tid < 32) cnts[tid] = (int)__hip_atomic_load(ecnt + tid, __ATOMIC_RELAXED, __HIP_MEMORY_SCOPE_AGENT);
    __syncthreads();
    if (tid == 0) { int s = 0; for (int e = 0; e < 32; ++e) { pre[e] = s; s += (cnts[e] + 255) >> 8; } pre[32] = s; }
    __syncthreads();
    if (tid < 16) { const int i = tid, nblk = pre[32]; int rbg, pn;
        if (nb == 256) { const int x = bid & 7, slot = bid >> 3, rpr = 32 / npn; rbg = i * (8 * rpr) + x * rpr + slot / npn; pn = slot % npn; }
        else { const int L = i * nb + bid; rbg = L / npn; pn = L % npn; }
        LAS int* t = ut + i * 8;
        if (rbg < nblk) { int e = 0; while (pre[e + 1] <= rbg) ++e; t[0] = 1; t[1] = e; t[2] = rbg - pre[e]; t[3] = rbg; t[4] = pn; t[5] = cnts[e]; }
        else { t[0] = 0; t[1] = 0; t[2] = 0; t[3] = 0; t[4] = 0; t[5] = 0; } }
    __syncthreads();
    if (up) { const unsigned* etok = WSP(unsigned, WS_ETOK);
        for (int idx = tid; idx < 16 * 256; idx += NTHR) { const int i = idx >> 8, r = idx & 255; const LAS int* t = ut + i * 8; unsigned off = 0;
            if (t[0]) { const int rl = t[2] * 256 + r; if (rl < t[5]) off = (etok[(size_t)t[1] * T + rl] >> 2) * (unsigned)(DM * 2); }
            gtab[idx] = off; }
        __syncthreads(); }
}
__device__ __forceinline__ void phase_moe_up(const Params& p, LAS unsigned char* lds, int layer, int bid, int nb) {
    moe_build_units(p, lds, layer, bid, nb, 8, true);
    MoeSched S{(const LAS int*)(lds + LDS_MISC) + 16, (const char*)WSP(bf16_t, WS_X1B), (const char*)(WSP(bf16_t, WS_WUP) + (size_t)layer * NEXP * 2 * DFF * DM), 1};
    EpiUp E{p.in[I_BUP] + (size_t)layer * NEXP * 2 * DFF, WSP(bf16_t, WS_ACT)};
    pg8::gemm_phase<EpiUp, MoeSched, true>(lds + LDS_STAGE, DM, S, E, (const LAS unsigned*)(lds + LDS_GTAB));
}
__device__ __forceinline__ void phase_moe_down(const Params& p, LAS unsigned char* lds, int layer, int bid, int nb) {
    moe_build_units(p, lds, layer, bid, nb, 4, false);
    MoeSched S{(const LAS int*)(lds + LDS_MISC) + 16, (const char*)WSP(bf16_t, WS_ACT), (const char*)(WSP(bf16_t, WS_WDN) + (size_t)layer * NEXP * DM * DFF), 0};
    EpiDown E{p.in[I_BDN] + (size_t)layer * NEXP * DM, WSP(unsigned, WS_ETOK), WSP(bf16_t, WS_YE)};
    pg8::gemm_phase<EpiDown, MoeSched, false>(lds + LDS_STAGE, DFF, S, E, nullptr);
}

constexpr int AT_K0 = 0, AT_V0 = 32768, AT_AUX = 65536;
__device__ __forceinline__ int kswz(int row, int ch) { return row * 256 + ((ch ^ ((row & 3) | (((row >> 3) & 3) << 2))) << 4); }
__device__ __forceinline__ int vswz(int row, int ch) { return row * 128 + ((ch ^ (((row >> 1) & 1) | (((row >> 3) & 3) << 1))) << 4); }
struct AttnBias { float cq; int qpos; const LAS float* tab; int kpos0; int qmin; };
template <int MODE>
__device__ __forceinline__ void attn_tiles(LAS unsigned char* lds, const bf16_t* kbase, int ldk, const bf16_t* vtbase, int ldv, int ntiles, int wave_nt,
                                           const bf16x8 (&qf)[8], f32x16 (&o)[4], float& m, float& l, const AttnBias& B) {
    const int tid = threadIdx.x, lane = tid & 63, w = __builtin_amdgcn_readfirstlane(tid >> 6), r = lane & 31, hi = lane >> 5;
    int koff[2], voff[2];
#pragma unroll
    for (int i = 0; i < 2; ++i) { const int pz = (w * 2 + i) * 64 + lane;
        { const int row = pz >> 4, chp = pz & 15, ch = chp ^ ((row & 3) | (((row >> 3) & 3) << 2)); koff[i] = row * ldk + ch * 8; }
        { const int row = pz >> 3, chp = pz & 7, ch = chp ^ (((row >> 1) & 1) | (((row >> 3) & 3) << 1)); voff[i] = row * ldv + ch * 8; } }
    const int pr = (r & ~12) | ((r & 4) << 1) | ((r & 8) >> 1);
    int kaddr[8], vaddr[4];
#pragma unroll
    for (int ks = 0; ks < 8; ++ks) kaddr[ks] = kswz(pr, 2 * ks + hi);
#pragma unroll
    for (int s_ = 0; s_ < 4; ++s_) vaddr[s_] = vswz(r, 2 * s_ + hi);
#define AT_DMA(t, buf) do { _Pragma("unroll") for (int _i = 0; _i < 2; ++_i) { \
        __builtin_amdgcn_global_load_lds((const unsigned*)(kbase + (size_t)(t) * 64 * ldk + koff[_i]), (LAS unsigned*)(lds + AT_K0 + (buf) * 16384 + (w * 2 + _i) * 1024), 16, 0, 0); \
        __builtin_amdgcn_global_load_lds((const unsigned*)(vtbase + (t) * 64 + voff[_i]), (LAS unsigned*)(lds + AT_V0 + (buf) * 16384 + (w * 2 + _i) * 1024), 16, 0, 0); } } while (0)
    AT_DMA(0, 0);
    asm volatile("s_waitcnt vmcnt(0)" ::: "memory");
    __syncthreads();
    constexpr float C = QK_SCALE * LOG2E;
    const float NEG = -__builtin_inff();
    for (int t = 0; t < ntiles; ++t) {
        const int buf = t & 1;
        if (t + 1 < ntiles) AT_DMA(t + 1, buf ^ 1);
        if (t < wave_nt) {
            f32x16 s0, s1;
#pragma unroll
            for (int i = 0; i < 16; ++i) { s0[i] = 0.f; s1[i] = 0.f; }
            const LAS unsigned char* kb = lds + AT_K0 + buf * 16384;
#pragma unroll
            for (int kg = 0; kg < 4; ++kg) {
#pragma unroll
                for (int k2 = 0; k2 < 2; ++k2) { const int ks = 2 * kg + k2;
                    const bf16x8 k0 = *(const LAS bf16x8*)(kb + kaddr[ks]), k1 = *(const LAS bf16x8*)(kb + kaddr[ks] + 8192);
                    s0 = __builtin_amdgcn_mfma_f32_32x32x16_bf16(k0, qf[ks], s0, 0, 0, 0);
                    s1 = __builtin_amdgcn_mfma_f32_32x32x16_bf16(k1, qf[ks], s1, 0, 0, 0); }
                __builtin_amdgcn_sched_barrier(0);
            }
            float mx = NEG;
            if (MODE == 0) {
#pragma unroll
                for (int i = 0; i < 16; ++i) { s0[i] *= C; s1[i] *= C; mx = fmaxf(mx, fmaxf(s0[i], s1[i])); }
            } else if (MODE == 1) {
                const int tk = t * 64;
                const bool diag = (tk + 63 > B.qmin);
#pragma unroll
                for (int g = 0; g < 4; ++g) {
                    const int kq = 16 * (g >> 1) + 8 * hi + 4 * (g & 1);
                    const f32x4 c0 = *(const LAS f32x4*)(B.tab + tk + kq), c1 = *(const LAS f32x4*)(B.tab + tk + 32 + kq);
#pragma unroll
                    for (int j = 0; j < 4; ++j) { const int i = 4 * g + j; float v0 = s0[i] * C + (B.cq - c0[j]), v1 = s1[i] * C + (B.cq - c1[j]);
                        if (diag) { const int ko = tk + kq + j; if (ko > B.qpos) v0 = NEG; if (ko + 32 > B.qpos) v1 = NEG; }
                        s0[i] = v0; s1[i] = v1; mx = fmaxf(mx, fmaxf(v0, v1)); }
                    __builtin_amdgcn_sched_barrier(0);
                }
            } else {
                const int tk = B.kpos0 + t * 64;
                const bool far = (MODE == 2) && (B.qmin - (tk + 63) >= 128);
                if (far) { const float bb = B.tab[128];
#pragma unroll
                    for (int i = 0; i < 16; ++i) { s0[i] = s0[i] * C + bb; s1[i] = s1[i] * C + bb; mx = fmaxf(mx, fmaxf(s0[i], s1[i])); }
                } else {
#pragma unroll
                    for (int i = 0; i < 16; ++i) { const int ko = 16 * (i >> 3) + 8 * hi + (i & 7); const int d0 = B.qpos - (tk + ko), d1 = d0 - 32;
                        float v0 = s0[i] * C + B.tab[d0 < 0 ? 0 : (d0 > 128 ? 128 : d0)], v1 = s1[i] * C + B.tab[d1 < 0 ? 0 : (d1 > 128 ? 128 : d1)];
                        if (MODE == 3) { if (d0 < 0) v0 = NEG; if (d1 < 0) v1 = NEG; }
                        s0[i] = v0; s1[i] = v1; mx = fmaxf(mx, fmaxf(v0, v1)); }
                }
            }
            mx = swap_max(mx);
            const float mn = fmaxf(m, mx), alpha = fast_exp2(m - mn); m = mn;
            float ps = 0.f;
#pragma unroll
            for (int i = 0; i < 16; ++i) { s0[i] = fast_exp2(s0[i] - mn); s1[i] = fast_exp2(s1[i] - mn); ps += s0[i] + s1[i]; }
            ps = swap_sum(ps); l = l * alpha + ps;
            if (!__all(alpha == 1.0f)) {
#pragma unroll
                for (int db = 0; db < 4; ++db)
#pragma unroll
                    for (int i = 0; i < 16; ++i) o[db][i] *= alpha;
            }
            bf16x8 pf[4];
#pragma unroll
            for (int s = 0; s < 4; ++s) { u32x4 wv;
                if (s < 2) { wv.x = cvt_pk_bf16(s0[8 * s + 0], s0[8 * s + 1]); wv.y = cvt_pk_bf16(s0[8 * s + 2], s0[8 * s + 3]); wv.z = cvt_pk_bf16(s0[8 * s + 4], s0[8 * s + 5]); wv.w = cvt_pk_bf16(s0[8 * s + 6], s0[8 * s + 7]); }
                else { const int q = s - 2; wv.x = cvt_pk_bf16(s1[8 * q + 0], s1[8 * q + 1]); wv.y = cvt_pk_bf16(s1[8 * q + 2], s1[8 * q + 3]); wv.z = cvt_pk_bf16(s1[8 * q + 4], s1[8 * q + 5]); wv.w = cvt_pk_bf16(s1[8 * q + 6], s1[8 * q + 7]); }
                pf[s] = *reinterpret_cast<bf16x8*>(&wv); }
            const LAS unsigned char* vb = lds + AT_V0 + buf * 16384;
#pragma unroll
            for (int s = 0; s < 4; ++s) {
#pragma unroll
                for (int db = 0; db < 4; ++db) { const bf16x8 vf = *(const LAS bf16x8*)(vb + vaddr[s] + db * 4096); o[db] = __builtin_amdgcn_mfma_f32_32x32x16_bf16(vf, pf[s], o[db], 0, 0, 0); }
                __builtin_amdgcn_sched_barrier(0);
            }
        }
        asm volatile("s_waitcnt vmcnt(0)" ::: "memory");
        __syncthreads();
    }
#undef AT_DMA
}
__device__ __forceinline__ void attn_init(f32x16 (&o)[4], float& m, float& l) {
#pragma unroll
    for (int db = 0; db < 4; ++db)
#pragma unroll
        for (int i = 0; i < 16; ++i) o[db][i] = 0.f;
    m = -1e30f; l = 0.f;
}
__device__ __forceinline__ void load_q(const bf16_t* qrow, int hi, bf16x8 (&qf)[8]) {
#pragma unroll
    for (int ks = 0; ks < 8; ++ks) qf[ks] = *(const bf16x8*)(qrow + 16 * ks + 8 * hi);
}
__device__ __forceinline__ void store_o(const f32x16 (&o)[4], float sc, bf16_t* orow, int hi) {
#pragma unroll
    for (int db = 0; db < 4; ++db)
#pragma unroll
        for (int g = 0; g < 4; ++g) { u32x2 w; w.x = cvt_pk_bf16(o[db][4 * g] * sc, o[db][4 * g + 1] * sc); w.y = cvt_pk_bf16(o[db][4 * g + 2] * sc, o[db][4 * g + 3] * sc);
            *(u32x2*)(orow + 32 * db + 8 * g + 4 * hi) = w; }
}

__device__ __forceinline__ void phase_memattn(const Params& p, LAS unsigned char* lds, int bid, int nb) {
    const int tid = threadIdx.x, lane = tid & 63, w = tid >> 6, c = lane & 31, hi = lane >> 5;
    for (int u = bid; u < BATCH * MH * 32; u += nb) {
        const int b = u >> 7, mh = (u >> 5) & 3, qb = u & 31;
        const int tok = b * SEQ + qb * 256 + 32 * w + c;
        bf16x8 qf[8]; load_q(WSP(bf16_t, WS_PMQ) + (size_t)tok * MEMW + mh * HD, hi, qf);
        f32x16 o[4]; float m, l; attn_init(o, m, l);
        AttnBias B{0.f, 0, nullptr, 0, 0};
        attn_tiles<0>(lds, WSP(bf16_t, WS_MEMK) + (size_t)b * MEMT * MEMW + mh * HD, MEMW, WSP(bf16_t, WS_MEMVT) + (size_t)mh * HD * 512 + b * MEMT, 512, 4, 4, qf, o, m, l, B);
        store_o(o, 1.0f / l, WSP(bf16_t, WS_MIX) + (size_t)tok * OUT_IN + DM + mh * HD, hi);
    }
}

__device__ __forceinline__ void phase_fox_logf(const Params& p, int layer, int bid, int nb) {
    const int tid = threadIdx.x, lane = tid & 63, w = tid >> 6;
    const float* xin = (layer == 0) ? p.in[I_X] : WSP(float, WS_XF);
    const float* wf = p.in[I_FOX_W] + (size_t)(layer / 3) * DM * FOX_IN + 3072;
    const float* bf = p.in[I_FOX_BF] + (layer / 3) * NH;
    float wr[16][8];
#pragma unroll
    for (int j = 0; j < 4; ++j)
#pragma unroll
        for (int q = 0; q < 4; ++q) { const int k = 256 * j + 4 * lane + q;
#pragma unroll
            for (int h = 0; h < 8; ++h) wr[4 * j + q][h] = wf[(size_t)k * FOX_IN + h]; }
    for (int tok = bid * NWAVES + w; tok < T; tok += nb * NWAVES) {
        float acc[8];
#pragma unroll
        for (int h = 0; h < 8; ++h) acc[h] = 0.f;
#pragma unroll
        for (int j = 0; j < 4; ++j) { const f32x4 xv = *(const f32x4*)(xin + (size_t)tok * DM + 256 * j + 4 * lane);
#pragma unroll
            for (int q = 0; q < 4; ++q)
#pragma unroll
                for (int h = 0; h < 8; ++h) acc[h] = fmaf(xv[q], wr[4 * j + q][h], acc[h]); }
#pragma unroll
        for (int h = 0; h < 8; ++h) acc[h] = wave_sum(acc[h]);
        if (lane < 8) { float z = 0.f;
#pragma unroll
            for (int h = 0; h < 8; ++h) z = (lane == h) ? acc[h] : z;
            const int b = tok / SEQ, s = tok % SEQ;
            WSP(float, WS_LOGF)[((size_t)b * NH + lane) * SEQ + s] = logsigmoidf_(z + bf[lane]) * LOG2E; }
    }
}
__device__ __forceinline__ void phase_fox_attn(const Params& p, LAS unsigned char* lds, int bid, int nb) {
    const int tid = threadIdx.x, lane = tid & 63, w = tid >> 6, c = lane & 31, hi = lane >> 5;
    LAS float* c2 = (LAS float*)(lds + AT_AUX);
    LAS float* wtot = (LAS float*)(lds + AT_AUX + 32768);
    for (int item = bid; item < 256; item += nb) {
        const int bh = item >> 4, pr = item & 15, b = bh >> 3, h = bh & 7;
        for (int half = 0; half < 2; ++half) {
            const int qb = half == 0 ? 31 - pr : pr;
            const int n = (qb + 1) * 256;
            __syncthreads();
            {
                const float* src = WSP(float, WS_LOGF) + (size_t)bh * SEQ; const int i0 = tid * 16;
                float v[16]; float run = 0.f;
                if (i0 < n) {
#pragma unroll
                    for (int j = 0; j < 4; ++j) { const f32x4 x = *(const f32x4*)(src + i0 + 4 * j); v[4 * j] = x[0]; v[4 * j + 1] = x[1]; v[4 * j + 2] = x[2]; v[4 * j + 3] = x[3]; }
#pragma unroll
                    for (int j = 0; j < 16; ++j) { run += v[j]; v[j] = run; }
                }
                float inc = run;
#pragma unroll
                for (int o_ = 1; o_ < 64; o_ <<= 1) { const float y = __shfl_up(inc, o_); if (lane >= o_) inc += y; }
                if (lane == 63) wtot[w] = inc;
                __syncthreads();
                float base = inc - run;
                for (int q = 0; q < w; ++q) base += wtot[q];
                if (i0 < n) {
#pragma unroll
                    for (int j = 0; j < 16; ++j) c2[i0 + j] = v[j] + base; }
                __syncthreads();
            }
            const int qpos = qb * 256 + 32 * w + c, tok = b * SEQ + qpos;
            bf16x8 qf[8]; load_q(WSP(bf16_t, WS_PA) + (size_t)tok * DM + h * HD, hi, qf);
            f32x16 o[4]; float m, l; attn_init(o, m, l);
            AttnBias B{c2[qpos], qpos, c2, 0, qb * 256 + 32 * w};
            const int wave_nt = ((qb * 256 + 32 * w + 31) >> 6) + 1;
            attn_tiles<1>(lds, WSP(bf16_t, WS_PB) + (size_t)b * SEQ * DM + h * HD, DM, WSP(bf16_t, WS_PVT) + (size_t)h * HD * T + (size_t)b * SEQ, T, (qb + 1) * 4, wave_nt, qf, o, m, l, B);
            store_o(o, 1.0f / l, WSP(bf16_t, WS_MIX) + (size_t)tok * OUT_IN + h * HD, hi);
        }
    }
}

__device__ __forceinline__ int t5_bucket(int n) {
    if (n < 16) return n;
    const int v = 16 + (int)(__log2f((float)n * (1.0f / 16.0f)) * (16.0f / 3.0f));
    return v < 31 ? v : 31;
}
__device__ __forceinline__ void phase_moba_kmean(const Params& p, LAS unsigned char* lds, int bid, int nb) {
    const int tid = threadIdx.x; LAS float* red = (LAS float*)lds;
    const int dp = tid & 63, kg = tid >> 6;
    for (int u = bid; u < 512; u += nb) {
        const int bh = u >> 5, j = u & 31, b = bh >> 3, h = bh & 7;
        const bf16_t* kp = WSP(bf16_t, WS_PB) + ((size_t)b * SEQ + j * 256 + kg * 32) * DM + h * HD + 2 * dp;
        float s0 = 0.f, s1 = 0.f;
#pragma unroll 8
        for (int k = 0; k < 32; ++k) { const unsigned wv = *(const unsigned*)(kp + (size_t)k * DM); s0 += bflo(wv); s1 += bfhi(wv); }
        __syncthreads();
        red[kg * 128 + 2 * dp] = s0; red[kg * 128 + 2 * dp + 1] = s1;
        __syncthreads();
        if (tid < 128) { float s = 0.f;
#pragma unroll
            for (int g = 0; g < 8; ++g) s += red[g * 128 + tid];
            WSP(float, WS_KMEAN)[(size_t)u * 128 + tid] = s * (1.0f / 256.0f); }
    }
}
__device__ __forceinline__ void phase_moba_gate(const Params& p, LAS unsigned char* lds, int bid, int nb) {
    const int tid = threadIdx.x; LAS float* km = (LAS float*)lds;
    LAS int* lcnt = (LAS int*)(lds + 16384); LAS int* lbase = lcnt + 32;
    unsigned* gl = ctl(p) + CW_LCNT;
    for (int u = bid; u < 512; u += nb) {
        const int bh = u >> 5, own = u & 31, b = bh >> 3, h = bh & 7;
        __syncthreads();
        for (int i = tid; i < 32 * 128; i += NTHR) km[i] = WSP(float, WS_KMEAN)[(size_t)bh * 32 * 128 + i];
        if (tid < 32) lcnt[tid] = 0;
        __syncthreads();
        int sel[3] = {-1, -1, -1}, rank[3] = {0, 0, 0}; int nv = 0;
        const int q = own * 256 + (tid & 255);
        if (tid < 256) {
            const bf16_t* qp = WSP(bf16_t, WS_PA) + ((size_t)b * SEQ + q) * DM + h * HD;
            unsigned qw[64];
#pragma unroll
            for (int i = 0; i < 16; ++i) { const u32x4 x = *(const u32x4*)(qp + 8 * i); qw[4 * i] = x.x; qw[4 * i + 1] = x.y; qw[4 * i + 2] = x.z; qw[4 * i + 3] = x.w; }
            float best[3] = {-__builtin_inff(), -__builtin_inff(), -__builtin_inff()};
            for (int j = 0; j < own; ++j) { const LAS float* kr = km + j * 128; float g = 0.f;
#pragma unroll
                for (int i = 0; i < 64; ++i) { g = fmaf(bflo(qw[i]), kr[2 * i], g); g = fmaf(bfhi(qw[i]), kr[2 * i + 1], g); }
                if (g > best[0]) { best[2] = best[1]; sel[2] = sel[1]; best[1] = best[0]; sel[1] = sel[0]; best[0] = g; sel[0] = j; }
                else if (g > best[1]) { best[2] = best[1]; sel[2] = sel[1]; best[1] = g; sel[1] = j; }
                else if (g > best[2]) { best[2] = g; sel[2] = j; } }
            nv = own < 3 ? own : 3;
            for (int s = 0; s < 3; ++s) if (s < nv) rank[s] = atomicAdd((int*)&lcnt[sel[s]], 1);
            int* sp = WSP(int, WS_SEL) + (((size_t)b * SEQ + q) * NH + h) * 4; sp[0] = sel[0]; sp[1] = sel[1]; sp[2] = sel[2]; sp[3] = nv;
        }
        __syncthreads();
        if (tid < 32) lbase[tid] = lcnt[tid] ? (int)atomicAdd(gl + bh * 32 + tid, (unsigned)lcnt[tid]) : 0;
        __syncthreads();
        if (tid < 256) for (int s = 0; s < 3; ++s) if (s < nv) WSP(unsigned, WS_LISTS)[((size_t)bh * 32 + sel[s]) * 8192 + lbase[sel[s]] + rank[s]] = (unsigned)q | ((unsigned)s << 16);
    }
}
__device__ __forceinline__ void moba_bias_tab(const Params& p, LAS float* tab, int h) {
    const int tid = threadIdx.x;
    if (tid <= 128) tab[tid] = p.in[I_RELB][t5_bucket(tid) * NH + h] * LOG2E;
}
__device__ __forceinline__ void phase_moba_past(const Params& p, LAS unsigned char* lds, int bid, int nb) {
    const int tid = threadIdx.x, lane = tid & 63, w = tid >> 6, c = lane & 31, hi = lane >> 5;
    LAS float* tab = (LAS float*)(lds + AT_AUX); LAS int* pre = (LAS int*)(lds + AT_AUX + 1024);
    LAS int* wsum = (LAS int*)(lds + AT_AUX + 1024 + 4096);
    const unsigned* gl = ctl(p) + CW_LCNT;
    {
        const int n = (int)__hip_atomic_load(gl + tid, __ATOMIC_RELAXED, __HIP_MEMORY_SCOPE_AGENT); const int nu = (n + 255) >> 8;
        int inc = nu;
#pragma unroll
        for (int o_ = 1; o_ < 64; o_ <<= 1) { const int y = __shfl_up(inc, o_); if (lane >= o_) inc += y; }
        if (lane == 63) wsum[w] = inc;
        __syncthreads();
        int base = inc - nu; for (int q = 0; q < w; ++q) base += wsum[q];
        pre[tid] = base; if (tid == 511) pre[512] = base + nu;
        __syncthreads();
    }
    const int total = pre[512];
    int cur_h = -1;
    for (int u = bid; u < total; u += nb) {
        int lo = 0, hiL = 511;
        while (lo < hiL) { const int mid = (lo + hiL + 1) >> 1; if (pre[mid] <= u) lo = mid; else hiL = mid - 1; }
        const int list = lo, chunk = u - pre[list], bh = list >> 5, j = list & 31, b = bh >> 3, h = bh & 7;
        const int n = (int)__hip_atomic_load(gl + list, __ATOMIC_RELAXED, __HIP_MEMORY_SCOPE_AGENT);
        if (h != cur_h) { __syncthreads(); moba_bias_tab(p, tab, h); cur_h = h; __syncthreads(); }
        const int e0 = chunk * 256 + 32 * w; const bool active = e0 < n;
        int ei = e0 + c; if (ei > n - 1) ei = n - 1;
        const unsigned ent = WSP(unsigned, WS_LISTS)[(size_t)list * 8192 + ei]; const int q = ent & 0xffff, slot = ent >> 16;
        const int tok = b * SEQ + q;
        bf16x8 qf[8]; load_q(WSP(bf16_t, WS_PA) + (size_t)tok * DM + h * HD, hi, qf);
        int qmin = q;
#pragma unroll
        for (int o_ = 1; o_ < 64; o_ <<= 1) { const int y = __shfl_xor(qmin, o_); qmin = y < qmin ? y : qmin; }
        f32x16 o[4]; float m, l; attn_init(o, m, l);
        AttnBias B{0.f, q, tab, j * 256, qmin};
        attn_tiles<2>(lds, WSP(bf16_t, WS_PB) + ((size_t)b * SEQ + j * 256) * DM + h * HD, DM, WSP(bf16_t, WS_PVT) + (size_t)h * HD * T + (size_t)b * SEQ + j * 256, T, 4, active ? 4 : 0, qf, o, m, l, B);
        if (active) { const size_t P = ((size_t)tok * NH + h) * 3 + slot;
            store_o(o, 1.0f / l, WSP(bf16_t, WS_PARTO) + P * HD, hi);
            if (hi == 0) WSP(float, WS_PARTL)[P] = m + __log2f(l); }
    }
}
__device__ __forceinline__ void phase_moba_own(const Params& p, LAS unsigned char* lds, int bid, int nb) {
    const int tid = threadIdx.x, lane = tid & 63, w = tid >> 6, c = lane & 31, hi = lane >> 5;
    LAS float* tab = (LAS float*)(lds + AT_AUX);
    int cur_h = -1;
    for (int u = bid; u < 512; u += nb) {
        const int bh = u >> 5, blk = u & 31, b = bh >> 3, h = bh & 7;
        if (h != cur_h) { __syncthreads(); moba_bias_tab(p, tab, h); cur_h = h; __syncthreads(); }
        const int qrel = 32 * w + c, q = blk * 256 + qrel, tok = b * SEQ + q;
        bf16x8 qf[8]; load_q(WSP(bf16_t, WS_PA) + (size_t)tok * DM + h * HD, hi, qf);
        f32x16 o[4]; float m, l; attn_init(o, m, l);
        AttnBias B{0.f, qrel, tab, 0, 32 * w};
        attn_tiles<3>(lds, WSP(bf16_t, WS_PB) + ((size_t)b * SEQ + blk * 256) * DM + h * HD, DM, WSP(bf16_t, WS_PVT) + (size_t)h * HD * T + (size_t)b * SEQ + blk * 256, T, 4, (w >> 1) + 1, qf, o, m, l, B);
        const int* sp = WSP(int, WS_SEL) + ((size_t)tok * NH + h) * 4; const int nv = sp[3];
        const size_t P = ((size_t)tok * NH + h) * 3;
        float lse[3], M = m;
#pragma unroll
        for (int s = 0; s < 3; ++s) { lse[s] = (s < nv) ? WSP(float, WS_PARTL)[P + s] : -__builtin_inff(); M = fmaxf(M, lse[s]); }
        const float wo = fast_exp2(m - M); float den = l * wo;
#pragma unroll
        for (int db = 0; db < 4; ++db)
#pragma unroll
            for (int i = 0; i < 16; ++i) o[db][i] *= wo;
#pragma unroll
        for (int s = 0; s < 3; ++s) { if (s < nv) { const float ws_ = fast_exp2(lse[s] - M); den += ws_; const bf16_t* po = WSP(bf16_t, WS_PARTO) + (P + s) * HD;
#pragma unroll
                for (int db = 0; db < 4; ++db)
#pragma unroll
                    for (int g = 0; g < 4; ++g) { const u32x2 x = *(const u32x2*)(po + 32 * db + 8 * g + 4 * hi);
                        o[db][4 * g] += ws_ * bflo(x.x); o[db][4 * g + 1] += ws_ * bfhi(x.x); o[db][4 * g + 2] += ws_ * bflo(x.y); o[db][4 * g + 3] += ws_ * bfhi(x.y); } } }
        store_o(o, 1.0f / den, WSP(bf16_t, WS_MIX) + (size_t)tok * OUT_IN + h * HD, hi);
    }
}

__device__ __forceinline__ void phase_hgrn_pre(const Params& p, int layer, int bid, int nb) {
    const int jj = layer / 3;
    const float* lbp = p.in[I_HGRN_LB];
    for (int gid = bid * NTHR + threadIdx.x; gid < 256 * 512; gid += nb * NTHR) {
        const int crow = gid >> 9, cp = gid & 511, ch = 2 * cp;
        const int b = crow >> 7, cc = crow & 127; const size_t tok0 = (size_t)b * SEQ + cc * 64;
        float lb[2];
#pragma unroll
        for (int e = 0; e < 2; ++e) lb[e] = (jj == 0) ? 0.f : sigmoidf_(lbp[DM + ch + e] - lbp[ch + e]);
        const float* zp = WSP(float, WS_PZ) + tok0 * DM + ch;
        float bmid[2] = {0.f, 0.f}, run[2] = {0.f, 0.f};
        for (int t = 0; t < 64; ++t) { const f32x2 z = *(const f32x2*)(zp + (size_t)t * DM);
#pragma unroll
            for (int e = 0; e < 2; ++e) { const float ls = logsigmoidf_(z[e]); const float lf = (lb[e] == 0.f) ? ls : __logf(lb[e] + (1.f - lb[e]) * __expf(ls)); run[e] += lf; }
            if (t == 31) { bmid[0] = run[0]; bmid[1] = run[1]; } }
        const float blast[2] = {run[0], run[1]};
        run[0] = 0.f; run[1] = 0.f;
        const unsigned* qp = (const unsigned*)(WSP(bf16_t, WS_PA) + tok0 * DM + ch);
        unsigned* qb = (unsigned*)(WSP(bf16_t, WS_HQB) + tok0 * DM + ch); unsigned* qr = (unsigned*)(WSP(bf16_t, WS_HQR) + tok0 * DM + ch); unsigned* kr = (unsigned*)(WSP(bf16_t, WS_HKR) + tok0 * DM + ch);
        bf16_t* kd0 = WSP(bf16_t, WS_HKDT) + (size_t)ch * T + tok0; bf16_t* kd1 = kd0 + T;
        float kdv[2][8];
        for (int t8 = 0; t8 < 8; ++t8) {
#pragma unroll
            for (int tt = 0; tt < 8; ++tt) { const int t = t8 * 8 + tt; const f32x2 z = *(const f32x2*)(zp + (size_t)t * DM); const unsigned qw = qp[(size_t)t * (DM / 2)];
                float o_qb[2], o_qr[2], o_kr[2];
#pragma unroll
                for (int e = 0; e < 2; ++e) { const float ls = logsigmoidf_(z[e]); const float lf = (lb[e] == 0.f) ? ls : __logf(lb[e] + (1.f - lb[e]) * __expf(ls)); run[e] += lf;
                    const float kk = (1.f - lb[e]) * sigmoidf_(-z[e]); const float qv = e ? bfhi(qw) : bflo(qw);
                    o_qb[e] = qv * __expf(run[e]); o_qr[e] = qv * __expf(fminf(run[e] - bmid[e], 80.f)); o_kr[e] = kk * __expf(fminf(bmid[e] - run[e], 80.f)); kdv[e][tt] = kk * __expf(blast[e] - run[e]); }
                qb[(size_t)t * (DM / 2)] = cvt_pk_bf16(o_qb[0], o_qb[1]); qr[(size_t)t * (DM / 2)] = cvt_pk_bf16(o_qr[0], o_qr[1]); kr[(size_t)t * (DM / 2)] = cvt_pk_bf16(o_kr[0], o_kr[1]); }
            u32x4 w0, w1;
            w0.x = cvt_pk_bf16(kdv[0][0], kdv[0][1]); w0.y = cvt_pk_bf16(kdv[0][2], kdv[0][3]); w0.z = cvt_pk_bf16(kdv[0][4], kdv[0][5]); w0.w = cvt_pk_bf16(kdv[0][6], kdv[0][7]);
            w1.x = cvt_pk_bf16(kdv[1][0], kdv[1][1]); w1.y = cvt_pk_bf16(kdv[1][2], kdv[1][3]); w1.z = cvt_pk_bf16(kdv[1][4], kdv[1][5]); w1.w = cvt_pk_bf16(kdv[1][6], kdv[1][7]);
            *(u32x4*)(kd0 + t8 * 8) = w0; *(u32x4*)(kd1 + t8 * 8) = w1; }
        const int hh = ch >> 7, d = ch & 127;
        float* gp = WSP(float, WS_HG) + ((size_t)(b * NH + hh) * 128 + cc) * 128 + d; gp[0] = __expf(blast[0]); gp[1] = __expf(blast[1]);
    }
}
__device__ __forceinline__ void phase_hgrn_a(const Params& p, int bid, int nb) {
    const int tid = threadIdx.x, lane = tid & 63, w = tid >> 6, c = lane & 31, hi = lane >> 5, eb = w >> 1, dh = w & 1;
    for (int u = bid; u < 2048; u += nb) {
        const int bh = u >> 7, cc = u & 127, b = bh >> 3, hh = bh & 7; const size_t tok0 = (size_t)b * SEQ + cc * 64;
        const bf16_t* vt = WSP(bf16_t, WS_PVT) + (size_t)(hh * HD + 32 * eb + c) * T + tok0 + 8 * hi;
        const bf16_t* kd = WSP(bf16_t, WS_HKDT) + (size_t)(hh * HD + 64 * dh + c) * T + tok0 + 8 * hi;
        f32x16 a0, a1;
#pragma unroll
        for (int i = 0; i < 16; ++i) { a0[i] = 0.f; a1[i] = 0.f; }
#pragma unroll
        for (int ks = 0; ks < 4; ++ks) { const bf16x8 af = *(const bf16x8*)(vt + 16 * ks), b0 = *(const bf16x8*)(kd + 16 * ks), b1 = *(const bf16x8*)(kd + (size_t)32 * T + 16 * ks);
            a0 = __builtin_amdgcn_mfma_f32_32x32x16_bf16(af, b0, a0, 0, 0, 0); a1 = __builtin_amdgcn_mfma_f32_32x32x16_bf16(af, b1, a1, 0, 0, 0); }
        float* st = WSP(float, WS_HST) + (size_t)u * 128 * 128;
#pragma unroll
        for (int i = 0; i < 16; ++i) { const int e = 32 * eb + (i & 3) + 8 * (i >> 2) + 4 * hi; st[(size_t)e * 128 + 64 * dh + c] = a0[i]; st[(size_t)e * 128 + 64 * dh + 32 + c] = a1[i]; }
    }
}
__device__ __forceinline__ void phase_hgrn_b(const Params& p, int bid, int nb) {
    for (int gid = bid * NTHR + threadIdx.x; gid < 16 * 128 * 64; gid += nb * NTHR) {
        const int bh = gid >> 13, e = (gid >> 6) & 127, dp = gid & 63;
        float* st = WSP(float, WS_HST) + (size_t)bh * 128 * 16384 + (size_t)e * 128 + 2 * dp; const float* gp = WSP(float, WS_HG) + (size_t)bh * 128 * 128 + 2 * dp;
        f32x2 S = {0.f, 0.f};
#pragma unroll 4
        for (int cc = 0; cc < 128; ++cc) { const f32x2 U = *(const f32x2*)(st + (size_t)cc * 16384), g = *(const f32x2*)(gp + cc * 128);
            *(f32x2*)(st + (size_t)cc * 16384) = S; S = g * S + U; }
    }
}
__device__ __forceinline__ void phase_hgrn_c(const Params& p, int layer, int bid, int nb) {
    const int tid = threadIdx.x, lane = tid & 63, w = tid >> 6, c = lane & 31, hi = lane >> 5;
    const float* ng = p.in[I_HGRN_NG] + (layer / 3) * DM;
    for (int wu = bid * NWAVES + w; wu < 4096; wu += nb * NWAVES) {
        const int u = wu >> 1, tb = wu & 1, bh = u >> 7, cc = u & 127, b = bh >> 3, hh = bh & 7; const size_t tok0 = (size_t)b * SEQ + cc * 64;
        const size_t tokq = tok0 + 32 * tb + c;
        f32x16 o[4];
#pragma unroll
        for (int db = 0; db < 4; ++db)
#pragma unroll
            for (int i = 0; i < 16; ++i) o[db][i] = 0.f;
        {
            bf16x8 qf[8]; load_q(WSP(bf16_t, WS_HQB) + tokq * DM + hh * HD, hi, qf);
            const float* st = WSP(float, WS_HST) + (size_t)u * 16384 + (size_t)c * 128 + 8 * hi;
#pragma unroll
            for (int db = 0; db < 4; ++db)
#pragma unroll
                for (int ks = 0; ks < 8; ++ks) { const float* sp = st + (size_t)(32 * db) * 128 + 16 * ks; const f32x4 x0 = *(const f32x4*)sp, x1 = *(const f32x4*)(sp + 4);
                    u32x4 wv; wv.x = cvt_pk_bf16(x0[0], x0[1]); wv.y = cvt_pk_bf16(x0[2], x0[3]); wv.z = cvt_pk_bf16(x1[0], x1[1]); wv.w = cvt_pk_bf16(x1[2], x1[3]);
                    o[db] = __builtin_amdgcn_mfma_f32_32x32x16_bf16(*reinterpret_cast<bf16x8*>(&wv), qf[ks], o[db], 0, 0, 0); }
        }
        {
            bf16x8 qf[8]; load_q(WSP(bf16_t, WS_HQR) + tokq * DM + hh * HD, hi, qf);
            for (int kb = 0; kb <= tb; ++kb) {
                f32x16 s;
#pragma unroll
                for (int i = 0; i < 16; ++i) s[i] = 0.f;
                const bf16_t* kp = WSP(bf16_t, WS_HKR) + (tok0 + 32 * kb + c) * DM + hh * HD + 8 * hi;
#pragma unroll
                for (int ks = 0; ks < 8; ++ks) s = __builtin_amdgcn_mfma_f32_32x32x16_bf16(*(const bf16x8*)(kp + 16 * ks), qf[ks], s, 0, 0, 0);
                if (kb == tb) {
#pragma unroll
                    for (int i = 0; i < 16; ++i) { const int ko = (i & 3) + 8 * (i >> 2) + 4 * hi; if (ko > c) s[i] = 0.f; } }
#pragma unroll
                for (int sq = 0; sq < 2; ++sq) { u32x4 wv; wv.x = cvt_pk_bf16(s[8 * sq], s[8 * sq + 1]); wv.y = cvt_pk_bf16(s[8 * sq + 2], s[8 * sq + 3]); wv.z = cvt_pk_bf16(s[8 * sq + 4], s[8 * sq + 5]); wv.w = cvt_pk_bf16(s[8 * sq + 6], s[8 * sq + 7]);
                    const bf16x8 pf = *reinterpret_cast<bf16x8*>(&wv);
                    const bf16_t* vp = WSP(bf16_t, WS_PVT) + (size_t)(hh * HD + c) * T + tok0 + 32 * kb + 16 * sq + 4 * hi;
#pragma unroll
                    for (int db = 0; db < 4; ++db) { const u32x2 lo = *(const u32x2*)(vp + (size_t)(32 * db) * T), hi2 = *(const u32x2*)(vp + (size_t)(32 * db) * T + 8);
                        u32x4 vv; vv.x = lo.x; vv.y = lo.y; vv.z = hi2.x; vv.w = hi2.y;
                        o[db] = __builtin_amdgcn_mfma_f32_32x32x16_bf16(*reinterpret_cast<bf16x8*>(&vv), pf, o[db], 0, 0, 0); } }
            }
        }
        float ss = 0.f;
#pragma unroll
        for (int db = 0; db < 4; ++db)
#pragma unroll
            for (int i = 0; i < 16; ++i) ss += o[db][i] * o[db][i];
        ss = swap_sum(ss);
        const float rinv = rsqrtf(ss * (1.0f / 128.0f) + RMS_EPS);
        const bf16_t* gt = WSP(bf16_t, WS_PB) + tokq * DM + hh * HD; bf16_t* orow = WSP(bf16_t, WS_MIX) + tokq * OUT_IN + hh * HD;
#pragma unroll
        for (int db = 0; db < 4; ++db)
#pragma unroll
            for (int g = 0; g < 4; ++g) { const int d = 32 * db + 8 * g + 4 * hi; const u32x2 gw = *(const u32x2*)(gt + d); const f32x4 nv = *(const f32x4*)(ng + hh * HD + d);
                u32x2 wv; wv.x = cvt_pk_bf16(o[db][4 * g] * rinv * nv[0] * bflo(gw.x), o[db][4 * g + 1] * rinv * nv[1] * bfhi(gw.x));
                wv.y = cvt_pk_bf16(o[db][4 * g + 2] * rinv * nv[2] * bflo(gw.y), o[db][4 * g + 3] * rinv * nv[3] * bfhi(gw.y));
                *(u32x2*)(orow + d) = wv; }
    }
}

__device__ __forceinline__ void ln_row(f32x4 (&v)[4], const float* g, const float* bta, int lane) {
    float s = 0.f;
#pragma unroll
    for (int j = 0; j < 4; ++j) s += (v[j][0] + v[j][1]) + (v[j][2] + v[j][3]);
    const float mean = wave_sum(s) * (1.0f / DM); float s2 = 0.f;
#pragma unroll
    for (int j = 0; j < 4; ++j) { v[j] = v[j] - mean; s2 += (v[j][0] * v[j][0] + v[j][1] * v[j][1]) + (v[j][2] * v[j][2] + v[j][3] * v[j][3]); }
    const float rstd = rsqrtf(wave_sum(s2) * (1.0f / DM) + LN_EPS);
#pragma unroll
    for (int j = 0; j < 4; ++j) { const f32x4 gg = *(const f32x4*)(g + 256 * j + 4 * lane), bb = *(const f32x4*)(bta + 256 * j + 4 * lane); v[j] = v[j] * rstd * gg + bb; }
}
__device__ __forceinline__ void phase_ln1_router(const Params& p, LAS unsigned char* lds, int layer, int bid, int nb) {
    const int tid = threadIdx.x, lane = tid & 63, w = tid >> 6;
    LAS float* part = (LAS float*)lds;
    LAS float* logit = (LAS float*)(lds + 32768);
    LAS int* asg_e = (LAS int*)(lds + 32768 + 8448 + 64); LAS unsigned* asg_v = (LAS unsigned*)(asg_e + 256);
    const float* g1 = p.in[I_LN1G] + layer * DM; const float* b1 = p.in[I_LN1B] + layer * DM;
    const float* rw = p.in[I_RW] + (size_t)layer * DM * NEXP; const float* rb = p.in[I_RB] + layer * NEXP;
    unsigned* ecnt = ctl(p) + CW_ECNT + layer * 32;
    for (int blk = bid; blk < T / 64; blk += nb) {
        const int row0 = blk * 64;
        for (int rr = 0; rr < 8; ++rr) { const size_t row = row0 + 8 * w + rr; const float* yp = WSP(float, WS_Y1) + row * DM;
            f32x4 v[4];
#pragma unroll
            for (int j = 0; j < 4; ++j) v[j] = *(const f32x4*)(yp + 256 * j + 4 * lane);
            ln_row(v, g1, b1, lane);
#pragma unroll
            for (int j = 0; j < 4; ++j) { *(f32x4*)(WSP(float, WS_X1F) + row * DM + 256 * j + 4 * lane) = v[j];
                u32x2 o; o.x = cvt_pk_bf16(v[j][0], v[j][1]); o.y = cvt_pk_bf16(v[j][2], v[j][3]); *(u32x2*)(WSP(bf16_t, WS_X1B) + row * DM + 256 * j + 4 * lane) = o; } }
        __syncthreads();
        {
            const int rt = w >> 2, kq = w & 3, i = lane & 31, kh = lane >> 5;
            const float* xp = WSP(float, WS_X1F) + (size_t)(row0 + 32 * rt + i) * DM + 256 * kq; const float* wp = rw + (size_t)(256 * kq + kh) * NEXP + i;
            f32x16 acc;
#pragma unroll
            for (int q = 0; q < 16; ++q) acc[q] = 0.f;
#pragma unroll 8
            for (int q = 0; q < 64; ++q) { const f32x4 xv = *(const f32x4*)(xp + 4 * q);
                acc = __builtin_amdgcn_mfma_f32_32x32x2f32(kh ? xv[1] : xv[0], wp[(size_t)(4 * q) * NEXP], acc, 0, 0, 0);
                acc = __builtin_amdgcn_mfma_f32_32x32x2f32(kh ? xv[3] : xv[2], wp[(size_t)(4 * q + 2) * NEXP], acc, 0, 0, 0); }
#pragma unroll
            for (int q = 0; q < 16; ++q) { const int r = (q & 3) + 8 * (q >> 2) + 4 * kh; part[(w * 32 + r) * 32 + i] = acc[q]; }
        }
        __syncthreads();
        for (int o_ = tid; o_ < 64 * 32; o_ += NTHR) { const int r = o_ >> 5, e = o_ & 31, rt = r >> 5, rl = r & 31; float s = rb[e];
#pragma unroll
            for (int kq = 0; kq < 4; ++kq) s += part[((rt * 4 + kq) * 32 + rl) * 32 + e];
            logit[r * 33 + e] = s; }
        __syncthreads();
        if (tid < 64) { const int tok = row0 + tid; float bv[4] = {-__builtin_inff(), -__builtin_inff(), -__builtin_inff(), -__builtin_inff()}; int bi[4] = {0, 0, 0, 0};
            for (int e = 0; e < 32; ++e) { const float x = logit[tid * 33 + e];
                if (x > bv[0]) { bv[3] = bv[2]; bi[3] = bi[2]; bv[2] = bv[1]; bi[2] = bi[1]; bv[1] = bv[0]; bi[1] = bi[0]; bv[0] = x; bi[0] = e; }
                else if (x > bv[1]) { bv[3] = bv[2]; bi[3] = bi[2]; bv[2] = bv[1]; bi[2] = bi[1]; bv[1] = x; bi[1] = e; }
                else if (x > bv[2]) { bv[3] = bv[2]; bi[3] = bi[2]; bv[2] = x; bi[2] = e; }
                else if (x > bv[3]) { bv[3] = x; bi[3] = e; } }
            float ex[4], se = 0.f;
#pragma unroll
            for (int k = 0; k < 4; ++k) { ex[k] = __expf(bv[k] - bv[0]); se += ex[k]; }
#pragma unroll
            for (int k = 0; k < 4; ++k) { WSP(float, WS_GATE)[(size_t)tok * 4 + k] = ex[k] / se; asg_e[tid * 4 + k] = bi[k]; asg_v[tid * 4 + k] = (unsigned)tok * 4u + k; } }
        __syncthreads();
        if (tid < 32) { int cnt = 0;
            for (int a = 0; a < 256; ++a) cnt += (asg_e[a] == tid) ? 1 : 0;
            if (cnt) { unsigned pos = atomicAdd(ecnt + tid, (unsigned)cnt); unsigned* et = WSP(unsigned, WS_ETOK) + (size_t)tid * T;
                for (int a = 0; a < 256; ++a) if (asg_e[a] == tid) et[pos++] = asg_v[a]; } }
        __syncthreads();
    }
}
__device__ __forceinline__ void phase_ln2(const Params& p, int layer, int bid, int nb) {
    const int tid = threadIdx.x, lane = tid & 63, w = tid >> 6;
    const float* g2 = p.in[I_LN2G] + layer * DM; const float* b2 = p.in[I_LN2B] + layer * DM;
    float* dst = (layer == 3) ? p.out : WSP(float, WS_XF);
    for (size_t row = bid * NWAVES + w; row < T; row += (size_t)nb * NWAVES) {
        const float* xp = WSP(float, WS_X1F) + row * DM; const bf16_t* yp = WSP(bf16_t, WS_YE) + row * 4 * DM;
        float gk[4];
#pragma unroll
        for (int k = 0; k < 4; ++k) gk[k] = WSP(float, WS_GATE)[row * 4 + k];
        f32x4 v[4];
#pragma unroll
        for (int j = 0; j < 4; ++j) { v[j] = *(const f32x4*)(xp + 256 * j + 4 * lane) * DN_ALPHA;
#pragma unroll
            for (int k = 0; k < 4; ++k) { const u32x2 y = *(const u32x2*)(yp + (size_t)k * DM + 256 * j + 4 * lane);
                v[j][0] += gk[k] * bflo(y.x); v[j][1] += gk[k] * bfhi(y.x); v[j][2] += gk[k] * bflo(y.y); v[j][3] += gk[k] * bfhi(y.y); } }
        ln_row(v, g2, b2, lane);
#pragma unroll
        for (int j = 0; j < 4; ++j) { *(f32x4*)(dst + row * DM + 256 * j + 4 * lane) = v[j];
            u32x2 o; o.x = cvt_pk_bf16(v[j][0], v[j][1]); o.y = cvt_pk_bf16(v[j][2], v[j][3]); *(u32x2*)(WSP(bf16_t, WS_XB) + row * DM + 256 * j + 4 * lane) = o; }
    }
}

enum { PH_PROLOGUE = 0, PH_PROJ, PH_FOXLOGF, PH_HPRE, PH_HA, PH_HB, PH_HC, PH_FOXATTN, PH_KMEAN, PH_GATE, PH_PAST, PH_OWN, PH_MEMATTN, PH_OUTPROJ, PH_LN1, PH_UP, PH_DOWN, PH_LN2 };
template <int PH>
__device__ __forceinline__ void run_phase(const Params& p, LAS unsigned char* lds, int layer, int bid, int nb) {
    if constexpr (PH == PH_PROLOGUE) phase_prologue(p, lds, bid, nb);
    else if constexpr (PH == PH_PROJ) phase_proj(p, lds, layer, bid, nb);
    else if constexpr (PH == PH_FOXLOGF) phase_fox_logf(p, layer, bid, nb);
    else if constexpr (PH == PH_HPRE) phase_hgrn_pre(p, layer, bid, nb);
    else if constexpr (PH == PH_HA) phase_hgrn_a(p, bid, nb);
    else if constexpr (PH == PH_HB) phase_hgrn_b(p, bid, nb);
    else if constexpr (PH == PH_HC) phase_hgrn_c(p, layer, bid, nb);
    else if constexpr (PH == PH_FOXATTN) phase_fox_attn(p, lds, bid, nb);
    else if constexpr (PH == PH_KMEAN) phase_moba_kmean(p, lds, bid, nb);
    else if constexpr (PH == PH_GATE) phase_moba_gate(p, lds, bid, nb);
    else if constexpr (PH == PH_PAST) phase_moba_past(p, lds, bid, nb);
    else if constexpr (PH == PH_OWN) phase_moba_own(p, lds, bid, nb);
    else if constexpr (PH == PH_MEMATTN) phase_memattn(p, lds, bid, nb);
    else if constexpr (PH == PH_OUTPROJ) phase_outproj(p, lds, layer, bid, nb);
    else if constexpr (PH == PH_LN1) phase_ln1_router(p, lds, layer, bid, nb);
    else if constexpr (PH == PH_UP) phase_moe_up(p, lds, layer, bid, nb);
    else if constexpr (PH == PH_DOWN) phase_moe_down(p, lds, layer, bid, nb);
    else if constexpr (PH == PH_LN2) phase_ln2(p, layer, bid, nb);
}
template <int PH>
__global__ void __launch_bounds__(NTHR, 2) k_phase(Params p, int layer) {
    extern __shared__ __attribute__((aligned(16))) unsigned char lds_raw[];
    run_phase<PH>(p, (LAS unsigned char*)lds_raw, layer, (int)blockIdx.x, (int)gridDim.x);
}

#ifndef DEBUG_CHECKS
#define DEBUG_CHECKS 0
#endif
#if DEBUG_CHECKS
constexpr size_t WS_CHK = WS_END;
__device__ __forceinline__ float bfr(float x) { return bf2f(f2bf(x)); }
__device__ __forceinline__ unsigned hashu(unsigned x) { x ^= x >> 16; x *= 0x7feb352du; x ^= x >> 15; x *= 0x846ca68bu; x ^= x >> 16; return x; }
__device__ __forceinline__ void chk_report(const Params& p, int id, float err) { if (!(err == err)) err = 1e30f; atomicMax(ctl(p) + CW_CHK + id, __float_as_uint(fabsf(err))); }
__device__ __forceinline__ float blk_sum(float v, LAS float* red) {
    v = wave_sum(v); const int w = threadIdx.x >> 6, nw = blockDim.x >> 6; __syncthreads(); if ((threadIdx.x & 63) == 0) red[w] = v; __syncthreads(); float s = 0.f; for (int i = 0; i < nw; ++i) s += red[i]; return s; }
__device__ __forceinline__ float blk_max(float v, LAS float* red) {
#pragma unroll
    for (int o = 1; o < 64; o <<= 1) v = fmaxf(v, __shfl_xor(v, o));
    const int w = threadIdx.x >> 6, nw = blockDim.x >> 6; __syncthreads(); if ((threadIdx.x & 63) == 0) red[w] = v; __syncthreads(); float s = red[0]; for (int i = 1; i < nw; ++i) s = fmaxf(s, red[i]); return s; }

__global__ void chk_proj(Params p, int layer, int id) {
    const int kind = layer % 3, jj = layer / 3; const unsigned sidx = blockIdx.x * blockDim.x + threadIdx.x; const unsigned hsh = hashu(sidx * 2654435761u + layer * 977u + 12345u);
    const int nin = kind == 0 ? HGRN_IN : (kind == 1 ? FOX_IN : MOBA_IN);
    const float* W = kind == 0 ? p.in[I_HGRN_W] + (size_t)jj * DM * HGRN_IN : (kind == 1 ? p.in[I_FOX_W] : p.in[I_MOBA_W]);
    int tok = hsh % T; int col = (hsh >> 14) % (nin + 128);
    float exp_v, got;
    if (col >= nin) {
        const int c = (hashu(hsh) % 1024), row = tok % 512; const float* wk = p.in[I_WKV] + (size_t)layer * DM * 1024; float s = 0.f;
        for (int k = 0; k < DM; ++k) s += bfr(p.in[I_MEM][(size_t)row * DM + k]) * bfr(wk[(size_t)k * 1024 + c]);
        exp_v = s; got = c < 512 ? bf2f(WSP(bf16_t, WS_MEMK)[(size_t)row * 512 + c]) : bf2f(WSP(bf16_t, WS_MEMVT)[(size_t)(c - 512) * 512 + row]);
    } else {
        float s = 0.f, sf = 0.f;
        for (int k = 0; k < DM; ++k) { const float xv = (layer == 0) ? p.in[I_X][(size_t)tok * DM + k] : WSP(float, WS_XF)[(size_t)tok * DM + k]; const float xb = (layer == 0) ? bfr(xv) : bf2f(WSP(bf16_t, WS_XB)[(size_t)tok * DM + k]);
            const float wv = W[(size_t)k * nin + col]; s += xb * bfr(wv); sf += xv * wv; }
        const int sec = col >> 10, c = col & 1023; exp_v = s;
        if (kind == 0) { if (sec == 0) { exp_v = siluf_(s); got = bf2f(WSP(bf16_t, WS_PA)[(size_t)tok * DM + c]); } else if (sec == 1) got = WSP(float, WS_PZ)[(size_t)tok * DM + c];
            else if (sec == 2) got = bf2f(WSP(bf16_t, WS_PVT)[(size_t)c * T + tok]); else if (sec == 3) { exp_v = siluf_(s); got = bf2f(WSP(bf16_t, WS_PB)[(size_t)tok * DM + c]); } else got = bf2f(WSP(bf16_t, WS_PMQ)[(size_t)tok * MEMW + c]); }
        else { if (sec == 0) got = bf2f(WSP(bf16_t, WS_PA)[(size_t)tok * DM + c]); else if (sec == 1) got = bf2f(WSP(bf16_t, WS_PB)[(size_t)tok * DM + c]); else if (sec == 2) got = bf2f(WSP(bf16_t, WS_PVT)[(size_t)c * T + tok]);
            else if (kind == 1 && col < 3080) { exp_v = logsigmoidf_(sf + p.in[I_FOX_BF][jj * NH + (col - 3072)]) * LOG2E; got = WSP(float, WS_LOGF)[((size_t)(tok / SEQ) * NH + (col - 3072)) * SEQ + tok % SEQ]; }
            else got = bf2f(WSP(bf16_t, WS_PMQ)[(size_t)tok * MEMW + (col - (kind == 1 ? 3080 : 3072))]); }
    }
    chk_report(p, id, fabsf(got - exp_v) / (fabsf(exp_v) + 0.05f));
}
__global__ void chk_fox_prep(Params p) { const int bh = threadIdx.x; if (bh < 16) { float s = 0.f; for (int k = 0; k < SEQ; ++k) { s += WSP(float, WS_LOGF)[(size_t)bh * SEQ + k]; WSP(float, WS_CHK)[(size_t)bh * SEQ + k] = s; } } }
__device__ __forceinline__ float chk_softmax_out(const Params& p, LAS float* sc, const LAS int* kp, int n, int b, int h, int tok, LAS float* red) {
    float mx = -1e30f; for (int i = threadIdx.x; i < n; i += blockDim.x) mx = fmaxf(mx, sc[i]); mx = blk_max(mx, red);
    float sm = 0.f; for (int i = threadIdx.x; i < n; i += blockDim.x) { const float e = exp2f(sc[i] - mx); sc[i] = e; sm += e; } sm = blk_sum(sm, red);
    float err = 0.f, mag = 0.f;
    if (threadIdx.x < 128) { const int d = threadIdx.x; float o = 0.f; for (int i = 0; i < n; ++i) o += sc[i] * bf2f(WSP(bf16_t, WS_PVT)[(size_t)(h * HD + d) * T + (size_t)b * SEQ + (kp ? kp[i] : i)]);
        o /= sm; const float got = bf2f(WSP(bf16_t, WS_MIX)[(size_t)tok * OUT_IN + h * HD + d]); err = fabsf(got - o); mag = fabsf(o); }
    err = blk_max(err, red); mag = blk_max(mag, red); return err / (mag + 1e-3f);
}
__global__ void chk_fox(Params p, int id) {
    extern __shared__ __attribute__((aligned(16))) unsigned char sm_raw[]; LAS float* sc = (LAS float*)sm_raw; LAS float* red = sc + 8192;
    const unsigned hsh = hashu(blockIdx.x * 7919u + 17u); const int b = hsh & 1, h = (hsh >> 1) & 7; int q = (hsh >> 4) % SEQ; if (blockIdx.x < 8) q = blockIdx.x * 37; if (blockIdx.x == 8) q = SEQ - 1;
    const int tok = b * SEQ + q; const float* c2 = WSP(float, WS_CHK) + (size_t)(b * NH + h) * SEQ;
    for (int k = threadIdx.x; k <= q; k += blockDim.x) { float s = 0.f; for (int d = 0; d < HD; ++d) s += bf2f(WSP(bf16_t, WS_PA)[(size_t)tok * DM + h * HD + d]) * bf2f(WSP(bf16_t, WS_PB)[((size_t)b * SEQ + k) * DM + h * HD + d]);
        sc[k] = s * QK_SCALE * LOG2E + c2[q] - c2[k]; }
    __syncthreads();
    const float e = chk_softmax_out(p, sc, nullptr, q + 1, b, h, tok, red);
    if (threadIdx.x == 0) chk_report(p, id, e);
}
__global__ void chk_moba(Params p, int id) {
    extern __shared__ __attribute__((aligned(16))) unsigned char sm_raw[]; LAS float* sc = (LAS float*)sm_raw; LAS int* kp = (LAS int*)(sc + 1024); LAS float* km = (LAS float*)(kp + 1024); LAS float* red = km + 32 * 128; LAS float* gate = red + 16; LAS int* selb = (LAS int*)(gate + 32);
    const unsigned hsh = hashu(blockIdx.x * 7919u + 29u); const int b = hsh & 1, h = (hsh >> 1) & 7; int q = (hsh >> 4) % SEQ; if (blockIdx.x < 6) q = blockIdx.x * 173; if (blockIdx.x == 6) q = 256; if (blockIdx.x == 7) q = 1024 + 5;
    const int own = q >> 8, tok = b * SEQ + q;
    for (int idx = threadIdx.x; idx < own * 128; idx += blockDim.x) { const int j = idx >> 7, d = idx & 127; float s = 0.f; for (int k = 0; k < 256; ++k) s += bf2f(WSP(bf16_t, WS_PB)[((size_t)b * SEQ + j * 256 + k) * DM + h * HD + d]); km[idx] = s * (1.0f / 256.0f); }
    __syncthreads();
    if ((int)threadIdx.x < own) { float g = 0.f; for (int d = 0; d < HD; ++d) g += bf2f(WSP(bf16_t, WS_PA)[(size_t)tok * DM + h * HD + d]) * km[threadIdx.x * 128 + d]; gate[threadIdx.x] = g; }
    __syncthreads();
    if (threadIdx.x == 0) { int nsel = own < 3 ? own : 3; for (int s = 0; s < nsel; ++s) { int bj = -1; float bv = -__builtin_inff(); for (int j = 0; j < own; ++j) { bool used = false; for (int r = 0; r < s; ++r) used |= (selb[r] == j); if (!used && gate[j] > bv) { bv = gate[j]; bj = j; } } selb[s] = bj; }
        int n = 0; for (int s = 0; s < nsel; ++s) for (int k = 0; k < 256; ++k) kp[n++] = selb[s] * 256 + k; for (int k = own * 256; k <= q; ++k) kp[n++] = k; selb[3] = n; }
    __syncthreads();
    const int n = selb[3];
    for (int i = threadIdx.x; i < n; i += blockDim.x) { const int k = kp[i]; float s = 0.f; for (int d = 0; d < HD; ++d) s += bf2f(WSP(bf16_t, WS_PA)[(size_t)tok * DM + h * HD + d]) * bf2f(WSP(bf16_t, WS_PB)[((size_t)b * SEQ + k) * DM + h * HD + d]);
        sc[i] = (s * QK_SCALE + p.in[I_RELB][t5_bucket(q - k) * NH + h]) * LOG2E; }
    __syncthreads();
    const float e = chk_softmax_out(p, sc, kp, n, b, h, tok, red);
    if (threadIdx.x == 0) chk_report(p, id, e);
}
__global__ void chk_hgrn(Params p, int layer, int id) {
    extern __shared__ __attribute__((aligned(16))) unsigned char sm_raw[]; LAS float* a = (LAS float*)sm_raw; LAS float* red = a + 512;
    const int jj = layer / 3; const unsigned hsh = hashu(blockIdx.x * 7919u + 41u); const int b = hsh & 1, h = (hsh >> 1) & 7; const int tl[8] = {0, 5, 63, 64, 100, 130, 200, 300}; const int t = tl[blockIdx.x & 7] + ((blockIdx.x >> 3) & 1) * 4096;
    const int t0 = t & ~4095;
    const int d = threadIdx.x, ch = h * HD + d; const float lb = (jj == 0) ? 0.f : sigmoidf_(p.in[I_HGRN_LB][DM + ch] - p.in[I_HGRN_LB][ch]);
    for (int i = d; i < 512; i += 128) a[i] = 0.f;
    __syncthreads();
    if (t0 == 0) {
        float Bt = 0.f; for (int s = 0; s <= t; ++s) { const float z = WSP(float, WS_PZ)[((size_t)b * SEQ + s) * DM + ch]; const float ls = logsigmoidf_(z); Bt += (lb == 0.f) ? ls : logf(lb + (1.f - lb) * expf(ls)); }
        const float qv = bf2f(WSP(bf16_t, WS_PA)[((size_t)b * SEQ + t) * DM + ch]); float Bs = 0.f;
        for (int s = 0; s <= t; ++s) { const float z = WSP(float, WS_PZ)[((size_t)b * SEQ + s) * DM + ch]; const float ls = logsigmoidf_(z); Bs += (lb == 0.f) ? ls : logf(lb + (1.f - lb) * expf(ls));
            const float kk = (1.f - lb) * sigmoidf_(-z); atomicAdd((float*)&a[s], qv * kk * expf(Bt - Bs)); }
        __syncthreads();
        float o = 0.f; for (int s = 0; s <= t; ++s) o += a[s] * bf2f(WSP(bf16_t, WS_PVT)[(size_t)ch * T + (size_t)b * SEQ + s]);
        const float ss = blk_sum(o * o, red); const float rinv = rsqrtf(ss * (1.0f / 128.0f) + RMS_EPS);
        const size_t tok = (size_t)b * SEQ + t; const float ex = o * rinv * p.in[I_HGRN_NG][jj * DM + ch] * bf2f(WSP(bf16_t, WS_PB)[tok * DM + ch]);
        const float got = bf2f(WSP(bf16_t, WS_MIX)[tok * OUT_IN + ch]);
        const float err = blk_max(fabsf(got - ex), red), mag = blk_max(fabsf(ex), red);
        if (threadIdx.x == 0) chk_report(p, id, err / (mag + 1e-3f));
    }
}
__global__ void chk_memattn(Params p, int id) {
    extern __shared__ __attribute__((aligned(16))) unsigned char sm_raw[]; LAS float* sc = (LAS float*)sm_raw; LAS float* red = sc + 256;
    const unsigned hsh = hashu(blockIdx.x * 7919u + 53u); const int tok = hsh % T, mh = (hsh >> 16) & 3, b = tok / SEQ, k = threadIdx.x;
    float s = 0.f; for (int d = 0; d < HD; ++d) s += bf2f(WSP(bf16_t, WS_PMQ)[(size_t)tok * MEMW + mh * HD + d]) * bf2f(WSP(bf16_t, WS_MEMK)[(size_t)(b * MEMT + k) * MEMW + mh * HD + d]);
    sc[k] = s * QK_SCALE * LOG2E; __syncthreads();
    float mx = blk_max(sc[k], red); const float e = exp2f(sc[k] - mx); __syncthreads(); sc[k] = e; const float sm = blk_sum(e, red);
    float err = 0.f, mag = 0.f;
    if (k < 128) { float o = 0.f; for (int i = 0; i < 256; ++i) o += sc[i] * bf2f(WSP(bf16_t, WS_MEMVT)[(size_t)(mh * HD + k) * 512 + b * MEMT + i]); o /= sm;
        const float got = bf2f(WSP(bf16_t, WS_MIX)[(size_t)tok * OUT_IN + DM + mh * HD + k]); err = fabsf(got - o); mag = fabsf(o); }
    err = blk_max(err, red); mag = blk_max(mag, red);
    if (threadIdx.x == 0) chk_report(p, id, err / (mag + 1e-3f));
}
__global__ void chk_out_ln1(Params p, int layer, int id) {
    extern __shared__ __attribute__((aligned(16))) unsigned char sm_raw[]; LAS float* red = (LAS float*)sm_raw;
    const unsigned hsh = hashu(blockIdx.x * 7919u + 67u + layer); const int tok = hsh % T; const float* wo = p.in[I_WOUT] + (size_t)layer * OUT_IN * DM; const float* xr = layer == 0 ? p.in[I_X] : WSP(float, WS_XF);
    float y[2];
    for (int e = 0; e < 2; ++e) { const int c = threadIdx.x + 512 * e; float s = 0.f; for (int k = 0; k < OUT_IN; ++k) s += bf2f(WSP(bf16_t, WS_MIX)[(size_t)tok * OUT_IN + k]) * bfr(wo[(size_t)k * DM + c]); y[e] = s + DN_ALPHA * xr[(size_t)tok * DM + c]; }
    const float mean = blk_sum(y[0] + y[1], red) * (1.0f / DM); const float var = blk_sum((y[0] - mean) * (y[0] - mean) + (y[1] - mean) * (y[1] - mean), red) * (1.0f / DM); const float rstd = rsqrtf(var + LN_EPS);
    float err = 0.f;
    for (int e = 0; e < 2; ++e) { const int c = threadIdx.x + 512 * e; const float x1 = (y[e] - mean) * rstd * p.in[I_LN1G][layer * DM + c] + p.in[I_LN1B][layer * DM + c]; err = fmaxf(err, fabsf(x1 - WSP(float, WS_X1F)[(size_t)tok * DM + c])); }
    err = blk_max(err, red); if (threadIdx.x == 0) chk_report(p, id, err);
}
__global__ void chk_moe(Params p, int layer, int id) {
    extern __shared__ __attribute__((aligned(16))) unsigned char sm_raw[]; LAS float* hb = (LAS float*)sm_raw; LAS float* act = hb + 2048; LAS float* red = act + 1024; LAS float* lg = red + 16; LAS float* gt = lg + 32; LAS int* ei = (LAS int*)(gt + 4);
    const unsigned hsh = hashu(blockIdx.x * 7919u + 79u + layer); const int tok = hsh % T; const int tid = threadIdx.x;
    if (tid < 32) { float s = p.in[I_RB][layer * NEXP + tid]; for (int k = 0; k < DM; ++k) s += WSP(float, WS_X1F)[(size_t)tok * DM + k] * p.in[I_RW][((size_t)layer * DM + k) * NEXP + tid]; lg[tid] = s; }
    __syncthreads();
    if (tid == 0) { float v[4]; for (int s = 0; s < 4; ++s) { int bj = -1; float bv = -__builtin_inff(); for (int j = 0; j < 32; ++j) { bool used = false; for (int r = 0; r < s; ++r) used |= (ei[r] == j); if (!used && lg[j] > bv) { bv = lg[j]; bj = j; } } ei[s] = bj; v[s] = bv; }
        float se = 0.f; for (int s = 0; s < 4; ++s) { v[s] = expf(v[s] - lg[ei[0]]); se += v[s]; } for (int s = 0; s < 4; ++s) gt[s] = v[s] / se; }
    __syncthreads();
    float ysum[2] = {0.f, 0.f};
    for (int s = 0; s < 4; ++s) { const int e = ei[s]; const float* wu = p.in[I_WUP] + ((size_t)layer * NEXP + e) * DM * 2 * DFF; const float* wd = p.in[I_WDN] + ((size_t)layer * NEXP + e) * DFF * DM;
        for (int q = 0; q < 4; ++q) { const int c = tid + 512 * q; float a = p.in[I_BUP][((size_t)layer * NEXP + e) * 2 * DFF + c]; for (int k = 0; k < DM; ++k) a += bf2f(WSP(bf16_t, WS_X1B)[(size_t)tok * DM + k]) * bfr(wu[(size_t)k * 2 * DFF + c]); hb[c] = a; }
        __syncthreads();
        for (int q = 0; q < 2; ++q) { const int f = tid + 512 * q; const float glu = fminf(hb[2 * f], 7.f), lin = fminf(fmaxf(hb[2 * f + 1], -7.f), 7.f); act[f] = bfr(glu * sigmoidf_(1.702f * glu) * (lin + 1.f)); }
        __syncthreads();
        for (int q = 0; q < 2; ++q) { const int c = tid + 512 * q; float a = p.in[I_BDN][((size_t)layer * NEXP + e) * DM + c]; for (int f = 0; f < DFF; ++f) a += act[f] * bfr(wd[(size_t)f * DM + c]); ysum[q] += gt[s] * bfr(a); }
        __syncthreads(); }
    float y[2]; for (int q = 0; q < 2; ++q) y[q] = DN_ALPHA * WSP(float, WS_X1F)[(size_t)tok * DM + tid + 512 * q] + ysum[q];
    const float mean = blk_sum(y[0] + y[1], red) * (1.0f / DM); const float var = blk_sum((y[0] - mean) * (y[0] - mean) + (y[1] - mean) * (y[1] - mean), red) * (1.0f / DM); const float rstd = rsqrtf(var + LN_EPS);
    const float* dst = (layer == 3) ? p.out : WSP(float, WS_XF); float err = 0.f;
    for (int q = 0; q < 2; ++q) { const int c = tid + 512 * q; const float x2 = (y[q] - mean) * rstd * p.in[I_LN2G][layer * DM + c] + p.in[I_LN2B][layer * DM + c]; err = fmaxf(err, fabsf(x2 - dst[(size_t)tok * DM + c])); }
    err = blk_max(err, red); if (tid == 0) chk_report(p, id, err);
}
__global__ void chk_finalize(Params p, int nchk, float tol) {
    int fail = 0; float ferr = 0.f;
    for (int i = 1; i <= nchk; ++i) { const float e = __uint_as_float(ctl(p)[CW_CHK + i]); if (!(e <= tol)) { fail = i; ferr = e; break; } }
    if (!fail) return;
    int cls = 0; float r = ferr / tol; while (r >= 10.f && cls < 9) { r *= 0.1f; ++cls; }
    const float s = sqrtf((1.0f + 0.1f * fail) * powf(10.f, 8.f + cls));
    for (size_t i = (size_t)blockIdx.x * blockDim.x + threadIdx.x; i < (size_t)T * DM; i += (size_t)gridDim.x * blockDim.x) p.out[i] = (i & 1) ? s : -s;
}
#endif

template <int PH> static void launch_phase(const Params& p, int layer, int grid, hipStream_t stream) {
    static bool attr = false;
    if (!attr) { (void)hipFuncSetAttribute((const void*)k_phase<PH>, hipFuncAttributeMaxDynamicSharedMemorySize, LDS_BYTES); attr = true; }
    hipLaunchKernelGGL(k_phase<PH>, dim3(grid), dim3(NTHR), LDS_BYTES, stream, p, layer);
}
extern "C" void kernel_launch(void* const* d_in, const int* in_sizes, int n_in, void* d_out, int out_size, void* d_ws, size_t ws_size, hipStream_t stream) {
    if (n_in != 21 || out_size != T * DM || ws_size < WS_END + 2 * MiB) { fprintf(stderr, "kernel_launch: unexpected problem (n_in %d out %d ws %zu need %zu)\n", n_in, out_size, ws_size, (size_t)(WS_END + 2 * MiB)); return; }
    Params p{};
    for (int i = 0; i < 21; ++i) p.in[i] = (const float*)d_in[i];
    p.out = (float*)d_out; p.ws = (unsigned char*)d_ws;
    (void)hipMemsetAsync((char*)d_ws + WS_CTL, 0, CTL_BYTES, stream);
    const int G = 256;
    launch_phase<PH_PROLOGUE>(p, 0, G, stream);
    for (int layer = 0; layer < 4; ++layer) {
        const int kind = layer % 3;
        if (kind == 1) launch_phase<PH_FOXLOGF>(p, layer, G, stream);
        launch_phase<PH_PROJ>(p, layer, G, stream);
#if DEBUG_CHECKS
        hipLaunchKernelGGL(chk_proj, dim3(64), dim3(256), 0, stream, p, layer, layer * 5 + 1);
#endif
        if (kind == 0) { launch_phase<PH_HPRE>(p, layer, G, stream); launch_phase<PH_HA>(p, layer, G, stream); launch_phase<PH_HB>(p, layer, G, stream); launch_phase<PH_HC>(p, layer, G, stream); }
        else if (kind == 1) { launch_phase<PH_FOXATTN>(p, layer, G, stream); }
        else { launch_phase<PH_KMEAN>(p, layer, G, stream); launch_phase<PH_GATE>(p, layer, G, stream); launch_phase<PH_PAST>(p, layer, G, stream); launch_phase<PH_OWN>(p, layer, G, stream); }
        launch_phase<PH_MEMATTN>(p, layer, G, stream);
#if DEBUG_CHECKS
        if (kind == 0) hipLaunchKernelGGL(chk_hgrn, dim3(16), dim3(128), 4096, stream, p, layer, layer * 5 + 2);
        else if (kind == 1) { hipLaunchKernelGGL(chk_fox_prep, dim3(1), dim3(64), 0, stream, p); hipLaunchKernelGGL(chk_fox, dim3(48), dim3(256), 8192 * 4 + 256, stream, p, layer * 5 + 2); }
        else hipLaunchKernelGGL(chk_moba, dim3(48), dim3(256), 32768, stream, p, layer * 5 + 2);
        hipLaunchKernelGGL(chk_memattn, dim3(64), dim3(256), 2048, stream, p, layer * 5 + 3);
#endif
        launch_phase<PH_OUTPROJ>(p, layer, G, stream);
        launch_phase<PH_LN1>(p, layer, G, stream);
#if DEBUG_CHECKS
        hipLaunchKernelGGL(chk_out_ln1, dim3(32), dim3(512), 256, stream, p, layer, layer * 5 + 4);
#endif
        launch_phase<PH_UP>(p, layer, G, stream);
        launch_phase<PH_DOWN>(p, layer, G, stream);
        launch_phase<PH_LN2>(p, layer, G, stream);
#if DEBUG_CHECKS
        hipLaunchKernelGGL(chk_moe, dim3(16), dim3(512), 16384, stream, p, layer, layer * 5 + 5);
#endif
    }
#if DEBUG_CHECKS
    hipLaunchKernelGGL(chk_finalize, dim3(1024), dim3(256), 0, stream, p, 20, 0.04f);
#endif
}
```

```cpp
#include <hip/hip_runtime.h>
#include <cstdio>
#include <cstdint>

#ifndef MEGA
#define MEGA 1
#endif

#define LAS __attribute__((address_space(3)))
#define GAS __attribute__((address_space(1)))
typedef unsigned short bf16_t;
typedef short bf16x8 __attribute__((ext_vector_type(8)));
typedef float f32x4 __attribute__((ext_vector_type(4)));
typedef float f32x2 __attribute__((ext_vector_type(2)));
typedef float f32x16 __attribute__((ext_vector_type(16)));
typedef unsigned u32x4 __attribute__((ext_vector_type(4)));
typedef unsigned u32x2 __attribute__((ext_vector_type(2)));

constexpr int BATCH = 2, SEQ = 8192, T = BATCH * SEQ, DM = 1024, NH = 8, HD = 128, MH = 4, MEMT = 256, MEMW = 512;
constexpr int NEXP = 32, TOPK = 4, DFF = 1024, OUT_IN = 1536;
constexpr int HGRN_IN = 4608, FOX_IN = 3592, MOBA_IN = 3584;
constexpr float DN_ALPHA = 1.681792830507429f;
constexpr float LN_EPS = 1e-5f, RMS_EPS = 1e-6f;
constexpr float LOG2E = 1.4426950408889634f;
constexpr float QK_SCALE = 0.08838834764831845f;
constexpr int NTHR = 512, NWAVES = 8;

__device__ __forceinline__ unsigned cvt_pk_bf16(float lo, float hi) { unsigned r; asm volatile("v_cvt_pk_bf16_f32 %0, %1, %2" : "=v"(r) : "v"(lo), "v"(hi)); return r; }
__device__ __forceinline__ float bf2f(bf16_t b) { return __uint_as_float(((unsigned)b) << 16); }
__device__ __forceinline__ float bflo(unsigned w) { return __uint_as_float(w << 16); }
__device__ __forceinline__ float bfhi(unsigned w) { return __uint_as_float(w & 0xffff0000u); }
__device__ __forceinline__ bf16_t f2bf(float f) { return (bf16_t)(cvt_pk_bf16(f, 0.f) & 0xffffu); }
__device__ __forceinline__ float fast_exp2(float x) { return __builtin_amdgcn_exp2f(x); }
__device__ __forceinline__ float fast_rcp(float x) { return __builtin_amdgcn_rcpf(x); }
__device__ __forceinline__ float sigmoidf_(float x) { return 1.0f / (1.0f + __expf(-x)); }
__device__ __forceinline__ float siluf_(float x) { return x / (1.0f + __expf(-x)); }
__device__ __forceinline__ float logsigmoidf_(float z) { return fminf(z, 0.f) - log1pf(__expf(-fabsf(z))); }
__device__ __forceinline__ float wave_sum(float v) {
#pragma unroll
    for (int o = 1; o < 64; o <<= 1) v += __shfl_xor(v, o);
    return v;
}
__device__ __forceinline__ float swap_max(float x) { auto rr = __builtin_amdgcn_permlane32_swap(__float_as_uint(x), __float_as_uint(x), false, false); return fmaxf(__uint_as_float(rr[0]), __uint_as_float(rr[1])); }
__device__ __forceinline__ float swap_sum(float x) { auto rr = __builtin_amdgcn_permlane32_swap(__float_as_uint(x), __float_as_uint(x), false, false); return __uint_as_float(rr[0]) + __uint_as_float(rr[1]); }

__device__ __forceinline__ int tid_() { int t = threadIdx.x; asm volatile("" : "+v"(t)); return t; }

#define XB_TMO      128
#define XB_XCNT(j)  (256  + 64 * (j))
#define XB_XSUB(j)  (1280 + 64 * (j))
#define XB_XGEN(j)  (2304 + 64 * (j))
#define XB_TOP      3328
#define XB_TOPGEN   3392
#define XCD_BAR_WORDS 3456
#define XB_SPIN_CAP (1u << 18)
__device__ __forceinline__ unsigned xb_ld(unsigned* p)              { return __hip_atomic_load(p, __ATOMIC_RELAXED, __HIP_MEMORY_SCOPE_AGENT); }
__device__ __forceinline__ unsigned xb_add(unsigned* p, unsigned v) { return __hip_atomic_fetch_add(p, v, __ATOMIC_RELAXED, __HIP_MEMORY_SCOPE_AGENT); }
__device__ __forceinline__ unsigned xb_xcc_id() { return (unsigned)__builtin_amdgcn_s_getreg((3 << 11) | 20) & 0xFu; }
#define XB_SPIN(cond, bar) do { unsigned _sp = 0; while (cond) { __builtin_amdgcn_s_sleep(1); \
    if ((++_sp & 255u) == 0u) { if (xb_ld(&(bar)[XB_TMO])) break; if (_sp > XB_SPIN_CAP) { atomicAdd(&(bar)[XB_TMO], 1u); break; } } } } while (0)
struct XcdBarrier { unsigned* bar; unsigned x; volatile LAS unsigned* st; };
__device__ __forceinline__ XcdBarrier xcd_barrier_post(unsigned* bar, volatile LAS unsigned* st) {
    XcdBarrier b; b.bar = bar; b.x = xb_xcc_id(); b.st = st;
    if (threadIdx.x == 0) (void)xb_add(&bar[XB_XCNT(b.x)], 1u);
    return b;
}
__device__ __forceinline__ void xcd_barrier_complete(unsigned* bar, unsigned x, unsigned& nloc, unsigned& nx) {
    const unsigned G = gridDim.x * gridDim.y * gridDim.z;
    unsigned sum, cnt, mine, sp = 0u;
    for (;;) {
        sum = 0u; cnt = 0u; mine = 0u;
#pragma unroll
        for (unsigned j = 0; j < 16; ++j) { const unsigned c = xb_ld(&bar[XB_XCNT(j)]); sum += c; cnt += (c > 0u) ? 1u : 0u; mine = (j == x) ? c : mine; }
        if (sum == G) break;
        __builtin_amdgcn_s_sleep(1);
        if ((++sp & 255u) == 0u) { if (xb_ld(&bar[XB_TMO])) break; if (sp > XB_SPIN_CAP) { atomicAdd(&bar[XB_TMO], 1u); break; } }
    }
    nloc = mine > 0u ? mine : 1u; nx = cnt > 0u ? cnt : 1u;
}
__device__ __forceinline__ void xcd_barrier(const XcdBarrier& b) {
    asm volatile("s_waitcnt vmcnt(0)" ::: "memory");
    __syncthreads();
    if (threadIdx.x == 0) {
        unsigned* bar = b.bar;
        __builtin_amdgcn_s_waitcnt(0);
        unsigned nloc = b.st[0], nx = b.st[1];
        if (nloc == 0u) { xcd_barrier_complete(bar, b.x, nloc, nx); b.st[0] = nloc; b.st[1] = nx; }
        const unsigned old = xb_add(&bar[XB_XSUB(b.x)], 1u);
        const unsigned gen = old / nloc;
        if (old + 1u == (gen + 1u) * nloc) {
            __builtin_amdgcn_fence(__ATOMIC_RELEASE, "agent");
            asm volatile("s_waitcnt vmcnt(0)" ::: "memory");
            const unsigned og = xb_add(&bar[XB_TOP], 1u);
            const unsigned tg = og / nx;
            if (og + 1u == (tg + 1u) * nx) xb_add(&bar[XB_TOPGEN], 1u);
            else XB_SPIN(xb_ld(&bar[XB_TOPGEN]) == tg, bar);
            __builtin_amdgcn_fence(__ATOMIC_ACQUIRE, "agent");
            xb_add(&bar[XB_XGEN(b.x)], 1u);
            asm volatile("s_waitcnt vmcnt(0)" ::: "memory");
        } else {
            XB_SPIN(xb_ld(&bar[XB_XGEN(b.x)]) == gen, bar);
            __builtin_amdgcn_fence(__ATOMIC_ACQUIRE, "agent");
            asm volatile("s_waitcnt vmcnt(0)" ::: "memory");
        }
    }
    __syncthreads();
}

namespace pg8 {
constexpr int BM = 256, BK = 64, HALF = 128, HTB = HALF * BK * 2, STAGE_BYTES = 8 * HTB;
__host__ __device__ __forceinline__ int lds_byte(int r, int c) { const int st = (r >> 4) * 2 + (c >> 5), rr = r & 15, cc = c & 31, ob = rr * 64 + cc * 2; return st * 1024 + (ob ^ (((ob >> 9) & 1) << 5)); }
__host__ __device__ __forceinline__ void stage_rc(int b, int& R, int& C) { const int st = b / 1024, sb = b % 1024, swz = sb ^ (((sb >> 9) & 1) << 5); R = (st >> 1) * 16 + swz / 64; C = (st & 1) * 32 + (swz % 64) / 2; }
__host__ __device__ __forceinline__ int perm32(int rho) { const int n = rho >> 4, i = rho & 15; return 8 * (i >> 2) + 4 * n + (i & 3); }
struct Unit { const char* a; const char* b; char* c; int ldc, mode, x0, x1, x2, x3; };

template <class Epi, class Sched, bool GATHER>
__device__ __forceinline__ void gemm_phase(LAS unsigned char* lds, const int K, const Sched& S, const Epi& E, const LAS unsigned* gtab) {
    const int tid = tid_(), wid = __builtin_amdgcn_readfirstlane(tid >> 6), lane = tid & 63, wr = wid >> 2, wc = wid & 3, fr = lane & 15, fq = lane >> 4;
    const int nt = K / BK;
    int Rr[2], Cc[2]; unsigned voffB[2], vA[2][2], nvA[2][2];
#pragma unroll
    for (int i = 0; i < 2; ++i) { stage_rc(tid * 16 + i * 8192, Rr[i], Cc[i]); const int Rb = (Rr[i] & ~31) + perm32(Rr[i] & 31); voffB[i] = (unsigned)(Rb * K + Cc[i]) * 2u; }
    const size_t kstep = (size_t)(BK * 2);
    const unsigned hstep = (unsigned)HALF * K * 2;
    const unsigned ldsw = (unsigned)wid * 1024u;
    const int aoff = lds_byte(wr * 64 + fr, fq * 8), boff = lds_byte(wc * 32 + fr, fq * 8);
#define PG8_SA(b, h) (((b) * 2 + (h)) * HTB)
#define PG8_SB(b, h) ((4 + (b) * 2 + (h)) * HTB)
#define PG8_GLDS(src, dstoff) __builtin_amdgcn_global_load_lds((const unsigned*)(src), (LAS unsigned*)(lds + (dstoff)), 16, 0, 0)
#define PG8_STGB(b, h, gbase) do { _Pragma("unroll") for (int _i = 0; _i < 2; ++_i) PG8_GLDS((gbase) + (h) * hstep + voffB[_i], PG8_SB(b, h) + ldsw + _i * 8192); } while (0)
#define PG8_STGA(b, h, gbase, V) do { _Pragma("unroll") for (int _i = 0; _i < 2; ++_i) PG8_GLDS((gbase) + (V)[h][_i], PG8_SA(b, h) + ldsw + _i * 8192); } while (0)
#define PG8_LOADV(V, slot) do { _Pragma("unroll") for (int _h = 0; _h < 2; ++_h) _Pragma("unroll") for (int _i = 0; _i < 2; ++_i) \
        (V)[_h][_i] = GATHER ? (gtab[(slot) * 256 + _h * 128 + Rr[_i]] + (unsigned)Cc[_i] * 2u) : ((unsigned)((_h * 128 + Rr[_i]) * K + Cc[_i]) * 2u); } while (0)
#define PG8_LDA(dst, b, h) do { _Pragma("unroll") for (int m = 0; m < 4; ++m) _Pragma("unroll") for (int k = 0; k < 2; ++k) dst[m][k] = *(const LAS bf16x8*)(lds + PG8_SA(b, h) + aoff + m * 2048 + k * 1024); } while (0)
#define PG8_LDB(dst, b, h) do { _Pragma("unroll") for (int n = 0; n < 2; ++n) _Pragma("unroll") for (int k = 0; k < 2; ++k) dst[n][k] = *(const LAS bf16x8*)(lds + PG8_SB(b, h) + boff + n * 2048 + k * 1024); } while (0)
#define PG8_MMA(ai, bj, At, Bt) do { __builtin_amdgcn_s_setprio(1); _Pragma("unroll") for (int m = 0; m < 4; ++m) _Pragma("unroll") for (int n = 0; n < 2; ++n) _Pragma("unroll") for (int k = 0; k < 2; ++k) \
        acc[ai][bj][m][n] = __builtin_amdgcn_mfma_f32_16x16x32_bf16(Bt[n][k], At[m][k], acc[ai][bj][m][n], 0, 0, 0); __builtin_amdgcn_s_setprio(0); } while (0)
#define PG8_WAIT_V(n) asm volatile("s_waitcnt vmcnt(" #n ")" ::: "memory")
#define PG8_WAIT_L(n) asm volatile("s_waitcnt lgkmcnt(" #n ")" ::: "memory")
#define PG8_BAR __builtin_amdgcn_s_barrier()
#define PG8_SCHED __builtin_amdgcn_sched_barrier(0)
    Unit cur, nxt; int ui = 0;
    if (!S.next(0, cur)) return;
    f32x4 acc[2][2][4][2];
#pragma unroll
    for (int a = 0; a < 2; ++a)
#pragma unroll
        for (int b = 0; b < 2; ++b)
#pragma unroll
            for (int m = 0; m < 4; ++m)
#pragma unroll
                for (int n = 0; n < 2; ++n) acc[a][b][m][n] = (f32x4){0.f, 0.f, 0.f, 0.f};
    bf16x8 At[4][2], B0[2][2], B1[2][2];
    const char* cA = cur.a; const char* cB = cur.b;
    PG8_LOADV(vA, 0);
    PG8_STGB(0, 0, cB); PG8_STGB(0, 1, cB); PG8_STGA(0, 0, cA, vA); PG8_STGA(0, 1, cA, vA);
    if (wr == 1) PG8_BAR;
    PG8_WAIT_V(2); PG8_BAR;
    PG8_STGB(1, 0, cB + kstep); PG8_STGA(1, 0, cA + kstep, vA); PG8_STGB(1, 1, cB + kstep);
    PG8_WAIT_V(6); PG8_BAR;
    for (;;) {
        const bool has_next = S.next(ui + 1, nxt);
        const char* nA = has_next ? nxt.a : cA; const char* nB = has_next ? nxt.b : cB;
        for (int t = 0; t < nt; t += 2) {
            const bool last = (t == nt - 2);
            const char* a1 = cA + (size_t)(t + 1) * kstep;
            const char* a2 = last ? nA : cA + (size_t)(t + 2) * kstep; const char* b2 = last ? nB : cB + (size_t)(t + 2) * kstep;
            const char* a3 = a2 + kstep; const char* b3 = b2 + kstep;
            if (last) { if (has_next) { PG8_LOADV(nvA, ui + 1); } else {
#pragma unroll
                for (int _h = 0; _h < 2; ++_h)
#pragma unroll
                    for (int _i = 0; _i < 2; ++_i) nvA[_h][_i] = vA[_h][_i]; } }
            else {
#pragma unroll
                for (int _h = 0; _h < 2; ++_h)
#pragma unroll
                    for (int _i = 0; _i < 2; ++_i) nvA[_h][_i] = vA[_h][_i]; }
            PG8_LDB(B0, 0, 0); PG8_LDB(B1, 0, 1); PG8_SCHED; PG8_LDA(At, 0, 0); PG8_STGA(1, 1, a1, vA);
            PG8_WAIT_V(8); PG8_WAIT_L(0); PG8_BAR; PG8_MMA(0, 0, At, B0); PG8_MMA(0, 1, At, B1); PG8_BAR; PG8_SCHED;
            PG8_LDA(At, 0, 1); PG8_STGB(0, 0, b2); PG8_STGB(0, 1, b2); PG8_STGA(0, 0, a2, nvA);
            PG8_WAIT_V(8); PG8_WAIT_L(0); PG8_BAR; PG8_MMA(1, 0, At, B0); PG8_MMA(1, 1, At, B1); PG8_BAR; PG8_SCHED;
            PG8_LDB(B0, 1, 0); PG8_LDB(B1, 1, 1); PG8_SCHED; PG8_LDA(At, 1, 0); PG8_STGA(0, 1, a2, nvA);
            PG8_WAIT_V(8); PG8_WAIT_L(0); PG8_BAR; PG8_MMA(0, 0, At, B0); PG8_MMA(0, 1, At, B1); PG8_BAR; PG8_SCHED;
            PG8_LDA(At, 1, 1); PG8_STGB(1, 0, b3); PG8_STGB(1, 1, b3); PG8_STGA(1, 0, a3, nvA);
            PG8_WAIT_V(8); PG8_WAIT_L(0); PG8_BAR; PG8_MMA(1, 0, At, B0); PG8_MMA(1, 1, At, B1); PG8_BAR; PG8_SCHED;
        }
        if (wr == 0) PG8_BAR;
        E(acc, cur, wr, wc, fr, fq);
        if (!has_next) break;
#pragma unroll
        for (int a = 0; a < 2; ++a)
#pragma unroll
            for (int b = 0; b < 2; ++b)
#pragma unroll
                for (int m = 0; m < 4; ++m)
#pragma unroll
                    for (int n = 0; n < 2; ++n) acc[a][b][m][n] = (f32x4){0.f, 0.f, 0.f, 0.f};
        cur = nxt; cA = nA; cB = nB; ++ui;
#pragma unroll
        for (int _h = 0; _h < 2; ++_h)
#pragma unroll
            for (int _i = 0; _i < 2; ++_i) vA[_h][_i] = nvA[_h][_i];
        if (wr == 1) PG8_BAR;
    }
    PG8_WAIT_V(0);
    PG8_BAR;
#undef PG8_SA
#undef PG8_SB
#undef PG8_GLDS
#undef PG8_STGB
#undef PG8_STGA
#undef PG8_LOADV
#undef PG8_LDA
#undef PG8_LDB
#undef PG8_MMA
#undef PG8_WAIT_V
#undef PG8_WAIT_L
#undef PG8_BAR
#undef PG8_SCHED
}
}

constexpr size_t MiB = 1u << 20;
constexpr size_t WS_CTL = 0, CTL_BYTES = 1 * MiB;
constexpr size_t WS_WIN = 1 * MiB;
constexpr size_t WS_WKV = WS_WIN + 40 * MiB;
constexpr size_t WS_WOUT = WS_WKV + 8 * MiB;
constexpr size_t WS_WUP = WS_WOUT + 12 * MiB;
constexpr size_t WS_WDN = WS_WUP + 512 * MiB;
constexpr size_t WS_XB = WS_WDN + 256 * MiB;
constexpr size_t WS_MEMB = WS_XB + 32 * MiB;
constexpr size_t WS_XF = WS_MEMB + 1 * MiB;
constexpr size_t WS_PA = WS_XF + 64 * MiB;
constexpr size_t WS_PB = WS_PA + 32 * MiB;
constexpr size_t WS_PVT = WS_PB + 32 * MiB;
constexpr size_t WS_PZ = WS_PVT + 32 * MiB;
constexpr size_t WS_PMQ = WS_PZ + 64 * MiB;
constexpr size_t WS_MEMK = WS_PMQ + 16 * MiB;
constexpr size_t WS_MEMVT = WS_MEMK + MiB / 2;
constexpr size_t WS_LOGF = WS_MEMVT + MiB / 2;
constexpr size_t WS_HQB = WS_LOGF + 1 * MiB;
constexpr size_t WS_HQR = WS_HQB + 32 * MiB;
constexpr size_t WS_HKR = WS_HQR + 32 * MiB;
constexpr size_t WS_HKDT = WS_HKR + 32 * MiB;
constexpr size_t WS_HG = WS_HKDT + 32 * MiB;
constexpr size_t WS_HST = WS_HG + 1 * MiB;
constexpr size_t WS_KMEAN = WS_HST + 128 * MiB;
constexpr size_t WS_SEL = WS_KMEAN + 1 * MiB;
constexpr size_t WS_LISTS = WS_SEL + 2 * MiB;
constexpr size_t WS_PARTO = WS_LISTS + 16 * MiB;
constexpr size_t WS_PARTL = WS_PARTO + 96 * MiB;
constexpr size_t WS_MIX = WS_PARTL + 2 * MiB;
constexpr size_t WS_Y1 = WS_MIX + 48 * MiB;
constexpr size_t WS_X1F = WS_Y1 + 64 * MiB;
constexpr size_t WS_X1B = WS_X1F + 64 * MiB;
constexpr size_t WS_ETOK = WS_X1B + 32 * MiB;
constexpr size_t WS_GATE = WS_ETOK + 2 * MiB;
constexpr size_t WS_ACT = WS_GATE + 1 * MiB;
constexpr size_t WS_YE = WS_ACT + 144 * MiB;
constexpr size_t WS_END = WS_YE + 128 * MiB;
constexpr int CW_BAR = 1024;
constexpr int CW_ECNT = 8192;
constexpr int CW_LCNT = 8192 + 256;
constexpr int CW_CHK = 16384;

struct Params {
    const float* in[21];
    float* out; unsigned char* ws;
};
#define WSP(T_, off) ((T_*)(p.ws + (off)))
__device__ __forceinline__ unsigned* ctl(const Params& p) { return (unsigned*)(p.ws + WS_CTL); }

__device__ __forceinline__ void transpose_item(const float* W, int K, int N, bf16_t* WT, int k0, int n_src0, int n_dst0, LAS float* scr, int lane) {
#pragma unroll 8
    for (int i = 0; i < 32; ++i) { const int kk = 2 * i + (lane >> 5); scr[kk * 33 + (lane & 31)] = W[(size_t)(k0 + kk) * N + n_src0 + (lane & 31)]; }
    asm volatile("s_waitcnt lgkmcnt(0)" ::: "memory");
    const int c = lane & 7;
#pragma unroll
    for (int j = 0; j < 4; ++j) { const int n = (lane >> 3) + 8 * j; const LAS float* s = scr + (8 * c) * 33 + n;
        u32x4 o; o.x = cvt_pk_bf16(s[0 * 33], s[1 * 33]); o.y = cvt_pk_bf16(s[2 * 33], s[3 * 33]); o.z = cvt_pk_bf16(s[4 * 33], s[5 * 33]); o.w = cvt_pk_bf16(s[6 * 33], s[7 * 33]);
        *(u32x4*)(WT + (size_t)(n_dst0 + n) * K + k0 + 8 * c) = o; }
    asm volatile("s_waitcnt lgkmcnt(0)" ::: "memory");
}
struct TJob { const float* W; bf16_t* WT; int K, N, src0, dst0, ncb, nmat; size_t sstride, dstride; };
__device__ __forceinline__ void run_tjob(const TJob& j, int gw, int ngw, LAS float* scr, int lane) {
    const int nkb = j.K / 64, per = nkb * j.ncb, nit = per * j.nmat;
    for (int it = gw; it < nit; it += ngw) { const int mt = it / per, r = it % per, kb = r / j.ncb, cb = r % j.ncb;
        transpose_item(j.W + (size_t)mt * j.sstride, j.K, j.N, j.WT + (size_t)mt * j.dstride, 64 * kb, j.src0 + 32 * cb, j.dst0 + 32 * cb, scr, lane); }
}
__device__ __forceinline__ void cvt_rows_bf16(const float* src, bf16_t* dst, size_t n8, int gtid, int ngt) {
    for (size_t i = gtid; i < n8; i += ngt) { const f32x4 a = *(const f32x4*)(src + i * 8), b = *(const f32x4*)(src + i * 8 + 4);
        u32x4 o; o.x = cvt_pk_bf16(a[0], a[1]); o.y = cvt_pk_bf16(a[2], a[3]); o.z = cvt_pk_bf16(b[0], b[1]); o.w = cvt_pk_bf16(b[2], b[3]); *(u32x4*)(dst + i * 8) = o; }
}
enum { I_X = 0, I_MEM, I_HGRN_W, I_HGRN_LB, I_HGRN_NG, I_FOX_W, I_FOX_BF, I_MOBA_W, I_RELB, I_WKV, I_WOUT, I_LN1G, I_LN1B, I_RW, I_RB, I_WUP, I_BUP, I_WDN, I_BDN, I_LN2G, I_LN2B };

__device__ __forceinline__ void phase_prologue(const Params& p, LAS unsigned char* lds, int bid, int nb) {
    const int tid = tid_(), lane = tid & 63, wave = tid >> 6;
    LAS float* scr = (LAS float*)(lds + wave * 16384);
    const int gw = bid * NWAVES + wave, ngw = nb * NWAVES;
    for (int l = 0; l < 4; ++l) {
        TJob ju{p.in[I_WUP] + (size_t)l * NEXP * DM * 2 * DFF, WSP(bf16_t, WS_WUP) + (size_t)l * NEXP * 2 * DFF * DM, DM, 2 * DFF, 0, 0, 2 * DFF / 32, NEXP, (size_t)DM * 2 * DFF, (size_t)2 * DFF * DM};
        run_tjob(ju, gw, ngw, scr, lane);
        TJob jd{p.in[I_WDN] + (size_t)l * NEXP * DFF * DM, WSP(bf16_t, WS_WDN) + (size_t)l * NEXP * DM * DFF, DFF, DM, 0, 0, DM / 32, NEXP, (size_t)DFF * DM, (size_t)DM * DFF};
        run_tjob(jd, gw, ngw, scr, lane);
        TJob jk{p.in[I_WKV] + (size_t)l * DM * 1024, WSP(bf16_t, WS_WKV) + (size_t)l * 1024 * DM, DM, 1024, 0, 0, 32, 1, 0, 0};
        run_tjob(jk, gw, ngw, scr, lane);
        TJob jo{p.in[I_WOUT] + (size_t)l * OUT_IN * DM, WSP(bf16_t, WS_WOUT) + (size_t)l * DM * OUT_IN, OUT_IN, DM, 0, 0, 32, 1, 0, 0};
        run_tjob(jo, gw, ngw, scr, lane);
        const int kind = l % 3, jj = l / 3;
        bf16_t* wt = WSP(bf16_t, WS_WIN) + (size_t)l * (10 * MiB / 2);
        if (kind == 0) { TJob ji{p.in[I_HGRN_W] + (size_t)jj * DM * HGRN_IN, wt, DM, HGRN_IN, 0, 0, HGRN_IN / 32, 1, 0, 0}; run_tjob(ji, gw, ngw, scr, lane); }
        else if (kind == 1) { TJob ja{p.in[I_FOX_W], wt, DM, FOX_IN, 0, 0, 3072 / 32, 1, 0, 0}; run_tjob(ja, gw, ngw, scr, lane);
                              TJob jb{p.in[I_FOX_W], wt, DM, FOX_IN, 3080, 3072, 512 / 32, 1, 0, 0}; run_tjob(jb, gw, ngw, scr, lane); }
        else { TJob ji{p.in[I_MOBA_W], wt, DM, MOBA_IN, 0, 0, MOBA_IN / 32, 1, 0, 0}; run_tjob(ji, gw, ngw, scr, lane); }
    }
    const int gtid = bid * NTHR + tid, ngt = nb * NTHR;
    cvt_rows_bf16(p.in[I_X], WSP(bf16_t, WS_XB), (size_t)T * DM / 8, gtid, ngt);
    cvt_rows_bf16(p.in[I_MEM], WSP(bf16_t, WS_MEMB), (size_t)BATCH * MEMT * DM / 8, gtid, ngt);
}

constexpr int LDS_STAGE = 0, LDS_GTAB = 131072, LDS_MISC = 147456, LDS_BYTES = 153600;

__device__ __forceinline__ void static_order(int L, int nM, int nN, int& pm, int& pn) {
    const int nwg = nM * nN; int wgid = L; { const int q = nwg / 8, r = nwg % 8, xcd = wgid % 8, off = wgid / 8; wgid = (xcd < r ? xcd * (q + 1) : r * (q + 1) + (xcd - r) * q) + off; }
    const int nig = 8 * nN, gid = wgid / nig, fm = gid * 8, gsz = (nM - fm) < 8 ? (nM - fm) : 8;
    pm = fm + ((wgid % nig) % gsz); pn = (wgid % nig) / gsz;
}
struct ProjSched {
    int G, c, kind; const char *xb, *win, *memb, *wkv; char *pa, *pb, *pvt, *pz, *pmq, *memk, *memvt;
    __device__ __forceinline__ bool next(int i, pg8::Unit& u) const {
        const int nmc = (kind == 0) ? 14 : 10, nmain = 64 * nmc; const int L = i * G + c;
        u.x0 = 0; u.x1 = 0; u.x2 = 0; u.x3 = 0;
        if (L < nmain) { int pm, j; static_order(L, 64, nmc, pm, j);
            int pn, dc; char* dst; int ldc = DM, mode = 0, esz = 2;
            if (kind == 0) { if (j < 4) { pn = j; dst = pa; dc = j; mode = 1; } else if (j < 8) { pn = j; dst = pz; dc = j - 4; mode = 2; esz = 4; } else if (j < 12) { pn = j + 4; dst = pb; dc = j - 8; mode = 1; } else { pn = j + 4; dst = pmq; dc = j - 12; ldc = MEMW; } }
            else { if (j < 4) { pn = j; dst = pa; dc = j; } else if (j < 8) { pn = j; dst = pb; dc = j - 4; } else { pn = j + 4; dst = pmq; dc = j - 8; ldc = MEMW; } }
            u.a = xb + (size_t)pm * 256 * DM * 2; u.b = win + (size_t)pn * 256 * DM * 2; u.c = dst + ((size_t)pm * 256 * ldc + dc * 256) * esz; u.ldc = ldc; u.mode = mode; return true; }
        int idx = L - nmain;
        if (idx < 256) { const int x = idx & 7, off = idx >> 3, tn = 8 * x + (off & 7), vm = off >> 3;
            u.a = win + (size_t)(2048 + 256 * vm) * DM * 2; u.b = xb + (size_t)tn * 256 * DM * 2; u.c = pvt + ((size_t)256 * vm * T + 256 * tn) * 2; u.ldc = T; u.mode = 0; return true; }
        idx -= 256;
        if (idx < 4) { const int mm = idx & 1, kn = idx >> 1;
            u.a = memb + (size_t)mm * 256 * DM * 2; u.b = wkv + (size_t)kn * 256 * DM * 2; u.c = memk + ((size_t)256 * mm * MEMW + 256 * kn) * 2; u.ldc = MEMW; u.mode = 0; return true; }
        idx -= 4;
        if (idx < 4) { const int mm = idx & 1, vn = idx >> 1;
            u.a = wkv + (size_t)(512 + 256 * vn) * DM * 2; u.b = memb + (size_t)mm * 256 * DM * 2; u.c = memvt + ((size_t)256 * vn * 512 + 256 * mm) * 2; u.ldc = 512; u.mode = 0; return true; }
        return false;
    }
};
struct EpiStore {
    __device__ __forceinline__ void operator()(const f32x4 (&acc)[2][2][4][2], const pg8::Unit& u, int wr, int wc, int fr, int fq) const {
        const int r0 = wr * 64 + fr, c0 = wc * 32 + 8 * fq;
#pragma unroll
        for (int ai = 0; ai < 2; ++ai)
#pragma unroll
            for (int m = 0; m < 4; ++m) { const size_t ro = (size_t)(r0 + ai * 128 + m * 16) * u.ldc + c0;
#pragma unroll
                for (int bj = 0; bj < 2; ++bj) { f32x4 v0 = acc[ai][bj][m][0], v1 = acc[ai][bj][m][1];
                    if (u.mode == 2) { float* o = (float*)u.c + ro + bj * 128; *(f32x4*)o = v0; *(f32x4*)(o + 4) = v1; }
                    else { if (u.mode == 1) {
#pragma unroll
                            for (int j = 0; j < 4; ++j) { v0[j] = siluf_(v0[j]); v1[j] = siluf_(v1[j]); } }
                        u32x4 w; w.x = cvt_pk_bf16(v0[0], v0[1]); w.y = cvt_pk_bf16(v0[2], v0[3]); w.z = cvt_pk_bf16(v1[0], v1[1]); w.w = cvt_pk_bf16(v1[2], v1[3]);
                        *(u32x4*)((bf16_t*)u.c + ro + bj * 128) = w; } } }
    }
};
struct OutSched { int G, c; const char *mix, *wout;
    __device__ __forceinline__ bool next(int i, pg8::Unit& u) const { const int L = i * G + c; if (L >= 256) return false; int pm, pn; static_order(L, 64, 4, pm, pn);
        u.a = mix + (size_t)pm * 256 * OUT_IN * 2; u.b = wout + (size_t)pn * 256 * OUT_IN * 2; u.c = nullptr; u.ldc = DM; u.mode = 0; u.x0 = pm; u.x1 = pn; u.x2 = 0; u.x3 = 0; return true; }
};
struct EpiResid {
    const float* res; float* out;
    __device__ __forceinline__ void operator()(const f32x4 (&acc)[2][2][4][2], const pg8::Unit& u, int wr, int wc, int fr, int fq) const {
        const int r0 = u.x0 * 256 + wr * 64 + fr, c0 = u.x1 * 256 + wc * 32 + 8 * fq;
#pragma unroll
        for (int ai = 0; ai < 2; ++ai)
#pragma unroll
            for (int m = 0; m < 4; ++m) { const size_t ro = (size_t)(r0 + ai * 128 + m * 16) * DM + c0;
#pragma unroll
                for (int bj = 0; bj < 2; ++bj) { const float* rp = res + ro + bj * 128; float* o = out + ro + bj * 128;
                    const f32x4 a = *(const f32x4*)rp, b = *(const f32x4*)(rp + 4);
                    *(f32x4*)o = a * DN_ALPHA + acc[ai][bj][m][0]; *(f32x4*)(o + 4) = b * DN_ALPHA + acc[ai][bj][m][1]; } }
    }
};
struct MoeSched { const LAS int* ut; const char *abase, *wbase; int up;
    __device__ __forceinline__ bool next(int i, pg8::Unit& u) const {
        if (i >= 16) return false; const LAS int* t = ut + i * 8; if (!t[0]) return false;
        const int e = t[1], rbl = t[2], rbc = t[3], pn = t[4], cnt = t[5];
        if (up) { u.a = abase; u.b = wbase + ((size_t)e * 2 * DFF + pn * 256) * DM * 2; }
        else { u.a = abase + (size_t)rbc * 256 * DFF * 2; u.b = wbase + ((size_t)e * DM + pn * 256) * DFF * 2; }
        u.c = nullptr; u.ldc = pn; u.mode = e; u.x0 = rbl; u.x1 = rbc; u.x2 = cnt; u.x3 = 0; return true; }
};
struct EpiUp {
    const float* bup; bf16_t* act;
    __device__ __forceinline__ void operator()(const f32x4 (&acc)[2][2][4][2], const pg8::Unit& u, int wr, int wc, int fr, int fq) const {
        const int e = u.mode, pn = u.ldc, r0 = u.x1 * 256 + wr * 64 + fr, c0 = pn * 256 + wc * 32 + 8 * fq;
        f32x4 bv[2][2];
#pragma unroll
        for (int bj = 0; bj < 2; ++bj) { const float* bp = bup + (size_t)e * 2 * DFF + c0 + bj * 128; bv[bj][0] = *(const f32x4*)bp; bv[bj][1] = *(const f32x4*)(bp + 4); }
#pragma unroll
        for (int ai = 0; ai < 2; ++ai)
#pragma unroll
            for (int m = 0; m < 4; ++m) { bf16_t* rowp = act + (size_t)(r0 + ai * 128 + m * 16) * DFF + (c0 >> 1);
#pragma unroll
                for (int bj = 0; bj < 2; ++bj) { const f32x4 v0 = acc[ai][bj][m][0] + bv[bj][0], v1 = acc[ai][bj][m][1] + bv[bj][1];
                    float o[4];
#pragma unroll
                    for (int j = 0; j < 4; ++j) { const float hg = (j < 2) ? v0[2 * j] : v1[2 * j - 4], hl = (j < 2) ? v0[2 * j + 1] : v1[2 * j - 3];
                        const float glu = fminf(hg, 7.0f), lin = fminf(fmaxf(hl, -7.0f), 7.0f); o[j] = glu * sigmoidf_(1.702f * glu) * (lin + 1.0f); }
                    u32x2 w; w.x = cvt_pk_bf16(o[0], o[1]); w.y = cvt_pk_bf16(o[2], o[3]); *(u32x2*)(rowp + bj * 64) = w; } }
    }
};
struct EpiDown {
    const float* bdn; const unsigned* etok; bf16_t* ye;
    __device__ __forceinline__ void operator()(const f32x4 (&acc)[2][2][4][2], const pg8::Unit& u, int wr, int wc, int fr, int fq) const {
        const int e = u.mode, pn = u.ldc, rl0 = u.x0 * 256 + wr * 64 + fr, cnt = u.x2, c0 = pn * 256 + wc * 32 + 8 * fq;
        f32x4 bv[2][2];
#pragma unroll
        for (int bj = 0; bj < 2; ++bj) { const float* bp = bdn + (size_t)e * DM + c0 + bj * 128; bv[bj][0] = *(const f32x4*)bp; bv[bj][1] = *(const f32x4*)(bp + 4); }
        unsigned dest[2][4];
#pragma unroll
        for (int ai = 0; ai < 2; ++ai)
#pragma unroll
            for (int m = 0; m < 4; ++m) { const int rl = rl0 + ai * 128 + m * 16; dest[ai][m] = (rl < cnt) ? etok[(size_t)e * T + rl] : 0xffffffffu; }
#pragma unroll
        for (int ai = 0; ai < 2; ++ai)
#pragma unroll
            for (int m = 0; m < 4; ++m) { if (dest[ai][m] != 0xffffffffu) { bf16_t* rowp = ye + (size_t)dest[ai][m] * DM + c0;
#pragma unroll
                for (int bj = 0; bj < 2; ++bj) { const f32x4 v0 = acc[ai][bj][m][0] + bv[bj][0], v1 = acc[ai][bj][m][1] + bv[bj][1];
                    u32x4 w; w.x = cvt_pk_bf16(v0[0], v0[1]); w.y = cvt_pk_bf16(v0[2], v0[3]); w.z = cvt_pk_bf16(v1[0], v1[1]); w.w = cvt_pk_bf16(v1[2], v1[3]);
                    *(u32x4*)(rowp + bj * 128) = w; } } }
    }
};

__device__ __forceinline__ void phase_proj(const Params& p, LAS unsigned char* lds, int layer, int bid, int nb) {
    ProjSched S; S.G = nb; S.c = bid; S.kind = layer % 3;
    S.xb = (const char*)WSP(bf16_t, WS_XB); S.win = (const char*)(WSP(bf16_t, WS_WIN) + (size_t)layer * (10 * MiB / 2)); S.memb = (const char*)WSP(bf16_t, WS_MEMB);
    S.wkv = (const char*)(WSP(bf16_t, WS_WKV) + (size_t)layer * 1024 * DM);
    S.pa = (char*)WSP(bf16_t, WS_PA); S.pb = (char*)WSP(bf16_t, WS_PB); S.pvt = (char*)WSP(bf16_t, WS_PVT); S.pz = (char*)WSP(float, WS_PZ); S.pmq = (char*)WSP(bf16_t, WS_PMQ);
    S.memk = (char*)WSP(bf16_t, WS_MEMK); S.memvt = (char*)WSP(bf16_t, WS_MEMVT);
    EpiStore E;
    pg8::gemm_phase<EpiStore, ProjSched, false>(lds + LDS_STAGE, DM, S, E, nullptr);
}
__device__ __forceinline__ void phase_outproj(const Params& p, LAS unsigned char* lds, int layer, int bid, int nb) {
    OutSched S{nb, bid, (const char*)WSP(bf16_t, WS_MIX), (const char*)(WSP(bf16_t, WS_WOUT) + (size_t)layer * DM * OUT_IN)};
    EpiResid E{layer == 0 ? p.in[I_X] : WSP(float, WS_XF), WSP(float, WS_Y1)};
    pg8::gemm_phase<EpiResid, OutSched, false>(lds + LDS_STAGE, OUT_IN, S, E, nullptr);
}
__device__ __forceinline__ void moe_build_units(const Params& p, LAS unsigned char* lds, int layer, int bid, int nb, int npn, bool up) {
    LAS int* misc = (LAS int*)(lds + LDS_MISC); LAS int* ut = misc + 16; LAS int* pre = misc + 160; LAS int* cnts = misc + 200;
    LAS unsigned* gtab = (LAS unsigned*)(lds + LDS_GTAB);
    const int tid = tid_();
    const unsigned* ecnt = ctl(p) + CW_ECNT + layer * 32;
    if (tid < 32) cnts[tid] = (int)__hip_atomic_load(ecnt + tid, __ATOMIC_RELAXED, __HIP_MEMORY_SCOPE_AGENT);
    __syncthreads();
    if (tid == 0) { int s = 0; for (int e = 0; e < 32; ++e) { pre[e] = s; s += (cnts[e] + 255) >> 8; } pre[32] = s; }
    __syncthreads();
    if (tid < 16) { const int i = tid, nblk = pre[32]; int rbg, pn;
        if (nb == 256) { const int x = bid & 7, slot = bid >> 3, rpr = 32 / npn; rbg = i * (8 * rpr) + x * rpr + slot / npn; pn = slot % npn; }
        else { const int L = i * nb + bid; rbg = L / npn; pn = L % npn; }
        LAS int* t = ut + i * 8;
        if (rbg < nblk) { int e = 0; while (pre[e + 1] <= rbg) ++e; t[0] = 1; t[1] = e; t[2] = rbg - pre[e]; t[3] = rbg; t[4] = pn; t[5] = cnts[e]; }
        else { t[0] = 0; t[1] = 0; t[2] = 0; t[3] = 0; t[4] = 0; t[5] = 0; } }
    __syncthreads();
    if (up) { const unsigned* etok = WSP(unsigned, WS_ETOK);
        for (int idx = tid; idx < 16 * 256; idx += NTHR) { const int i = idx >> 8, r = idx & 255; const LAS int* t = ut + i * 8; unsigned off = 0;
            if (t[0]) { const int rl = t[2] * 256 + r; if (rl < t[5]) off = (etok[(size_t)t[1] * T + rl] >> 2) * (unsigned)(DM * 2); }
            gtab[idx] = off; }
        __syncthreads(); }
}
__device__ __forceinline__ void phase_moe_up(const Params& p, LAS unsigned char* lds, int layer, int bid, int nb) {
    moe_build_units(p, lds, layer, bid, nb, 8, true);
    MoeSched S{(const LAS int*)(lds + LDS_MISC) + 16, (const char*)WSP(bf16_t, WS_X1B), (const char*)(WSP(bf16_t, WS_WUP) + (size_t)layer * NEXP * 2 * DFF * DM), 1};
    EpiUp E{p.in[I_BUP] + (size_t)layer * NEXP * 2 * DFF, WSP(bf16_t, WS_ACT)};
    pg8::gemm_phase<EpiUp, MoeSched, true>(lds + LDS_STAGE, DM, S, E, (const LAS unsigned*)(lds + LDS_GTAB));
}
__device__ __forceinline__ void phase_moe_down(const Params& p, LAS unsigned char* lds, int layer, int bid, int nb) {
    moe_build_units(p, lds, layer, bid, nb, 4, false);
    MoeSched S{(const LAS int*)(lds + LDS_MISC) + 16, (const char*)WSP(bf16_t, WS_ACT), (const char*)(WSP(bf16_t, WS_WDN) + (size_t)layer * NEXP * DM * DFF), 0};
    EpiDown E{p.in[I_BDN] + (size_t)layer * NEXP * DM, WSP(unsigned, WS_ETOK), WSP(bf16_t, WS_YE)};
    pg8::gemm_phase<EpiDown, MoeSched, false>(lds + LDS_STAGE, DFF, S, E, nullptr);
}

constexpr int AT_K0 = 0, AT_V0 = 32768, AT_AUX = 65536;
__device__ __forceinline__ int kswz(int row, int ch) { return row * 256 + ((ch ^ ((row & 3) | (((row >> 3) & 3) << 2))) << 4); }
__device__ __forceinline__ int vswz(int row, int ch) { return row * 128 + ((ch ^ (((row >> 1) & 1) | (((row >> 3) & 3) << 1))) << 4); }
struct AttnBias { float cq; int qpos; const LAS float* tab; int kpos0; int qmin; };
template <int MODE>
__device__ __forceinline__ void attn_tiles(LAS unsigned char* lds, const bf16_t* kbase, int ldk, const bf16_t* vtbase, int ldv, int ntiles, int wave_nt,
                                           const bf16x8 (&qf)[8], f32x16 (&o)[4], float& m, float& l, const AttnBias& B) {
    const int tid = tid_(), lane = tid & 63, w = __builtin_amdgcn_readfirstlane(tid >> 6), r = lane & 31, hi = lane >> 5;
    int koff[2], voff[2];
#pragma unroll
    for (int i = 0; i < 2; ++i) { const int pz = (w * 2 + i) * 64 + lane;
        { const int row = pz >> 4, chp = pz & 15, ch = chp ^ ((row & 3) | (((row >> 3) & 3) << 2)); koff[i] = row * ldk + ch * 8; }
        { const int row = pz >> 3, chp = pz & 7, ch = chp ^ (((row >> 1) & 1) | (((row >> 3) & 3) << 1)); voff[i] = row * ldv + ch * 8; } }
    const int pr = (r & ~12) | ((r & 4) << 1) | ((r & 8) >> 1);
    int kaddr[8], vaddr[4];
#pragma unroll
    for (int ks = 0; ks < 8; ++ks) kaddr[ks] = kswz(pr, 2 * ks + hi);
#pragma unroll
    for (int s_ = 0; s_ < 4; ++s_) vaddr[s_] = vswz(r, 2 * s_ + hi);
#define AT_DMA(t, buf) do { _Pragma("unroll") for (int _i = 0; _i < 2; ++_i) { \
        __builtin_amdgcn_global_load_lds((const unsigned*)(kbase + (size_t)(t) * 64 * ldk + koff[_i]), (LAS unsigned*)(lds + AT_K0 + (buf) * 16384 + (w * 2 + _i) * 1024), 16, 0, 0); \
        __builtin_amdgcn_global_load_lds((const unsigned*)(vtbase + (t) * 64 + voff[_i]), (LAS unsigned*)(lds + AT_V0 + (buf) * 16384 + (w * 2 + _i) * 1024), 16, 0, 0); } } while (0)
    AT_DMA(0, 0);
    asm volatile("s_waitcnt vmcnt(0)" ::: "memory");
    __syncthreads();
    constexpr float C = QK_SCALE * LOG2E;
    const float NEG = -__builtin_inff();
    for (int t = 0; t < ntiles; ++t) {
        const int buf = t & 1;
        if (t + 1 < ntiles) AT_DMA(t + 1, buf ^ 1);
        if (t < wave_nt) {
            f32x16 s0, s1;
#pragma unroll
            for (int i = 0; i < 16; ++i) { s0[i] = 0.f; s1[i] = 0.f; }
            const LAS unsigned char* kb = lds + AT_K0 + buf * 16384;
#pragma unroll
            for (int kg = 0; kg < 4; ++kg) {
#pragma unroll
                for (int k2 = 0; k2 < 2; ++k2) { const int ks = 2 * kg + k2;
                    const bf16x8 k0 = *(const LAS bf16x8*)(kb + kaddr[ks]), k1 = *(const LAS bf16x8*)(kb + kaddr[ks] + 8192);
                    s0 = __builtin_amdgcn_mfma_f32_32x32x16_bf16(k0, qf[ks], s0, 0, 0, 0);
                    s1 = __builtin_amdgcn_mfma_f32_32x32x16_bf16(k1, qf[ks], s1, 0, 0, 0); }
                __builtin_amdgcn_sched_barrier(0);
            }
            float mx = NEG;
            if (MODE == 0) {
#pragma unroll
                for (int i = 0; i < 16; ++i) { s0[i] *= C; s1[i] *= C; mx = fmaxf(mx, fmaxf(s0[i], s1[i])); }
            } else if (MODE == 1) {
                const int tk = t * 64;
                const bool diag = (tk + 63 > B.qmin);
#pragma unroll
                for (int g = 0; g < 4; ++g) {
                    const int kq = 16 * (g >> 1) + 8 * hi + 4 * (g & 1);
                    const f32x4 c0 = *(const LAS f32x4*)(B.tab + tk + kq), c1 = *(const LAS f32x4*)(B.tab + tk + 32 + kq);
#pragma unroll
                    for (int j = 0; j < 4; ++j) { const int i = 4 * g + j; float v0 = s0[i] * C + (B.cq - c0[j]), v1 = s1[i] * C + (B.cq - c1[j]);
                        if (diag) { const int ko = tk + kq + j; if (ko > B.qpos) v0 = NEG; if (ko + 32 > B.qpos) v1 = NEG; }
                        s0[i] = v0; s1[i] = v1; mx = fmaxf(mx, fmaxf(v0, v1)); }
                    __builtin_amdgcn_sched_barrier(0);
                }
            } else {
                const int tk = B.kpos0 + t * 64;
                const bool far = (MODE == 2) && (B.qmin - (tk + 63) >= 128);
                if (far) { const float bb = B.tab[128];
#pragma unroll
                    for (int i = 0; i < 16; ++i) { s0[i] = s0[i] * C + bb; s1[i] = s1[i] * C + bb; mx = fmaxf(mx, fmaxf(s0[i], s1[i])); }
                } else {
#pragma unroll
                    for (int i = 0; i < 16; ++i) { const int ko = 16 * (i >> 3) + 8 * hi + (i & 7); const int d0 = B.qpos - (tk + ko), d1 = d0 - 32;
                        float v0 = s0[i] * C + B.tab[d0 < 0 ? 0 : (d0 > 128 ? 128 : d0)], v1 = s1[i] * C + B.tab[d1 < 0 ? 0 : (d1 > 128 ? 128 : d1)];
                        if (MODE == 3) { if (d0 < 0) v0 = NEG; if (d1 < 0) v1 = NEG; }
                        s0[i] = v0; s1[i] = v1; mx = fmaxf(mx, fmaxf(v0, v1)); }
                }
            }
            mx = swap_max(mx);
            const float mn = fmaxf(m, mx), alpha = fast_exp2(m - mn); m = mn;
            float ps = 0.f;
#pragma unroll
            for (int i = 0; i < 16; ++i) { s0[i] = fast_exp2(s0[i] - mn); s1[i] = fast_exp2(s1[i] - mn); ps += s0[i] + s1[i]; }
            ps = swap_sum(ps); l = l * alpha + ps;
            if (!__all(alpha == 1.0f)) {
#pragma unroll
                for (int db = 0; db < 4; ++db)
#pragma unroll
                    for (int i = 0; i < 16; ++i) o[db][i] *= alpha;
            }
            bf16x8 pf[4];
#pragma unroll
            for (int s = 0; s < 4; ++s) { u32x4 wv;
                if (s < 2) { wv.x = cvt_pk_bf16(s0[8 * s + 0], s0[8 * s + 1]); wv.y = cvt_pk_bf16(s0[8 * s + 2], s0[8 * s + 3]); wv.z = cvt_pk_bf16(s0[8 * s + 4], s0[8 * s + 5]); wv.w = cvt_pk_bf16(s0[8 * s + 6], s0[8 * s + 7]); }
                else { const int q = s - 2; wv.x = cvt_pk_bf16(s1[8 * q + 0], s1[8 * q + 1]); wv.y = cvt_pk_bf16(s1[8 * q + 2], s1[8 * q + 3]); wv.z = cvt_pk_bf16(s1[8 * q + 4], s1[8 * q + 5]); wv.w = cvt_pk_bf16(s1[8 * q + 6], s1[8 * q + 7]); }
                pf[s] = *reinterpret_cast<bf16x8*>(&wv); }
            const LAS unsigned char* vb = lds + AT_V0 + buf * 16384;
#pragma unroll
            for (int s = 0; s < 4; ++s) {
#pragma unroll
                for (int db = 0; db < 4; ++db) { const bf16x8 vf = *(const LAS bf16x8*)(vb + vaddr[s] + db * 4096); o[db] = __builtin_amdgcn_mfma_f32_32x32x16_bf16(vf, pf[s], o[db], 0, 0, 0); }
                __builtin_amdgcn_sched_barrier(0);
            }
        }
        asm volatile("s_waitcnt vmcnt(0)" ::: "memory");
        __syncthreads();
    }
#undef AT_DMA
}
__device__ __forceinline__ void attn_init(f32x16 (&o)[4], float& m, float& l) {
#pragma unroll
    for (int db = 0; db < 4; ++db)
#pragma unroll
        for (int i = 0; i < 16; ++i) o[db][i] = 0.f;
    m = -1e30f; l = 0.f;
}
__device__ __forceinline__ void load_q(const bf16_t* qrow, int hi, bf16x8 (&qf)[8]) {
#pragma unroll
    for (int ks = 0; ks < 8; ++ks) qf[ks] = *(const bf16x8*)(qrow + 16 * ks + 8 * hi);
}
__device__ __forceinline__ void store_o(const f32x16 (&o)[4], float sc, bf16_t* orow, int hi) {
#pragma unroll
    for (int db = 0; db < 4; ++db)
#pragma unroll
        for (int g = 0; g < 4; ++g) { u32x2 w; w.x = cvt_pk_bf16(o[db][4 * g] * sc, o[db][4 * g + 1] * sc); w.y = cvt_pk_bf16(o[db][4 * g + 2] * sc, o[db][4 * g + 3] * sc);
            *(u32x2*)(orow + 32 * db + 8 * g + 4 * hi) = w; }
}

__device__ __forceinline__ void phase_memattn(const Params& p, LAS unsigned char* lds, int bid, int nb) {
    const int tid = tid_(), lane = tid & 63, w = tid >> 6, c = lane & 31, hi = lane >> 5;
    for (int u = bid; u < BATCH * MH * 32; u += nb) {
        const int b = u >> 7, mh = (u >> 5) & 3, qb = u & 31;
        const int tok = b * SEQ + qb * 256 + 32 * w + c;
        bf16x8 qf[8]; load_q(WSP(bf16_t, WS_PMQ) + (size_t)tok * MEMW + mh * HD, hi, qf);
        f32x16 o[4]; float m, l; attn_init(o, m, l);
        AttnBias B{0.f, 0, nullptr, 0, 0};
        attn_tiles<0>(lds, WSP(bf16_t, WS_MEMK) + (size_t)b * MEMT * MEMW + mh * HD, MEMW, WSP(bf16_t, WS_MEMVT) + (size_t)mh * HD * 512 + b * MEMT, 512, 4, 4, qf, o, m, l, B);
        store_o(o, 1.0f / l, WSP(bf16_t, WS_MIX) + (size_t)tok * OUT_IN + DM + mh * HD, hi);
    }
}

__device__ __forceinline__ void phase_fox_logf(const Params& p, int layer, int bid, int nb) {
    const int tid = tid_(), lane = tid & 63, w = tid >> 6;
    const float* xin = (layer == 0) ? p.in[I_X] : WSP(float, WS_XF);
    const float* wf = p.in[I_FOX_W] + (size_t)(layer / 3) * DM * FOX_IN + 3072;
    const float* bf = p.in[I_FOX_BF] + (layer / 3) * NH;
    float wr[16][8];
#pragma unroll
    for (int j = 0; j < 4; ++j)
#pragma unroll
        for (int q = 0; q < 4; ++q) { const int k = 256 * j + 4 * lane + q;
#pragma unroll
            for (int h = 0; h < 8; ++h) wr[4 * j + q][h] = wf[(size_t)k * FOX_IN + h]; }
    for (int tok = bid * NWAVES + w; tok < T; tok += nb * NWAVES) {
        float acc[8];
#pragma unroll
        for (int h = 0; h < 8; ++h) acc[h] = 0.f;
#pragma unroll
        for (int j = 0; j < 4; ++j) { const f32x4 xv = *(const f32x4*)(xin + (size_t)tok * DM + 256 * j + 4 * lane);
#pragma unroll
            for (int q = 0; q < 4; ++q)
#pragma unroll
                for (int h = 0; h < 8; ++h) acc[h] = fmaf(xv[q], wr[4 * j + q][h], acc[h]); }
#pragma unroll
        for (int h = 0; h < 8; ++h) acc[h] = wave_sum(acc[h]);
        if (lane < 8) { float z = 0.f;
#pragma unroll
            for (int h = 0; h < 8; ++h) z = (lane == h) ? acc[h] : z;
            const int b = tok / SEQ, s = tok % SEQ;
            WSP(float, WS_LOGF)[((size_t)b * NH + lane) * SEQ + s] = logsigmoidf_(z + bf[lane]) * LOG2E; }
    }
}
__device__ __forceinline__ void phase_fox_attn(const Params& p, LAS unsigned char* lds, int bid, int nb) {
    const int tid = tid_(), lane = tid & 63, w = tid >> 6, c = lane & 31, hi = lane >> 5;
    LAS float* c2 = (LAS float*)(lds + AT_AUX);
    LAS float* wtot = (LAS float*)(lds + AT_AUX + 32768);
    for (int item = bid; item < 256; item += nb) {
        const int bh = item >> 4, pr = item & 15, b = bh >> 3, h = bh & 7;
        for (int half = 0; half < 2; ++half) {
            const int qb = half == 0 ? 31 - pr : pr;
            const int n = (qb + 1) * 256;
            __syncthreads();
            {
                const float* src = WSP(float, WS_LOGF) + (size_t)bh * SEQ; const int i0 = tid * 16;
                float v[16]; float run = 0.f;
                if (i0 < n) {
#pragma unroll
                    for (int j = 0; j < 4; ++j) { const f32x4 x = *(const f32x4*)(src + i0 + 4 * j); v[4 * j] = x[0]; v[4 * j + 1] = x[1]; v[4 * j + 2] = x[2]; v[4 * j + 3] = x[3]; }
#pragma unroll
                    for (int j = 0; j < 16; ++j) { run += v[j]; v[j] = run; }
                }
                float inc = run;
#pragma unroll
                for (int o_ = 1; o_ < 64; o_ <<= 1) { const float y = __shfl_up(inc, o_); if (lane >= o_) inc += y; }
                if (lane == 63) wtot[w] = inc;
                __syncthreads();
                float base = inc - run;
                for (int q = 0; q < w; ++q) base += wtot[q];
                if (i0 < n) {
#pragma unroll
                    for (int j = 0; j < 16; ++j) c2[i0 + j] = v[j] + base; }
                __syncthreads();
            }
            const int qpos = qb * 256 + 32 * w + c, tok = b * SEQ + qpos;
            bf16x8 qf[8]; load_q(WSP(bf16_t, WS_PA) + (size_t)tok * DM + h * HD, hi, qf);
            f32x16 o[4]; float m, l; attn_init(o, m, l);
            AttnBias B{c2[qpos], qpos, c2, 0, qb * 256 + 32 * w};
            const int wave_nt = ((qb * 256 + 32 * w + 31) >> 6) + 1;
            attn_tiles<1>(lds, WSP(bf16_t, WS_PB) + (size_t)b * SEQ * DM + h * HD, DM, WSP(bf16_t, WS_PVT) + (size_t)h * HD * T + (size_t)b * SEQ, T, (qb + 1) * 4, wave_nt, qf, o, m, l, B);
            store_o(o, 1.0f / l, WSP(bf16_t, WS_MIX) + (size_t)tok * OUT_IN + h * HD, hi);
        }
    }
}

__device__ __forceinline__ int t5_bucket(int n) {
    if (n < 16) return n;
    const int v = 16 + (int)(__log2f((float)n * (1.0f / 16.0f)) * (16.0f / 3.0f));
    return v < 31 ? v : 31;
}
__device__ __forceinline__ void phase_moba_kmean(const Params& p, LAS unsigned char* lds, int bid, int nb) {
    const int tid = tid_(); LAS float* red = (LAS float*)lds;
    const int dp = tid & 63, kg = tid >> 6;
    for (int u = bid; u < 512; u += nb) {
        const int bh = u >> 5, j = u & 31, b = bh >> 3, h = bh & 7;
        const bf16_t* kp = WSP(bf16_t, WS_PB) + ((size_t)b * SEQ + j * 256 + kg * 32) * DM + h * HD + 2 * dp;
        float s0 = 0.f, s1 = 0.f;
#pragma unroll 8
        for (int k = 0; k < 32; ++k) { const unsigned wv = *(const unsigned*)(kp + (size_t)k * DM); s0 += bflo(wv); s1 += bfhi(wv); }
        __syncthreads();
        red[kg * 128 + 2 * dp] = s0; red[kg * 128 + 2 * dp + 1] = s1;
        __syncthreads();
        if (tid < 128) { float s = 0.f;
#pragma unroll
            for (int g = 0; g < 8; ++g) s += red[g * 128 + tid];
            WSP(float, WS_KMEAN)[(size_t)u * 128 + tid] = s * (1.0f / 256.0f); }
    }
}
__device__ __forceinline__ void phase_moba_gate(const Params& p, LAS unsigned char* lds, int bid, int nb) {
    const int tid = tid_(); LAS float* km = (LAS float*)lds;
    LAS int* lcnt = (LAS int*)(lds + 16384); LAS int* lbase = lcnt + 32;
    unsigned* gl = ctl(p) + CW_LCNT;
    for (int u = bid; u < 512; u += nb) {
        const int bh = u >> 5, own = u & 31, b = bh >> 3, h = bh & 7;
        __syncthreads();
        for (int i = tid; i < 32 * 128; i += NTHR) km[i] = WSP(float, WS_KMEAN)[(size_t)bh * 32 * 128 + i];
        if (tid < 32) lcnt[tid] = 0;
        __syncthreads();
        int sel[3] = {-1, -1, -1}, rank[3] = {0, 0, 0}; int nv = 0;
        const int q = own * 256 + (tid & 255);
        if (tid < 256) {
            const bf16_t* qp = WSP(bf16_t, WS_PA) + ((size_t)b * SEQ + q) * DM + h * HD;
            unsigned qw[64];
#pragma unroll
            for (int i = 0; i < 16; ++i) { const u32x4 x = *(const u32x4*)(qp + 8 * i); qw[4 * i] = x.x; qw[4 * i + 1] = x.y; qw[4 * i + 2] = x.z; qw[4 * i + 3] = x.w; }
            float best[3] = {-__builtin_inff(), -__builtin_inff(), -__builtin_inff()};
            for (int j = 0; j < own; ++j) { const LAS float* kr = km + j * 128; float g = 0.f;
#pragma unroll
                for (int i = 0; i < 64; ++i) { g = fmaf(bflo(qw[i]), kr[2 * i], g); g = fmaf(bfhi(qw[i]), kr[2 * i + 1], g); }
                if (g > best[0]) { best[2] = best[1]; sel[2] = sel[1]; best[1] = best[0]; sel[1] = sel[0]; best[0] = g; sel[0] = j; }
                else if (g > best[1]) { best[2] = best[1]; sel[2] = sel[1]; best[1] = g; sel[1] = j; }
                else if (g > best[2]) { best[2] = g; sel[2] = j; } }
            nv = own < 3 ? own : 3;
            for (int s = 0; s < 3; ++s) if (s < nv) rank[s] = atomicAdd((int*)&lcnt[sel[s]], 1);
            int* sp = WSP(int, WS_SEL) + (((size_t)b * SEQ + q) * NH + h) * 4; sp[0] = sel[0]; sp[1] = sel[1]; sp[2] = sel[2]; sp[3] = nv;
        }
        __syncthreads();
        if (tid < 32) lbase[tid] = lcnt[tid] ? (int)atomicAdd(gl + bh * 32 + tid, (unsigned)lcnt[tid]) : 0;
        __syncthreads();
        if (tid < 256) for (int s = 0; s < 3; ++s) if (s < nv) WSP(unsigned, WS_LISTS)[((size_t)bh * 32 + sel[s]) * 8192 + lbase[sel[s]] + rank[s]] = (unsigned)q | ((unsigned)s << 16);
    }
}
__device__ __forceinline__ void moba_bias_tab(const Params& p, LAS float* tab, int h) {
    const int tid = tid_();
    if (tid <= 128) tab[tid] = p.in[I_RELB][t5_bucket(tid) * NH + h] * LOG2E;
}
__device__ __forceinline__ void phase_moba_past(const Params& p, LAS unsigned char* lds, int bid, int nb) {
    const int tid = tid_(), lane = tid & 63, w = tid >> 6, c = lane & 31, hi = lane >> 5;
    LAS float* tab = (LAS float*)(lds + AT_AUX); LAS int* pre = (LAS int*)(lds + AT_AUX + 1024);
    LAS int* wsum = (LAS int*)(lds + AT_AUX + 1024 + 4096);
    const unsigned* gl = ctl(p) + CW_LCNT;
    {
        const int n = (int)__hip_atomic_load(gl + tid, __ATOMIC_RELAXED, __HIP_MEMORY_SCOPE_AGENT); const int nu = (n + 255) >> 8;
        int inc = nu;
#pragma unroll
        for (int o_ = 1; o_ < 64; o_ <<= 1) { const int y = __shfl_up(inc, o_); if (lane >= o_) inc += y; }
        if (lane == 63) wsum[w] = inc;
        __syncthreads();
        int base = inc - nu; for (int q = 0; q < w; ++q) base += wsum[q];
        pre[tid] = base; if (tid == 511) pre[512] = base + nu;
        __syncthreads();
    }
    const int total = pre[512];
    int cur_h = -1;
    for (int u = bid; u < total; u += nb) {
        int lo = 0, hiL = 511;
        while (lo < hiL) { const int mid = (lo + hiL + 1) >> 1; if (pre[mid] <= u) lo = mid; else hiL = mid - 1; }
        const int list = lo, chunk = u - pre[list], bh = list >> 5, j = list & 31, b = bh >> 3, h = bh & 7;
        const int n = (int)__hip_atomic_load(gl + list, __ATOMIC_RELAXED, __HIP_MEMORY_SCOPE_AGENT);
        if (h != cur_h) { __syncthreads(); moba_bias_tab(p, tab, h); cur_h = h; __syncthreads(); }
        const int e0 = chunk * 256 + 32 * w; const bool active = e0 < n;
        int ei = e0 + c; if (ei > n - 1) ei = n - 1;
        const unsigned ent = WSP(unsigned, WS_LISTS)[(size_t)list * 8192 + ei]; const int q = ent & 0xffff, slot = ent >> 16;
        const int tok = b * SEQ + q;
        bf16x8 qf[8]; load_q(WSP(bf16_t, WS_PA) + (size_t)tok * DM + h * HD, hi, qf);
        int qmin = q;
#pragma unroll
        for (int o_ = 1; o_ < 64; o_ <<= 1) { const int y = __shfl_xor(qmin, o_); qmin = y < qmin ? y : qmin; }
        f32x16 o[4]; float m, l; attn_init(o, m, l);
        AttnBias B{0.f, q, tab, j * 256, qmin};
        attn_tiles<2>(lds, WSP(bf16_t, WS_PB) + ((size_t)b * SEQ + j * 256) * DM + h * HD, DM, WSP(bf16_t, WS_PVT) + (size_t)h * HD * T + (size_t)b * SEQ + j * 256, T, 4, active ? 4 : 0, qf, o, m, l, B);
        if (active) { const size_t P = ((size_t)tok * NH + h) * 3 + slot;
            store_o(o, 1.0f / l, WSP(bf16_t, WS_PARTO) + P * HD, hi);
            if (hi == 0) WSP(float, WS_PARTL)[P] = m + __log2f(l); }
    }
}
__device__ __forceinline__ void phase_moba_own(const Params& p, LAS unsigned char* lds, int bid, int nb) {
    const int tid = tid_(), lane = tid & 63, w = tid >> 6, c = lane & 31, hi = lane >> 5;
    LAS float* tab = (LAS float*)(lds + AT_AUX);
    int cur_h = -1;
    for (int u = bid; u < 512; u += nb) {
        const int bh = u >> 5, blk = u & 31, b = bh >> 3, h = bh & 7;
        if (h != cur_h) { __syncthreads(); moba_bias_tab(p, tab, h); cur_h = h; __syncthreads(); }
        const int qrel = 32 * w + c, q = blk * 256 + qrel, tok = b * SEQ + q;
        bf16x8 qf[8]; load_q(WSP(bf16_t, WS_PA) + (size_t)tok * DM + h * HD, hi, qf);
        f32x16 o[4]; float m, l; attn_init(o, m, l);
        AttnBias B{0.f, qrel, tab, 0, 32 * w};
        attn_tiles<3>(lds, WSP(bf16_t, WS_PB) + ((size_t)b * SEQ + blk * 256) * DM + h * HD, DM, WSP(bf16_t, WS_PVT) + (size_t)h * HD * T + (size_t)b * SEQ + blk * 256, T, 4, (w >> 1) + 1, qf, o, m, l, B);
        const int* sp = WSP(int, WS_SEL) + ((size_t)tok * NH + h) * 4; const int nv = sp[3];
        const size_t P = ((size_t)tok * NH + h) * 3;
        float lse[3], M = m;
#pragma unroll
        for (int s = 0; s < 3; ++s) { lse[s] = (s < nv) ? WSP(float, WS_PARTL)[P + s] : -__builtin_inff(); M = fmaxf(M, lse[s]); }
        const float wo = fast_exp2(m - M); float den = l * wo;
#pragma unroll
        for (int db = 0; db < 4; ++db)
#pragma unroll
            for (int i = 0; i < 16; ++i) o[db][i] *= wo;
#pragma unroll
        for (int s = 0; s < 3; ++s) { if (s < nv) { const float ws_ = fast_exp2(lse[s] - M); den += ws_; const bf16_t* po = WSP(bf16_t, WS_PARTO) + (P + s) * HD;
#pragma unroll
                for (int db = 0; db < 4; ++db)
#pragma unroll
                    for (int g = 0; g < 4; ++g) { const u32x2 x = *(const u32x2*)(po + 32 * db + 8 * g + 4 * hi);
                        o[db][4 * g] += ws_ * bflo(x.x); o[db][4 * g + 1] += ws_ * bfhi(x.x); o[db][4 * g + 2] += ws_ * bflo(x.y); o[db][4 * g + 3] += ws_ * bfhi(x.y); } } }
        store_o(o, 1.0f / den, WSP(bf16_t, WS_MIX) + (size_t)tok * OUT_IN + h * HD, hi);
    }
}

__device__ __forceinline__ void phase_hgrn_pre(const Params& p, int layer, int bid, int nb) {
    const int jj = layer / 3;
    const float* lbp = p.in[I_HGRN_LB];
    for (int gid = bid * NTHR + tid_(); gid < 256 * 512; gid += nb * NTHR) {
        const int crow = gid >> 9, cp = gid & 511, ch = 2 * cp;
        const int b = crow >> 7, cc = crow & 127; const size_t tok0 = (size_t)b * SEQ + cc * 64;
        float lb[2];
#pragma unroll
        for (int e = 0; e < 2; ++e) lb[e] = (jj == 0) ? 0.f : sigmoidf_(lbp[DM + ch + e] - lbp[ch + e]);
        const float* zp = WSP(float, WS_PZ) + tok0 * DM + ch;
        float bmid[2] = {0.f, 0.f}, run[2] = {0.f, 0.f};
        for (int t = 0; t < 64; ++t) { const f32x2 z = *(const f32x2*)(zp + (size_t)t * DM);
#pragma unroll
            for (int e = 0; e < 2; ++e) { const float ls = logsigmoidf_(z[e]); const float lf = (lb[e] == 0.f) ? ls : __logf(lb[e] + (1.f - lb[e]) * __expf(ls)); run[e] += lf; }
            if (t == 31) { bmid[0] = run[0]; bmid[1] = run[1]; } }
        const float blast[2] = {run[0], run[1]};
        run[0] = 0.f; run[1] = 0.f;
        const unsigned* qp = (const unsigned*)(WSP(bf16_t, WS_PA) + tok0 * DM + ch);
        unsigned* qb = (unsigned*)(WSP(bf16_t, WS_HQB) + tok0 * DM + ch); unsigned* qr = (unsigned*)(WSP(bf16_t, WS_HQR) + tok0 * DM + ch); unsigned* kr = (unsigned*)(WSP(bf16_t, WS_HKR) + tok0 * DM + ch);
        bf16_t* kd0 = WSP(bf16_t, WS_HKDT) + (size_t)ch * T + tok0; bf16_t* kd1 = kd0 + T;
        float kdv[2][8];
        for (int t8 = 0; t8 < 8; ++t8) {
#pragma unroll
            for (int tt = 0; tt < 8; ++tt) { const int t = t8 * 8 + tt; const f32x2 z = *(const f32x2*)(zp + (size_t)t * DM); const unsigned qw = qp[(size_t)t * (DM / 2)];
                float o_qb[2], o_qr[2], o_kr[2];
#pragma unroll
                for (int e = 0; e < 2; ++e) { const float ls = logsigmoidf_(z[e]); const float lf = (lb[e] == 0.f) ? ls : __logf(lb[e] + (1.f - lb[e]) * __expf(ls)); run[e] += lf;
                    const float kk = (1.f - lb[e]) * sigmoidf_(-z[e]); const float qv = e ? bfhi(qw) : bflo(qw);
                    o_qb[e] = qv * __expf(run[e]); o_qr[e] = qv * __expf(fminf(run[e] - bmid[e], 80.f)); o_kr[e] = kk * __expf(fminf(bmid[e] - run[e], 80.f)); kdv[e][tt] = kk * __expf(blast[e] - run[e]); }
                qb[(size_t)t * (DM / 2)] = cvt_pk_bf16(o_qb[0], o_qb[1]); qr[(size_t)t * (DM / 2)] = cvt_pk_bf16(o_qr[0], o_qr[1]); kr[(size_t)t * (DM / 2)] = cvt_pk_bf16(o_kr[0], o_kr[1]); }
            u32x4 w0, w1;
            w0.x = cvt_pk_bf16(kdv[0][0], kdv[0][1]); w0.y = cvt_pk_bf16(kdv[0][2], kdv[0][3]); w0.z = cvt_pk_bf16(kdv[0][4], kdv[0][5]); w0.w = cvt_pk_bf16(kdv[0][6], kdv[0][7]);
            w1.x = cvt_pk_bf16(kdv[1][0], kdv[1][1]); w1.y = cvt_pk_bf16(kdv[1][2], kdv[1][3]); w1.z = cvt_pk_bf16(kdv[1][4], kdv[1][5]); w1.w = cvt_pk_bf16(kdv[1][6], kdv[1][7]);
            *(u32x4*)(kd0 + t8 * 8) = w0; *(u32x4*)(kd1 + t8 * 8) = w1; }
        const int hh = ch >> 7, d = ch & 127;
        float* gp = WSP(float, WS_HG) + ((size_t)(b * NH + hh) * 128 + cc) * 128 + d; gp[0] = __expf(blast[0]); gp[1] = __expf(blast[1]);
    }
}
__device__ __forceinline__ void phase_hgrn_a(const Params& p, int bid, int nb) {
    const int tid = tid_(), lane = tid & 63, w = tid >> 6, c = lane & 31, hi = lane >> 5, eb = w >> 1, dh = w & 1;
    for (int u = bid; u < 2048; u += nb) {
        const int bh = u >> 7, cc = u & 127, b = bh >> 3, hh = bh & 7; const size_t tok0 = (size_t)b * SEQ + cc * 64;
        const bf16_t* vt = WSP(bf16_t, WS_PVT) + (size_t)(hh * HD + 32 * eb + c) * T + tok0 + 8 * hi;
        const bf16_t* kd = WSP(bf16_t, WS_HKDT) + (size_t)(hh * HD + 64 * dh + c) * T + tok0 + 8 * hi;
        f32x16 a0, a1;
#pragma unroll
        for (int i = 0; i < 16; ++i) { a0[i] = 0.f; a1[i] = 0.f; }
#pragma unroll
        for (int ks = 0; ks < 4; ++ks) { const bf16x8 af = *(const bf16x8*)(vt + 16 * ks), b0 = *(const bf16x8*)(kd + 16 * ks), b1 = *(const bf16x8*)(kd + (size_t)32 * T + 16 * ks);
            a0 = __builtin_amdgcn_mfma_f32_32x32x16_bf16(af, b0, a0, 0, 0, 0); a1 = __builtin_amdgcn_mfma_f32_32x32x16_bf16(af, b1, a1, 0, 0, 0); }
        float* st = WSP(float, WS_HST) + (size_t)u * 128 * 128;
#pragma unroll
        for (int i = 0; i < 16; ++i) { const int e = 32 * eb + (i & 3) + 8 * (i >> 2) + 4 * hi; st[(size_t)e * 128 + 64 * dh + c] = a0[i]; st[(size_t)e * 128 + 64 * dh + 32 + c] = a1[i]; }
    }
}
__device__ __forceinline__ void phase_hgrn_b(const Params& p, int bid, int nb) {
    for (int gid = bid * NTHR + tid_(); gid < 16 * 128 * 64; gid += nb * NTHR) {
        const int bh = gid >> 13, e = (gid >> 6) & 127, dp = gid & 63;
        float* st = WSP(float, WS_HST) + (size_t)bh * 128 * 16384 + (size_t)e * 128 + 2 * dp; const float* gp = WSP(float, WS_HG) + (size_t)bh * 128 * 128 + 2 * dp;
        f32x2 S = {0.f, 0.f};
#pragma unroll 4
        for (int cc = 0; cc < 128; ++cc) { const f32x2 U = *(const f32x2*)(st + (size_t)cc * 16384), g = *(const f32x2*)(gp + cc * 128);
            *(f32x2*)(st + (size_t)cc * 16384) = S; S = g * S + U; }
    }
}
__device__ __forceinline__ void phase_hgrn_c(const Params& p, int layer, int bid, int nb) {
    const int tid = tid_(), lane = tid & 63, w = tid >> 6, c = lane & 31, hi = lane >> 5;
    const float* ng = p.in[I_HGRN_NG] + (layer / 3) * DM;
    for (int wu = bid * NWAVES + w; wu < 4096; wu += nb * NWAVES) {
        const int u = wu >> 1, tb = wu & 1, bh = u >> 7, cc = u & 127, b = bh >> 3, hh = bh & 7; const size_t tok0 = (size_t)b * SEQ + cc * 64;
        const size_t tokq = tok0 + 32 * tb + c;
        f32x16 o[4];
#pragma unroll
        for (int db = 0; db < 4; ++db)
#pragma unroll
            for (int i = 0; i < 16; ++i) o[db][i] = 0.f;
        {
            bf16x8 qf[8]; load_q(WSP(bf16_t, WS_HQB) + tokq * DM + hh * HD, hi, qf);
            const float* st = WSP(float, WS_HST) + (size_t)u * 16384 + (size_t)c * 128 + 8 * hi;
#pragma unroll
            for (int db = 0; db < 4; ++db)
#pragma unroll
                for (int ks = 0; ks < 8; ++ks) { const float* sp = st + (size_t)(32 * db) * 128 + 16 * ks; const f32x4 x0 = *(const f32x4*)sp, x1 = *(const f32x4*)(sp + 4);
                    u32x4 wv; wv.x = cvt_pk_bf16(x0[0], x0[1]); wv.y = cvt_pk_bf16(x0[2], x0[3]); wv.z = cvt_pk_bf16(x1[0], x1[1]); wv.w = cvt_pk_bf16(x1[2], x1[3]);
                    o[db] = __builtin_amdgcn_mfma_f32_32x32x16_bf16(*reinterpret_cast<bf16x8*>(&wv), qf[ks], o[db], 0, 0, 0); }
        }
        {
            bf16x8 qf[8]; load_q(WSP(bf16_t, WS_HQR) + tokq * DM + hh * HD, hi, qf);
            for (int kb = 0; kb <= tb; ++kb) {
                f32x16 s;
#pragma unroll
                for (int i = 0; i < 16; ++i) s[i] = 0.f;
                const bf16_t* kp = WSP(bf16_t, WS_HKR) + (tok0 + 32 * kb + c) * DM + hh * HD + 8 * hi;
#pragma unroll
                for (int ks = 0; ks < 8; ++ks) s = __builtin_amdgcn_mfma_f32_32x32x16_bf16(*(const bf16x8*)(kp + 16 * ks), qf[ks], s, 0, 0, 0);
                if (kb == tb) {
#pragma unroll
                    for (int i = 0; i < 16; ++i) { const int ko = (i & 3) + 8 * (i >> 2) + 4 * hi; if (ko > c) s[i] = 0.f; } }
#pragma unroll
                for (int sq = 0; sq < 2; ++sq) { u32x4 wv; wv.x = cvt_pk_bf16(s[8 * sq], s[8 * sq + 1]); wv.y = cvt_pk_bf16(s[8 * sq + 2], s[8 * sq + 3]); wv.z = cvt_pk_bf16(s[8 * sq + 4], s[8 * sq + 5]); wv.w = cvt_pk_bf16(s[8 * sq + 6], s[8 * sq + 7]);
                    const bf16x8 pf = *reinterpret_cast<bf16x8*>(&wv);
                    const bf16_t* vp = WSP(bf16_t, WS_PVT) + (size_t)(hh * HD + c) * T + tok0 + 32 * kb + 16 * sq + 4 * hi;
#pragma unroll
                    for (int db = 0; db < 4; ++db) { const u32x2 lo = *(const u32x2*)(vp + (size_t)(32 * db) * T), hi2 = *(const u32x2*)(vp + (size_t)(32 * db) * T + 8);
                        u32x4 vv; vv.x = lo.x; vv.y = lo.y; vv.z = hi2.x; vv.w = hi2.y;
                        o[db] = __builtin_amdgcn_mfma_f32_32x32x16_bf16(*reinterpret_cast<bf16x8*>(&vv), pf, o[db], 0, 0, 0); } }
            }
        }
        float ss = 0.f;
#pragma unroll
        for (int db = 0; db < 4; ++db)
#pragma unroll
            for (int i = 0; i < 16; ++i) ss += o[db][i] * o[db][i];
        ss = swap_sum(ss);
        const float rinv = rsqrtf(ss * (1.0f / 128.0f) + RMS_EPS);
        const bf16_t* gt = WSP(bf16_t, WS_PB) + tokq * DM + hh * HD; bf16_t* orow = WSP(bf16_t, WS_MIX) + tokq * OUT_IN + hh * HD;
#pragma unroll
        for (int db = 0; db < 4; ++db)
#pragma unroll
            for (int g = 0; g < 4; ++g) { const int d = 32 * db + 8 * g + 4 * hi; const u32x2 gw = *(const u32x2*)(gt + d); const f32x4 nv = *(const f32x4*)(ng + hh * HD + d);
                u32x2 wv; wv.x = cvt_pk_bf16(o[db][4 * g] * rinv * nv[0] * bflo(gw.x), o[db][4 * g + 1] * rinv * nv[1] * bfhi(gw.x));
                wv.y = cvt_pk_bf16(o[db][4 * g + 2] * rinv * nv[2] * bflo(gw.y), o[db][4 * g + 3] * rinv * nv[3] * bfhi(gw.y));
                *(u32x2*)(orow + d) = wv; }
    }
}

__device__ __forceinline__ void ln_row(f32x4 (&v)[4], const float* g, const float* bta, int lane) {
    float s = 0.f;
#pragma unroll
    for (int j = 0; j < 4; ++j) s += (v[j][0] + v[j][1]) + (v[j][2] + v[j][3]);
    const float mean = wave_sum(s) * (1.0f / DM); float s2 = 0.f;
#pragma unroll
    for (int j = 0; j < 4; ++j) { v[j] = v[j] - mean; s2 += (v[j][0] * v[j][0] + v[j][1] * v[j][1]) + (v[j][2] * v[j][2] + v[j][3] * v[j][3]); }
    const float rstd = rsqrtf(wave_sum(s2) * (1.0f / DM) + LN_EPS);
#pragma unroll
    for (int j = 0; j < 4; ++j) { const f32x4 gg = *(const f32x4*)(g + 256 * j + 4 * lane), bb = *(const f32x4*)(bta + 256 * j + 4 * lane); v[j] = v[j] * rstd * gg + bb; }
}
__device__ __forceinline__ void phase_ln1_router(const Params& p, LAS unsigned char* lds, int layer, int bid, int nb) {
    const int tid = tid_(), lane = tid & 63, w = tid >> 6;
    LAS float* part = (LAS float*)lds;
    LAS float* logit = (LAS float*)(lds + 32768);
    LAS int* asg_e = (LAS int*)(lds + 32768 + 8448 + 64); LAS unsigned* asg_v = (LAS unsigned*)(asg_e + 256);
    const float* g1 = p.in[I_LN1G] + layer * DM; const float* b1 = p.in[I_LN1B] + layer * DM;
    const float* rw = p.in[I_RW] + (size_t)layer * DM * NEXP; const float* rb = p.in[I_RB] + layer * NEXP;
    unsigned* ecnt = ctl(p) + CW_ECNT + layer * 32;
    for (int blk = bid; blk < T / 64; blk += nb) {
        const int row0 = blk * 64;
        for (int rr = 0; rr < 8; ++rr) { const size_t row = row0 + 8 * w + rr; const float* yp = WSP(float, WS_Y1) + row * DM;
            f32x4 v[4];
#pragma unroll
            for (int j = 0; j < 4; ++j) v[j] = *(const f32x4*)(yp + 256 * j + 4 * lane);
            ln_row(v, g1, b1, lane);
#pragma unroll
            for (int j = 0; j < 4; ++j) { *(f32x4*)(WSP(float, WS_X1F) + row * DM + 256 * j + 4 * lane) = v[j];
                u32x2 o; o.x = cvt_pk_bf16(v[j][0], v[j][1]); o.y = cvt_pk_bf16(v[j][2], v[j][3]); *(u32x2*)(WSP(bf16_t, WS_X1B) + row * DM + 256 * j + 4 * lane) = o; } }
        __syncthreads();
        {
            const int rt = w >> 2, kq = w & 3, i = lane & 31, kh = lane >> 5;
            const float* xp = WSP(float, WS_X1F) + (size_t)(row0 + 32 * rt + i) * DM + 256 * kq; const float* wp = rw + (size_t)(256 * kq + kh) * NEXP + i;
            f32x16 acc;
#pragma unroll
            for (int q = 0; q < 16; ++q) acc[q] = 0.f;
#pragma unroll 8
            for (int q = 0; q < 64; ++q) { const f32x4 xv = *(const f32x4*)(xp + 4 * q);
                acc = __builtin_amdgcn_mfma_f32_32x32x2f32(kh ? xv[1] : xv[0], wp[(size_t)(4 * q) * NEXP], acc, 0, 0, 0);
                acc = __builtin_amdgcn_mfma_f32_32x32x2f32(kh ? xv[3] : xv[2], wp[(size_t)(4 * q + 2) * NEXP], acc, 0, 0, 0); }
#pragma unroll
            for (int q = 0; q < 16; ++q) { const int r = (q & 3) + 8 * (q >> 2) + 4 * kh; part[(w * 32 + r) * 32 + i] = acc[q]; }
        }
        __syncthreads();
        for (int o_ = tid; o_ < 64 * 32; o_ += NTHR) { const int r = o_ >> 5, e = o_ & 31, rt = r >> 5, rl = r & 31; float s = rb[e];
#pragma unroll
            for (int kq = 0; kq < 4; ++kq) s += part[((rt * 4 + kq) * 32 + rl) * 32 + e];
            logit[r * 33 + e] = s; }
        __syncthreads();
        if (tid < 64) { const int tok = row0 + tid; float bv[4] = {-__builtin_inff(), -__builtin_inff(), -__builtin_inff(), -__builtin_inff()}; int bi[4] = {0, 0, 0, 0};
            for (int e = 0; e < 32; ++e) { const float x = logit[tid * 33 + e];
                if (x > bv[0]) { bv[3] = bv[2]; bi[3] = bi[2]; bv[2] = bv[1]; bi[2] = bi[1]; bv[1] = bv[0]; bi[1] = bi[0]; bv[0] = x; bi[0] = e; }
                else if (x > bv[1]) { bv[3] = bv[2]; bi[3] = bi[2]; bv[2] = bv[1]; bi[2] = bi[1]; bv[1] = x; bi[1] = e; }
                else if (x > bv[2]) { bv[3] = bv[2]; bi[3] = bi[2]; bv[2] = x; bi[2] = e; }
                else if (x > bv[3]) { bv[3] = x; bi[3] = e; } }
            float ex[4], se = 0.f;
#pragma unroll
            for (int k = 0; k < 4; ++k) { ex[k] = __expf(bv[k] - bv[0]); se += ex[k]; }
#pragma unroll
            for (int k = 0; k < 4; ++k) { WSP(float, WS_GATE)[(size_t)tok * 4 + k] = ex[k] / se; asg_e[tid * 4 + k] = bi[k]; asg_v[tid * 4 + k] = (unsigned)tok * 4u + k; } }
        __syncthreads();
        if (tid < 32) { int cnt = 0;
            for (int a = 0; a < 256; ++a) cnt += (asg_e[a] == tid) ? 1 : 0;
            if (cnt) { unsigned pos = atomicAdd(ecnt + tid, (unsigned)cnt); unsigned* et = WSP(unsigned, WS_ETOK) + (size_t)tid * T;
                for (int a = 0; a < 256; ++a) if (asg_e[a] == tid) et[pos++] = asg_v[a]; } }
        __syncthreads();
    }
}
__device__ __forceinline__ void phase_ln2(const Params& p, int layer, int bid, int nb) {
    const int tid = tid_(), lane = tid & 63, w = tid >> 6;
    const float* g2 = p.in[I_LN2G] + layer * DM; const float* b2 = p.in[I_LN2B] + layer * DM;
    float* dst = (layer == 3) ? p.out : WSP(float, WS_XF);
    for (size_t row = bid * NWAVES + w; row < T; row += (size_t)nb * NWAVES) {
        const float* xp = WSP(float, WS_X1F) + row * DM; const bf16_t* yp = WSP(bf16_t, WS_YE) + row * 4 * DM;
        float gk[4];
#pragma unroll
        for (int k = 0; k < 4; ++k) gk[k] = WSP(float, WS_GATE)[row * 4 + k];
        f32x4 v[4];
#pragma unroll
        for (int j = 0; j < 4; ++j) { v[j] = *(const f32x4*)(xp + 256 * j + 4 * lane) * DN_ALPHA;
#pragma unroll
            for (int k = 0; k < 4; ++k) { const u32x2 y = *(const u32x2*)(yp + (size_t)k * DM + 256 * j + 4 * lane);
                v[j][0] += gk[k] * bflo(y.x); v[j][1] += gk[k] * bfhi(y.x); v[j][2] += gk[k] * bflo(y.y); v[j][3] += gk[k] * bfhi(y.y); } }
        ln_row(v, g2, b2, lane);
#pragma unroll
        for (int j = 0; j < 4; ++j) { *(f32x4*)(dst + row * DM + 256 * j + 4 * lane) = v[j];
            u32x2 o; o.x = cvt_pk_bf16(v[j][0], v[j][1]); o.y = cvt_pk_bf16(v[j][2], v[j][3]); *(u32x2*)(WSP(bf16_t, WS_XB) + row * DM + 256 * j + 4 * lane) = o; }
    }
}

enum { PH_PROLOGUE = 0, PH_PROJ, PH_FOXLOGF, PH_HPRE, PH_HA, PH_HB, PH_HC, PH_FOXATTN, PH_KMEAN, PH_GATE, PH_PAST, PH_OWN, PH_MEMATTN, PH_OUTPROJ, PH_LN1, PH_UP, PH_DOWN, PH_LN2 };
template <int PH>
__device__ __forceinline__ void run_phase(const Params& p, LAS unsigned char* lds, int layer, int bid, int nb) {
    if constexpr (PH == PH_PROLOGUE) phase_prologue(p, lds, bid, nb);
    else if constexpr (PH == PH_PROJ) phase_proj(p, lds, layer, bid, nb);
    else if constexpr (PH == PH_FOXLOGF) phase_fox_logf(p, layer, bid, nb);
    else if constexpr (PH == PH_HPRE) phase_hgrn_pre(p, layer, bid, nb);
    else if constexpr (PH == PH_HA) phase_hgrn_a(p, bid, nb);
    else if constexpr (PH == PH_HB) phase_hgrn_b(p, bid, nb);
    else if constexpr (PH == PH_HC) phase_hgrn_c(p, layer, bid, nb);
    else if constexpr (PH == PH_FOXATTN) phase_fox_attn(p, lds, bid, nb);
    else if constexpr (PH == PH_KMEAN) phase_moba_kmean(p, lds, bid, nb);
    else if constexpr (PH == PH_GATE) phase_moba_gate(p, lds, bid, nb);
    else if constexpr (PH == PH_PAST) phase_moba_past(p, lds, bid, nb);
    else if constexpr (PH == PH_OWN) phase_moba_own(p, lds, bid, nb);
    else if constexpr (PH == PH_MEMATTN) phase_memattn(p, lds, bid, nb);
    else if constexpr (PH == PH_OUTPROJ) phase_outproj(p, lds, layer, bid, nb);
    else if constexpr (PH == PH_LN1) phase_ln1_router(p, lds, layer, bid, nb);
    else if constexpr (PH == PH_UP) phase_moe_up(p, lds, layer, bid, nb);
    else if constexpr (PH == PH_DOWN) phase_moe_down(p, lds, layer, bid, nb);
    else if constexpr (PH == PH_LN2) phase_ln2(p, layer, bid, nb);
}
template <int PH>
__global__ void __launch_bounds__(NTHR, 2) k_phase(Params p, int layer) {
    extern __shared__ __attribute__((aligned(16))) unsigned char lds_raw[];
    run_phase<PH>(p, (LAS unsigned char*)lds_raw, layer, (int)blockIdx.x, (int)gridDim.x);
}

#ifndef DEBUG_CHECKS
#define DEBUG_CHECKS 0
#endif
#if DEBUG_CHECKS
constexpr size_t WS_CHK = WS_END;
__device__ __forceinline__ float bfr(float x) { return bf2f(f2bf(x)); }
__device__ __forceinline__ unsigned hashu(unsigned x) { x ^= x >> 16; x *= 0x7feb352du; x ^= x >> 15; x *= 0x846ca68bu; x ^= x >> 16; return x; }
__device__ __forceinline__ void chk_report(const Params& p, int id, float err) { if (!(err == err)) err = 1e30f; atomicMax(ctl(p) + CW_CHK + id, __float_as_uint(fabsf(err))); }
__device__ __forceinline__ float blk_sum(float v, LAS float* red) {
    v = wave_sum(v); const int w = threadIdx.x >> 6, nw = blockDim.x >> 6; __syncthreads(); if ((threadIdx.x & 63) == 0) red[w] = v; __syncthreads(); float s = 0.f; for (int i = 0; i < nw; ++i) s += red[i]; return s; }
__device__ __forceinline__ float blk_max(float v, LAS float* red) {
#pragma unroll
    for (int o = 1; o < 64; o <<= 1) v = fmaxf(v, __shfl_xor(v, o));
    const int w = threadIdx.x >> 6, nw = blockDim.x >> 6; __syncthreads(); if ((threadIdx.x & 63) == 0) red[w] = v; __syncthreads(); float s = red[0]; for (int i = 1; i < nw; ++i) s = fmaxf(s, red[i]); return s; }

__global__ void chk_proj(Params p, int layer, int id) {
    const int kind = layer % 3, jj = layer / 3; const unsigned sidx = blockIdx.x * blockDim.x + threadIdx.x; const unsigned hsh = hashu(sidx * 2654435761u + layer * 977u + 12345u);
    const int nin = kind == 0 ? HGRN_IN : (kind == 1 ? FOX_IN : MOBA_IN);
    const float* W = kind == 0 ? p.in[I_HGRN_W] + (size_t)jj * DM * HGRN_IN : (kind == 1 ? p.in[I_FOX_W] : p.in[I_MOBA_W]);
    int tok = hsh % T; int col = (hsh >> 14) % (nin + 128);
    float exp_v, got;
    if (col >= nin) {
        const int c = (hashu(hsh) % 1024), row = tok % 512; const float* wk = p.in[I_WKV] + (size_t)layer * DM * 1024; float s = 0.f;
        for (int k = 0; k < DM; ++k) s += bfr(p.in[I_MEM][(size_t)row * DM + k]) * bfr(wk[(size_t)k * 1024 + c]);
        exp_v = s; got = c < 512 ? bf2f(WSP(bf16_t, WS_MEMK)[(size_t)row * 512 + c]) : bf2f(WSP(bf16_t, WS_MEMVT)[(size_t)(c - 512) * 512 + row]);
    } else {
        float s = 0.f, sf = 0.f;
        for (int k = 0; k < DM; ++k) { const float xv = (layer == 0) ? p.in[I_X][(size_t)tok * DM + k] : WSP(float, WS_XF)[(size_t)tok * DM + k]; const float xb = (layer == 0) ? bfr(xv) : bf2f(WSP(bf16_t, WS_XB)[(size_t)tok * DM + k]);
            const float wv = W[(size_t)k * nin + col]; s += xb * bfr(wv); sf += xv * wv; }
        const int sec = col >> 10, c = col & 1023; exp_v = s;
        if (kind == 0) { if (sec == 0) { exp_v = siluf_(s); got = bf2f(WSP(bf16_t, WS_PA)[(size_t)tok * DM + c]); } else if (sec == 1) got = WSP(float, WS_PZ)[(size_t)tok * DM + c];
            else if (sec == 2) got = bf2f(WSP(bf16_t, WS_PVT)[(size_t)c * T + tok]); else if (sec == 3) { exp_v = siluf_(s); got = bf2f(WSP(bf16_t, WS_PB)[(size_t)tok * DM + c]); } else got = bf2f(WSP(bf16_t, WS_PMQ)[(size_t)tok * MEMW + c]); }
        else { if (sec == 0) got = bf2f(WSP(bf16_t, WS_PA)[(size_t)tok * DM + c]); else if (sec == 1) got = bf2f(WSP(bf16_t, WS_PB)[(size_t)tok * DM + c]); else if (sec == 2) got = bf2f(WSP(bf16_t, WS_PVT)[(size_t)c * T + tok]);
            else if (kind == 1 && col < 3080) { exp_v = logsigmoidf_(sf + p.in[I_FOX_BF][jj * NH + (col - 3072)]) * LOG2E; got = WSP(float, WS_LOGF)[((size_t)(tok / SEQ) * NH + (col - 3072)) * SEQ + tok % SEQ]; }
            else got = bf2f(WSP(bf16_t, WS_PMQ)[(size_t)tok * MEMW + (col - (kind == 1 ? 3080 : 3072))]); }
    }
    chk_report(p, id, fabsf(got - exp_v) / (fabsf(exp_v) + 0.05f));
}
__global__ void chk_fox_prep(Params p) { const int bh = threadIdx.x; if (bh < 16) { float s = 0.f; for (int k = 0; k < SEQ; ++k) { s += WSP(float, WS_LOGF)[(size_t)bh * SEQ + k]; WSP(float, WS_CHK)[(size_t)bh * SEQ + k] = s; } } }
__device__ __forceinline__ float chk_softmax_out(const Params& p, LAS float* sc, const LAS int* kp, int n, int b, int h, int tok, LAS float* red) {
    float mx = -1e30f; for (int i = threadIdx.x; i < n; i += blockDim.x) mx = fmaxf(mx, sc[i]); mx = blk_max(mx, red);
    float sm = 0.f; for (int i = threadIdx.x; i < n; i += blockDim.x) { const float e = exp2f(sc[i] - mx); sc[i] = e; sm += e; } sm = blk_sum(sm, red);
    float err = 0.f, mag = 0.f;
    if (threadIdx.x < 128) { const int d = threadIdx.x; float o = 0.f; for (int i = 0; i < n; ++i) o += sc[i] * bf2f(WSP(bf16_t, WS_PVT)[(size_t)(h * HD + d) * T + (size_t)b * SEQ + (kp ? kp[i] : i)]);
        o /= sm; const float got = bf2f(WSP(bf16_t, WS_MIX)[(size_t)tok * OUT_IN + h * HD + d]); err = fabsf(got - o); mag = fabsf(o); }
    err = blk_max(err, red); mag = blk_max(mag, red); return err / (mag + 1e-3f);
}
__global__ void chk_fox(Params p, int id) {
    extern __shared__ __attribute__((aligned(16))) unsigned char sm_raw[]; LAS float* sc = (LAS float*)sm_raw; LAS float* red = sc + 8192;
    const unsigned hsh = hashu(blockIdx.x * 7919u + 17u); const int b = hsh & 1, h = (hsh >> 1) & 7; int q = (hsh >> 4) % SEQ; if (blockIdx.x < 8) q = blockIdx.x * 37; if (blockIdx.x == 8) q = SEQ - 1;
    const int tok = b * SEQ + q; const float* c2 = WSP(float, WS_CHK) + (size_t)(b * NH + h) * SEQ;
    for (int k = threadIdx.x; k <= q; k += blockDim.x) { float s = 0.f; for (int d = 0; d < HD; ++d) s += bf2f(WSP(bf16_t, WS_PA)[(size_t)tok * DM + h * HD + d]) * bf2f(WSP(bf16_t, WS_PB)[((size_t)b * SEQ + k) * DM + h * HD + d]);
        sc[k] = s * QK_SCALE * LOG2E + c2[q] - c2[k]; }
    __syncthreads();
    const float e = chk_softmax_out(p, sc, nullptr, q + 1, b, h, tok, red);
    if (threadIdx.x == 0) chk_report(p, id, e);
}
__global__ void chk_moba(Params p, int id) {
    extern __shared__ __attribute__((aligned(16))) unsigned char sm_raw[]; LAS float* sc = (LAS float*)sm_raw; LAS int* kp = (LAS int*)(sc + 1024); LAS float* km = (LAS float*)(kp + 1024); LAS float* red = km + 32 * 128; LAS float* gate = red + 16; LAS int* selb = (LAS int*)(gate + 32);
    const unsigned hsh = hashu(blockIdx.x * 7919u + 29u); const int b = hsh & 1, h = (hsh >> 1) & 7; int q = (hsh >> 4) % SEQ; if (blockIdx.x < 6) q = blockIdx.x * 173; if (blockIdx.x == 6) q = 256; if (blockIdx.x == 7) q = 1024 + 5;
    const int own = q >> 8, tok = b * SEQ + q;
    for (int idx = threadIdx.x; idx < own * 128; idx += blockDim.x) { const int j = idx >> 7, d = idx & 127; float s = 0.f; for (int k = 0; k < 256; ++k) s += bf2f(WSP(bf16_t, WS_PB)[((size_t)b * SEQ + j * 256 + k) * DM + h * HD + d]); km[idx] = s * (1.0f / 256.0f); }
    __syncthreads();
    if ((int)threadIdx.x < own) { float g = 0.f; for (int d = 0; d < HD; ++d) g += bf2f(WSP(bf16_t, WS_PA)[(size_t)tok * DM + h * HD + d]) * km[threadIdx.x * 128 + d]; gate[threadIdx.x] = g; }
    __syncthreads();
    if (threadIdx.x == 0) { int nsel = own < 3 ? own : 3; for (int s = 0; s < nsel; ++s) { int bj = -1; float bv = -__builtin_inff(); for (int j = 0; j < own; ++j) { bool used = false; for (int r = 0; r < s; ++r) used |= (selb[r] == j); if (!used && gate[j] > bv) { bv = gate[j]; bj = j; } } selb[s] = bj; }
        int n = 0; for (int s = 0; s < nsel; ++s) for (int k = 0; k < 256; ++k) kp[n++] = selb[s] * 256 + k; for (int k = own * 256; k <= q; ++k) kp[n++] = k; selb[3] = n; }
    __syncthreads();
    const int n = selb[3];
    for (int i = threadIdx.x; i < n; i += blockDim.x) { const int k = kp[i]; float s = 0.f; for (int d = 0; d < HD; ++d) s += bf2f(WSP(bf16_t, WS_PA)[(size_t)tok * DM + h * HD + d]) * bf2f(WSP(bf16_t, WS_PB)[((size_t)b * SEQ + k) * DM + h * HD + d]);
        sc[i] = (s * QK_SCALE + p.in[I_RELB][t5_bucket(q - k) * NH + h]) * LOG2E; }
    __syncthreads();
    const float e = chk_softmax_out(p, sc, kp, n, b, h, tok, red);
    if (threadIdx.x == 0) chk_report(p, id, e);
}
__global__ void chk_hgrn(Params p, int layer, int id) {
    extern __shared__ __attribute__((aligned(16))) unsigned char sm_raw[]; LAS float* a = (LAS float*)sm_raw; LAS float* red = a + 512;
    const int jj = layer / 3; const unsigned hsh = hashu(blockIdx.x * 7919u + 41u); const int b = hsh & 1, h = (hsh >> 1) & 7; const int tl[8] = {0, 5, 63, 64, 100, 130, 200, 300}; const int t = tl[blockIdx.x & 7] + ((blockIdx.x >> 3) & 1) * 4096;
    const int t0 = t & ~4095;
    const int d = threadIdx.x, ch = h * HD + d; const float lb = (jj == 0) ? 0.f : sigmoidf_(p.in[I_HGRN_LB][DM + ch] - p.in[I_HGRN_LB][ch]);
    for (int i = d; i < 512; i += 128) a[i] = 0.f;
    __syncthreads();
    if (t0 == 0) {
        float Bt = 0.f; for (int s = 0; s <= t; ++s) { const float z = WSP(float, WS_PZ)[((size_t)b * SEQ + s) * DM + ch]; const float ls = logsigmoidf_(z); Bt += (lb == 0.f) ? ls : logf(lb + (1.f - lb) * expf(ls)); }
        const float qv = bf2f(WSP(bf16_t, WS_PA)[((size_t)b * SEQ + t) * DM + ch]); float Bs = 0.f;
        for (int s = 0; s <= t; ++s) { const float z = WSP(float, WS_PZ)[((size_t)b * SEQ + s) * DM + ch]; const float ls = logsigmoidf_(z); Bs += (lb == 0.f) ? ls : logf(lb + (1.f - lb) * expf(ls));
            const float kk = (1.f - lb) * sigmoidf_(-z); atomicAdd((float*)&a[s], qv * kk * expf(Bt - Bs)); }
        __syncthreads();
        float o = 0.f; for (int s = 0; s <= t; ++s) o += a[s] * bf2f(WSP(bf16_t, WS_PVT)[(size_t)ch * T + (size_t)b * SEQ + s]);
        const float ss = blk_sum(o * o, red); const float rinv = rsqrtf(ss * (1.0f / 128.0f) + RMS_EPS);
        const size_t tok = (size_t)b * SEQ + t; const float ex = o * rinv * p.in[I_HGRN_NG][jj * DM + ch] * bf2f(WSP(bf16_t, WS_PB)[tok * DM + ch]);
        const float got = bf2f(WSP(bf16_t, WS_MIX)[tok * OUT_IN + ch]);
        const float err = blk_max(fabsf(got - ex), red), mag = blk_max(fabsf(ex), red);
        if (threadIdx.x == 0) chk_report(p, id, err / (mag + 1e-3f));
    }
}
__global__ void chk_memattn(Params p, int id) {
    extern __shared__ __attribute__((aligned(16))) unsigned char sm_raw[]; LAS float* sc = (LAS float*)sm_raw; LAS float* red = sc + 256;
    const unsigned hsh = hashu(blockIdx.x * 7919u + 53u); const int tok = hsh % T, mh = (hsh >> 16) & 3, b = tok / SEQ, k = threadIdx.x;
    float s = 0.f; for (int d = 0; d < HD; ++d) s += bf2f(WSP(bf16_t, WS_PMQ)[(size_t)tok * MEMW + mh * HD + d]) * bf2f(WSP(bf16_t, WS_MEMK)[(size_t)(b * MEMT + k) * MEMW + mh * HD + d]);
    sc[k] = s * QK_SCALE * LOG2E; __syncthreads();
    float mx = blk_max(sc[k], red); const float e = exp2f(sc[k] - mx); __syncthreads(); sc[k] = e; const float sm = blk_sum(e, red);
    float err = 0.f, mag = 0.f;
    if (k < 128) { float o = 0.f; for (int i = 0; i < 256; ++i) o += sc[i] * bf2f(WSP(bf16_t, WS_MEMVT)[(size_t)(mh * HD + k) * 512 + b * MEMT + i]); o /= sm;
        const float got = bf2f(WSP(bf16_t, WS_MIX)[(size_t)tok * OUT_IN + DM + mh * HD + k]); err = fabsf(got - o); mag = fabsf(o); }
    err = blk_max(err, red); mag = blk_max(mag, red);
    if (threadIdx.x == 0) chk_report(p, id, err / (mag + 1e-3f));
}
__global__ void chk_out_ln1(Params p, int layer, int id) {
    extern __shared__ __attribute__((aligned(16))) unsigned char sm_raw[]; LAS float* red = (LAS float*)sm_raw;
    const unsigned hsh = hashu(blockIdx.x * 7919u + 67u + layer); const int tok = hsh % T; const float* wo = p.in[I_WOUT] + (size_t)layer * OUT_IN * DM; const float* xr = layer == 0 ? p.in[I_X] : WSP(float, WS_XF);
    float y[2];
    for (int e = 0; e < 2; ++e) { const int c = threadIdx.x + 512 * e; float s = 0.f; for (int k = 0; k < OUT_IN; ++k) s += bf2f(WSP(bf16_t, WS_MIX)[(size_t)tok * OUT_IN + k]) * bfr(wo[(size_t)k * DM + c]); y[e] = s + DN_ALPHA * xr[(size_t)tok * DM + c]; }
    const float mean = blk_sum(y[0] + y[1], red) * (1.0f / DM); const float var = blk_sum((y[0] - mean) * (y[0] - mean) + (y[1] - mean) * (y[1] - mean), red) * (1.0f / DM); const float rstd = rsqrtf(var + LN_EPS);
    float err = 0.f;
    for (int e = 0; e < 2; ++e) { const int c = threadIdx.x + 512 * e; const float x1 = (y[e] - mean) * rstd * p.in[I_LN1G][layer * DM + c] + p.in[I_LN1B][layer * DM + c]; err = fmaxf(err, fabsf(x1 - WSP(float, WS_X1F)[(size_t)tok * DM + c])); }
    err = blk_max(err, red); if (threadIdx.x == 0) chk_report(p, id, err);
}
__global__ void chk_moe(Params p, int layer, int id) {
    extern __shared__ __attribute__((aligned(16))) unsigned char sm_raw[]; LAS float* hb = (LAS float*)sm_raw; LAS float* act = hb + 2048; LAS float* red = act + 1024; LAS float* lg = red + 16; LAS float* gt = lg + 32; LAS int* ei = (LAS int*)(gt + 4);
    const unsigned hsh = hashu(blockIdx.x * 7919u + 79u + layer); const int tok = hsh % T; const int tid = threadIdx.x;
    if (tid < 32) { float s = p.in[I_RB][layer * NEXP + tid]; for (int k = 0; k < DM; ++k) s += WSP(float, WS_X1F)[(size_t)tok * DM + k] * p.in[I_RW][((size_t)layer * DM + k) * NEXP + tid]; lg[tid] = s; }
    __syncthreads();
    if (tid == 0) { float v[4]; for (int s = 0; s < 4; ++s) { int bj = -1; float bv = -__builtin_inff(); for (int j = 0; j < 32; ++j) { bool used = false; for (int r = 0; r < s; ++r) used |= (ei[r] == j); if (!used && lg[j] > bv) { bv = lg[j]; bj = j; } } ei[s] = bj; v[s] = bv; }
        float se = 0.f; for (int s = 0; s < 4; ++s) { v[s] = expf(v[s] - lg[ei[0]]); se += v[s]; } for (int s = 0; s < 4; ++s) gt[s] = v[s] / se; }
    __syncthreads();
    float ysum[2] = {0.f, 0.f};
    for (int s = 0; s < 4; ++s) { const int e = ei[s]; const float* wu = p.in[I_WUP] + ((size_t)layer * NEXP + e) * DM * 2 * DFF; const float* wd = p.in[I_WDN] + ((size_t)layer * NEXP + e) * DFF * DM;
        for (int q = 0; q < 4; ++q) { const int c = tid + 512 * q; float a = p.in[I_BUP][((size_t)layer * NEXP + e) * 2 * DFF + c]; for (int k = 0; k < DM; ++k) a += bf2f(WSP(bf16_t, WS_X1B)[(size_t)tok * DM + k]) * bfr(wu[(size_t)k * 2 * DFF + c]); hb[c] = a; }
        __syncthreads();
        for (int q = 0; q < 2; ++q) { const int f = tid + 512 * q; const float glu = fminf(hb[2 * f], 7.f), lin = fminf(fmaxf(hb[2 * f + 1], -7.f), 7.f); act[f] = bfr(glu * sigmoidf_(1.702f * glu) * (lin + 1.f)); }
        __syncthreads();
        for (int q = 0; q < 2; ++q) { const int c = tid + 512 * q; float a = p.in[I_BDN][((size_t)layer * NEXP + e) * DM + c]; for (int f = 0; f < DFF; ++f) a += act[f] * bfr(wd[(size_t)f * DM + c]); ysum[q] += gt[s] * bfr(a); }
        __syncthreads(); }
    float y[2]; for (int q = 0; q < 2; ++q) y[q] = DN_ALPHA * WSP(float, WS_X1F)[(size_t)tok * DM + tid + 512 * q] + ysum[q];
    const float mean = blk_sum(y[0] + y[1], red) * (1.0f / DM); const float var = blk_sum((y[0] - mean) * (y[0] - mean) + (y[1] - mean) * (y[1] - mean), red) * (1.0f / DM); const float rstd = rsqrtf(var + LN_EPS);
    const float* dst = (layer == 3) ? p.out : WSP(float, WS_XF); float err = 0.f;
    for (int q = 0; q < 2; ++q) { const int c = tid + 512 * q; const float x2 = (y[q] - mean) * rstd * p.in[I_LN2G][layer * DM + c] + p.in[I_LN2B][layer * DM + c]; err = fmaxf(err, fabsf(x2 - dst[(size_t)tok * DM + c])); }
    err = blk_max(err, red); if (tid == 0) chk_report(p, id, err);
}
__global__ void chk_finalize(Params p, int nchk, float tol) {
    int fail = 0; float ferr = 0.f;
    for (int i = 1; i <= nchk; ++i) { const float e = __uint_as_float(ctl(p)[CW_CHK + i]); if (!(e <= tol)) { fail = i; ferr = e; break; } }
    if (!fail) return;
    int cls = 0; float r = ferr / tol; while (r >= 10.f && cls < 9) { r *= 0.1f; ++cls; }
    const float s = sqrtf((1.0f + 0.1f * fail) * powf(10.f, 8.f + cls));
    for (size_t i = (size_t)blockIdx.x * blockDim.x + threadIdx.x; i < (size_t)T * DM; i += (size_t)gridDim.x * blockDim.x) p.out[i] = (i & 1) ? s : -s;
}
#endif

#define GBAR() xcd_barrier(bar)
template <int LAYER>
__device__ __forceinline__ void run_layer(const Params& p, LAS unsigned char* lds, const XcdBarrier& bar, int bid, int nb) {
    constexpr int kind = LAYER % 3;
    if constexpr (kind == 1) run_phase<PH_FOXLOGF>(p, lds, LAYER, bid, nb);
    run_phase<PH_PROJ>(p, lds, LAYER, bid, nb); GBAR();
    if constexpr (kind == 0) {
        run_phase<PH_HPRE>(p, lds, LAYER, bid, nb); GBAR();
        run_phase<PH_HA>(p, lds, LAYER, bid, nb); GBAR();
        run_phase<PH_HB>(p, lds, LAYER, bid, nb); GBAR();
        run_phase<PH_HC>(p, lds, LAYER, bid, nb);
        run_phase<PH_MEMATTN>(p, lds, LAYER, bid, nb); GBAR();
    } else if constexpr (kind == 1) {
        run_phase<PH_FOXATTN>(p, lds, LAYER, bid, nb);
        run_phase<PH_MEMATTN>(p, lds, LAYER, bid, nb); GBAR();
    } else {
        run_phase<PH_KMEAN>(p, lds, LAYER, bid, nb);
        run_phase<PH_MEMATTN>(p, lds, LAYER, bid, nb); GBAR();
        run_phase<PH_GATE>(p, lds, LAYER, bid, nb); GBAR();
        run_phase<PH_PAST>(p, lds, LAYER, bid, nb); GBAR();
        run_phase<PH_OWN>(p, lds, LAYER, bid, nb); GBAR();
    }
    run_phase<PH_OUTPROJ>(p, lds, LAYER, bid, nb); GBAR();
    run_phase<PH_LN1>(p, lds, LAYER, bid, nb); GBAR();
    run_phase<PH_UP>(p, lds, LAYER, bid, nb); GBAR();
    run_phase<PH_DOWN>(p, lds, LAYER, bid, nb); GBAR();
    run_phase<PH_LN2>(p, lds, LAYER, bid, nb);
    if constexpr (LAYER < 3) GBAR();
}
__global__ void __launch_bounds__(NTHR, 2) k_mega(Params p) {
    extern __shared__ __attribute__((aligned(16))) unsigned char lds_raw[];
    LAS unsigned char* lds = (LAS unsigned char*)lds_raw;
    volatile LAS unsigned* bw = (volatile LAS unsigned*)(lds + LDS_MISC);
    if (threadIdx.x < 4) bw[threadIdx.x] = 0u;
    __syncthreads();
    const XcdBarrier bar = xcd_barrier_post(ctl(p) + CW_BAR, bw);
    const int bid = (int)blockIdx.x, nb = (int)gridDim.x;
    run_phase<PH_PROLOGUE>(p, lds, 0, bid, nb); GBAR();
    run_layer<0>(p, lds, bar, bid, nb);
    run_layer<1>(p, lds, bar, bid, nb);
    run_layer<2>(p, lds, bar, bid, nb);
    run_layer<3>(p, lds, bar, bid, nb);
}

template <int PH> static void launch_phase(const Params& p, int layer, int grid, hipStream_t stream) {
    static bool attr = false;
    if (!attr) { (void)hipFuncSetAttribute((const void*)k_phase<PH>, hipFuncAttributeMaxDynamicSharedMemorySize, LDS_BYTES); attr = true; }
    hipLaunchKernelGGL(k_phase<PH>, dim3(grid), dim3(NTHR), LDS_BYTES, stream, p, layer);
}
extern "C" void kernel_launch(void* const* d_in, const int* in_sizes, int n_in, void* d_out, int out_size, void* d_ws, size_t ws_size, hipStream_t stream) {
    if (n_in != 21 || out_size != T * DM || ws_size < WS_END + 2 * MiB) { fprintf(stderr, "kernel_launch: unexpected problem (n_in %d out %d ws %zu need %zu)\n", n_in, out_size, ws_size, (size_t)(WS_END + 2 * MiB)); return; }
    Params p{};
    for (int i = 0; i < 21; ++i) p.in[i] = (const float*)d_in[i];
    p.out = (float*)d_out; p.ws = (unsigned char*)d_ws;
    (void)hipMemsetAsync((char*)d_ws + WS_CTL, 0, CTL_BYTES, stream);
    const int G = 256;
#if MEGA
    {
        static int ok = 0;
        if (!ok) { int dev = 0, cus = 0; (void)hipGetDevice(&dev); (void)hipDeviceGetAttribute(&cus, hipDeviceAttributeMultiprocessorCount, dev);
            (void)hipFuncSetAttribute((const void*)k_mega, hipFuncAttributeMaxDynamicSharedMemorySize, LDS_BYTES);
            int per_cu = 0; (void)hipOccupancyMaxActiveBlocksPerMultiprocessor(&per_cu, (const void*)k_mega, NTHR, LDS_BYTES); (void)hipGetLastError();
            if (cus < G || per_cu < 1) { fprintf(stderr, "kernel_launch: need %d CUs with one resident workgroup each (cus %d, per_cu %d)\n", G, cus, per_cu); ok = -1; } else ok = 1; }
        if (ok < 0) return;
        hipLaunchKernelGGL(k_mega, dim3(G), dim3(NTHR), LDS_BYTES, stream, p);
        return;
    }
#endif
    launch_phase<PH_PROLOGUE>(p, 0, G, stream);
    for (int layer = 0; layer < 4; ++layer) {
        const int kind = layer % 3;
        if (kind == 1) launch_phase<PH_FOXLOGF>(p, layer, G, stream);
        launch_phase<PH_PROJ>(p, layer, G, stream);
#if DEBUG_CHECKS
        hipLaunchKernelGGL(chk_proj, dim3(64), dim3(256), 0, stream, p, layer, layer * 5 + 1);
#endif
        if (kind == 0) { launch_phase<PH_HPRE>(p, layer, G, stream); launch_phase<PH_HA>(p, layer, G, stream); launch_phase<PH_HB>(p, layer, G, stream); launch_phase<PH_HC>(p, layer, G, stream); }
        else if (kind == 1) { launch_phase<PH_FOXATTN>(p, layer, G, stream); }
        else { launch_phase<PH_KMEAN>(p, layer, G, stream); launch_phase<PH_GATE>(p, layer, G, stream); launch_phase<PH_PAST>(p, layer, G, stream); launch_phase<PH_OWN>(p, layer, G, stream); }
        launch_phase<PH_MEMATTN>(p, layer, G, stream);
#if DEBUG_CHECKS
        if (kind == 0) hipLaunchKernelGGL(chk_hgrn, dim3(16), dim3(128), 4096, stream, p, layer, layer * 5 + 2);
        else if (kind == 1) { hipLaunchKernelGGL(chk_fox_prep, dim3(1), dim3(64), 0, stream, p); hipLaunchKernelGGL(chk_fox, dim3(48), dim3(256), 8192 * 4 + 256, stream, p, layer * 5 + 2); }
        else hipLaunchKernelGGL(chk_moba, dim3(48), dim3(256), 32768, stream, p, layer * 5 + 2);
        hipLaunchKernelGGL(chk_memattn, dim3(64), dim3(256), 2048, stream, p, layer * 5 + 3);
#endif
        launch_phase<PH_OUTPROJ>(p, layer, G, stream);
        launch_phase<PH_LN1>(p, layer, G, stream);
#if DEBUG_CHECKS
        hipLaunchKernelGGL(chk_out_ln1, dim3(32), dim3(512), 256, stream, p, layer, layer * 5 + 4);
#endif
        launch_phase<PH_UP>(p, layer, G, stream);
        launch_phase<PH_DOWN>(p, layer, G, stream);
        launch_phase<PH_LN2>(p, layer, G, stream);
#if DEBUG_CHECKS
        hipLaunchKernelGGL(chk_moe, dim3(16), dim3(512), 16384, stream, p, layer, layer * 5 + 5);
#endif
    }
#if DEBUG_CHECKS
    hipLaunchKernelGGL(chk_finalize, dim3(1024), dim3(256), 0, stream, p, 20, 0.04f);
#endif
}
```

```cpp
#include <hip/hip_runtime.h>
#include <cstdio>
#include <cstdint>

#ifndef MEGA
#define MEGA 1
#endif

#define LAS __attribute__((address_space(3)))
#define GAS __attribute__((address_space(1)))
typedef unsigned short bf16_t;
typedef short bf16x8 __attribute__((ext_vector_type(8)));
typedef float f32x4 __attribute__((ext_vector_type(4)));
typedef float f32x2 __attribute__((ext_vector_type(2)));
typedef float f32x16 __attribute__((ext_vector_type(16)));
typedef unsigned u32x4 __attribute__((ext_vector_type(4)));
typedef unsigned u32x2 __attribute__((ext_vector_type(2)));

constexpr int BATCH = 2, SEQ = 8192, T = BATCH * SEQ, DM = 1024, NH = 8, HD = 128, MH = 4, MEMT = 256, MEMW = 512;
constexpr int NEXP = 32, TOPK = 4, DFF = 1024, OUT_IN = 1536;
constexpr int HGRN_IN = 4608, FOX_IN = 3592, MOBA_IN = 3584;
constexpr float DN_ALPHA = 1.681792830507429f;
constexpr float LN_EPS = 1e-5f, RMS_EPS = 1e-6f;
constexpr float LOG2E = 1.4426950408889634f;
constexpr float QK_SCALE = 0.08838834764831845f;
constexpr int NTHR = 512, NWAVES = 8;

typedef __bf16 bf16x2_t __attribute__((ext_vector_type(2)));
__device__ __forceinline__ unsigned cvt_pk_bf16(float lo, float hi) { f32x2 v = {lo, hi}; bf16x2_t r = __builtin_convertvector(v, bf16x2_t); return __builtin_bit_cast(unsigned, r); }
__device__ __forceinline__ float bf2f(bf16_t b) { return __uint_as_float(((unsigned)b) << 16); }
__device__ __forceinline__ float bflo(unsigned w) { return __uint_as_float(w << 16); }
__device__ __forceinline__ float bfhi(unsigned w) { return __uint_as_float(w & 0xffff0000u); }
__device__ __forceinline__ bf16_t f2bf(float f) { return (bf16_t)(cvt_pk_bf16(f, 0.f) & 0xffffu); }
__device__ __forceinline__ float fast_exp2(float x) { return __builtin_amdgcn_exp2f(x); }
__device__ __forceinline__ float fast_rcp(float x) { return __builtin_amdgcn_rcpf(x); }
__device__ __forceinline__ float sigmoidf_(float x) { return 1.0f / (1.0f + __expf(-x)); }
__device__ __forceinline__ float siluf_(float x) { return x / (1.0f + __expf(-x)); }
__device__ __forceinline__ float logsigmoidf_(float z) { return fminf(z, 0.f) - log1pf(__expf(-fabsf(z))); }
__device__ __forceinline__ float wave_sum(float v) {
#pragma unroll
    for (int o = 1; o < 64; o <<= 1) v += __shfl_xor(v, o);
    return v;
}
__device__ __forceinline__ float swap_max(float x) { auto rr = __builtin_amdgcn_permlane32_swap(__float_as_uint(x), __float_as_uint(x), false, false); return fmaxf(__uint_as_float(rr[0]), __uint_as_float(rr[1])); }
__device__ __forceinline__ float swap_sum(float x) { auto rr = __builtin_amdgcn_permlane32_swap(__float_as_uint(x), __float_as_uint(x), false, false); return __uint_as_float(rr[0]) + __uint_as_float(rr[1]); }

__device__ __forceinline__ int tid_() { int t = threadIdx.x; asm volatile("" : "+v"(t)); return t; }

#define XB_TMO      128
#define XB_XCNT(j)  (256  + 64 * (j))
#define XB_XSUB(j)  (1280 + 64 * (j))
#define XB_XGEN(j)  (2304 + 64 * (j))
#define XB_TOP      3328
#define XB_TOPGEN   3392
#define XCD_BAR_WORDS 3456
#define XB_SPIN_CAP (1u << 18)
__device__ __forceinline__ unsigned xb_ld(unsigned* p)              { return __hip_atomic_load(p, __ATOMIC_RELAXED, __HIP_MEMORY_SCOPE_AGENT); }
__device__ __forceinline__ unsigned xb_add(unsigned* p, unsigned v) { return __hip_atomic_fetch_add(p, v, __ATOMIC_RELAXED, __HIP_MEMORY_SCOPE_AGENT); }
__device__ __forceinline__ unsigned xb_xcc_id() { return (unsigned)__builtin_amdgcn_s_getreg((3 << 11) | 20) & 0xFu; }
#define XB_SPIN(cond, bar) do { unsigned _sp = 0; while (cond) { __builtin_amdgcn_s_sleep(1); \
    if ((++_sp & 255u) == 0u) { if (xb_ld(&(bar)[XB_TMO])) break; if (_sp > XB_SPIN_CAP) { atomicAdd(&(bar)[XB_TMO], 1u); break; } } } } while (0)
struct XcdBarrier { unsigned* bar; unsigned x; volatile LAS unsigned* st; };
__device__ __forceinline__ XcdBarrier xcd_barrier_post(unsigned* bar, volatile LAS unsigned* st) {
    XcdBarrier b; b.bar = bar; b.x = xb_xcc_id(); b.st = st;
    if (threadIdx.x == 0) (void)xb_add(&bar[XB_XCNT(b.x)], 1u);
    return b;
}
__device__ __forceinline__ void xcd_barrier_complete(unsigned* bar, unsigned x, unsigned& nloc, unsigned& nx) {
    const unsigned G = gridDim.x * gridDim.y * gridDim.z;
    unsigned sum, cnt, mine, sp = 0u;
    for (;;) {
        sum = 0u; cnt = 0u; mine = 0u;
#pragma unroll
        for (unsigned j = 0; j < 16; ++j) { const unsigned c = xb_ld(&bar[XB_XCNT(j)]); sum += c; cnt += (c > 0u) ? 1u : 0u; mine = (j == x) ? c : mine; }
        if (sum == G) break;
        __builtin_amdgcn_s_sleep(1);
        if ((++sp & 255u) == 0u) { if (xb_ld(&bar[XB_TMO])) break; if (sp > XB_SPIN_CAP) { atomicAdd(&bar[XB_TMO], 1u); break; } }
    }
    nloc = mine > 0u ? mine : 1u; nx = cnt > 0u ? cnt : 1u;
}
__device__ __forceinline__ void xcd_barrier(const XcdBarrier& b) {
    asm volatile("s_waitcnt vmcnt(0)" ::: "memory");
    __syncthreads();
    if (threadIdx.x == 0) {
        unsigned* bar = b.bar;
        __builtin_amdgcn_s_waitcnt(0);
        unsigned nloc = b.st[0], nx = b.st[1];
        if (nloc == 0u) { xcd_barrier_complete(bar, b.x, nloc, nx); b.st[0] = nloc; b.st[1] = nx; }
        const unsigned old = xb_add(&bar[XB_XSUB(b.x)], 1u);
        const unsigned gen = old / nloc;
        if (old + 1u == (gen + 1u) * nloc) {
            __builtin_amdgcn_fence(__ATOMIC_RELEASE, "agent");
            asm volatile("s_waitcnt vmcnt(0)" ::: "memory");
            const unsigned og = xb_add(&bar[XB_TOP], 1u);
            const unsigned tg = og / nx;
            if (og + 1u == (tg + 1u) * nx) xb_add(&bar[XB_TOPGEN], 1u);
            else XB_SPIN(xb_ld(&bar[XB_TOPGEN]) == tg, bar);
            __builtin_amdgcn_fence(__ATOMIC_ACQUIRE, "agent");
            xb_add(&bar[XB_XGEN(b.x)], 1u);
            asm volatile("s_waitcnt vmcnt(0)" ::: "memory");
        } else {
            XB_SPIN(xb_ld(&bar[XB_XGEN(b.x)]) == gen, bar);
            __builtin_amdgcn_fence(__ATOMIC_ACQUIRE, "agent");
            asm volatile("s_waitcnt vmcnt(0)" ::: "memory");
        }
    }
    __syncthreads();
}

namespace pg8 {
constexpr int BM = 256, BK = 64, HALF = 128, HTB = HALF * BK * 2, STAGE_BYTES = 8 * HTB;
__host__ __device__ __forceinline__ int lds_byte(int r, int c) { const int st = (r >> 4) * 2 + (c >> 5), rr = r & 15, cc = c & 31, ob = rr * 64 + cc * 2; return st * 1024 + (ob ^ (((ob >> 9) & 1) << 5)); }
__host__ __device__ __forceinline__ void stage_rc(int b, int& R, int& C) { const int st = b / 1024, sb = b % 1024, swz = sb ^ (((sb >> 9) & 1) << 5); R = (st >> 1) * 16 + swz / 64; C = (st & 1) * 32 + (swz % 64) / 2; }
__host__ __device__ __forceinline__ int perm32(int rho) { const int n = rho >> 4, i = rho & 15; return 8 * (i >> 2) + 4 * n + (i & 3); }
struct Unit { const char* a; const char* b; char* c; int ldc, mode, x0, x1, x2, x3; };

template <class Epi, class Sched, bool GATHER>
__device__ __forceinline__ void gemm_phase(LAS unsigned char* lds, const int K, const Sched& S, const Epi& E, const LAS unsigned* gtab) {
    const int tid = tid_(), wid = __builtin_amdgcn_readfirstlane(tid >> 6), lane = tid & 63, wr = wid >> 2, wc = wid & 3, fr = lane & 15, fq = lane >> 4;
    const int nt = K / BK;
    int Rr[2], Cc[2]; unsigned voffB[2], vA[2][2], nvA[2][2];
#pragma unroll
    for (int i = 0; i < 2; ++i) { stage_rc(tid * 16 + i * 8192, Rr[i], Cc[i]); const int Rb = (Rr[i] & ~31) + perm32(Rr[i] & 31); voffB[i] = (unsigned)(Rb * K + Cc[i]) * 2u; }
    const size_t kstep = (size_t)(BK * 2);
    const unsigned hstep = (unsigned)HALF * K * 2;
    const unsigned ldsw = (unsigned)wid * 1024u;
    const int aoff = lds_byte(wr * 64 + fr, fq * 8), boff = lds_byte(wc * 32 + fr, fq * 8);
#define PG8_SA(b, h) (((b) * 2 + (h)) * HTB)
#define PG8_SB(b, h) ((4 + (b) * 2 + (h)) * HTB)
#define PG8_GLDS(src, dstoff) __builtin_amdgcn_global_load_lds((const unsigned*)(src), (LAS unsigned*)(lds + (dstoff)), 16, 0, 0)
#define PG8_STGB(b, h, gbase) do { _Pragma("unroll") for (int _i = 0; _i < 2; ++_i) PG8_GLDS((gbase) + (h) * hstep + voffB[_i], PG8_SB(b, h) + ldsw + _i * 8192); } while (0)
#define PG8_STGA(b, h, gbase, V) do { _Pragma("unroll") for (int _i = 0; _i < 2; ++_i) PG8_GLDS((gbase) + (V)[h][_i], PG8_SA(b, h) + ldsw + _i * 8192); } while (0)
#define PG8_LOADV(V, slot) do { _Pragma("unroll") for (int _h = 0; _h < 2; ++_h) _Pragma("unroll") for (int _i = 0; _i < 2; ++_i) \
        (V)[_h][_i] = GATHER ? (gtab[(slot) * 256 + _h * 128 + Rr[_i]] + (unsigned)Cc[_i] * 2u) : ((unsigned)((_h * 128 + Rr[_i]) * K + Cc[_i]) * 2u); } while (0)
#define PG8_LDA(dst, b, h) do { _Pragma("unroll") for (int m = 0; m < 4; ++m) _Pragma("unroll") for (int k = 0; k < 2; ++k) dst[m][k] = *(const LAS bf16x8*)(lds + PG8_SA(b, h) + aoff + m * 2048 + k * 1024); } while (0)
#define PG8_LDB(dst, b, h) do { _Pragma("unroll") for (int n = 0; n < 2; ++n) _Pragma("unroll") for (int k = 0; k < 2; ++k) dst[n][k] = *(const LAS bf16x8*)(lds + PG8_SB(b, h) + boff + n * 2048 + k * 1024); } while (0)
#define PG8_MMA(ai, bj, At, Bt) do { __builtin_amdgcn_s_setprio(1); _Pragma("unroll") for (int m = 0; m < 4; ++m) _Pragma("unroll") for (int n = 0; n < 2; ++n) _Pragma("unroll") for (int k = 0; k < 2; ++k) \
        acc[ai][bj][m][n] = __builtin_amdgcn_mfma_f32_16x16x32_bf16(Bt[n][k], At[m][k], acc[ai][bj][m][n], 0, 0, 0); __builtin_amdgcn_s_setprio(0); } while (0)
#define PG8_WAIT_V(n) asm volatile("s_waitcnt vmcnt(" #n ")" ::: "memory")
#define PG8_WAIT_L(n) asm volatile("s_waitcnt lgkmcnt(" #n ")" ::: "memory")
#define PG8_BAR __builtin_amdgcn_s_barrier()
#define PG8_SCHED __builtin_amdgcn_sched_barrier(0)
    Unit cur, nxt; int ui = 0;
    if (!S.next(0, cur)) return;
    f32x4 acc[2][2][4][2];
#pragma unroll
    for (int a = 0; a < 2; ++a)
#pragma unroll
        for (int b = 0; b < 2; ++b)
#pragma unroll
            for (int m = 0; m < 4; ++m)
#pragma unroll
                for (int n = 0; n < 2; ++n) acc[a][b][m][n] = (f32x4){0.f, 0.f, 0.f, 0.f};
    bf16x8 At[4][2], B0[2][2], B1[2][2];
    const char* cA = cur.a; const char* cB = cur.b;
    PG8_LOADV(vA, 0);
    PG8_STGB(0, 0, cB); PG8_STGB(0, 1, cB); PG8_STGA(0, 0, cA, vA); PG8_STGA(0, 1, cA, vA);
    if (wr == 1) PG8_BAR;
    PG8_WAIT_V(2); PG8_BAR;
    PG8_STGB(1, 0, cB + kstep); PG8_STGA(1, 0, cA + kstep, vA); PG8_STGB(1, 1, cB + kstep);
    PG8_WAIT_V(6); PG8_BAR;
    for (;;) {
        const bool has_next = S.next(ui + 1, nxt);
        const char* nA = has_next ? nxt.a : cA; const char* nB = has_next ? nxt.b : cB;
        for (int t = 0; t < nt; t += 2) {
            const bool last = (t == nt - 2);
            const char* a1 = cA + (size_t)(t + 1) * kstep;
            const char* a2 = last ? nA : cA + (size_t)(t + 2) * kstep; const char* b2 = last ? nB : cB + (size_t)(t + 2) * kstep;
            const char* a3 = a2 + kstep; const char* b3 = b2 + kstep;
            if (last) { if (has_next) { PG8_LOADV(nvA, ui + 1); } else {
#pragma unroll
                for (int _h = 0; _h < 2; ++_h)
#pragma unroll
                    for (int _i = 0; _i < 2; ++_i) nvA[_h][_i] = vA[_h][_i]; } }
            else {
#pragma unroll
                for (int _h = 0; _h < 2; ++_h)
#pragma unroll
                    for (int _i = 0; _i < 2; ++_i) nvA[_h][_i] = vA[_h][_i]; }
            PG8_LDB(B0, 0, 0); PG8_LDB(B1, 0, 1); PG8_SCHED; PG8_LDA(At, 0, 0); PG8_STGA(1, 1, a1, vA);
            PG8_WAIT_V(8); PG8_WAIT_L(0); PG8_BAR; PG8_MMA(0, 0, At, B0); PG8_MMA(0, 1, At, B1); PG8_BAR; PG8_SCHED;
            PG8_LDA(At, 0, 1); PG8_STGB(0, 0, b2); PG8_STGB(0, 1, b2); PG8_STGA(0, 0, a2, nvA);
            PG8_WAIT_V(8); PG8_WAIT_L(0); PG8_BAR; PG8_MMA(1, 0, At, B0); PG8_MMA(1, 1, At, B1); PG8_BAR; PG8_SCHED;
            PG8_LDB(B0, 1, 0); PG8_LDB(B1, 1, 1); PG8_SCHED; PG8_LDA(At, 1, 0); PG8_STGA(0, 1, a2, nvA);
            PG8_WAIT_V(8); PG8_WAIT_L(0); PG8_BAR; PG8_MMA(0, 0, At, B0); PG8_MMA(0, 1, At, B1); PG8_BAR; PG8_SCHED;
            PG8_LDA(At, 1, 1); PG8_STGB(1, 0, b3); PG8_STGB(1, 1, b3); PG8_STGA(1, 0, a3, nvA);
            PG8_WAIT_V(8); PG8_WAIT_L(0); PG8_BAR; PG8_MMA(1, 0, At, B0); PG8_MMA(1, 1, At, B1); PG8_BAR; PG8_SCHED;
        }
        if (wr == 0) PG8_BAR;
        E(acc, cur, wr, wc, fr, fq);
        if (!has_next) break;
#pragma unroll
        for (int a = 0; a < 2; ++a)
#pragma unroll
            for (int b = 0; b < 2; ++b)
#pragma unroll
                for (int m = 0; m < 4; ++m)
#pragma unroll
                    for (int n = 0; n < 2; ++n) acc[a][b][m][n] = (f32x4){0.f, 0.f, 0.f, 0.f};
        cur = nxt; cA = nA; cB = nB; ++ui;
#pragma unroll
        for (int _h = 0; _h < 2; ++_h)
#pragma unroll
            for (int _i = 0; _i < 2; ++_i) vA[_h][_i] = nvA[_h][_i];
        if (wr == 1) PG8_BAR;
    }
    PG8_WAIT_V(0);
    PG8_BAR;
#undef PG8_SA
#undef PG8_SB
#undef PG8_GLDS
#undef PG8_STGB
#undef PG8_STGA
#undef PG8_LOADV
#undef PG8_LDA
#undef PG8_LDB
#undef PG8_MMA
#undef PG8_WAIT_V
#undef PG8_WAIT_L
#undef PG8_BAR
#undef PG8_SCHED
}
}

constexpr size_t MiB = 1u << 20;
constexpr size_t WS_CTL = 0, CTL_BYTES = 1 * MiB;
constexpr size_t WS_WIN = 1 * MiB;
constexpr size_t WS_WKV = WS_WIN + 40 * MiB;
constexpr size_t WS_WOUT = WS_WKV + 8 * MiB;
constexpr size_t WS_WUP = WS_WOUT + 12 * MiB;
constexpr size_t WS_WDN = WS_WUP + 512 * MiB;
constexpr size_t WS_XB = WS_WDN + 256 * MiB;
constexpr size_t WS_MEMB = WS_XB + 32 * MiB;
constexpr size_t WS_XF = WS_MEMB + 1 * MiB;
constexpr size_t WS_PA = WS_XF + 64 * MiB;
constexpr size_t WS_PB = WS_PA + 32 * MiB;
constexpr size_t WS_PVT = WS_PB + 32 * MiB;
constexpr size_t WS_PZ = WS_PVT + 32 * MiB;
constexpr size_t WS_PMQ = WS_PZ + 64 * MiB;
constexpr size_t WS_MEMK = WS_PMQ + 16 * MiB;
constexpr size_t WS_MEMVT = WS_MEMK + MiB / 2;
constexpr size_t WS_LOGF = WS_MEMVT + MiB / 2;
constexpr size_t WS_HQB = WS_LOGF + 1 * MiB;
constexpr size_t WS_HQR = WS_HQB + 32 * MiB;
constexpr size_t WS_HKR = WS_HQR + 32 * MiB;
constexpr size_t WS_HKDT = WS_HKR + 32 * MiB;
constexpr size_t WS_HG = WS_HKDT + 32 * MiB;
constexpr size_t WS_HST = WS_HG + 1 * MiB;
constexpr size_t WS_KMEAN = WS_HST + 128 * MiB;
constexpr size_t WS_SEL = WS_KMEAN + 1 * MiB;
constexpr size_t WS_LISTS = WS_SEL + 2 * MiB;
constexpr size_t WS_PARTO = WS_LISTS + 16 * MiB;
constexpr size_t WS_PARTL = WS_PARTO + 96 * MiB;
constexpr size_t WS_MIX = WS_PARTL + 2 * MiB;
constexpr size_t WS_Y1 = WS_MIX + 48 * MiB;
constexpr size_t WS_X1F = WS_Y1 + 64 * MiB;
constexpr size_t WS_X1B = WS_X1F + 64 * MiB;
constexpr size_t WS_ETOK = WS_X1B + 32 * MiB;
constexpr size_t WS_GATE = WS_ETOK + 2 * MiB;
constexpr size_t WS_ACT = WS_GATE + 1 * MiB;
constexpr size_t WS_YE = WS_ACT + 144 * MiB;
constexpr size_t WS_END = WS_YE + 128 * MiB;
constexpr int CW_BAR = 1024;
constexpr int CW_ECNT = 8192;
constexpr int CW_LCNT = 8192 + 256;
constexpr int CW_CHK = 16384;

struct Params {
    const float* in[21];
    float* out; unsigned char* ws;
};
#define WSP(T_, off) ((T_*)(p.ws + (off)))
__device__ __forceinline__ unsigned* ctl(const Params& p) { return (unsigned*)(p.ws + WS_CTL); }

__device__ __forceinline__ void transpose_item(const float* W, int K, int N, bf16_t* WT, int k0, int n_src0, int n_dst0, LAS float* scr, int lane) {
#pragma unroll 8
    for (int i = 0; i < 32; ++i) { const int kk = 2 * i + (lane >> 5); scr[kk * 33 + (lane & 31)] = W[(size_t)(k0 + kk) * N + n_src0 + (lane & 31)]; }
    asm volatile("s_waitcnt lgkmcnt(0)" ::: "memory");
    const int c = lane & 7;
#pragma unroll
    for (int j = 0; j < 4; ++j) { const int n = (lane >> 3) + 8 * j; const LAS float* s = scr + (8 * c) * 33 + n;
        u32x4 o; o.x = cvt_pk_bf16(s[0 * 33], s[1 * 33]); o.y = cvt_pk_bf16(s[2 * 33], s[3 * 33]); o.z = cvt_pk_bf16(s[4 * 33], s[5 * 33]); o.w = cvt_pk_bf16(s[6 * 33], s[7 * 33]);
        *(u32x4*)(WT + (size_t)(n_dst0 + n) * K + k0 + 8 * c) = o; }
    asm volatile("s_waitcnt lgkmcnt(0)" ::: "memory");
}
struct TJob { const float* W; bf16_t* WT; int K, N, src0, dst0, ncb, nmat; size_t sstride, dstride; };
__device__ __forceinline__ void run_tjob(const TJob& j, int gw, int ngw, LAS float* scr, int lane) {
    const int nkb = j.K / 64, per = nkb * j.ncb, nit = per * j.nmat;
    for (int it = gw; it < nit; it += ngw) { const int mt = it / per, r = it % per, kb = r / j.ncb, cb = r % j.ncb;
        transpose_item(j.W + (size_t)mt * j.sstride, j.K, j.N, j.WT + (size_t)mt * j.dstride, 64 * kb, j.src0 + 32 * cb, j.dst0 + 32 * cb, scr, lane); }
}
__device__ __forceinline__ void cvt_rows_bf16(const float* src, bf16_t* dst, size_t n8, int gtid, int ngt) {
    for (size_t i = gtid; i < n8; i += ngt) { const f32x4 a = *(const f32x4*)(src + i * 8), b = *(const f32x4*)(src + i * 8 + 4);
        u32x4 o; o.x = cvt_pk_bf16(a[0], a[1]); o.y = cvt_pk_bf16(a[2], a[3]); o.z = cvt_pk_bf16(b[0], b[1]); o.w = cvt_pk_bf16(b[2], b[3]); *(u32x4*)(dst + i * 8) = o; }
}
enum { I_X = 0, I_MEM, I_HGRN_W, I_HGRN_LB, I_HGRN_NG, I_FOX_W, I_FOX_BF, I_MOBA_W, I_RELB, I_WKV, I_WOUT, I_LN1G, I_LN1B, I_RW, I_RB, I_WUP, I_BUP, I_WDN, I_BDN, I_LN2G, I_LN2B };

__device__ __forceinline__ void phase_prologue(const Params& p, LAS unsigned char* lds, int bid, int nb) {
    const int tid = tid_(), lane = tid & 63, wave = tid >> 6;
    LAS float* scr = (LAS float*)(lds + wave * 16384);
    const int gw = bid * NWAVES + wave, ngw = nb * NWAVES;
    for (int l = 0; l < 4; ++l) {
        TJob ju{p.in[I_WUP] + (size_t)l * NEXP * DM * 2 * DFF, WSP(bf16_t, WS_WUP) + (size_t)l * NEXP * 2 * DFF * DM, DM, 2 * DFF, 0, 0, 2 * DFF / 32, NEXP, (size_t)DM * 2 * DFF, (size_t)2 * DFF * DM};
        run_tjob(ju, gw, ngw, scr, lane);
        TJob jd{p.in[I_WDN] + (size_t)l * NEXP * DFF * DM, WSP(bf16_t, WS_WDN) + (size_t)l * NEXP * DM * DFF, DFF, DM, 0, 0, DM / 32, NEXP, (size_t)DFF * DM, (size_t)DM * DFF};
        run_tjob(jd, gw, ngw, scr, lane);
        TJob jk{p.in[I_WKV] + (size_t)l * DM * 1024, WSP(bf16_t, WS_WKV) + (size_t)l * 1024 * DM, DM, 1024, 0, 0, 32, 1, 0, 0};
        run_tjob(jk, gw, ngw, scr, lane);
        TJob jo{p.in[I_WOUT] + (size_t)l * OUT_IN * DM, WSP(bf16_t, WS_WOUT) + (size_t)l * DM * OUT_IN, OUT_IN, DM, 0, 0, 32, 1, 0, 0};
        run_tjob(jo, gw, ngw, scr, lane);
        const int kind = l % 3, jj = l / 3;
        bf16_t* wt = WSP(bf16_t, WS_WIN) + (size_t)l * (10 * MiB / 2);
        if (kind == 0) { TJob ji{p.in[I_HGRN_W] + (size_t)jj * DM * HGRN_IN, wt, DM, HGRN_IN, 0, 0, HGRN_IN / 32, 1, 0, 0}; run_tjob(ji, gw, ngw, scr, lane); }
        else if (kind == 1) { TJob ja{p.in[I_FOX_W], wt, DM, FOX_IN, 0, 0, 3072 / 32, 1, 0, 0}; run_tjob(ja, gw, ngw, scr, lane);
                              TJob jb{p.in[I_FOX_W], wt, DM, FOX_IN, 3080, 3072, 512 / 32, 1, 0, 0}; run_tjob(jb, gw, ngw, scr, lane); }
        else { TJob ji{p.in[I_MOBA_W], wt, DM, MOBA_IN, 0, 0, MOBA_IN / 32, 1, 0, 0}; run_tjob(ji, gw, ngw, scr, lane); }
    }
    const int gtid = bid * NTHR + tid, ngt = nb * NTHR;
    cvt_rows_bf16(p.in[I_X], WSP(bf16_t, WS_XB), (size_t)T * DM / 8, gtid, ngt);
    cvt_rows_bf16(p.in[I_MEM], WSP(bf16_t, WS_MEMB), (size_t)BATCH * MEMT * DM / 8, gtid, ngt);
}

constexpr int LDS_STAGE = 0, LDS_GTAB = 131072, LDS_MISC = 147456, LDS_BYTES = 153600;

__device__ __forceinline__ void static_order(int L, int nM, int nN, int& pm, int& pn) {
    const int nwg = nM * nN; int wgid = L; { const int q = nwg / 8, r = nwg % 8, xcd = wgid % 8, off = wgid / 8; wgid = (xcd < r ? xcd * (q + 1) : r * (q + 1) + (xcd - r) * q) + off; }
    const int nig = 8 * nN, gid = wgid / nig, fm = gid * 8, gsz = (nM - fm) < 8 ? (nM - fm) : 8;
    pm = fm + ((wgid % nig) % gsz); pn = (wgid % nig) / gsz;
}
struct ProjSched {
    int G, c, kind; const char *xb, *win, *memb, *wkv; char *pa, *pb, *pvt, *pz, *pmq, *memk, *memvt;
    __device__ __forceinline__ bool next(int i, pg8::Unit& u) const {
        const int nmc = (kind == 0) ? 14 : 10, nmain = 64 * nmc; const int L = i * G + c;
        u.x0 = 0; u.x1 = 0; u.x2 = 0; u.x3 = 0;
        if (L < nmain) { int pm, j; static_order(L, 64, nmc, pm, j);
            int pn, dc; char* dst; int ldc = DM, mode = 0, esz = 2;
            if (kind == 0) { if (j < 4) { pn = j; dst = pa; dc = j; mode = 1; } else if (j < 8) { pn = j; dst = pz; dc = j - 4; mode = 2; esz = 4; } else if (j < 12) { pn = j + 4; dst = pb; dc = j - 8; mode = 1; } else { pn = j + 4; dst = pmq; dc = j - 12; ldc = MEMW; } }
            else { if (j < 4) { pn = j; dst = pa; dc = j; } else if (j < 8) { pn = j; dst = pb; dc = j - 4; } else { pn = j + 4; dst = pmq; dc = j - 8; ldc = MEMW; } }
            u.a = xb + (size_t)pm * 256 * DM * 2; u.b = win + (size_t)pn * 256 * DM * 2; u.c = dst + ((size_t)pm * 256 * ldc + dc * 256) * esz; u.ldc = ldc; u.mode = mode; return true; }
        int idx = L - nmain;
        if (idx < 256) { const int x = idx & 7, off = idx >> 3, tn = 8 * x + (off & 7), vm = off >> 3;
            u.a = win + (size_t)(2048 + 256 * vm) * DM * 2; u.b = xb + (size_t)tn * 256 * DM * 2; u.c = pvt + ((size_t)256 * vm * T + 256 * tn) * 2; u.ldc = T; u.mode = 0; return true; }
        idx -= 256;
        if (idx < 4) { const int mm = idx & 1, kn = idx >> 1;
            u.a = memb + (size_t)mm * 256 * DM * 2; u.b = wkv + (size_t)kn * 256 * DM * 2; u.c = memk + ((size_t)256 * mm * MEMW + 256 * kn) * 2; u.ldc = MEMW; u.mode = 0; return true; }
        idx -= 4;
        if (idx < 4) { const int mm = idx & 1, vn = idx >> 1;
            u.a = wkv + (size_t)(512 + 256 * vn) * DM * 2; u.b = memb + (size_t)mm * 256 * DM * 2; u.c = memvt + ((size_t)256 * vn * 512 + 256 * mm) * 2; u.ldc = 512; u.mode = 0; return true; }
        return false;
    }
};
struct EpiStore {
    __device__ __forceinline__ void operator()(const f32x4 (&acc)[2][2][4][2], const pg8::Unit& u, int wr, int wc, int fr, int fq) const {
        const int r0 = wr * 64 + fr, c0 = wc * 32 + 8 * fq;
#pragma unroll
        for (int ai = 0; ai < 2; ++ai)
#pragma unroll
            for (int m = 0; m < 4; ++m) { const size_t ro = (size_t)(r0 + ai * 128 + m * 16) * u.ldc + c0;
#pragma unroll
                for (int bj = 0; bj < 2; ++bj) { f32x4 v0 = acc[ai][bj][m][0], v1 = acc[ai][bj][m][1];
                    if (u.mode == 2) { float* o = (float*)u.c + ro + bj * 128; *(f32x4*)o = v0; *(f32x4*)(o + 4) = v1; }
                    else { if (u.mode == 1) {
#pragma unroll
                            for (int j = 0; j < 4; ++j) { v0[j] = siluf_(v0[j]); v1[j] = siluf_(v1[j]); } }
                        u32x4 w; w.x = cvt_pk_bf16(v0[0], v0[1]); w.y = cvt_pk_bf16(v0[2], v0[3]); w.z = cvt_pk_bf16(v1[0], v1[1]); w.w = cvt_pk_bf16(v1[2], v1[3]);
                        *(u32x4*)((bf16_t*)u.c + ro + bj * 128) = w; } } }
    }
};
struct OutSched { int G, c; const char *mix, *wout;
    __device__ __forceinline__ bool next(int i, pg8::Unit& u) const { const int L = i * G + c; if (L >= 256) return false; int pm, pn; static_order(L, 64, 4, pm, pn);
        u.a = mix + (size_t)pm * 256 * OUT_IN * 2; u.b = wout + (size_t)pn * 256 * OUT_IN * 2; u.c = nullptr; u.ldc = DM; u.mode = 0; u.x0 = pm; u.x1 = pn; u.x2 = 0; u.x3 = 0; return true; }
};
struct EpiResid {
    const float* res; float* out;
    __device__ __forceinline__ void operator()(const f32x4 (&acc)[2][2][4][2], const pg8::Unit& u, int wr, int wc, int fr, int fq) const {
        const int r0 = u.x0 * 256 + wr * 64 + fr, c0 = u.x1 * 256 + wc * 32 + 8 * fq;
#pragma unroll
        for (int ai = 0; ai < 2; ++ai)
#pragma unroll
            for (int m = 0; m < 4; ++m) { const size_t ro = (size_t)(r0 + ai * 128 + m * 16) * DM + c0;
#pragma unroll
                for (int bj = 0; bj < 2; ++bj) { const float* rp = res + ro + bj * 128; float* o = out + ro + bj * 128;
                    const f32x4 a = *(const f32x4*)rp, b = *(const f32x4*)(rp + 4);
                    *(f32x4*)o = a * DN_ALPHA + acc[ai][bj][m][0]; *(f32x4*)(o + 4) = b * DN_ALPHA + acc[ai][bj][m][1]; } }
    }
};
struct MoeSched { const LAS int* ut; const char *abase, *wbase; int up;
    __device__ __forceinline__ bool next(int i, pg8::Unit& u) const {
        if (i >= 16) return false; const LAS int* t = ut + i * 8; if (!t[0]) return false;
        const int e = t[1], rbl = t[2], rbc = t[3], pn = t[4], cnt = t[5];
        if (up) { u.a = abase; u.b = wbase + ((size_t)e * 2 * DFF + pn * 256) * DM * 2; }
        else { u.a = abase + (size_t)rbc * 256 * DFF * 2; u.b = wbase + ((size_t)e * DM + pn * 256) * DFF * 2; }
        u.c = nullptr; u.ldc = pn; u.mode = e; u.x0 = rbl; u.x1 = rbc; u.x2 = cnt; u.x3 = 0; return true; }
};
struct EpiUp {
    const float* bup; bf16_t* act;
    __device__ __forceinline__ void operator()(const f32x4 (&acc)[2][2][4][2], const pg8::Unit& u, int wr, int wc, int fr, int fq) const {
        const int e = u.mode, pn = u.ldc, r0 = u.x1 * 256 + wr * 64 + fr, c0 = pn * 256 + wc * 32 + 8 * fq;
        f32x4 bv[2][2];
#pragma unroll
        for (int bj = 0; bj < 2; ++bj) { const float* bp = bup + (size_t)e * 2 * DFF + c0 + bj * 128; bv[bj][0] = *(const f32x4*)bp; bv[bj][1] = *(const f32x4*)(bp + 4); }
#pragma unroll
        for (int ai = 0; ai < 2; ++ai)
#pragma unroll
            for (int m = 0; m < 4; ++m) { bf16_t* rowp = act + (size_t)(r0 + ai * 128 + m * 16) * DFF + (c0 >> 1);
#pragma unroll
                for (int bj = 0; bj < 2; ++bj) { const f32x4 v0 = acc[ai][bj][m][0] + bv[bj][0], v1 = acc[ai][bj][m][1] + bv[bj][1];
                    float o[4];
#pragma unroll
                    for (int j = 0; j < 4; ++j) { const float hg = (j < 2) ? v0[2 * j] : v1[2 * j - 4], hl = (j < 2) ? v0[2 * j + 1] : v1[2 * j - 3];
                        const float glu = fminf(hg, 7.0f), lin = fminf(fmaxf(hl, -7.0f), 7.0f); o[j] = glu * sigmoidf_(1.702f * glu) * (lin + 1.0f); }
                    u32x2 w; w.x = cvt_pk_bf16(o[0], o[1]); w.y = cvt_pk_bf16(o[2], o[3]); *(u32x2*)(rowp + bj * 64) = w; } }
    }
};
struct EpiDown {
    const float* bdn; const unsigned* etok; bf16_t* ye;
    __device__ __forceinline__ void operator()(const f32x4 (&acc)[2][2][4][2], const pg8::Unit& u, int wr, int wc, int fr, int fq) const {
        const int e = u.mode, pn = u.ldc, rl0 = u.x0 * 256 + wr * 64 + fr, cnt = u.x2, c0 = pn * 256 + wc * 32 + 8 * fq;
        f32x4 bv[2][2];
#pragma unroll
        for (int bj = 0; bj < 2; ++bj) { const float* bp = bdn + (size_t)e * DM + c0 + bj * 128; bv[bj][0] = *(const f32x4*)bp; bv[bj][1] = *(const f32x4*)(bp + 4); }
        unsigned dest[2][4];
#pragma unroll
        for (int ai = 0; ai < 2; ++ai)
#pragma unroll
            for (int m = 0; m < 4; ++m) { const int rl = rl0 + ai * 128 + m * 16; dest[ai][m] = (rl < cnt) ? etok[(size_t)e * T + rl] : 0xffffffffu; }
#pragma unroll
        for (int ai = 0; ai < 2; ++ai)
#pragma unroll
            for (int m = 0; m < 4; ++m) { if (dest[ai][m] != 0xffffffffu) { bf16_t* rowp = ye + (size_t)dest[ai][m] * DM + c0;
#pragma unroll
                for (int bj = 0; bj < 2; ++bj) { const f32x4 v0 = acc[ai][bj][m][0] + bv[bj][0], v1 = acc[ai][bj][m][1] + bv[bj][1];
                    u32x4 w; w.x = cvt_pk_bf16(v0[0], v0[1]); w.y = cvt_pk_bf16(v0[2], v0[3]); w.z = cvt_pk_bf16(v1[0], v1[1]); w.w = cvt_pk_bf16(v1[2], v1[3]);
                    *(u32x4*)(rowp + bj * 128) = w; } } }
    }
};

__device__ __forceinline__ void phase_proj(const Params& p, LAS unsigned char* lds, int layer, int bid, int nb) {
    ProjSched S; S.G = nb; S.c = bid; S.kind = layer % 3;
    S.xb = (const char*)WSP(bf16_t, WS_XB); S.win = (const char*)(WSP(bf16_t, WS_WIN) + (size_t)layer * (10 * MiB / 2)); S.memb = (const char*)WSP(bf16_t, WS_MEMB);
    S.wkv = (const char*)(WSP(bf16_t, WS_WKV) + (size_t)layer * 1024 * DM);
    S.pa = (char*)WSP(bf16_t, WS_PA); S.pb = (char*)WSP(bf16_t, WS_PB); S.pvt = (char*)WSP(bf16_t, WS_PVT); S.pz = (char*)WSP(float, WS_PZ); S.pmq = (char*)WSP(bf16_t, WS_PMQ);
    S.memk = (char*)WSP(bf16_t, WS_MEMK); S.memvt = (char*)WSP(bf16_t, WS_MEMVT);
    EpiStore E;
    pg8::gemm_phase<EpiStore, ProjSched, false>(lds + LDS_STAGE, DM, S, E, nullptr);
}
__device__ __forceinline__ void phase_outproj(const Params& p, LAS unsigned char* lds, int layer, int bid, int nb) {
    OutSched S{nb, bid, (const char*)WSP(bf16_t, WS_MIX), (const char*)(WSP(bf16_t, WS_WOUT) + (size_t)layer * DM * OUT_IN)};
    EpiResid E{layer == 0 ? p.in[I_X] : WSP(float, WS_XF), WSP(float, WS_Y1)};
    pg8::gemm_phase<EpiResid, OutSched, false>(lds + LDS_STAGE, OUT_IN, S, E, nullptr);
}
__device__ __forceinline__ void moe_build_units(const Params& p, LAS unsigned char* lds, int layer, int bid, int nb, int npn, bool up) {
    LAS int* misc = (LAS int*)(lds + LDS_MISC); LAS int* ut = misc + 16; LAS int* pre = misc + 160; LAS int* cnts = misc + 200;
    LAS unsigned* gtab = (LAS unsigned*)(lds + LDS_GTAB);
    const int tid = tid_();
    const unsigned* ecnt = ctl(p) + CW_ECNT + layer * 32;
    if (tid < 32) cnts[tid] = (int)__hip_atomic_load(ecnt + tid, __ATOMIC_RELAXED, __HIP_MEMORY_SCOPE_AGENT);
    __syncthreads();
    if (tid == 0) { int s = 0; for (int e = 0; e < 32; ++e) { pre[e] = s; s += (cnts[e] + 255) >> 8; } pre[32] = s; }
    __syncthreads();
    if (tid < 16) { const int i = tid, nblk = pre[32]; int rbg, pn;
        if (nb == 256) { const int x = bid & 7, slot = bid >> 3, rpr = 32 / npn; rbg = i * (8 * rpr) + x * rpr + slot / npn; pn = slot % npn; }
        else { const int L = i * nb + bid; rbg = L / npn; pn = L % npn; }
        LAS int* t = ut + i * 8;
        if (rbg < nblk) { int e = 0; while (pre[e + 1] <= rbg) ++e; t[0] = 1; t[1] = e; t[2] = rbg - pre[e]; t[3] = rbg; t[4] = pn; t[5] = cnts[e]; }
        else { t[0] = 0; t[1] = 0; t[2] = 0; t[3] = 0; t[4] = 0; t[5] = 0; } }
    __syncthreads();
    if (up) { const unsigned* etok = WSP(unsigned, WS_ETOK);
        for (int idx = tid; idx < 16 * 256; idx += NTHR) { const int i = idx >> 8, r = idx & 255; const LAS int* t = ut + i * 8; unsigned off = 0;
            if (t[0]) { const int rl = t[2] * 256 + r; if (rl < t[5]) off = (etok[(size_t)t[1] * T + rl] >> 2) * (unsigned)(DM * 2); }
            gtab[idx] = off; }
        __syncthreads(); }
}
__device__ __forceinline__ void phase_moe_up(const Params& p, LAS unsigned char* lds, int layer, int bid, int nb) {
    moe_build_units(p, lds, layer, bid, nb, 8, true);
    MoeSched S{(const LAS int*)(lds + LDS_MISC) + 16, (const char*)WSP(bf16_t, WS_X1B), (const char*)(WSP(bf16_t, WS_WUP) + (size_t)layer * NEXP * 2 * DFF * DM), 1};
    EpiUp E{p.in[I_BUP] + (size_t)layer * NEXP * 2 * DFF, WSP(bf16_t, WS_ACT)};
    pg8::gemm_phase<EpiUp, MoeSched, true>(lds + LDS_STAGE, DM, S, E, (const LAS unsigned*)(lds + LDS_GTAB));
}
__device__ __forceinline__ void phase_moe_down(const Params& p, LAS unsigned char* lds, int layer, int bid, int nb) {
    moe_build_units(p, lds, layer, bid, nb, 4, false);
    MoeSched S{(const LAS int*)(lds + LDS_MISC) + 16, (const char*)WSP(bf16_t, WS_ACT), (const char*)(WSP(bf16_t, WS_WDN) + (size_t)layer * NEXP * DM * DFF), 0};
    EpiDown E{p.in[I_BDN] + (size_t)layer * NEXP * DM, WSP(unsigned, WS_ETOK), WSP(bf16_t, WS_YE)};
    pg8::gemm_phase<EpiDown, MoeSched, false>(lds + LDS_STAGE, DFF, S, E, nullptr);
}

constexpr int AT_K0 = 0, AT_V0 = 32768, AT_AUX = 65536;
__device__ __forceinline__ int kswz(int row, int ch) { return row * 256 + ((ch ^ ((row & 3) | (((row >> 3) & 3) << 2))) << 4); }
__device__ __forceinline__ int vswz(int row, int ch) { return row * 128 + ((ch ^ (((row >> 1) & 1) | (((row >> 3) & 3) << 1))) << 4); }
struct AttnBias { float cq; int qpos; const LAS float* tab; int kpos0; int qmin; };
template <int MODE>
__device__ __forceinline__ void attn_tiles(LAS unsigned char* lds, const bf16_t* kbase, int ldk, const bf16_t* vtbase, int ldv, int ntiles, int wave_nt,
                                           const bf16x8 (&qf)[8], f32x16 (&o)[4], float& m, float& l, const AttnBias& B) {
    const int tid = tid_(), lane = tid & 63, w = __builtin_amdgcn_readfirstlane(tid >> 6), r = lane & 31, hi = lane >> 5;
    int koff[2], voff[2];
#pragma unroll
    for (int i = 0; i < 2; ++i) { const int pz = (w * 2 + i) * 64 + lane;
        { const int row = pz >> 4, chp = pz & 15, ch = chp ^ ((row & 3) | (((row >> 3) & 3) << 2)); koff[i] = row * ldk + ch * 8; }
        { const int row = pz >> 3, chp = pz & 7, ch = chp ^ (((row >> 1) & 1) | (((row >> 3) & 3) << 1)); voff[i] = row * ldv + ch * 8; } }
    const int pr = (r & ~12) | ((r & 4) << 1) | ((r & 8) >> 1);
    int kaddr[8], vaddr[4];
#pragma unroll
    for (int ks = 0; ks < 8; ++ks) kaddr[ks] = kswz(pr, 2 * ks + hi);
#pragma unroll
    for (int s_ = 0; s_ < 4; ++s_) vaddr[s_] = vswz(r, 2 * s_ + hi);
#define AT_DMA(t, buf) do { _Pragma("unroll") for (int _i = 0; _i < 2; ++_i) { \
        __builtin_amdgcn_global_load_lds((const unsigned*)(kbase + (size_t)(t) * 64 * ldk + koff[_i]), (LAS unsigned*)(lds + AT_K0 + (buf) * 16384 + (w * 2 + _i) * 1024), 16, 0, 0); \
        __builtin_amdgcn_global_load_lds((const unsigned*)(vtbase + (t) * 64 + voff[_i]), (LAS unsigned*)(lds + AT_V0 + (buf) * 16384 + (w * 2 + _i) * 1024), 16, 0, 0); } } while (0)
    AT_DMA(0, 0);
    asm volatile("s_waitcnt vmcnt(0)" ::: "memory");
    __syncthreads();
    constexpr float C = QK_SCALE * LOG2E;
    const float NEG = -__builtin_inff();
    for (int t = 0; t < ntiles; ++t) {
        const int buf = t & 1;
        if (t + 1 < ntiles) AT_DMA(t + 1, buf ^ 1);
        if (t < wave_nt) {
            f32x16 s0, s1;
#pragma unroll
            for (int i = 0; i < 16; ++i) { s0[i] = 0.f; s1[i] = 0.f; }
            const LAS unsigned char* kb = lds + AT_K0 + buf * 16384;
#pragma unroll
            for (int kg = 0; kg < 4; ++kg) {
#pragma unroll
                for (int k2 = 0; k2 < 2; ++k2) { const int ks = 2 * kg + k2;
                    const bf16x8 k0 = *(const LAS bf16x8*)(kb + kaddr[ks]), k1 = *(const LAS bf16x8*)(kb + kaddr[ks] + 8192);
                    s0 = __builtin_amdgcn_mfma_f32_32x32x16_bf16(k0, qf[ks], s0, 0, 0, 0);
                    s1 = __builtin_amdgcn_mfma_f32_32x32x16_bf16(k1, qf[ks], s1, 0, 0, 0); }
                __builtin_amdgcn_sched_barrier(0);
            }
            float mx = NEG;
            if (MODE == 0) {
#pragma unroll
                for (int i = 0; i < 16; ++i) { s0[i] *= C; s1[i] *= C; mx = fmaxf(mx, fmaxf(s0[i], s1[i])); }
            } else if (MODE == 1) {
                const int tk = t * 64;
                const bool diag = (tk + 63 > B.qmin);
#pragma unroll
                for (int g = 0; g < 4; ++g) {
                    const int kq = 16 * (g >> 1) + 8 * hi + 4 * (g & 1);
                    const f32x4 c0 = *(const LAS f32x4*)(B.tab + tk + kq), c1 = *(const LAS f32x4*)(B.tab + tk + 32 + kq);
#pragma unroll
                    for (int j = 0; j < 4; ++j) { const int i = 4 * g + j; float v0 = s0[i] * C + (B.cq - c0[j]), v1 = s1[i] * C + (B.cq - c1[j]);
                        if (diag) { const int ko = tk + kq + j; if (ko > B.qpos) v0 = NEG; if (ko + 32 > B.qpos) v1 = NEG; }
                        s0[i] = v0; s1[i] = v1; mx = fmaxf(mx, fmaxf(v0, v1)); }
                    __builtin_amdgcn_sched_barrier(0);
                }
            } else {
                const int tk = B.kpos0 + t * 64;
                const bool far = (MODE == 2) && (B.qmin - (tk + 63) >= 128);
                if (far) { const float bb = B.tab[128];
#pragma unroll
                    for (int i = 0; i < 16; ++i) { s0[i] = s0[i] * C + bb; s1[i] = s1[i] * C + bb; mx = fmaxf(mx, fmaxf(s0[i], s1[i])); }
                } else {
#pragma unroll
                    for (int i = 0; i < 16; ++i) { const int ko = 16 * (i >> 3) + 8 * hi + (i & 7); const int d0 = B.qpos - (tk + ko), d1 = d0 - 32;
                        float v0 = s0[i] * C + B.tab[d0 < 0 ? 0 : (d0 > 128 ? 128 : d0)], v1 = s1[i] * C + B.tab[d1 < 0 ? 0 : (d1 > 128 ? 128 : d1)];
                        if (MODE == 3) { if (d0 < 0) v0 = NEG; if (d1 < 0) v1 = NEG; }
                        s0[i] = v0; s1[i] = v1; mx = fmaxf(mx, fmaxf(v0, v1)); }
                }
            }
            mx = swap_max(mx);
            const float mn = fmaxf(m, mx), alpha = fast_exp2(m - mn); m = mn;
            float ps = 0.f;
#pragma unroll
            for (int i = 0; i < 16; ++i) { s0[i] = fast_exp2(s0[i] - mn); s1[i] = fast_exp2(s1[i] - mn); ps += s0[i] + s1[i]; }
            ps = swap_sum(ps); l = l * alpha + ps;
            if (!__all(alpha == 1.0f)) {
#pragma unroll
                for (int db = 0; db < 4; ++db)
#pragma unroll
                    for (int i = 0; i < 16; ++i) o[db][i] *= alpha;
            }
            bf16x8 pf[4];
#pragma unroll
            for (int s = 0; s < 4; ++s) { u32x4 wv;
                if (s < 2) { wv.x = cvt_pk_bf16(s0[8 * s + 0], s0[8 * s + 1]); wv.y = cvt_pk_bf16(s0[8 * s + 2], s0[8 * s + 3]); wv.z = cvt_pk_bf16(s0[8 * s + 4], s0[8 * s + 5]); wv.w = cvt_pk_bf16(s0[8 * s + 6], s0[8 * s + 7]); }
                else { const int q = s - 2; wv.x = cvt_pk_bf16(s1[8 * q + 0], s1[8 * q + 1]); wv.y = cvt_pk_bf16(s1[8 * q + 2], s1[8 * q + 3]); wv.z = cvt_pk_bf16(s1[8 * q + 4], s1[8 * q + 5]); wv.w = cvt_pk_bf16(s1[8 * q + 6], s1[8 * q + 7]); }
                pf[s] = *reinterpret_cast<bf16x8*>(&wv); }
            const LAS unsigned char* vb = lds + AT_V0 + buf * 16384;
#pragma unroll
            for (int s = 0; s < 4; ++s) {
#pragma unroll
                for (int db = 0; db < 4; ++db) { const bf16x8 vf = *(const LAS bf16x8*)(vb + vaddr[s] + db * 4096); o[db] = __builtin_amdgcn_mfma_f32_32x32x16_bf16(vf, pf[s], o[db], 0, 0, 0); }
                __builtin_amdgcn_sched_barrier(0);
            }
        }
        asm volatile("s_waitcnt vmcnt(0)" ::: "memory");
        __syncthreads();
    }
#undef AT_DMA
}
__device__ __forceinline__ void attn_init(f32x16 (&o)[4], float& m, float& l) {
#pragma unroll
    for (int db = 0; db < 4; ++db)
#pragma unroll
        for (int i = 0; i < 16; ++i) o[db][i] = 0.f;
    m = -1e30f; l = 0.f;
}
__device__ __forceinline__ void load_q(const bf16_t* qrow, int hi, bf16x8 (&qf)[8]) {
#pragma unroll
    for (int ks = 0; ks < 8; ++ks) qf[ks] = *(const bf16x8*)(qrow + 16 * ks + 8 * hi);
}
__device__ __forceinline__ void store_o(const f32x16 (&o)[4], float sc, bf16_t* orow, int hi) {
#pragma unroll
    for (int db = 0; db < 4; ++db)
#pragma unroll
        for (int g = 0; g < 4; ++g) { u32x2 w; w.x = cvt_pk_bf16(o[db][4 * g] * sc, o[db][4 * g + 1] * sc); w.y = cvt_pk_bf16(o[db][4 * g + 2] * sc, o[db][4 * g + 3] * sc);
            *(u32x2*)(orow + 32 * db + 8 * g + 4 * hi) = w; }
}

__device__ __forceinline__ void phase_memattn(const Params& p, LAS unsigned char* lds, int bid, int nb) {
    const int tid = tid_(), lane = tid & 63, w = tid >> 6, c = lane & 31, hi = lane >> 5;
    for (int u = bid; u < BATCH * MH * 32; u += nb) {
        const int b = u >> 7, mh = (u >> 5) & 3, qb = u & 31;
        const int tok = b * SEQ + qb * 256 + 32 * w + c;
        bf16x8 qf[8]; load_q(WSP(bf16_t, WS_PMQ) + (size_t)tok * MEMW + mh * HD, hi, qf);
        f32x16 o[4]; float m, l; attn_init(o, m, l);
        AttnBias B{0.f, 0, nullptr, 0, 0};
        attn_tiles<0>(lds, WSP(bf16_t, WS_MEMK) + (size_t)b * MEMT * MEMW + mh * HD, MEMW, WSP(bf16_t, WS_MEMVT) + (size_t)mh * HD * 512 + b * MEMT, 512, 4, 4, qf, o, m, l, B);
        store_o(o, 1.0f / l, WSP(bf16_t, WS_MIX) + (size_t)tok * OUT_IN + DM + mh * HD, hi);
    }
}

__device__ __forceinline__ void phase_fox_logf(const Params& p, int layer, int bid, int nb) {
    const int tid = tid_(), lane = tid & 63, w = tid >> 6;
    const float* xin = (layer == 0) ? p.in[I_X] : WSP(float, WS_XF);
    const float* wf = p.in[I_FOX_W] + (size_t)(layer / 3) * DM * FOX_IN + 3072;
    const float* bf = p.in[I_FOX_BF] + (layer / 3) * NH;
    float wr[16][8];
#pragma unroll
    for (int j = 0; j < 4; ++j)
#pragma unroll
        for (int q = 0; q < 4; ++q) { const int k = 256 * j + 4 * lane + q;
#pragma unroll
            for (int h = 0; h < 8; ++h) wr[4 * j + q][h] = wf[(size_t)k * FOX_IN + h]; }
    for (int tok = bid * NWAVES + w; tok < T; tok += nb * NWAVES) {
        float acc[8];
#pragma unroll
        for (int h = 0; h < 8; ++h) acc[h] = 0.f;
#pragma unroll
        for (int j = 0; j < 4; ++j) { const f32x4 xv = *(const f32x4*)(xin + (size_t)tok * DM + 256 * j + 4 * lane);
#pragma unroll
            for (int q = 0; q < 4; ++q)
#pragma unroll
                for (int h = 0; h < 8; ++h) acc[h] = fmaf(xv[q], wr[4 * j + q][h], acc[h]); }
#pragma unroll
        for (int h = 0; h < 8; ++h) acc[h] = wave_sum(acc[h]);
        if (lane < 8) { float z = 0.f;
#pragma unroll
            for (int h = 0; h < 8; ++h) z = (lane == h) ? acc[h] : z;
            const int b = tok / SEQ, s = tok % SEQ;
            WSP(float, WS_LOGF)[((size_t)b * NH + lane) * SEQ + s] = logsigmoidf_(z + bf[lane]) * LOG2E; }
    }
}
__device__ __forceinline__ void phase_fox_attn(const Params& p, LAS unsigned char* lds, int bid, int nb) {
    const int tid = tid_(), lane = tid & 63, w = tid >> 6, c = lane & 31, hi = lane >> 5;
    LAS float* c2 = (LAS float*)(lds + AT_AUX);
    LAS float* wtot = (LAS float*)(lds + AT_AUX + 32768);
    for (int item = bid; item < 256; item += nb) {
        const int bh = item >> 4, pr = item & 15, b = bh >> 3, h = bh & 7;
        for (int half = 0; half < 2; ++half) {
            const int qb = half == 0 ? 31 - pr : pr;
            const int n = (qb + 1) * 256;
            __syncthreads();
            {
                const float* src = WSP(float, WS_LOGF) + (size_t)bh * SEQ; const int i0 = tid * 16;
                float v[16]; float run = 0.f;
                if (i0 < n) {
#pragma unroll
                    for (int j = 0; j < 4; ++j) { const f32x4 x = *(const f32x4*)(src + i0 + 4 * j); v[4 * j] = x[0]; v[4 * j + 1] = x[1]; v[4 * j + 2] = x[2]; v[4 * j + 3] = x[3]; }
#pragma unroll
                    for (int j = 0; j < 16; ++j) { run += v[j]; v[j] = run; }
                }
                float inc = run;
#pragma unroll
                for (int o_ = 1; o_ < 64; o_ <<= 1) { const float y = __shfl_up(inc, o_); if (lane >= o_) inc += y; }
                if (lane == 63) wtot[w] = inc;
                __syncthreads();
                float base = inc - run;
                for (int q = 0; q < w; ++q) base += wtot[q];
                if (i0 < n) {
#pragma unroll
                    for (int j = 0; j < 16; ++j) c2[i0 + j] = v[j] + base; }
                __syncthreads();
            }
            const int qpos = qb * 256 + 32 * w + c, tok = b * SEQ + qpos;
            bf16x8 qf[8]; load_q(WSP(bf16_t, WS_PA) + (size_t)tok * DM + h * HD, hi, qf);
            f32x16 o[4]; float m, l; attn_init(o, m, l);
            AttnBias B{c2[qpos], qpos, c2, 0, qb * 256 + 32 * w};
            const int wave_nt = ((qb * 256 + 32 * w + 31) >> 6) + 1;
            attn_tiles<1>(lds, WSP(bf16_t, WS_PB) + (size_t)b * SEQ * DM + h * HD, DM, WSP(bf16_t, WS_PVT) + (size_t)h * HD * T + (size_t)b * SEQ, T, (qb + 1) * 4, wave_nt, qf, o, m, l, B);
            store_o(o, 1.0f / l, WSP(bf16_t, WS_MIX) + (size_t)tok * OUT_IN + h * HD, hi);
        }
    }
}

__device__ __forceinline__ int t5_bucket(int n) {
    if (n < 16) return n;
    const int v = 16 + (int)(__log2f((float)n * (1.0f / 16.0f)) * (16.0f / 3.0f));
    return v < 31 ? v : 31;
}
__device__ __forceinline__ void phase_moba_kmean(const Params& p, LAS unsigned char* lds, int bid, int nb) {
    const int tid = tid_(); LAS float* red = (LAS float*)lds;
    const int dp = tid & 63, kg = tid >> 6;
    for (int u = bid; u < 512; u += nb) {
        const int bh = u >> 5, j = u & 31, b = bh >> 3, h = bh & 7;
        const bf16_t* kp = WSP(bf16_t, WS_PB) + ((size_t)b * SEQ + j * 256 + kg * 32) * DM + h * HD + 2 * dp;
        float s0 = 0.f, s1 = 0.f;
#pragma unroll 8
        for (int k = 0; k < 32; ++k) { const unsigned wv = *(const unsigned*)(kp + (size_t)k * DM); s0 += bflo(wv); s1 += bfhi(wv); }
        __syncthreads();
        red[kg * 128 + 2 * dp] = s0; red[kg * 128 + 2 * dp + 1] = s1;
        __syncthreads();
        if (tid < 128) { float s = 0.f;
#pragma unroll
            for (int g = 0; g < 8; ++g) s += red[g * 128 + tid];
            WSP(float, WS_KMEAN)[(size_t)u * 128 + tid] = s * (1.0f / 256.0f); }
    }
}
__device__ __forceinline__ void phase_moba_gate(const Params& p, LAS unsigned char* lds, int bid, int nb) {
    const int tid = tid_(); LAS float* km = (LAS float*)lds;
    LAS int* lcnt = (LAS int*)(lds + 16384); LAS int* lbase = lcnt + 32;
    unsigned* gl = ctl(p) + CW_LCNT;
    for (int u = bid; u < 512; u += nb) {
        const int bh = u >> 5, own = u & 31, b = bh >> 3, h = bh & 7;
        __syncthreads();
        for (int i = tid; i < 32 * 128; i += NTHR) km[i] = WSP(float, WS_KMEAN)[(size_t)bh * 32 * 128 + i];
        if (tid < 32) lcnt[tid] = 0;
        __syncthreads();
        int sel[3] = {-1, -1, -1}, rank[3] = {0, 0, 0}; int nv = 0;
        const int q = own * 256 + (tid & 255);
        if (tid < 256) {
            const bf16_t* qp = WSP(bf16_t, WS_PA) + ((size_t)b * SEQ + q) * DM + h * HD;
            unsigned qw[64];
#pragma unroll
            for (int i = 0; i < 16; ++i) { const u32x4 x = *(const u32x4*)(qp + 8 * i); qw[4 * i] = x.x; qw[4 * i + 1] = x.y; qw[4 * i + 2] = x.z; qw[4 * i + 3] = x.w; }
            float best[3] = {-__builtin_inff(), -__builtin_inff(), -__builtin_inff()};
            for (int j = 0; j < own; ++j) { const LAS float* kr = km + j * 128; float g = 0.f;
#pragma unroll
                for (int i = 0; i < 64; ++i) { g = fmaf(bflo(qw[i]), kr[2 * i], g); g = fmaf(bfhi(qw[i]), kr[2 * i + 1], g); }
                if (g > best[0]) { best[2] = best[1]; sel[2] = sel[1]; best[1] = best[0]; sel[1] = sel[0]; best[0] = g; sel[0] = j; }
                else if (g > best[1]) { best[2] = best[1]; sel[2] = sel[1]; best[1] = g; sel[1] = j; }
                else if (g > best[2]) { best[2] = g; sel[2] = j; } }
            nv = own < 3 ? own : 3;
            for (int s = 0; s < 3; ++s) if (s < nv) rank[s] = atomicAdd((int*)&lcnt[sel[s]], 1);
            int* sp = WSP(int, WS_SEL) + (((size_t)b * SEQ + q) * NH + h) * 4; sp[0] = sel[0]; sp[1] = sel[1]; sp[2] = sel[2]; sp[3] = nv;
        }
        __syncthreads();
        if (tid < 32) lbase[tid] = lcnt[tid] ? (int)atomicAdd(gl + bh * 32 + tid, (unsigned)lcnt[tid]) : 0;
        __syncthreads();
        if (tid < 256) for (int s = 0; s < 3; ++s) if (s < nv) WSP(unsigned, WS_LISTS)[((size_t)bh * 32 + sel[s]) * 8192 + lbase[sel[s]] + rank[s]] = (unsigned)q | ((unsigned)s << 16);
    }
}
__device__ __forceinline__ void moba_bias_tab(const Params& p, LAS float* tab, int h) {
    const int tid = tid_();
    if (tid <= 128) tab[tid] = p.in[I_RELB][t5_bucket(tid) * NH + h] * LOG2E;
}
__device__ __forceinline__ void phase_moba_past(const Params& p, LAS unsigned char* lds, int bid, int nb) {
    const int tid = tid_(), lane = tid & 63, w = tid >> 6, c = lane & 31, hi = lane >> 5;
    LAS float* tab = (LAS float*)(lds + AT_AUX); LAS int* pre = (LAS int*)(lds + AT_AUX + 1024);
    LAS int* wsum = (LAS int*)(lds + AT_AUX + 1024 + 4096);
    const unsigned* gl = ctl(p) + CW_LCNT;
    {
        const int n = (int)__hip_atomic_load(gl + tid, __ATOMIC_RELAXED, __HIP_MEMORY_SCOPE_AGENT); const int nu = (n + 255) >> 8;
        int inc = nu;
#pragma unroll
        for (int o_ = 1; o_ < 64; o_ <<= 1) { const int y = __shfl_up(inc, o_); if (lane >= o_) inc += y; }
        if (lane == 63) wsum[w] = inc;
        __syncthreads();
        int base = inc - nu; for (int q = 0; q < w; ++q) base += wsum[q];
        pre[tid] = base; if (tid == 511) pre[512] = base + nu;
        __syncthreads();
    }
    const int total = pre[512];
    int cur_h = -1;
    for (int u = bid; u < total; u += nb) {
        int lo = 0, hiL = 511;
        while (lo < hiL) { const int mid = (lo + hiL + 1) >> 1; if (pre[mid] <= u) lo = mid; else hiL = mid - 1; }
        const int list = lo, chunk = u - pre[list], bh = list >> 5, j = list & 31, b = bh >> 3, h = bh & 7;
        const int n = (int)__hip_atomic_load(gl + list, __ATOMIC_RELAXED, __HIP_MEMORY_SCOPE_AGENT);
        if (h != cur_h) { __syncthreads(); moba_bias_tab(p, tab, h); cur_h = h; __syncthreads(); }
        const int e0 = chunk * 256 + 32 * w; const bool active = e0 < n;
        int ei = e0 + c; if (ei > n - 1) ei = n - 1;
        const unsigned ent = WSP(unsigned, WS_LISTS)[(size_t)list * 8192 + ei]; const int q = ent & 0xffff, slot = ent >> 16;
        const int tok = b * SEQ + q;
        bf16x8 qf[8]; load_q(WSP(bf16_t, WS_PA) + (size_t)tok * DM + h * HD, hi, qf);
        int qmin = q;
#pragma unroll
        for (int o_ = 1; o_ < 64; o_ <<= 1) { const int y = __shfl_xor(qmin, o_); qmin = y < qmin ? y : qmin; }
        f32x16 o[4]; float m, l; attn_init(o, m, l);
        AttnBias B{0.f, q, tab, j * 256, qmin};
        attn_tiles<2>(lds, WSP(bf16_t, WS_PB) + ((size_t)b * SEQ + j * 256) * DM + h * HD, DM, WSP(bf16_t, WS_PVT) + (size_t)h * HD * T + (size_t)b * SEQ + j * 256, T, 4, active ? 4 : 0, qf, o, m, l, B);
        if (active) { const size_t P = ((size_t)tok * NH + h) * 3 + slot;
            store_o(o, 1.0f / l, WSP(bf16_t, WS_PARTO) + P * HD, hi);
            if (hi == 0) WSP(float, WS_PARTL)[P] = m + __log2f(l); }
    }
}
__device__ __forceinline__ void phase_moba_own(const Params& p, LAS unsigned char* lds, int bid, int nb) {
    const int tid = tid_(), lane = tid & 63, w = tid >> 6, c = lane & 31, hi = lane >> 5;
    LAS float* tab = (LAS float*)(lds + AT_AUX);
    int cur_h = -1;
    for (int u = bid; u < 512; u += nb) {
        const int bh = u >> 5, blk = u & 31, b = bh >> 3, h = bh & 7;
        if (h != cur_h) { __syncthreads(); moba_bias_tab(p, tab, h); cur_h = h; __syncthreads(); }
        const int qrel = 32 * w + c, q = blk * 256 + qrel, tok = b * SEQ + q;
        bf16x8 qf[8]; load_q(WSP(bf16_t, WS_PA) + (size_t)tok * DM + h * HD, hi, qf);
        f32x16 o[4]; float m, l; attn_init(o, m, l);
        AttnBias B{0.f, qrel, tab, 0, 32 * w};
        attn_tiles<3>(lds, WSP(bf16_t, WS_PB) + ((size_t)b * SEQ + blk * 256) * DM + h * HD, DM, WSP(bf16_t, WS_PVT) + (size_t)h * HD * T + (size_t)b * SEQ + blk * 256, T, 4, (w >> 1) + 1, qf, o, m, l, B);
        const int* sp = WSP(int, WS_SEL) + ((size_t)tok * NH + h) * 4; const int nv = sp[3];
        const size_t P = ((size_t)tok * NH + h) * 3;
        float lse[3], M = m;
#pragma unroll
        for (int s = 0; s < 3; ++s) { lse[s] = (s < nv) ? WSP(float, WS_PARTL)[P + s] : -__builtin_inff(); M = fmaxf(M, lse[s]); }
        const float wo = fast_exp2(m - M); float den = l * wo;
#pragma unroll
        for (int db = 0; db < 4; ++db)
#pragma unroll
            for (int i = 0; i < 16; ++i) o[db][i] *= wo;
#pragma unroll
        for (int s = 0; s < 3; ++s) { if (s < nv) { const float ws_ = fast_exp2(lse[s] - M); den += ws_; const bf16_t* po = WSP(bf16_t, WS_PARTO) + (P + s) * HD;
#pragma unroll
                for (int db = 0; db < 4; ++db)
#pragma unroll
                    for (int g = 0; g < 4; ++g) { const u32x2 x = *(const u32x2*)(po + 32 * db + 8 * g + 4 * hi);
                        o[db][4 * g] += ws_ * bflo(x.x); o[db][4 * g + 1] += ws_ * bfhi(x.x); o[db][4 * g + 2] += ws_ * bflo(x.y); o[db][4 * g + 3] += ws_ * bfhi(x.y); } } }
        store_o(o, 1.0f / den, WSP(bf16_t, WS_MIX) + (size_t)tok * OUT_IN + h * HD, hi);
    }
}

__device__ __forceinline__ void phase_hgrn_pre(const Params& p, int layer, int bid, int nb) {
    const int jj = layer / 3; const int tid = tid_(), lane = tid & 63, w = tid >> 6;
    const float* lbp = p.in[I_HGRN_LB];
    for (int item = bid * NWAVES + w; item < 256 * 32; item += nb * NWAVES) {
        const int crow = item >> 5, cg = item & 31, ch0 = cg * 32;
        const int b = crow >> 7, cc = crow & 127; const size_t tok = (size_t)b * SEQ + cc * 64 + lane;
        f32x4 z[8]; u32x4 qw[4];
#pragma unroll
        for (int j = 0; j < 8; ++j) z[j] = *(const f32x4*)(WSP(float, WS_PZ) + tok * DM + ch0 + 4 * j);
#pragma unroll
        for (int j = 0; j < 4; ++j) qw[j] = *(const u32x4*)(WSP(bf16_t, WS_PA) + tok * DM + ch0 + 8 * j);
        unsigned oqb[16], oqr[16], okr[16]; float gsel = 0.f;
#pragma unroll
        for (int j = 0; j < 8; ++j) {
            float vqb[4], vqr[4], vkr[4];
#pragma unroll
            for (int q = 0; q < 4; ++q) { const int cl = 4 * j + q, ch = ch0 + cl; const float zz = z[j][q];
                const float lb = (jj == 0) ? 0.f : sigmoidf_(lbp[DM + ch] - lbp[ch]);
                const float e = __expf(-fabsf(zz)), r1 = fast_rcp(1.0f + e), l1 = __logf(1.0f + e);
                const float sg = (zz >= 0.f) ? r1 : e * r1, sgn = (zz >= 0.f) ? e * r1 : r1;
                const float ls = fminf(zz, 0.f) - l1;
                const float lf = (jj == 0) ? ls : __logf(lb + (1.f - lb) * sg);
                float bc = lf;
#pragma unroll
                for (int o_ = 1; o_ < 64; o_ <<= 1) { const float y = __shfl_up(bc, o_); if (lane >= o_) bc += y; }
                const float bmid = __shfl(bc, 31), blast = __shfl(bc, 63);
                const float kk = (1.f - lb) * sgn;
                const unsigned qword = (cl & 1) ? 0u : 0u; (void)qword;
                const unsigned qwv = ((const unsigned*)&qw[cl >> 3])[(cl & 7) >> 1]; const float qv = (cl & 1) ? bfhi(qwv) : bflo(qwv);
                vqb[q] = qv * __expf(bc); vqr[q] = qv * __expf(fminf(bc - bmid, 80.f)); vkr[q] = kk * __expf(fminf(bmid - bc, 80.f));
                WSP(bf16_t, WS_HKDT)[(size_t)ch * T + tok] = f2bf(kk * __expf(blast - bc));
                gsel = (lane == cl) ? __expf(blast) : gsel; }
            oqb[2 * j] = cvt_pk_bf16(vqb[0], vqb[1]); oqb[2 * j + 1] = cvt_pk_bf16(vqb[2], vqb[3]);
            oqr[2 * j] = cvt_pk_bf16(vqr[0], vqr[1]); oqr[2 * j + 1] = cvt_pk_bf16(vqr[2], vqr[3]);
            okr[2 * j] = cvt_pk_bf16(vkr[0], vkr[1]); okr[2 * j + 1] = cvt_pk_bf16(vkr[2], vkr[3]);
        }
#pragma unroll
        for (int j = 0; j < 4; ++j) {
            *(u32x4*)(WSP(bf16_t, WS_HQB) + tok * DM + ch0 + 8 * j) = (u32x4){oqb[4 * j], oqb[4 * j + 1], oqb[4 * j + 2], oqb[4 * j + 3]};
            *(u32x4*)(WSP(bf16_t, WS_HQR) + tok * DM + ch0 + 8 * j) = (u32x4){oqr[4 * j], oqr[4 * j + 1], oqr[4 * j + 2], oqr[4 * j + 3]};
            *(u32x4*)(WSP(bf16_t, WS_HKR) + tok * DM + ch0 + 8 * j) = (u32x4){okr[4 * j], okr[4 * j + 1], okr[4 * j + 2], okr[4 * j + 3]}; }
        if (lane < 32) { const int ch = ch0 + lane, hh = ch >> 7, d = ch & 127; WSP(float, WS_HG)[((size_t)(b * NH + hh) * 128 + cc) * 128 + d] = gsel; }
    }
}
__device__ __forceinline__ void phase_hgrn_a(const Params& p, int bid, int nb) {
    const int tid = tid_(), lane = tid & 63, w = tid >> 6, c = lane & 31, hi = lane >> 5, eb = w >> 1, dh = w & 1;
    for (int u = bid; u < 2048; u += nb) {
        const int bh = u >> 7, cc = u & 127, b = bh >> 3, hh = bh & 7; const size_t tok0 = (size_t)b * SEQ + cc * 64;
        const bf16_t* vt = WSP(bf16_t, WS_PVT) + (size_t)(hh * HD + 32 * eb + c) * T + tok0 + 8 * hi;
        const bf16_t* kd = WSP(bf16_t, WS_HKDT) + (size_t)(hh * HD + 64 * dh + c) * T + tok0 + 8 * hi;
        f32x16 a0, a1;
#pragma unroll
        for (int i = 0; i < 16; ++i) { a0[i] = 0.f; a1[i] = 0.f; }
#pragma unroll
        for (int ks = 0; ks < 4; ++ks) { const bf16x8 vf = *(const bf16x8*)(vt + 16 * ks), k0 = *(const bf16x8*)(kd + 16 * ks), k1 = *(const bf16x8*)(kd + (size_t)32 * T + 16 * ks);
            a0 = __builtin_amdgcn_mfma_f32_32x32x16_bf16(k0, vf, a0, 0, 0, 0); a1 = __builtin_amdgcn_mfma_f32_32x32x16_bf16(k1, vf, a1, 0, 0, 0); }
        bf16_t* st = WSP(bf16_t, WS_HST) + (size_t)u * 128 * 128 + (size_t)(32 * eb + c) * 128 + 64 * dh + 4 * hi;
#pragma unroll
        for (int g = 0; g < 4; ++g) { u32x2 x0, x1; x0.x = cvt_pk_bf16(a0[4 * g], a0[4 * g + 1]); x0.y = cvt_pk_bf16(a0[4 * g + 2], a0[4 * g + 3]); x1.x = cvt_pk_bf16(a1[4 * g], a1[4 * g + 1]); x1.y = cvt_pk_bf16(a1[4 * g + 2], a1[4 * g + 3]);
            *(u32x2*)(st + 8 * g) = x0; *(u32x2*)(st + 32 + 8 * g) = x1; }
    }
}
__device__ __forceinline__ void phase_hgrn_b(const Params& p, int bid, int nb) {
    for (int gid = bid * NTHR + tid_(); gid < 16 * 128 * 64; gid += nb * NTHR) {
        const int bh = gid >> 13, e = (gid >> 6) & 127, dp = gid & 63;
        unsigned* st = (unsigned*)(WSP(bf16_t, WS_HST) + (size_t)bh * 128 * 16384 + (size_t)e * 128 + 2 * dp); const float* gp = WSP(float, WS_HG) + (size_t)bh * 128 * 128 + 2 * dp;
        float S0 = 0.f, S1 = 0.f;
        for (int c8 = 0; c8 < 128; c8 += 8) { unsigned U[8]; f32x2 g[8];
#pragma unroll
            for (int q = 0; q < 8; ++q) { U[q] = st[(size_t)(c8 + q) * 8192]; g[q] = *(const f32x2*)(gp + (c8 + q) * 128); }
#pragma unroll
            for (int q = 0; q < 8; ++q) { st[(size_t)(c8 + q) * 8192] = cvt_pk_bf16(S0, S1); S0 = g[q][0] * S0 + bflo(U[q]); S1 = g[q][1] * S1 + bfhi(U[q]); } }
    }
}
__device__ __forceinline__ void phase_hgrn_c(const Params& p, int layer, int bid, int nb) {
    const int tid = tid_(), lane = tid & 63, w = tid >> 6, c = lane & 31, hi = lane >> 5;
    const float* ng = p.in[I_HGRN_NG] + (layer / 3) * DM;
    for (int wu = bid * NWAVES + w; wu < 4096; wu += nb * NWAVES) {
        const int u = wu >> 1, tb = wu & 1, bh = u >> 7, cc = u & 127, b = bh >> 3, hh = bh & 7; const size_t tok0 = (size_t)b * SEQ + cc * 64;
        const size_t tokq = tok0 + 32 * tb + c;
        f32x16 o[4];
#pragma unroll
        for (int db = 0; db < 4; ++db)
#pragma unroll
            for (int i = 0; i < 16; ++i) o[db][i] = 0.f;
        {
            bf16x8 qf[8]; load_q(WSP(bf16_t, WS_HQB) + tokq * DM + hh * HD, hi, qf);
            const bf16_t* st = WSP(bf16_t, WS_HST) + (size_t)u * 16384 + (size_t)c * 128 + 8 * hi;
#pragma unroll
            for (int db = 0; db < 4; ++db)
#pragma unroll
                for (int ks = 0; ks < 8; ++ks) o[db] = __builtin_amdgcn_mfma_f32_32x32x16_bf16(*(const bf16x8*)(st + (size_t)(32 * db) * 128 + 16 * ks), qf[ks], o[db], 0, 0, 0);
        }
        {
            bf16x8 qf[8]; load_q(WSP(bf16_t, WS_HQR) + tokq * DM + hh * HD, hi, qf);
            for (int kb = 0; kb <= tb; ++kb) {
                f32x16 s;
#pragma unroll
                for (int i = 0; i < 16; ++i) s[i] = 0.f;
                const bf16_t* kp = WSP(bf16_t, WS_HKR) + (tok0 + 32 * kb + c) * DM + hh * HD + 8 * hi;
#pragma unroll
                for (int ks = 0; ks < 8; ++ks) s = __builtin_amdgcn_mfma_f32_32x32x16_bf16(*(const bf16x8*)(kp + 16 * ks), qf[ks], s, 0, 0, 0);
                if (kb == tb) {
#pragma unroll
                    for (int i = 0; i < 16; ++i) { const int ko = (i & 3) + 8 * (i >> 2) + 4 * hi; if (ko > c) s[i] = 0.f; } }
#pragma unroll
                for (int sq = 0; sq < 2; ++sq) { u32x4 wv; wv.x = cvt_pk_bf16(s[8 * sq], s[8 * sq + 1]); wv.y = cvt_pk_bf16(s[8 * sq + 2], s[8 * sq + 3]); wv.z = cvt_pk_bf16(s[8 * sq + 4], s[8 * sq + 5]); wv.w = cvt_pk_bf16(s[8 * sq + 6], s[8 * sq + 7]);
                    const bf16x8 pf = *reinterpret_cast<bf16x8*>(&wv);
                    const bf16_t* vp = WSP(bf16_t, WS_PVT) + (size_t)(hh * HD + c) * T + tok0 + 32 * kb + 16 * sq + 4 * hi;
#pragma unroll
                    for (int db = 0; db < 4; ++db) { const u32x2 lo = *(const u32x2*)(vp + (size_t)(32 * db) * T), hi2 = *(const u32x2*)(vp + (size_t)(32 * db) * T + 8);
                        u32x4 vv; vv.x = lo.x; vv.y = lo.y; vv.z = hi2.x; vv.w = hi2.y;
                        o[db] = __builtin_amdgcn_mfma_f32_32x32x16_bf16(*reinterpret_cast<bf16x8*>(&vv), pf, o[db], 0, 0, 0); } }
            }
        }
        float ss = 0.f;
#pragma unroll
        for (int db = 0; db < 4; ++db)
#pragma unroll
            for (int i = 0; i < 16; ++i) ss += o[db][i] * o[db][i];
        ss = swap_sum(ss);
        const float rinv = rsqrtf(ss * (1.0f / 128.0f) + RMS_EPS);
        const bf16_t* gt = WSP(bf16_t, WS_PB) + tokq * DM + hh * HD; bf16_t* orow = WSP(bf16_t, WS_MIX) + tokq * OUT_IN + hh * HD;
#pragma unroll
        for (int db = 0; db < 4; ++db)
#pragma unroll
            for (int g = 0; g < 4; ++g) { const int d = 32 * db + 8 * g + 4 * hi; const u32x2 gw = *(const u32x2*)(gt + d); const f32x4 nv = *(const f32x4*)(ng + hh * HD + d);
                u32x2 wv; wv.x = cvt_pk_bf16(o[db][4 * g] * rinv * nv[0] * bflo(gw.x), o[db][4 * g + 1] * rinv * nv[1] * bfhi(gw.x));
                wv.y = cvt_pk_bf16(o[db][4 * g + 2] * rinv * nv[2] * bflo(gw.y), o[db][4 * g + 3] * rinv * nv[3] * bfhi(gw.y));
                *(u32x2*)(orow + d) = wv; }
    }
}

__device__ __forceinline__ void ln_row(f32x4 (&v)[4], const float* g, const float* bta, int lane) {
    float s = 0.f;
#pragma unroll
    for (int j = 0; j < 4; ++j) s += (v[j][0] + v[j][1]) + (v[j][2] + v[j][3]);
    const float mean = wave_sum(s) * (1.0f / DM); float s2 = 0.f;
#pragma unroll
    for (int j = 0; j < 4; ++j) { v[j] = v[j] - mean; s2 += (v[j][0] * v[j][0] + v[j][1] * v[j][1]) + (v[j][2] * v[j][2] + v[j][3] * v[j][3]); }
    const float rstd = rsqrtf(wave_sum(s2) * (1.0f / DM) + LN_EPS);
#pragma unroll
    for (int j = 0; j < 4; ++j) { const f32x4 gg = *(const f32x4*)(g + 256 * j + 4 * lane), bb = *(const f32x4*)(bta + 256 * j + 4 * lane); v[j] = v[j] * rstd * gg + bb; }
}
__device__ __forceinline__ void phase_ln1_router(const Params& p, LAS unsigned char* lds, int layer, int bid, int nb) {
    const int tid = tid_(), lane = tid & 63, w = tid >> 6;
    LAS float* part = (LAS float*)lds;
    LAS float* logit = (LAS float*)(lds + 32768);
    LAS int* asg_e = (LAS int*)(lds + 32768 + 8448 + 64); LAS unsigned* asg_v = (LAS unsigned*)(asg_e + 256);
    const float* g1 = p.in[I_LN1G] + layer * DM; const float* b1 = p.in[I_LN1B] + layer * DM;
    const float* rw = p.in[I_RW] + (size_t)layer * DM * NEXP; const float* rb = p.in[I_RB] + layer * NEXP;
    unsigned* ecnt = ctl(p) + CW_ECNT + layer * 32;
    for (int blk = bid; blk < T / 64; blk += nb) {
        const int row0 = blk * 64;
        for (int rr = 0; rr < 8; ++rr) { const size_t row = row0 + 8 * w + rr; const float* yp = WSP(float, WS_Y1) + row * DM;
            f32x4 v[4];
#pragma unroll
            for (int j = 0; j < 4; ++j) v[j] = *(const f32x4*)(yp + 256 * j + 4 * lane);
            ln_row(v, g1, b1, lane);
#pragma unroll
            for (int j = 0; j < 4; ++j) { *(f32x4*)(WSP(float, WS_X1F) + row * DM + 256 * j + 4 * lane) = v[j];
                u32x2 o; o.x = cvt_pk_bf16(v[j][0], v[j][1]); o.y = cvt_pk_bf16(v[j][2], v[j][3]); *(u32x2*)(WSP(bf16_t, WS_X1B) + row * DM + 256 * j + 4 * lane) = o; } }
        __syncthreads();
        {
            const int rt = w >> 2, kq = w & 3, i = lane & 31, kh = lane >> 5;
            const float* xp = WSP(float, WS_X1F) + (size_t)(row0 + 32 * rt + i) * DM + 256 * kq; const float* wp = rw + (size_t)(256 * kq + kh) * NEXP + i;
            f32x16 acc;
#pragma unroll
            for (int q = 0; q < 16; ++q) acc[q] = 0.f;
#pragma unroll 8
            for (int q = 0; q < 64; ++q) { const f32x4 xv = *(const f32x4*)(xp + 4 * q);
                acc = __builtin_amdgcn_mfma_f32_32x32x2f32(kh ? xv[1] : xv[0], wp[(size_t)(4 * q) * NEXP], acc, 0, 0, 0);
                acc = __builtin_amdgcn_mfma_f32_32x32x2f32(kh ? xv[3] : xv[2], wp[(size_t)(4 * q + 2) * NEXP], acc, 0, 0, 0); }
#pragma unroll
            for (int q = 0; q < 16; ++q) { const int r = (q & 3) + 8 * (q >> 2) + 4 * kh; part[(w * 32 + r) * 32 + i] = acc[q]; }
        }
        __syncthreads();
        for (int o_ = tid; o_ < 64 * 32; o_ += NTHR) { const int r = o_ >> 5, e = o_ & 31, rt = r >> 5, rl = r & 31; float s = rb[e];
#pragma unroll
            for (int kq = 0; kq < 4; ++kq) s += part[((rt * 4 + kq) * 32 + rl) * 32 + e];
            logit[r * 33 + e] = s; }
        __syncthreads();
        if (tid < 64) { const int tok = row0 + tid; float bv[4] = {-__builtin_inff(), -__builtin_inff(), -__builtin_inff(), -__builtin_inff()}; int bi[4] = {0, 0, 0, 0};
            for (int e = 0; e < 32; ++e) { const float x = logit[tid * 33 + e];
                if (x > bv[0]) { bv[3] = bv[2]; bi[3] = bi[2]; bv[2] = bv[1]; bi[2] = bi[1]; bv[1] = bv[0]; bi[1] = bi[0]; bv[0] = x; bi[0] = e; }
                else if (x > bv[1]) { bv[3] = bv[2]; bi[3] = bi[2]; bv[2] = bv[1]; bi[2] = bi[1]; bv[1] = x; bi[1] = e; }
                else if (x > bv[2]) { bv[3] = bv[2]; bi[3] = bi[2]; bv[2] = x; bi[2] = e; }
                else if (x > bv[3]) { bv[3] = x; bi[3] = e; } }
            float ex[4], se = 0.f;
#pragma unroll
            for (int k = 0; k < 4; ++k) { ex[k] = __expf(bv[k] - bv[0]); se += ex[k]; }
#pragma unroll
            for (int k = 0; k < 4; ++k) { WSP(float, WS_GATE)[(size_t)tok * 4 + k] = ex[k] / se; asg_e[tid * 4 + k] = bi[k]; asg_v[tid * 4 + k] = (unsigned)tok * 4u + k; } }
        __syncthreads();
        if (tid < 32) { int cnt = 0;
            for (int a = 0; a < 256; ++a) cnt += (asg_e[a] == tid) ? 1 : 0;
            if (cnt) { unsigned pos = atomicAdd(ecnt + tid, (unsigned)cnt); unsigned* et = WSP(unsigned, WS_ETOK) + (size_t)tid * T;
                for (int a = 0; a < 256; ++a) if (asg_e[a] == tid) et[pos++] = asg_v[a]; } }
        __syncthreads();
    }
}
__device__ __forceinline__ void phase_ln2(const Params& p, int layer, int bid, int nb) {
    const int tid = tid_(), lane = tid & 63, w = tid >> 6;
    const float* g2 = p.in[I_LN2G] + layer * DM; const float* b2 = p.in[I_LN2B] + layer * DM;
    float* dst = (layer == 3) ? p.out : WSP(float, WS_XF);
    for (size_t row = bid * NWAVES + w; row < T; row += (size_t)nb * NWAVES) {
        const float* xp = WSP(float, WS_X1F) + row * DM; const bf16_t* yp = WSP(bf16_t, WS_YE) + row * 4 * DM;
        float gk[4];
#pragma unroll
        for (int k = 0; k < 4; ++k) gk[k] = WSP(float, WS_GATE)[row * 4 + k];
        f32x4 v[4];
#pragma unroll
        for (int j = 0; j < 4; ++j) { v[j] = *(const f32x4*)(xp + 256 * j + 4 * lane) * DN_ALPHA;
#pragma unroll
            for (int k = 0; k < 4; ++k) { const u32x2 y = *(const u32x2*)(yp + (size_t)k * DM + 256 * j + 4 * lane);
                v[j][0] += gk[k] * bflo(y.x); v[j][1] += gk[k] * bfhi(y.x); v[j][2] += gk[k] * bflo(y.y); v[j][3] += gk[k] * bfhi(y.y); } }
        ln_row(v, g2, b2, lane);
#pragma unroll
        for (int j = 0; j < 4; ++j) { *(f32x4*)(dst + row * DM + 256 * j + 4 * lane) = v[j];
            u32x2 o; o.x = cvt_pk_bf16(v[j][0], v[j][1]); o.y = cvt_pk_bf16(v[j][2], v[j][3]); *(u32x2*)(WSP(bf16_t, WS_XB) + row * DM + 256 * j + 4 * lane) = o; }
    }
}

enum { PH_PROLOGUE = 0, PH_PROJ, PH_FOXLOGF, PH_HPRE, PH_HA, PH_HB, PH_HC, PH_FOXATTN, PH_KMEAN, PH_GATE, PH_PAST, PH_OWN, PH_MEMATTN, PH_OUTPROJ, PH_LN1, PH_UP, PH_DOWN, PH_LN2 };
template <int PH>
__device__ __forceinline__ void run_phase(const Params& p, LAS unsigned char* lds, int layer, int bid, int nb) {
    if constexpr (PH == PH_PROLOGUE) phase_prologue(p, lds, bid, nb);
    else if constexpr (PH == PH_PROJ) phase_proj(p, lds, layer, bid, nb);
    else if constexpr (PH == PH_FOXLOGF) phase_fox_logf(p, layer, bid, nb);
    else if constexpr (PH == PH_HPRE) phase_hgrn_pre(p, layer, bid, nb);
    else if constexpr (PH == PH_HA) phase_hgrn_a(p, bid, nb);
    else if constexpr (PH == PH_HB) phase_hgrn_b(p, bid, nb);
    else if constexpr (PH == PH_HC) phase_hgrn_c(p, layer, bid, nb);
    else if constexpr (PH == PH_FOXATTN) phase_fox_attn(p, lds, bid, nb);
    else if constexpr (PH == PH_KMEAN) phase_moba_kmean(p, lds, bid, nb);
    else if constexpr (PH == PH_GATE) phase_moba_gate(p, lds, bid, nb);
    else if constexpr (PH == PH_PAST) phase_moba_past(p, lds, bid, nb);
    else if constexpr (PH == PH_OWN) phase_moba_own(p, lds, bid, nb);
    else if constexpr (PH == PH_MEMATTN) phase_memattn(p, lds, bid, nb);
    else if constexpr (PH == PH_OUTPROJ) phase_outproj(p, lds, layer, bid, nb);
    else if constexpr (PH == PH_LN1) phase_ln1_router(p, lds, layer, bid, nb);
    else if constexpr (PH == PH_UP) phase_moe_up(p, lds, layer, bid, nb);
    else if constexpr (PH == PH_DOWN) phase_moe_down(p, lds, layer, bid, nb);
    else if constexpr (PH == PH_LN2) phase_ln2(p, layer, bid, nb);
}
template <int PH>
__global__ void __launch_bounds__(NTHR, 2) k_phase(Params p, int layer) {
    extern __shared__ __attribute__((aligned(16))) unsigned char lds_raw[];
    run_phase<PH>(p, (LAS unsigned char*)lds_raw, layer, (int)blockIdx.x, (int)gridDim.x);
}

#ifndef DEBUG_CHECKS
#define DEBUG_CHECKS 0
#endif
#if DEBUG_CHECKS
constexpr size_t WS_CHK = WS_END;
__device__ __forceinline__ float bfr(float x) { return bf2f(f2bf(x)); }
__device__ __forceinline__ unsigned hashu(unsigned x) { x ^= x >> 16; x *= 0x7feb352du; x ^= x >> 15; x *= 0x846ca68bu; x ^= x >> 16; return x; }
__device__ __forceinline__ void chk_report(const Params& p, int id, float err) { if (!(err == err)) err = 1e30f; atomicMax(ctl(p) + CW_CHK + id, __float_as_uint(fabsf(err))); }
__device__ __forceinline__ float blk_sum(float v, LAS float* red) {
    v = wave_sum(v); const int w = threadIdx.x >> 6, nw = blockDim.x >> 6; __syncthreads(); if ((threadIdx.x & 63) == 0) red[w] = v; __syncthreads(); float s = 0.f; for (int i = 0; i < nw; ++i) s += red[i]; return s; }
__device__ __forceinline__ float blk_max(float v, LAS float* red) {
#pragma unroll
    for (int o = 1; o < 64; o <<= 1) v = fmaxf(v, __shfl_xor(v, o));
    const int w = threadIdx.x >> 6, nw = blockDim.x >> 6; __syncthreads(); if ((threadIdx.x & 63) == 0) red[w] = v; __syncthreads(); float s = red[0]; for (int i = 1; i < nw; ++i) s = fmaxf(s, red[i]); return s; }

__global__ void chk_proj(Params p, int layer, int id) {
    const int kind = layer % 3, jj = layer / 3; const unsigned sidx = blockIdx.x * blockDim.x + threadIdx.x; const unsigned hsh = hashu(sidx * 2654435761u + layer * 977u + 12345u);
    const int nin = kind == 0 ? HGRN_IN : (kind == 1 ? FOX_IN : MOBA_IN);
    const float* W = kind == 0 ? p.in[I_HGRN_W] + (size_t)jj * DM * HGRN_IN : (kind == 1 ? p.in[I_FOX_W] : p.in[I_MOBA_W]);
    int tok = hsh % T; int col = (hsh >> 14) % (nin + 128);
    float exp_v, got;
    if (col >= nin) {
        const int c = (hashu(hsh) % 1024), row = tok % 512; const float* wk = p.in[I_WKV] + (size_t)layer * DM * 1024; float s = 0.f;
        for (int k = 0; k < DM; ++k) s += bfr(p.in[I_MEM][(size_t)row * DM + k]) * bfr(wk[(size_t)k * 1024 + c]);
        exp_v = s; got = c < 512 ? bf2f(WSP(bf16_t, WS_MEMK)[(size_t)row * 512 + c]) : bf2f(WSP(bf16_t, WS_MEMVT)[(size_t)(c - 512) * 512 + row]);
    } else {
        float s = 0.f, sf = 0.f;
        for (int k = 0; k < DM; ++k) { const float xv = (layer == 0) ? p.in[I_X][(size_t)tok * DM + k] : WSP(float, WS_XF)[(size_t)tok * DM + k]; const float xb = (layer == 0) ? bfr(xv) : bf2f(WSP(bf16_t, WS_XB)[(size_t)tok * DM + k]);
            const float wv = W[(size_t)k * nin + col]; s += xb * bfr(wv); sf += xv * wv; }
        const int sec = col >> 10, c = col & 1023; exp_v = s;
        if (kind == 0) { if (sec == 0) { exp_v = siluf_(s); got = bf2f(WSP(bf16_t, WS_PA)[(size_t)tok * DM + c]); } else if (sec == 1) got = WSP(float, WS_PZ)[(size_t)tok * DM + c];
            else if (sec == 2) got = bf2f(WSP(bf16_t, WS_PVT)[(size_t)c * T + tok]); else if (sec == 3) { exp_v = siluf_(s); got = bf2f(WSP(bf16_t, WS_PB)[(size_t)tok * DM + c]); } else got = bf2f(WSP(bf16_t, WS_PMQ)[(size_t)tok * MEMW + c]); }
        else { if (sec == 0) got = bf2f(WSP(bf16_t, WS_PA)[(size_t)tok * DM + c]); else if (sec == 1) got = bf2f(WSP(bf16_t, WS_PB)[(size_t)tok * DM + c]); else if (sec == 2) got = bf2f(WSP(bf16_t, WS_PVT)[(size_t)c * T + tok]);
            else if (kind == 1 && col < 3080) { exp_v = logsigmoidf_(sf + p.in[I_FOX_BF][jj * NH + (col - 3072)]) * LOG2E; got = WSP(float, WS_LOGF)[((size_t)(tok / SEQ) * NH + (col - 3072)) * SEQ + tok % SEQ]; }
            else got = bf2f(WSP(bf16_t, WS_PMQ)[(size_t)tok * MEMW + (col - (kind == 1 ? 3080 : 3072))]); }
    }
    chk_report(p, id, fabsf(got - exp_v) / (fabsf(exp_v) + 0.05f));
}
__global__ void chk_fox_prep(Params p) { const int bh = threadIdx.x; if (bh < 16) { float s = 0.f; for (int k = 0; k < SEQ; ++k) { s += WSP(float, WS_LOGF)[(size_t)bh * SEQ + k]; WSP(float, WS_CHK)[(size_t)bh * SEQ + k] = s; } } }
__device__ __forceinline__ float chk_softmax_out(const Params& p, LAS float* sc, const LAS int* kp, int n, int b, int h, int tok, LAS float* red) {
    float mx = -1e30f; for (int i = threadIdx.x; i < n; i += blockDim.x) mx = fmaxf(mx, sc[i]); mx = blk_max(mx, red);
    float sm = 0.f; for (int i = threadIdx.x; i < n; i += blockDim.x) { const float e = exp2f(sc[i] - mx); sc[i] = e; sm += e; } sm = blk_sum(sm, red);
    float err = 0.f, mag = 0.f;
    if (threadIdx.x < 128) { const int d = threadIdx.x; float o = 0.f; for (int i = 0; i < n; ++i) o += sc[i] * bf2f(WSP(bf16_t, WS_PVT)[(size_t)(h * HD + d) * T + (size_t)b * SEQ + (kp ? kp[i] : i)]);
        o /= sm; const float got = bf2f(WSP(bf16_t, WS_MIX)[(size_t)tok * OUT_IN + h * HD + d]); err = fabsf(got - o); mag = fabsf(o); }
    err = blk_max(err, red); mag = blk_max(mag, red); return err / (mag + 1e-3f);
}
__global__ void chk_fox(Params p, int id) {
    extern __shared__ __attribute__((aligned(16))) unsigned char sm_raw[]; LAS float* sc = (LAS float*)sm_raw; LAS float* red = sc + 8192;
    const unsigned hsh = hashu(blockIdx.x * 7919u + 17u); const int b = hsh & 1, h = (hsh >> 1) & 7; int q = (hsh >> 4) % SEQ; if (blockIdx.x < 8) q = blockIdx.x * 37; if (blockIdx.x == 8) q = SEQ - 1;
    const int tok = b * SEQ + q; const float* c2 = WSP(float, WS_CHK) + (size_t)(b * NH + h) * SEQ;
    for (int k = threadIdx.x; k <= q; k += blockDim.x) { float s = 0.f; for (int d = 0; d < HD; ++d) s += bf2f(WSP(bf16_t, WS_PA)[(size_t)tok * DM + h * HD + d]) * bf2f(WSP(bf16_t, WS_PB)[((size_t)b * SEQ + k) * DM + h * HD + d]);
        sc[k] = s * QK_SCALE * LOG2E + c2[q] - c2[k]; }
    __syncthreads();
    const float e = chk_softmax_out(p, sc, nullptr, q + 1, b, h, tok, red);
    if (threadIdx.x == 0) chk_report(p, id, e);
}
__global__ void chk_moba(Params p, int id) {
    extern __shared__ __attribute__((aligned(16))) unsigned char sm_raw[]; LAS float* sc = (LAS float*)sm_raw; LAS int* kp = (LAS int*)(sc + 1024); LAS float* km = (LAS float*)(kp + 1024); LAS float* red = km + 32 * 128; LAS float* gate = red + 16; LAS int* selb = (LAS int*)(gate + 32);
    const unsigned hsh = hashu(blockIdx.x * 7919u + 29u); const int b = hsh & 1, h = (hsh >> 1) & 7; int q = (hsh >> 4) % SEQ; if (blockIdx.x < 6) q = blockIdx.x * 173; if (blockIdx.x == 6) q = 256; if (blockIdx.x == 7) q = 1024 + 5;
    const int own = q >> 8, tok = b * SEQ + q;
    for (int idx = threadIdx.x; idx < own * 128; idx += blockDim.x) { const int j = idx >> 7, d = idx & 127; float s = 0.f; for (int k = 0; k < 256; ++k) s += bf2f(WSP(bf16_t, WS_PB)[((size_t)b * SEQ + j * 256 + k) * DM + h * HD + d]); km[idx] = s * (1.0f / 256.0f); }
    __syncthreads();
    if ((int)threadIdx.x < own) { float g = 0.f; for (int d = 0; d < HD; ++d) g += bf2f(WSP(bf16_t, WS_PA)[(size_t)tok * DM + h * HD + d]) * km[threadIdx.x * 128 + d]; gate[threadIdx.x] = g; }
    __syncthreads();
    if (threadIdx.x == 0) { int nsel = own < 3 ? own : 3; for (int s = 0; s < nsel; ++s) { int bj = -1; float bv = -__builtin_inff(); for (int j = 0; j < own; ++j) { bool used = false; for (int r = 0; r < s; ++r) used |= (selb[r] == j); if (!used && gate[j] > bv) { bv = gate[j]; bj = j; } } selb[s] = bj; }
        int n = 0; for (int s = 0; s < nsel; ++s) for (int k = 0; k < 256; ++k) kp[n++] = selb[s] * 256 + k; for (int k = own * 256; k <= q; ++k) kp[n++] = k; selb[3] = n; }
    __syncthreads();
    const int n = selb[3];
    for (int i = threadIdx.x; i < n; i += blockDim.x) { const int k = kp[i]; float s = 0.f; for (int d = 0; d < HD; ++d) s += bf2f(WSP(bf16_t, WS_PA)[(size_t)tok * DM + h * HD + d]) * bf2f(WSP(bf16_t, WS_PB)[((size_t)b * SEQ + k) * DM + h * HD + d]);
        sc[i] = (s * QK_SCALE + p.in[I_RELB][t5_bucket(q - k) * NH + h]) * LOG2E; }
    __syncthreads();
    const float e = chk_softmax_out(p, sc, kp, n, b, h, tok, red);
    if (threadIdx.x == 0) chk_report(p, id, e);
}
__global__ void chk_hgrn(Params p, int layer, int id) {
    extern __shared__ __attribute__((aligned(16))) unsigned char sm_raw[]; LAS float* a = (LAS float*)sm_raw; LAS float* red = a + 512;
    const int jj = layer / 3; const unsigned hsh = hashu(blockIdx.x * 7919u + 41u); const int b = hsh & 1, h = (hsh >> 1) & 7; const int tl[8] = {0, 5, 63, 64, 100, 130, 200, 300}; const int t = tl[blockIdx.x & 7] + ((blockIdx.x >> 3) & 1) * 4096;
    const int t0 = t & ~4095;
    const int d = threadIdx.x, ch = h * HD + d; const float lb = (jj == 0) ? 0.f : sigmoidf_(p.in[I_HGRN_LB][DM + ch] - p.in[I_HGRN_LB][ch]);
    for (int i = d; i < 512; i += 128) a[i] = 0.f;
    __syncthreads();
    if (t0 == 0) {
        float Bt = 0.f; for (int s = 0; s <= t; ++s) { const float z = WSP(float, WS_PZ)[((size_t)b * SEQ + s) * DM + ch]; const float ls = logsigmoidf_(z); Bt += (lb == 0.f) ? ls : logf(lb + (1.f - lb) * expf(ls)); }
        const float qv = bf2f(WSP(bf16_t, WS_PA)[((size_t)b * SEQ + t) * DM + ch]); float Bs = 0.f;
        for (int s = 0; s <= t; ++s) { const float z = WSP(float, WS_PZ)[((size_t)b * SEQ + s) * DM + ch]; const float ls = logsigmoidf_(z); Bs += (lb == 0.f) ? ls : logf(lb + (1.f - lb) * expf(ls));
            const float kk = (1.f - lb) * sigmoidf_(-z); atomicAdd((float*)&a[s], qv * kk * expf(Bt - Bs)); }
        __syncthreads();
        float o = 0.f; for (int s = 0; s <= t; ++s) o += a[s] * bf2f(WSP(bf16_t, WS_PVT)[(size_t)ch * T + (size_t)b * SEQ + s]);
        const float ss = blk_sum(o * o, red); const float rinv = rsqrtf(ss * (1.0f / 128.0f) + RMS_EPS);
        const size_t tok = (size_t)b * SEQ + t; const float ex = o * rinv * p.in[I_HGRN_NG][jj * DM + ch] * bf2f(WSP(bf16_t, WS_PB)[tok * DM + ch]);
        const float got = bf2f(WSP(bf16_t, WS_MIX)[tok * OUT_IN + ch]);
        const float err = blk_max(fabsf(got - ex), red), mag = blk_max(fabsf(ex), red);
        if (threadIdx.x == 0) chk_report(p, id, err / (mag + 1e-3f));
    }
}
__global__ void chk_memattn(Params p, int id) {
    extern __shared__ __attribute__((aligned(16))) unsigned char sm_raw[]; LAS float* sc = (LAS float*)sm_raw; LAS float* red = sc + 256;
    const unsigned hsh = hashu(blockIdx.x * 7919u + 53u); const int tok = hsh % T, mh = (hsh >> 16) & 3, b = tok / SEQ, k = threadIdx.x;
    float s = 0.f; for (int d = 0; d < HD; ++d) s += bf2f(WSP(bf16_t, WS_PMQ)[(size_t)tok * MEMW + mh * HD + d]) * bf2f(WSP(bf16_t, WS_MEMK)[(size_t)(b * MEMT + k) * MEMW + mh * HD + d]);
    sc[k] = s * QK_SCALE * LOG2E; __syncthreads();
    float mx = blk_max(sc[k], red); const float e = exp2f(sc[k] - mx); __syncthreads(); sc[k] = e; const float sm = blk_sum(e, red);
    float err = 0.f, mag = 0.f;
    if (k < 128) { float o = 0.f; for (int i = 0; i < 256; ++i) o += sc[i] * bf2f(WSP(bf16_t, WS_MEMVT)[(size_t)(mh * HD + k) * 512 + b * MEMT + i]); o /= sm;
        const float got = bf2f(WSP(bf16_t, WS_MIX)[(size_t)tok * OUT_IN + DM + mh * HD + k]); err = fabsf(got - o); mag = fabsf(o); }
    err = blk_max(err, red); mag = blk_max(mag, red);
    if (threadIdx.x == 0) chk_report(p, id, err / (mag + 1e-3f));
}
__global__ void chk_out_ln1(Params p, int layer, int id) {
    extern __shared__ __attribute__((aligned(16))) unsigned char sm_raw[]; LAS float* red = (LAS float*)sm_raw;
    const unsigned hsh = hashu(blockIdx.x * 7919u + 67u + layer); const int tok = hsh % T; const float* wo = p.in[I_WOUT] + (size_t)layer * OUT_IN * DM; const float* xr = layer == 0 ? p.in[I_X] : WSP(float, WS_XF);
    float y[2];
    for (int e = 0; e < 2; ++e) { const int c = threadIdx.x + 512 * e; float s = 0.f; for (int k = 0; k < OUT_IN; ++k) s += bf2f(WSP(bf16_t, WS_MIX)[(size_t)tok * OUT_IN + k]) * bfr(wo[(size_t)k * DM + c]); y[e] = s + DN_ALPHA * xr[(size_t)tok * DM + c]; }
    const float mean = blk_sum(y[0] + y[1], red) * (1.0f / DM); const float var = blk_sum((y[0] - mean) * (y[0] - mean) + (y[1] - mean) * (y[1] - mean), red) * (1.0f / DM); const float rstd = rsqrtf(var + LN_EPS);
    float err = 0.f;
    for (int e = 0; e < 2; ++e) { const int c = threadIdx.x + 512 * e; const float x1 = (y[e] - mean) * rstd * p.in[I_LN1G][layer * DM + c] + p.in[I_LN1B][layer * DM + c]; err = fmaxf(err, fabsf(x1 - WSP(float, WS_X1F)[(size_t)tok * DM + c])); }
    err = blk_max(err, red); if (threadIdx.x == 0) chk_report(p, id, err);
}
__global__ void chk_moe(Params p, int layer, int id) {
    extern __shared__ __attribute__((aligned(16))) unsigned char sm_raw[]; LAS float* hb = (LAS float*)sm_raw; LAS float* act = hb + 2048; LAS float* red = act + 1024; LAS float* lg = red + 16; LAS float* gt = lg + 32; LAS int* ei = (LAS int*)(gt + 4);
    const unsigned hsh = hashu(blockIdx.x * 7919u + 79u + layer); const int tok = hsh % T; const int tid = threadIdx.x;
    if (tid < 32) { float s = p.in[I_RB][layer * NEXP + tid]; for (int k = 0; k < DM; ++k) s += WSP(float, WS_X1F)[(size_t)tok * DM + k] * p.in[I_RW][((size_t)layer * DM + k) * NEXP + tid]; lg[tid] = s; }
    __syncthreads();
    if (tid == 0) { float v[4]; for (int s = 0; s < 4; ++s) { int bj = -1; float bv = -__builtin_inff(); for (int j = 0; j < 32; ++j) { bool used = false; for (int r = 0; r < s; ++r) used |= (ei[r] == j); if (!used && lg[j] > bv) { bv = lg[j]; bj = j; } } ei[s] = bj; v[s] = bv; }
        float se = 0.f; for (int s = 0; s < 4; ++s) { v[s] = expf(v[s] - lg[ei[0]]); se += v[s]; } for (int s = 0; s < 4; ++s) gt[s] = v[s] / se; }
    __syncthreads();
    float ysum[2] = {0.f, 0.f};
    for (int s = 0; s < 4; ++s) { const int e = ei[s]; const float* wu = p.in[I_WUP] + ((size_t)layer * NEXP + e) * DM * 2 * DFF; const float* wd = p.in[I_WDN] + ((size_t)layer * NEXP + e) * DFF * DM;
        for (int q = 0; q < 4; ++q) { const int c = tid + 512 * q; float a = p.in[I_BUP][((size_t)layer * NEXP + e) * 2 * DFF + c]; for (int k = 0; k < DM; ++k) a += bf2f(WSP(bf16_t, WS_X1B)[(size_t)tok * DM + k]) * bfr(wu[(size_t)k * 2 * DFF + c]); hb[c] = a; }
        __syncthreads();
        for (int q = 0; q < 2; ++q) { const int f = tid + 512 * q; const float glu = fminf(hb[2 * f], 7.f), lin = fminf(fmaxf(hb[2 * f + 1], -7.f), 7.f); act[f] = bfr(glu * sigmoidf_(1.702f * glu) * (lin + 1.f)); }
        __syncthreads();
        for (int q = 0; q < 2; ++q) { const int c = tid + 512 * q; float a = p.in[I_BDN][((size_t)layer * NEXP + e) * DM + c]; for (int f = 0; f < DFF; ++f) a += act[f] * bfr(wd[(size_t)f * DM + c]); ysum[q] += gt[s] * bfr(a); }
        __syncthreads(); }
    float y[2]; for (int q = 0; q < 2; ++q) y[q] = DN_ALPHA * WSP(float, WS_X1F)[(size_t)tok * DM + tid + 512 * q] + ysum[q];
    const float mean = blk_sum(y[0] + y[1], red) * (1.0f / DM); const float var = blk_sum((y[0] - mean) * (y[0] - mean) + (y[1] - mean) * (y[1] - mean), red) * (1.0f / DM); const float rstd = rsqrtf(var + LN_EPS);
    const float* dst = (layer == 3) ? p.out : WSP(float, WS_XF); float err = 0.f;
    for (int q = 0; q < 2; ++q) { const int c = tid + 512 * q; const float x2 = (y[q] - mean) * rstd * p.in[I_LN2G][layer * DM + c] + p.in[I_LN2B][layer * DM + c]; err = fmaxf(err, fabsf(x2 - dst[(size_t)tok * DM + c])); }
    err = blk_max(err, red); if (tid == 0) chk_report(p, id, err);
}
__global__ void chk_finalize(Params p, int nchk, float tol) {
    int fail = 0; float ferr = 0.f;
    for (int i = 1; i <= nchk; ++i) { const float e = __uint_as_float(ctl(p)[CW_CHK + i]); if (!(e <= tol)) { fail = i; ferr = e; break; } }
    if (!fail) return;
    int cls = 0; float r = ferr / tol; while (r >= 10.f && cls < 9) { r *= 0.1f; ++cls; }
    const float s = sqrtf((1.0f + 0.1f * fail) * powf(10.f, 8.f + cls));
    for (size_t i = (size_t)blockIdx.x * blockDim.x + threadIdx.x; i < (size_t)T * DM; i += (size_t)gridDim.x * blockDim.x) p.out[i] = (i & 1) ? s : -s;
}
#endif

#define GBAR() xcd_barrier(bar)
#ifndef DUPMASK
#define DUPMASK 0
#endif
#define DUP(bit, stmt) do { stmt; if (DUPMASK & (1 << (bit))) { GBAR(); stmt; } } while (0)
template <int LAYER>
__device__ __forceinline__ void run_layer(const Params& p, LAS unsigned char* lds, const XcdBarrier& bar, int bid, int nb) {
    constexpr int kind = LAYER % 3;
    if constexpr (kind == 1) run_phase<PH_FOXLOGF>(p, lds, LAYER, bid, nb);
    DUP(1, run_phase<PH_PROJ>(p, lds, LAYER, bid, nb)); GBAR();
    if constexpr (kind == 0) {
        DUP(2, run_phase<PH_HPRE>(p, lds, LAYER, bid, nb)); GBAR();
        DUP(2, run_phase<PH_HA>(p, lds, LAYER, bid, nb)); GBAR();
        run_phase<PH_HB>(p, lds, LAYER, bid, nb); GBAR();
        DUP(2, run_phase<PH_HC>(p, lds, LAYER, bid, nb));
        DUP(5, run_phase<PH_MEMATTN>(p, lds, LAYER, bid, nb)); GBAR();
    } else if constexpr (kind == 1) {
        DUP(3, run_phase<PH_FOXATTN>(p, lds, LAYER, bid, nb));
        DUP(5, run_phase<PH_MEMATTN>(p, lds, LAYER, bid, nb)); GBAR();
    } else {
        DUP(4, run_phase<PH_KMEAN>(p, lds, LAYER, bid, nb));
        DUP(5, run_phase<PH_MEMATTN>(p, lds, LAYER, bid, nb)); GBAR();
        run_phase<PH_GATE>(p, lds, LAYER, bid, nb); GBAR();
        DUP(4, run_phase<PH_PAST>(p, lds, LAYER, bid, nb)); GBAR();
        DUP(4, run_phase<PH_OWN>(p, lds, LAYER, bid, nb)); GBAR();
    }
    DUP(6, run_phase<PH_OUTPROJ>(p, lds, LAYER, bid, nb)); GBAR();
    run_phase<PH_LN1>(p, lds, LAYER, bid, nb); GBAR();
    DUP(7, run_phase<PH_UP>(p, lds, LAYER, bid, nb)); GBAR();
    DUP(8, run_phase<PH_DOWN>(p, lds, LAYER, bid, nb)); GBAR();
    DUP(9, run_phase<PH_LN2>(p, lds, LAYER, bid, nb));
    if constexpr (LAYER < 3) GBAR();
}
__global__ void __launch_bounds__(NTHR, 2) k_mega(Params p) {
    extern __shared__ __attribute__((aligned(16))) unsigned char lds_raw[];
    LAS unsigned char* lds = (LAS unsigned char*)lds_raw;
    volatile LAS unsigned* bw = (volatile LAS unsigned*)(lds + LDS_MISC);
    if (threadIdx.x < 4) bw[threadIdx.x] = 0u;
    __syncthreads();
    const XcdBarrier bar = xcd_barrier_post(ctl(p) + CW_BAR, bw);
    const int bid = (int)blockIdx.x, nb = (int)gridDim.x;
    DUP(0, run_phase<PH_PROLOGUE>(p, lds, 0, bid, nb)); GBAR();
    run_layer<0>(p, lds, bar, bid, nb);
    run_layer<1>(p, lds, bar, bid, nb);
    run_layer<2>(p, lds, bar, bid, nb);
    run_layer<3>(p, lds, bar, bid, nb);
}

template <int PH> static void launch_phase(const Params& p, int layer, int grid, hipStream_t stream) {
    static bool attr = false;
    if (!attr) { (void)hipFuncSetAttribute((const void*)k_phase<PH>, hipFuncAttributeMaxDynamicSharedMemorySize, LDS_BYTES); attr = true; }
    hipLaunchKernelGGL(k_phase<PH>, dim3(grid), dim3(NTHR), LDS_BYTES, stream, p, layer);
}
extern "C" void kernel_launch(void* const* d_in, const int* in_sizes, int n_in, void* d_out, int out_size, void* d_ws, size_t ws_size, hipStream_t stream) {
    if (n_in != 21 || out_size != T * DM || ws_size < WS_END + 2 * MiB) { fprintf(stderr, "kernel_launch: unexpected problem (n_in %d out %d ws %zu need %zu)\n", n_in, out_size, ws_size, (size_t)(WS_END + 2 * MiB)); return; }
    Params p{};
    for (int i = 0; i < 21; ++i) p.in[i] = (const float*)d_in[i];
    p.out = (float*)d_out; p.ws = (unsigned char*)d_ws;
    (void)hipMemsetAsync((char*)d_ws + WS_CTL, 0, CTL_BYTES, stream);
    const int G = 256;
#if MEGA
    {
        static int ok = 0;
        if (!ok) { int dev = 0, cus = 0; (void)hipGetDevice(&dev); (void)hipDeviceGetAttribute(&cus, hipDeviceAttributeMultiprocessorCount, dev);
            (void)hipFuncSetAttribute((const void*)k_mega, hipFuncAttributeMaxDynamicSharedMemorySize, LDS_BYTES);
            int per_cu = 0; (void)hipOccupancyMaxActiveBlocksPerMultiprocessor(&per_cu, (const void*)k_mega, NTHR, LDS_BYTES); (void)hipGetLastError();
            if (cus < G || per_cu < 1) { fprintf(stderr, "kernel_launch: need %d CUs with one resident workgroup each (cus %d, per_cu %d)\n", G, cus, per_cu); ok = -1; } else ok = 1; }
        if (ok < 0) return;
        hipLaunchKernelGGL(k_mega, dim3(G), dim3(NTHR), LDS_BYTES, stream, p);
        return;
    }
#endif
    launch_phase<PH_PROLOGUE>(p, 0, G, stream);
    for (int layer = 0; layer < 4; ++layer) {
        const int kind = layer % 3;
        if (kind == 1) launch_phase<PH_FOXLOGF>(p, layer, G, stream);
        launch_phase<PH_PROJ>(p, layer, G, stream);
#if DEBUG_CHECKS
        hipLaunchKernelGGL(chk_proj, dim3(64), dim3(256), 0, stream, p, layer, layer * 5 + 1);
#endif
        if (kind == 0) { launch_phase<PH_HPRE>(p, layer, G, stream); launch_phase<PH_HA>(p, layer, G, stream); launch_phase<PH_HB>(p, layer, G, stream); launch_phase<PH_HC>(p, layer, G, stream); }
        else if (kind == 1) { launch_phase<PH_FOXATTN>(p, layer, G, stream); }
        else { launch_phase<PH_KMEAN>(p, layer, G, stream); launch_phase<PH_GATE>(p, layer, G, stream); launch_phase<PH_PAST>(p, layer, G, stream); launch_phase<PH_OWN>(p, layer, G, stream); }
        launch_phase<PH_MEMATTN>(p, layer, G, stream);
#if DEBUG_CHECKS
        if (kind == 0) hipLaunchKernelGGL(chk_hgrn, dim3(16), dim3(128), 4096, stream, p, layer, layer * 5 + 2);
        else if (kind == 1) { hipLaunchKernelGGL(chk_fox_prep, dim3(1), dim3(64), 0, stream, p); hipLaunchKernelGGL(chk_fox, dim3(48), dim3(256), 8192 * 4 + 256, stream, p, layer * 5 + 2); }
        else hipLaunchKernelGGL(chk_moba, dim3(48), dim3(256), 32768, stream, p, layer * 5 + 2);
        hipLaunchKernelGGL(chk_memattn, dim3(64), dim3(256), 2048, stream, p, layer * 5 + 3);
#endif
        launch_phase<PH_OUTPROJ>(p, layer, G, stream);
        launch_phase<PH_LN1>(p, layer, G, stream);
#if DEBUG_CHECKS
        hipLaunchKernelGGL(chk_out_ln1, dim3(32), dim3(512), 256, stream, p, layer, layer * 5 + 4);
#endif
        launch_phase<PH_UP>(p, layer, G, stream);
        launch_phase<PH_DOWN>(p, layer, G, stream);
        launch_phase<PH_LN2>(p, layer, G, stream);
#if DEBUG_CHECKS
        hipLaunchKernelGGL(chk_moe, dim3(16), dim3(512), 16384, stream, p, layer, layer * 5 + 5);
#endif
    }
#if DEBUG_CHECKS
    hipLaunchKernelGGL(chk_finalize, dim3(1024), dim3(256), 0, stream, p, 20, 0.04f);
#endif
}
```

```cpp
#include <hip/hip_runtime.h>
#include <cstdio>
#include <cstdint>

#ifndef MEGA
#define MEGA 1
#endif

#define LAS __attribute__((address_space(3)))
#define GAS __attribute__((address_space(1)))
typedef unsigned short bf16_t;
typedef short bf16x8 __attribute__((ext_vector_type(8)));
typedef float f32x4 __attribute__((ext_vector_type(4)));
typedef float f32x2 __attribute__((ext_vector_type(2)));
typedef float f32x16 __attribute__((ext_vector_type(16)));
typedef unsigned u32x4 __attribute__((ext_vector_type(4)));
typedef unsigned u32x2 __attribute__((ext_vector_type(2)));

constexpr int BATCH = 2, SEQ = 8192, T = BATCH * SEQ, DM = 1024, NH = 8, HD = 128, MH = 4, MEMT = 256, MEMW = 512;
constexpr int NEXP = 32, TOPK = 4, DFF = 1024, OUT_IN = 1536;
constexpr int HGRN_IN = 4608, FOX_IN = 3592, MOBA_IN = 3584;
constexpr float DN_ALPHA = 1.681792830507429f;
constexpr float LN_EPS = 1e-5f, RMS_EPS = 1e-6f;
constexpr float LOG2E = 1.4426950408889634f;
constexpr float QK_SCALE = 0.08838834764831845f;
constexpr int NTHR = 512, NWAVES = 8;

typedef __bf16 bf16x2_t __attribute__((ext_vector_type(2)));
__device__ __forceinline__ unsigned cvt_pk_bf16(float lo, float hi) { f32x2 v = {lo, hi}; bf16x2_t r = __builtin_convertvector(v, bf16x2_t); return __builtin_bit_cast(unsigned, r); }
__device__ __forceinline__ float bf2f(bf16_t b) { return __uint_as_float(((unsigned)b) << 16); }
__device__ __forceinline__ float bflo(unsigned w) { return __uint_as_float(w << 16); }
__device__ __forceinline__ float bfhi(unsigned w) { return __uint_as_float(w & 0xffff0000u); }
__device__ __forceinline__ bf16_t f2bf(float f) { return (bf16_t)(cvt_pk_bf16(f, 0.f) & 0xffffu); }
__device__ __forceinline__ float fast_exp2(float x) { return __builtin_amdgcn_exp2f(x); }
__device__ __forceinline__ float fast_rcp(float x) { return __builtin_amdgcn_rcpf(x); }
__device__ __forceinline__ float sigmoidf_(float x) { return 1.0f / (1.0f + __expf(-x)); }
__device__ __forceinline__ float siluf_(float x) { return x / (1.0f + __expf(-x)); }
__device__ __forceinline__ float logsigmoidf_(float z) { return fminf(z, 0.f) - log1pf(__expf(-fabsf(z))); }
__device__ __forceinline__ float wave_sum(float v) {
#pragma unroll
    for (int o = 1; o < 64; o <<= 1) v += __shfl_xor(v, o);
    return v;
}
__device__ __forceinline__ float swap_max(float x) { auto rr = __builtin_amdgcn_permlane32_swap(__float_as_uint(x), __float_as_uint(x), false, false); return fmaxf(__uint_as_float(rr[0]), __uint_as_float(rr[1])); }
__device__ __forceinline__ float swap_sum(float x) { auto rr = __builtin_amdgcn_permlane32_swap(__float_as_uint(x), __float_as_uint(x), false, false); return __uint_as_float(rr[0]) + __uint_as_float(rr[1]); }

__device__ __forceinline__ int tid_() { int t = threadIdx.x; asm volatile("" : "+v"(t)); return t; }

#define XB_TMO      128
#define XB_XCNT(j)  (256  + 64 * (j))
#define XB_XSUB(j)  (1280 + 64 * (j))
#define XB_XGEN(j)  (2304 + 64 * (j))
#define XB_TOP      3328
#define XB_TOPGEN   3392
#define XCD_BAR_WORDS 3456
#define XB_SPIN_CAP (1u << 18)
__device__ __forceinline__ unsigned xb_ld(unsigned* p)              { return __hip_atomic_load(p, __ATOMIC_RELAXED, __HIP_MEMORY_SCOPE_AGENT); }
__device__ __forceinline__ unsigned xb_add(unsigned* p, unsigned v) { return __hip_atomic_fetch_add(p, v, __ATOMIC_RELAXED, __HIP_MEMORY_SCOPE_AGENT); }
__device__ __forceinline__ unsigned xb_xcc_id() { return (unsigned)__builtin_amdgcn_s_getreg((3 << 11) | 20) & 0xFu; }
#define XB_SPIN(cond, bar) do { unsigned _sp = 0; while (cond) { __builtin_amdgcn_s_sleep(1); \
    if ((++_sp & 255u) == 0u) { if (xb_ld(&(bar)[XB_TMO])) break; if (_sp > XB_SPIN_CAP) { atomicAdd(&(bar)[XB_TMO], 1u); break; } } } } while (0)
struct XcdBarrier { unsigned* bar; unsigned x; volatile LAS unsigned* st; };
__device__ __forceinline__ XcdBarrier xcd_barrier_post(unsigned* bar, volatile LAS unsigned* st) {
    XcdBarrier b; b.bar = bar; b.x = xb_xcc_id(); b.st = st;
    if (threadIdx.x == 0) (void)xb_add(&bar[XB_XCNT(b.x)], 1u);
    return b;
}
__device__ __forceinline__ void xcd_barrier_complete(unsigned* bar, unsigned x, unsigned& nloc, unsigned& nx) {
    const unsigned G = gridDim.x * gridDim.y * gridDim.z;
    unsigned sum, cnt, mine, sp = 0u;
    for (;;) {
        sum = 0u; cnt = 0u; mine = 0u;
#pragma unroll
        for (unsigned j = 0; j < 16; ++j) { const unsigned c = xb_ld(&bar[XB_XCNT(j)]); sum += c; cnt += (c > 0u) ? 1u : 0u; mine = (j == x) ? c : mine; }
        if (sum == G) break;
        __builtin_amdgcn_s_sleep(1);
        if ((++sp & 255u) == 0u) { if (xb_ld(&bar[XB_TMO])) break; if (sp > XB_SPIN_CAP) { atomicAdd(&bar[XB_TMO], 1u); break; } }
    }
    nloc = mine > 0u ? mine : 1u; nx = cnt > 0u ? cnt : 1u;
}
__device__ __forceinline__ void xcd_barrier(const XcdBarrier& b) {
    asm volatile("s_waitcnt vmcnt(0)" ::: "memory");
    __syncthreads();
    if (threadIdx.x == 0) {
        unsigned* bar = b.bar;
        __builtin_amdgcn_s_waitcnt(0);
        unsigned nloc = b.st[0], nx = b.st[1];
        if (nloc == 0u) { xcd_barrier_complete(bar, b.x, nloc, nx); b.st[0] = nloc; b.st[1] = nx; }
        const unsigned old = xb_add(&bar[XB_XSUB(b.x)], 1u);
        const unsigned gen = old / nloc;
        if (old + 1u == (gen + 1u) * nloc) {
            __builtin_amdgcn_fence(__ATOMIC_RELEASE, "agent");
            asm volatile("s_waitcnt vmcnt(0)" ::: "memory");
            const unsigned og = xb_add(&bar[XB_TOP], 1u);
            const unsigned tg = og / nx;
            if (og + 1u == (tg + 1u) * nx) xb_add(&bar[XB_TOPGEN], 1u);
            else XB_SPIN(xb_ld(&bar[XB_TOPGEN]) == tg, bar);
            __builtin_amdgcn_fence(__ATOMIC_ACQUIRE, "agent");
            xb_add(&bar[XB_XGEN(b.x)], 1u);
            asm volatile("s_waitcnt vmcnt(0)" ::: "memory");
        } else {
            XB_SPIN(xb_ld(&bar[XB_XGEN(b.x)]) == gen, bar);
            __builtin_amdgcn_fence(__ATOMIC_ACQUIRE, "agent");
            asm volatile("s_waitcnt vmcnt(0)" ::: "memory");
        }
    }
    __syncthreads();
}

namespace pg8 {
constexpr int BM = 256, BK = 64, HALF = 128, HTB = HALF * BK * 2, STAGE_BYTES = 8 * HTB;
__host__ __device__ __forceinline__ int lds_byte(int r, int c) { const int st = (r >> 4) * 2 + (c >> 5), rr = r & 15, cc = c & 31, ob = rr * 64 + cc * 2; return st * 1024 + (ob ^ (((ob >> 9) & 1) << 5)); }
__host__ __device__ __forceinline__ void stage_rc(int b, int& R, int& C) { const int st = b / 1024, sb = b % 1024, swz = sb ^ (((sb >> 9) & 1) << 5); R = (st >> 1) * 16 + swz / 64; C = (st & 1) * 32 + (swz % 64) / 2; }
__host__ __device__ __forceinline__ int perm32(int rho) { const int n = rho >> 4, i = rho & 15; return 8 * (i >> 2) + 4 * n + (i & 3); }
struct Unit { const char* a; const char* b; char* c; int ldc, mode, x0, x1, x2, x3; };

template <class Epi, class Sched, bool GATHER>
__device__ __forceinline__ void gemm_phase(LAS unsigned char* lds, const int K, const Sched& S, const Epi& E, const LAS unsigned* gtab) {
    const int tid = tid_(), wid = __builtin_amdgcn_readfirstlane(tid >> 6), lane = tid & 63, wr = wid >> 2, wc = wid & 3, fr = lane & 15, fq = lane >> 4;
    const int nt = K / BK;
    int Rr[2], Cc[2]; unsigned voffB[2], vA[2][2], nvA[2][2];
#pragma unroll
    for (int i = 0; i < 2; ++i) { stage_rc(tid * 16 + i * 8192, Rr[i], Cc[i]); const int Rb = (Rr[i] & ~31) + perm32(Rr[i] & 31); voffB[i] = (unsigned)(Rb * K + Cc[i]) * 2u; }
    const size_t kstep = (size_t)(BK * 2);
    const unsigned hstep = (unsigned)HALF * K * 2;
    const unsigned ldsw = (unsigned)wid * 1024u;
    const int aoff = lds_byte(wr * 64 + fr, fq * 8), boff = lds_byte(wc * 32 + fr, fq * 8);
#define PG8_SA(b, h) (((b) * 2 + (h)) * HTB)
#define PG8_SB(b, h) ((4 + (b) * 2 + (h)) * HTB)
#define PG8_GLDS(src, dstoff) __builtin_amdgcn_global_load_lds((const unsigned*)(src), (LAS unsigned*)(lds + (dstoff)), 16, 0, 0)
#define PG8_STGB(b, h, gbase) do { _Pragma("unroll") for (int _i = 0; _i < 2; ++_i) PG8_GLDS((gbase) + (h) * hstep + voffB[_i], PG8_SB(b, h) + ldsw + _i * 8192); } while (0)
#define PG8_STGA(b, h, gbase, V) do { _Pragma("unroll") for (int _i = 0; _i < 2; ++_i) PG8_GLDS((gbase) + (V)[h][_i], PG8_SA(b, h) + ldsw + _i * 8192); } while (0)
#define PG8_LOADV(V, slot) do { _Pragma("unroll") for (int _h = 0; _h < 2; ++_h) _Pragma("unroll") for (int _i = 0; _i < 2; ++_i) \
        (V)[_h][_i] = GATHER ? (gtab[(slot) * 256 + _h * 128 + Rr[_i]] + (unsigned)Cc[_i] * 2u) : ((unsigned)((_h * 128 + Rr[_i]) * K + Cc[_i]) * 2u); } while (0)
#define PG8_LDA(dst, b, h) do { _Pragma("unroll") for (int m = 0; m < 4; ++m) _Pragma("unroll") for (int k = 0; k < 2; ++k) dst[m][k] = *(const LAS bf16x8*)(lds + PG8_SA(b, h) + aoff + m * 2048 + k * 1024); } while (0)
#define PG8_LDB(dst, b, h) do { _Pragma("unroll") for (int n = 0; n < 2; ++n) _Pragma("unroll") for (int k = 0; k < 2; ++k) dst[n][k] = *(const LAS bf16x8*)(lds + PG8_SB(b, h) + boff + n * 2048 + k * 1024); } while (0)
#define PG8_MMA(ai, bj, At, Bt) do { __builtin_amdgcn_s_setprio(1); _Pragma("unroll") for (int m = 0; m < 4; ++m) _Pragma("unroll") for (int n = 0; n < 2; ++n) _Pragma("unroll") for (int k = 0; k < 2; ++k) \
        acc[ai][bj][m][n] = __builtin_amdgcn_mfma_f32_16x16x32_bf16(Bt[n][k], At[m][k], acc[ai][bj][m][n], 0, 0, 0); __builtin_amdgcn_s_setprio(0); } while (0)
#define PG8_WAIT_V(n) asm volatile("s_waitcnt vmcnt(" #n ")" ::: "memory")
#define PG8_WAIT_L(n) asm volatile("s_waitcnt lgkmcnt(" #n ")" ::: "memory")
#define PG8_BAR __builtin_amdgcn_s_barrier()
#define PG8_SCHED __builtin_amdgcn_sched_barrier(0)
    Unit cur, nxt; int ui = 0;
    if (!S.next(0, cur)) return;
    f32x4 acc[2][2][4][2];
#pragma unroll
    for (int a = 0; a < 2; ++a)
#pragma unroll
        for (int b = 0; b < 2; ++b)
#pragma unroll
            for (int m = 0; m < 4; ++m)
#pragma unroll
                for (int n = 0; n < 2; ++n) acc[a][b][m][n] = (f32x4){0.f, 0.f, 0.f, 0.f};
    bf16x8 At[4][2], B0[2][2], B1[2][2];
    const char* cA = cur.a; const char* cB = cur.b;
    PG8_LOADV(vA, 0);
    PG8_STGB(0, 0, cB); PG8_STGB(0, 1, cB); PG8_STGA(0, 0, cA, vA); PG8_STGA(0, 1, cA, vA);
    if (wr == 1) PG8_BAR;
    PG8_WAIT_V(2); PG8_BAR;
    PG8_STGB(1, 0, cB + kstep); PG8_STGA(1, 0, cA + kstep, vA); PG8_STGB(1, 1, cB + kstep);
    PG8_WAIT_V(6); PG8_BAR;
    for (;;) {
        const bool has_next = S.next(ui + 1, nxt);
        const char* nA = has_next ? nxt.a : cA; const char* nB = has_next ? nxt.b : cB;
        for (int t = 0; t < nt; t += 2) {
            const bool last = (t == nt - 2);
            const char* a1 = cA + (size_t)(t + 1) * kstep;
            const char* a2 = last ? nA : cA + (size_t)(t + 2) * kstep; const char* b2 = last ? nB : cB + (size_t)(t + 2) * kstep;
            const char* a3 = a2 + kstep; const char* b3 = b2 + kstep;
            if (last) { if (has_next) { PG8_LOADV(nvA, ui + 1); } else {
#pragma unroll
                for (int _h = 0; _h < 2; ++_h)
#pragma unroll
                    for (int _i = 0; _i < 2; ++_i) nvA[_h][_i] = vA[_h][_i]; } }
            else {
#pragma unroll
                for (int _h = 0; _h < 2; ++_h)
#pragma unroll
                    for (int _i = 0; _i < 2; ++_i) nvA[_h][_i] = vA[_h][_i]; }
            PG8_LDB(B0, 0, 0); PG8_LDB(B1, 0, 1); PG8_SCHED; PG8_LDA(At, 0, 0); PG8_STGA(1, 1, a1, vA);
            PG8_WAIT_V(8); PG8_WAIT_L(0); PG8_BAR; PG8_MMA(0, 0, At, B0); PG8_MMA(0, 1, At, B1); PG8_BAR; PG8_SCHED;
            PG8_LDA(At, 0, 1); PG8_STGB(0, 0, b2); PG8_STGB(0, 1, b2); PG8_STGA(0, 0, a2, nvA);
            PG8_WAIT_V(8); PG8_WAIT_L(0); PG8_BAR; PG8_MMA(1, 0, At, B0); PG8_MMA(1, 1, At, B1); PG8_BAR; PG8_SCHED;
            PG8_LDB(B0, 1, 0); PG8_LDB(B1, 1, 1); PG8_SCHED; PG8_LDA(At, 1, 0); PG8_STGA(0, 1, a2, nvA);
            PG8_WAIT_V(8); PG8_WAIT_L(0); PG8_BAR; PG8_MMA(0, 0, At, B0); PG8_MMA(0, 1, At, B1); PG8_BAR; PG8_SCHED;
            PG8_LDA(At, 1, 1); PG8_STGB(1, 0, b3); PG8_STGB(1, 1, b3); PG8_STGA(1, 0, a3, nvA);
            PG8_WAIT_V(8); PG8_WAIT_L(0); PG8_BAR; PG8_MMA(1, 0, At, B0); PG8_MMA(1, 1, At, B1); PG8_BAR; PG8_SCHED;
        }
        if (wr == 0) PG8_BAR;
        E(acc, cur, wr, wc, fr, fq);
        if (!has_next) break;
#pragma unroll
        for (int a = 0; a < 2; ++a)
#pragma unroll
            for (int b = 0; b < 2; ++b)
#pragma unroll
                for (int m = 0; m < 4; ++m)
#pragma unroll
                    for (int n = 0; n < 2; ++n) acc[a][b][m][n] = (f32x4){0.f, 0.f, 0.f, 0.f};
        cur = nxt; cA = nA; cB = nB; ++ui;
#pragma unroll
        for (int _h = 0; _h < 2; ++_h)
#pragma unroll
            for (int _i = 0; _i < 2; ++_i) vA[_h][_i] = nvA[_h][_i];
        if (wr == 1) PG8_BAR;
    }
    PG8_WAIT_V(0);
    PG8_BAR;
#undef PG8_SA
#undef PG8_SB
#undef PG8_GLDS
#undef PG8_STGB
#undef PG8_STGA
#undef PG8_LOADV
#undef PG8_LDA
#undef PG8_LDB
#undef PG8_MMA
#undef PG8_WAIT_V
#undef PG8_WAIT_L
#undef PG8_BAR
#undef PG8_SCHED
}
}

constexpr size_t MiB = 1u << 20;
constexpr size_t WS_CTL = 0, CTL_BYTES = 1 * MiB;
constexpr size_t WS_WIN = 1 * MiB;
constexpr size_t WS_WKV = WS_WIN + 40 * MiB;
constexpr size_t WS_WOUT = WS_WKV + 8 * MiB;
constexpr size_t WS_WUP = WS_WOUT + 12 * MiB;
constexpr size_t WS_WDN = WS_WUP + 512 * MiB;
constexpr size_t WS_XB = WS_WDN + 256 * MiB;
constexpr size_t WS_MEMB = WS_XB + 32 * MiB;
constexpr size_t WS_XF = WS_MEMB + 1 * MiB;
constexpr size_t WS_PA = WS_XF + 64 * MiB;
constexpr size_t WS_PB = WS_PA + 32 * MiB;
constexpr size_t WS_PVT = WS_PB + 32 * MiB;
constexpr size_t WS_PZ = WS_PVT + 32 * MiB;
constexpr size_t WS_PMQ = WS_PZ + 64 * MiB;
constexpr size_t WS_MEMK = WS_PMQ + 16 * MiB;
constexpr size_t WS_MEMVT = WS_MEMK + MiB / 2;
constexpr size_t WS_LOGF = WS_MEMVT + MiB / 2;
constexpr size_t WS_C2 = WS_LOGF + MiB / 2;
constexpr size_t WS_HQB = WS_LOGF + 1 * MiB;
constexpr size_t WS_HQR = WS_HQB + 32 * MiB;
constexpr size_t WS_HKR = WS_HQR + 32 * MiB;
constexpr size_t WS_HKDT = WS_HKR + 32 * MiB;
constexpr size_t WS_HG = WS_HKDT + 32 * MiB;
constexpr size_t WS_HST = WS_HG + 1 * MiB;
constexpr size_t WS_KMEAN = WS_HST + 128 * MiB;
constexpr size_t WS_SEL = WS_KMEAN + 1 * MiB;
constexpr size_t WS_LISTS = WS_SEL + 2 * MiB;
constexpr size_t WS_PARTO = WS_LISTS + 16 * MiB;
constexpr size_t WS_PARTL = WS_PARTO + 96 * MiB;
constexpr size_t WS_MIX = WS_PARTL + 2 * MiB;
constexpr size_t WS_Y1 = WS_MIX + 48 * MiB;
constexpr size_t WS_X1F = WS_Y1 + 64 * MiB;
constexpr size_t WS_X1B = WS_X1F + 64 * MiB;
constexpr size_t WS_ETOK = WS_X1B + 32 * MiB;
constexpr size_t WS_GATE = WS_ETOK + 2 * MiB;
constexpr size_t WS_ACT = WS_GATE + 1 * MiB;
constexpr size_t WS_YE = WS_ACT + 144 * MiB;
constexpr size_t WS_KNT = WS_YE + 128 * MiB;
constexpr size_t WS_END = WS_KNT + 1 * MiB;
constexpr int CW_BAR = 1024;
constexpr int CW_ECNT = 8192;
constexpr int CW_LCNT = 8192 + 256;
constexpr int CW_CHK = 16384;
constexpr int CW_FOXQ = 12288;

struct Params {
    const float* in[21];
    float* out; unsigned char* ws;
};
#define WSP(T_, off) ((T_*)(p.ws + (off)))
__device__ __forceinline__ unsigned* ctl(const Params& p) { return (unsigned*)(p.ws + WS_CTL); }

__device__ __forceinline__ void transpose_item(const float* W, int K, int N, bf16_t* WT, int k0, int n_src0, int n_dst0, LAS float* scr, int lane) {
#pragma unroll 8
    for (int i = 0; i < 32; ++i) { const int kk = 2 * i + (lane >> 5); scr[kk * 33 + (lane & 31)] = W[(size_t)(k0 + kk) * N + n_src0 + (lane & 31)]; }
    asm volatile("s_waitcnt lgkmcnt(0)" ::: "memory");
    const int c = lane & 7;
#pragma unroll
    for (int j = 0; j < 4; ++j) { const int n = (lane >> 3) + 8 * j; const LAS float* s = scr + (8 * c) * 33 + n;
        u32x4 o; o.x = cvt_pk_bf16(s[0 * 33], s[1 * 33]); o.y = cvt_pk_bf16(s[2 * 33], s[3 * 33]); o.z = cvt_pk_bf16(s[4 * 33], s[5 * 33]); o.w = cvt_pk_bf16(s[6 * 33], s[7 * 33]);
        *(u32x4*)(WT + (size_t)(n_dst0 + n) * K + k0 + 8 * c) = o; }
    asm volatile("s_waitcnt lgkmcnt(0)" ::: "memory");
}
struct TJob { const float* W; bf16_t* WT; int K, N, src0, dst0, ncb, nmat; size_t sstride, dstride; };
__device__ __forceinline__ void run_tjob(const TJob& j, int gw, int ngw, LAS float* scr, int lane) {
    const int nkb = j.K / 64, per = nkb * j.ncb, nit = per * j.nmat;
    for (int it = gw; it < nit; it += ngw) { const int mt = it / per, r = it % per, kb = r / j.ncb, cb = r % j.ncb;
        transpose_item(j.W + (size_t)mt * j.sstride, j.K, j.N, j.WT + (size_t)mt * j.dstride, 64 * kb, j.src0 + 32 * cb, j.dst0 + 32 * cb, scr, lane); }
}
__device__ __forceinline__ void cvt_rows_bf16(const float* src, bf16_t* dst, size_t n8, int gtid, int ngt) {
    for (size_t i = gtid; i < n8; i += ngt) { const f32x4 a = *(const f32x4*)(src + i * 8), b = *(const f32x4*)(src + i * 8 + 4);
        u32x4 o; o.x = cvt_pk_bf16(a[0], a[1]); o.y = cvt_pk_bf16(a[2], a[3]); o.z = cvt_pk_bf16(b[0], b[1]); o.w = cvt_pk_bf16(b[2], b[3]); *(u32x4*)(dst + i * 8) = o; }
}
enum { I_X = 0, I_MEM, I_HGRN_W, I_HGRN_LB, I_HGRN_NG, I_FOX_W, I_FOX_BF, I_MOBA_W, I_RELB, I_WKV, I_WOUT, I_LN1G, I_LN1B, I_RW, I_RB, I_WUP, I_BUP, I_WDN, I_BDN, I_LN2G, I_LN2B };

__device__ __forceinline__ void phase_prologue(const Params& p, LAS unsigned char* lds, int bid, int nb) {
    const int tid = tid_(), lane = tid & 63, wave = tid >> 6;
    LAS float* scr = (LAS float*)(lds + wave * 16384);
    const int gw = bid * NWAVES + wave, ngw = nb * NWAVES;
    for (int l = 0; l < 4; ++l) {
        TJob ju{p.in[I_WUP] + (size_t)l * NEXP * DM * 2 * DFF, WSP(bf16_t, WS_WUP) + (size_t)l * NEXP * 2 * DFF * DM, DM, 2 * DFF, 0, 0, 2 * DFF / 32, NEXP, (size_t)DM * 2 * DFF, (size_t)2 * DFF * DM};
        run_tjob(ju, gw, ngw, scr, lane);
        TJob jd{p.in[I_WDN] + (size_t)l * NEXP * DFF * DM, WSP(bf16_t, WS_WDN) + (size_t)l * NEXP * DM * DFF, DFF, DM, 0, 0, DM / 32, NEXP, (size_t)DFF * DM, (size_t)DM * DFF};
        run_tjob(jd, gw, ngw, scr, lane);
        TJob jk{p.in[I_WKV] + (size_t)l * DM * 1024, WSP(bf16_t, WS_WKV) + (size_t)l * 1024 * DM, DM, 1024, 0, 0, 32, 1, 0, 0};
        run_tjob(jk, gw, ngw, scr, lane);
        TJob jo{p.in[I_WOUT] + (size_t)l * OUT_IN * DM, WSP(bf16_t, WS_WOUT) + (size_t)l * DM * OUT_IN, OUT_IN, DM, 0, 0, 32, 1, 0, 0};
        run_tjob(jo, gw, ngw, scr, lane);
        const int kind = l % 3, jj = l / 3;
        bf16_t* wt = WSP(bf16_t, WS_WIN) + (size_t)l * (10 * MiB / 2);
        if (kind == 0) { TJob ji{p.in[I_HGRN_W] + (size_t)jj * DM * HGRN_IN, wt, DM, HGRN_IN, 0, 0, HGRN_IN / 32, 1, 0, 0}; run_tjob(ji, gw, ngw, scr, lane); }
        else if (kind == 1) { TJob ja{p.in[I_FOX_W], wt, DM, FOX_IN, 0, 0, 3072 / 32, 1, 0, 0}; run_tjob(ja, gw, ngw, scr, lane);
                              TJob jb{p.in[I_FOX_W], wt, DM, FOX_IN, 3080, 3072, 512 / 32, 1, 0, 0}; run_tjob(jb, gw, ngw, scr, lane); }
        else { TJob ji{p.in[I_MOBA_W], wt, DM, MOBA_IN, 0, 0, MOBA_IN / 32, 1, 0, 0}; run_tjob(ji, gw, ngw, scr, lane); }
    }
    const int gtid = bid * NTHR + tid, ngt = nb * NTHR;
    cvt_rows_bf16(p.in[I_X], WSP(bf16_t, WS_XB), (size_t)T * DM / 8, gtid, ngt);
    cvt_rows_bf16(p.in[I_MEM], WSP(bf16_t, WS_MEMB), (size_t)BATCH * MEMT * DM / 8, gtid, ngt);
}

constexpr int LDS_STAGE = 0, LDS_GTAB = 131072, LDS_MISC = 147456, LDS_BYTES = 153600;

__device__ __forceinline__ void static_order(int L, int nM, int nN, int& pm, int& pn) {
    const int nwg = nM * nN; int wgid = L; { const int q = nwg / 8, r = nwg % 8, xcd = wgid % 8, off = wgid / 8; wgid = (xcd < r ? xcd * (q + 1) : r * (q + 1) + (xcd - r) * q) + off; }
    const int nig = 8 * nN, gid = wgid / nig, fm = gid * 8, gsz = (nM - fm) < 8 ? (nM - fm) : 8;
    pm = fm + ((wgid % nig) % gsz); pn = (wgid % nig) / gsz;
}
struct ProjSched {
    int G, c, kind; const char *xb, *win, *memb, *wkv; char *pa, *pb, *pvt, *pz, *pmq, *memk, *memvt;
    __device__ __forceinline__ bool next(int i, pg8::Unit& u) const {
        const int nmc = (kind == 0) ? 14 : 10, nmain = 64 * nmc; const int L = i * G + c;
        u.x0 = 0; u.x1 = 0; u.x2 = 0; u.x3 = 0;
        if (L < nmain) { int pm, j; static_order(L, 64, nmc, pm, j);
            int pn, dc; char* dst; int ldc = DM, mode = 0, esz = 2;
            if (kind == 0) { if (j < 4) { pn = j; dst = pa; dc = j; mode = 1; } else if (j < 8) { pn = j; dst = pz; dc = j - 4; mode = 2; esz = 4; } else if (j < 12) { pn = j + 4; dst = pb; dc = j - 8; mode = 1; } else { pn = j + 4; dst = pmq; dc = j - 12; ldc = MEMW; } }
            else { if (j < 4) { pn = j; dst = pa; dc = j; } else if (j < 8) { pn = j; dst = pb; dc = j - 4; } else { pn = j + 4; dst = pmq; dc = j - 8; ldc = MEMW; } }
            u.a = xb + (size_t)pm * 256 * DM * 2; u.b = win + (size_t)pn * 256 * DM * 2; u.c = dst + ((size_t)pm * 256 * ldc + dc * 256) * esz; u.ldc = ldc; u.mode = mode; return true; }
        int idx = L - nmain;
        if (idx < 256) { const int x = idx & 7, off = idx >> 3, tn = 8 * x + (off & 7), vm = off >> 3;
            u.a = win + (size_t)(2048 + 256 * vm) * DM * 2; u.b = xb + (size_t)tn * 256 * DM * 2; u.c = pvt + ((size_t)256 * vm * T + 256 * tn) * 2; u.ldc = T; u.mode = 0; return true; }
        idx -= 256;
        if (idx < 4) { const int mm = idx & 1, kn = idx >> 1;
            u.a = memb + (size_t)mm * 256 * DM * 2; u.b = wkv + (size_t)kn * 256 * DM * 2; u.c = memk + ((size_t)256 * mm * MEMW + 256 * kn) * 2; u.ldc = MEMW; u.mode = 0; return true; }
        idx -= 4;
        if (idx < 4) { const int mm = idx & 1, vn = idx >> 1;
            u.a = wkv + (size_t)(512 + 256 * vn) * DM * 2; u.b = memb + (size_t)mm * 256 * DM * 2; u.c = memvt + ((size_t)256 * vn * 512 + 256 * mm) * 2; u.ldc = 512; u.mode = 0; return true; }
        return false;
    }
};
struct EpiStore {
    __device__ __forceinline__ void operator()(const f32x4 (&acc)[2][2][4][2], const pg8::Unit& u, int wr, int wc, int fr, int fq) const {
        const int r0 = wr * 64 + fr, c0 = wc * 32 + 8 * fq;
#pragma unroll
        for (int ai = 0; ai < 2; ++ai)
#pragma unroll
            for (int m = 0; m < 4; ++m) { const size_t ro = (size_t)(r0 + ai * 128 + m * 16) * u.ldc + c0;
#pragma unroll
                for (int bj = 0; bj < 2; ++bj) { f32x4 v0 = acc[ai][bj][m][0], v1 = acc[ai][bj][m][1];
                    if (u.mode == 2) { float* o = (float*)u.c + ro + bj * 128; *(f32x4*)o = v0; *(f32x4*)(o + 4) = v1; }
                    else { if (u.mode == 1) {
#pragma unroll
                            for (int j = 0; j < 4; ++j) { v0[j] = siluf_(v0[j]); v1[j] = siluf_(v1[j]); } }
                        u32x4 w; w.x = cvt_pk_bf16(v0[0], v0[1]); w.y = cvt_pk_bf16(v0[2], v0[3]); w.z = cvt_pk_bf16(v1[0], v1[1]); w.w = cvt_pk_bf16(v1[2], v1[3]);
                        *(u32x4*)((bf16_t*)u.c + ro + bj * 128) = w; } } }
    }
};
struct OutSched { int G, c; const char *mix, *wout;
    __device__ __forceinline__ bool next(int i, pg8::Unit& u) const { const int L = i * G + c; if (L >= 256) return false; int pm, pn; static_order(L, 64, 4, pm, pn);
        u.a = mix + (size_t)pm * 256 * OUT_IN * 2; u.b = wout + (size_t)pn * 256 * OUT_IN * 2; u.c = nullptr; u.ldc = DM; u.mode = 0; u.x0 = pm; u.x1 = pn; u.x2 = 0; u.x3 = 0; return true; }
};
struct EpiResid {
    const float* res; float* out;
    __device__ __forceinline__ void operator()(const f32x4 (&acc)[2][2][4][2], const pg8::Unit& u, int wr, int wc, int fr, int fq) const {
        const int r0 = u.x0 * 256 + wr * 64 + fr, c0 = u.x1 * 256 + wc * 32 + 8 * fq;
#pragma unroll
        for (int ai = 0; ai < 2; ++ai)
#pragma unroll
            for (int m = 0; m < 4; ++m) { const size_t ro = (size_t)(r0 + ai * 128 + m * 16) * DM + c0;
#pragma unroll
                for (int bj = 0; bj < 2; ++bj) { const float* rp = res + ro + bj * 128; float* o = out + ro + bj * 128;
                    const f32x4 a = *(const f32x4*)rp, b = *(const f32x4*)(rp + 4);
                    *(f32x4*)o = a * DN_ALPHA + acc[ai][bj][m][0]; *(f32x4*)(o + 4) = b * DN_ALPHA + acc[ai][bj][m][1]; } }
    }
};
struct MoeSched { const LAS int* ut; const char *abase, *wbase; int up;
    __device__ __forceinline__ bool next(int i, pg8::Unit& u) const {
        if (i >= 16) return false; const LAS int* t = ut + i * 8; if (!t[0]) return false;
        const int e = t[1], rbl = t[2], rbc = t[3], pn = t[4], cnt = t[5];
        if (up) { u.a = abase; u.b = wbase + ((size_t)e * 2 * DFF + pn * 256) * DM * 2; }
        else { u.a = abase + (size_t)rbc * 256 * DFF * 2; u.b = wbase + ((size_t)e * DM + pn * 256) * DFF * 2; }
        u.c = nullptr; u.ldc = pn; u.mode = e; u.x0 = rbl; u.x1 = rbc; u.x2 = cnt; u.x3 = 0; return true; }
};
struct EpiUp {
    const float* bup; bf16_t* act;
    __device__ __forceinline__ void operator()(const f32x4 (&acc)[2][2][4][2], const pg8::Unit& u, int wr, int wc, int fr, int fq) const {
        const int e = u.mode, pn = u.ldc, r0 = u.x1 * 256 + wr * 64 + fr, c0 = pn * 256 + wc * 32 + 8 * fq;
        f32x4 bv[2][2];
#pragma unroll
        for (int bj = 0; bj < 2; ++bj) { const float* bp = bup + (size_t)e * 2 * DFF + c0 + bj * 128; bv[bj][0] = *(const f32x4*)bp; bv[bj][1] = *(const f32x4*)(bp + 4); }
#pragma unroll
        for (int ai = 0; ai < 2; ++ai)
#pragma unroll
            for (int m = 0; m < 4; ++m) { bf16_t* rowp = act + (size_t)(r0 + ai * 128 + m * 16) * DFF + (c0 >> 1);
#pragma unroll
                for (int bj = 0; bj < 2; ++bj) { const f32x4 v0 = acc[ai][bj][m][0] + bv[bj][0], v1 = acc[ai][bj][m][1] + bv[bj][1];
                    float o[4];
#pragma unroll
                    for (int j = 0; j < 4; ++j) { const float hg = (j < 2) ? v0[2 * j] : v1[2 * j - 4], hl = (j < 2) ? v0[2 * j + 1] : v1[2 * j - 3];
                        const float glu = fminf(hg, 7.0f), lin = fminf(fmaxf(hl, -7.0f), 7.0f); o[j] = glu * sigmoidf_(1.702f * glu) * (lin + 1.0f); }
                    u32x2 w; w.x = cvt_pk_bf16(o[0], o[1]); w.y = cvt_pk_bf16(o[2], o[3]); *(u32x2*)(rowp + bj * 64) = w; } }
    }
};
struct EpiDown {
    const float* bdn; const unsigned* etok; bf16_t* ye;
    __device__ __forceinline__ void operator()(const f32x4 (&acc)[2][2][4][2], const pg8::Unit& u, int wr, int wc, int fr, int fq) const {
        const int e = u.mode, pn = u.ldc, rl0 = u.x0 * 256 + wr * 64 + fr, cnt = u.x2, c0 = pn * 256 + wc * 32 + 8 * fq;
        f32x4 bv[2][2];
#pragma unroll
        for (int bj = 0; bj < 2; ++bj) { const float* bp = bdn + (size_t)e * DM + c0 + bj * 128; bv[bj][0] = *(const f32x4*)bp; bv[bj][1] = *(const f32x4*)(bp + 4); }
        unsigned dest[2][4];
#pragma unroll
        for (int ai = 0; ai < 2; ++ai)
#pragma unroll
            for (int m = 0; m < 4; ++m) { const int rl = rl0 + ai * 128 + m * 16; dest[ai][m] = (rl < cnt) ? etok[(size_t)e * T + rl] : 0xffffffffu; }
#pragma unroll
        for (int ai = 0; ai < 2; ++ai)
#pragma unroll
            for (int m = 0; m < 4; ++m) { if (dest[ai][m] != 0xffffffffu) { bf16_t* rowp = ye + (size_t)dest[ai][m] * DM + c0;
#pragma unroll
                for (int bj = 0; bj < 2; ++bj) { const f32x4 v0 = acc[ai][bj][m][0] + bv[bj][0], v1 = acc[ai][bj][m][1] + bv[bj][1];
                    u32x4 w; w.x = cvt_pk_bf16(v0[0], v0[1]); w.y = cvt_pk_bf16(v0[2], v0[3]); w.z = cvt_pk_bf16(v1[0], v1[1]); w.w = cvt_pk_bf16(v1[2], v1[3]);
                    *(u32x4*)(rowp + bj * 128) = w; } } }
    }
};

__device__ __forceinline__ void phase_proj(const Params& p, LAS unsigned char* lds, int layer, int bid, int nb) {
    ProjSched S; S.G = nb; S.c = bid; S.kind = layer % 3;
    S.xb = (const char*)WSP(bf16_t, WS_XB); S.win = (const char*)(WSP(bf16_t, WS_WIN) + (size_t)layer * (10 * MiB / 2)); S.memb = (const char*)WSP(bf16_t, WS_MEMB);
    S.wkv = (const char*)(WSP(bf16_t, WS_WKV) + (size_t)layer * 1024 * DM);
    S.pa = (char*)WSP(bf16_t, WS_PA); S.pb = (char*)WSP(bf16_t, WS_PB); S.pvt = (char*)WSP(bf16_t, WS_PVT); S.pz = (char*)WSP(float, WS_PZ); S.pmq = (char*)WSP(bf16_t, WS_PMQ);
    S.memk = (char*)WSP(bf16_t, WS_MEMK); S.memvt = (char*)WSP(bf16_t, WS_MEMVT);
    EpiStore E;
    pg8::gemm_phase<EpiStore, ProjSched, false>(lds + LDS_STAGE, DM, S, E, nullptr);
}
__device__ __forceinline__ void phase_outproj(const Params& p, LAS unsigned char* lds, int layer, int bid, int nb) {
    OutSched S{nb, bid, (const char*)WSP(bf16_t, WS_MIX), (const char*)(WSP(bf16_t, WS_WOUT) + (size_t)layer * DM * OUT_IN)};
    EpiResid E{layer == 0 ? p.in[I_X] : WSP(float, WS_XF), WSP(float, WS_Y1)};
    pg8::gemm_phase<EpiResid, OutSched, false>(lds + LDS_STAGE, OUT_IN, S, E, nullptr);
}
__device__ __forceinline__ void moe_build_units(const Params& p, LAS unsigned char* lds, int layer, int bid, int nb, int npn, bool up) {
    LAS int* misc = (LAS int*)(lds + LDS_MISC); LAS int* ut = misc + 16; LAS int* pre = misc + 160; LAS int* cnts = misc + 200;
    LAS unsigned* gtab = (LAS unsigned*)(lds + LDS_GTAB);
    const int tid = tid_();
    const unsigned* ecnt = ctl(p) + CW_ECNT + layer * 32;
    if (tid < 32) cnts[tid] = (int)__hip_atomic_load(ecnt + tid, __ATOMIC_RELAXED, __HIP_MEMORY_SCOPE_AGENT);
    __syncthreads();
    if (tid == 0) { int s = 0; for (int e = 0; e < 32; ++e) { pre[e] = s; s += (cnts[e] + 255) >> 8; } pre[32] = s; }
    __syncthreads();
    if (tid < 16) { const int i = tid, nblk = pre[32]; int rbg, pn;
        if (nb == 256) { const int x = bid & 7, slot = bid >> 3, rpr = 32 / npn; rbg = i * (8 * rpr) + x * rpr + slot / npn; pn = slot % npn; }
        else { const int L = i * nb + bid; rbg = L / npn; pn = L % npn; }
        LAS int* t = ut + i * 8;
        if (rbg < nblk) { int e = 0; while (pre[e + 1] <= rbg) ++e; t[0] = 1; t[1] = e; t[2] = rbg - pre[e]; t[3] = rbg; t[4] = pn; t[5] = cnts[e]; }
        else { t[0] = 0; t[1] = 0; t[2] = 0; t[3] = 0; t[4] = 0; t[5] = 0; } }
    __syncthreads();
    if (up) { const unsigned* etok = WSP(unsigned, WS_ETOK);
        for (int idx = tid; idx < 16 * 256; idx += NTHR) { const int i = idx >> 8, r = idx & 255; const LAS int* t = ut + i * 8; unsigned off = 0;
            if (t[0]) { const int rl = t[2] * 256 + r; if (rl < t[5]) off = (etok[(size_t)t[1] * T + rl] >> 2) * (unsigned)(DM * 2); }
            gtab[idx] = off; }
        __syncthreads(); }
}
__device__ __forceinline__ void phase_moe_up(const Params& p, LAS unsigned char* lds, int layer, int bid, int nb) {
    moe_build_units(p, lds, layer, bid, nb, 8, true);
    MoeSched S{(const LAS int*)(lds + LDS_MISC) + 16, (const char*)WSP(bf16_t, WS_X1B), (const char*)(WSP(bf16_t, WS_WUP) + (size_t)layer * NEXP * 2 * DFF * DM), 1};
    EpiUp E{p.in[I_BUP] + (size_t)layer * NEXP * 2 * DFF, WSP(bf16_t, WS_ACT)};
    pg8::gemm_phase<EpiUp, MoeSched, true>(lds + LDS_STAGE, DM, S, E, (const LAS unsigned*)(lds + LDS_GTAB));
}
__device__ __forceinline__ void phase_moe_down(const Params& p, LAS unsigned char* lds, int layer, int bid, int nb) {
    moe_build_units(p, lds, layer, bid, nb, 4, false);
    MoeSched S{(const LAS int*)(lds + LDS_MISC) + 16, (const char*)WSP(bf16_t, WS_ACT), (const char*)(WSP(bf16_t, WS_WDN) + (size_t)layer * NEXP * DM * DFF), 0};
    EpiDown E{p.in[I_BDN] + (size_t)layer * NEXP * DM, WSP(unsigned, WS_ETOK), WSP(bf16_t, WS_YE)};
    pg8::gemm_phase<EpiDown, MoeSched, false>(lds + LDS_STAGE, DFF, S, E, nullptr);
}

constexpr int AT_K0 = 0, AT_V0 = 32768, AT_AUX = 65536;
__device__ __forceinline__ int kswz(int row, int ch) { return row * 256 + ((ch ^ ((row & 3) | (((row >> 3) & 3) << 2))) << 4); }
__device__ __forceinline__ int vswz(int row, int ch) { return row * 128 + ((ch ^ (((row >> 1) & 1) | (((row >> 3) & 3) << 1))) << 4); }
struct AttnBias { float cq; int qpos; const LAS float* tab; int kpos0; int qmin; };
template <int MODE>
__device__ __forceinline__ void attn_tiles(LAS unsigned char* lds, const bf16_t* kbase, int ldk, const bf16_t* vtbase, int ldv, int ntiles, int wave_nt,
                                           const bf16x8 (&qf)[8], f32x16 (&o)[4], float& m, float& l, const AttnBias& B) {
    const int tid = tid_(), lane = tid & 63, w = __builtin_amdgcn_readfirstlane(tid >> 6), r = lane & 31, hi = lane >> 5;
    int koff[2], voff[2];
#pragma unroll
    for (int i = 0; i < 2; ++i) { const int pz = (w * 2 + i) * 64 + lane;
        { const int row = pz >> 4, chp = pz & 15, ch = chp ^ ((row & 3) | (((row >> 3) & 3) << 2)); koff[i] = row * ldk + ch * 8; }
        { const int row = pz >> 3, chp = pz & 7, ch = chp ^ (((row >> 1) & 1) | (((row >> 3) & 3) << 1)); voff[i] = row * ldv + ch * 8; } }
    const int pr = (r & ~12) | ((r & 4) << 1) | ((r & 8) >> 1);
    int kaddr[8], vaddr[4];
#pragma unroll
    for (int ks = 0; ks < 8; ++ks) kaddr[ks] = kswz(pr, 2 * ks + hi);
#pragma unroll
    for (int s_ = 0; s_ < 4; ++s_) vaddr[s_] = vswz(r, 2 * s_ + hi);
#define AT_DMA(t, buf) do { _Pragma("unroll") for (int _i = 0; _i < 2; ++_i) { \
        __builtin_amdgcn_global_load_lds((const unsigned*)(kbase + (size_t)(t) * 64 * ldk + koff[_i]), (LAS unsigned*)(lds + AT_K0 + (buf) * 16384 + (w * 2 + _i) * 1024), 16, 0, 0); \
        __builtin_amdgcn_global_load_lds((const unsigned*)(vtbase + (t) * 64 + voff[_i]), (LAS unsigned*)(lds + AT_V0 + (buf) * 16384 + (w * 2 + _i) * 1024), 16, 0, 0); } } while (0)
    AT_DMA(0, 0);
    asm volatile("s_waitcnt vmcnt(0)" ::: "memory");
    __syncthreads();
    constexpr float C = QK_SCALE * LOG2E;
    const float NEG = -__builtin_inff();
    for (int t = 0; t < ntiles; ++t) {
        const int buf = t & 1;
        if (t + 1 < ntiles) AT_DMA(t + 1, buf ^ 1);
        if (t < wave_nt) {
            f32x16 s0, s1;
#pragma unroll
            for (int i = 0; i < 16; ++i) { s0[i] = 0.f; s1[i] = 0.f; }
            const LAS unsigned char* kb = lds + AT_K0 + buf * 16384;
#pragma unroll
            for (int kg = 0; kg < 4; ++kg) {
#pragma unroll
                for (int k2 = 0; k2 < 2; ++k2) { const int ks = 2 * kg + k2;
                    const bf16x8 k0 = *(const LAS bf16x8*)(kb + kaddr[ks]), k1 = *(const LAS bf16x8*)(kb + kaddr[ks] + 8192);
                    s0 = __builtin_amdgcn_mfma_f32_32x32x16_bf16(k0, qf[ks], s0, 0, 0, 0);
                    s1 = __builtin_amdgcn_mfma_f32_32x32x16_bf16(k1, qf[ks], s1, 0, 0, 0); }
                __builtin_amdgcn_sched_barrier(0);
            }
            float mx = NEG;
            if (MODE == 0) {
#pragma unroll
                for (int i = 0; i < 16; ++i) { s0[i] *= C; s1[i] *= C; mx = fmaxf(mx, fmaxf(s0[i], s1[i])); }
            } else if (MODE == 1) {
                const int tk = t * 64;
                const bool diag = (tk + 63 > B.qmin);
#pragma unroll
                for (int g = 0; g < 4; ++g) {
                    const int kq = 16 * (g >> 1) + 8 * hi + 4 * (g & 1);
                    const f32x4 c0 = *(const LAS f32x4*)(B.tab + tk + kq), c1 = *(const LAS f32x4*)(B.tab + tk + 32 + kq);
#pragma unroll
                    for (int j = 0; j < 4; ++j) { const int i = 4 * g + j; float v0 = s0[i] * C + (B.cq - c0[j]), v1 = s1[i] * C + (B.cq - c1[j]);
                        if (diag) { const int ko = tk + kq + j; if (ko > B.qpos) v0 = NEG; if (ko + 32 > B.qpos) v1 = NEG; }
                        s0[i] = v0; s1[i] = v1; mx = fmaxf(mx, fmaxf(v0, v1)); }
                    __builtin_amdgcn_sched_barrier(0);
                }
            } else {
                const int tk = B.kpos0 + t * 64;
                const bool far = (MODE == 2) && (B.qmin - (tk + 63) >= 128);
                if (far) { const float bb = B.tab[128];
#pragma unroll
                    for (int i = 0; i < 16; ++i) { s0[i] = s0[i] * C + bb; s1[i] = s1[i] * C + bb; mx = fmaxf(mx, fmaxf(s0[i], s1[i])); }
                } else {
#pragma unroll
                    for (int i = 0; i < 16; ++i) { const int ko = 16 * (i >> 3) + 8 * hi + (i & 7); const int d0 = B.qpos - (tk + ko), d1 = d0 - 32;
                        float v0 = s0[i] * C + B.tab[d0 < 0 ? 0 : (d0 > 128 ? 128 : d0)], v1 = s1[i] * C + B.tab[d1 < 0 ? 0 : (d1 > 128 ? 128 : d1)];
                        if (MODE == 3) { if (d0 < 0) v0 = NEG; if (d1 < 0) v1 = NEG; }
                        s0[i] = v0; s1[i] = v1; mx = fmaxf(mx, fmaxf(v0, v1)); }
                }
            }
            mx = swap_max(mx);
            const float mn = fmaxf(m, mx), alpha = fast_exp2(m - mn); m = mn;
            float ps = 0.f;
#pragma unroll
            for (int i = 0; i < 16; ++i) { s0[i] = fast_exp2(s0[i] - mn); s1[i] = fast_exp2(s1[i] - mn); ps += s0[i] + s1[i]; }
            ps = swap_sum(ps); l = l * alpha + ps;
            if (!__all(alpha == 1.0f)) {
#pragma unroll
                for (int db = 0; db < 4; ++db)
#pragma unroll
                    for (int i = 0; i < 16; ++i) o[db][i] *= alpha;
            }
            bf16x8 pf[4];
#pragma unroll
            for (int s = 0; s < 4; ++s) { u32x4 wv;
                if (s < 2) { wv.x = cvt_pk_bf16(s0[8 * s + 0], s0[8 * s + 1]); wv.y = cvt_pk_bf16(s0[8 * s + 2], s0[8 * s + 3]); wv.z = cvt_pk_bf16(s0[8 * s + 4], s0[8 * s + 5]); wv.w = cvt_pk_bf16(s0[8 * s + 6], s0[8 * s + 7]); }
                else { const int q = s - 2; wv.x = cvt_pk_bf16(s1[8 * q + 0], s1[8 * q + 1]); wv.y = cvt_pk_bf16(s1[8 * q + 2], s1[8 * q + 3]); wv.z = cvt_pk_bf16(s1[8 * q + 4], s1[8 * q + 5]); wv.w = cvt_pk_bf16(s1[8 * q + 6], s1[8 * q + 7]); }
                pf[s] = *reinterpret_cast<bf16x8*>(&wv); }
            const LAS unsigned char* vb = lds + AT_V0 + buf * 16384;
#pragma unroll
            for (int s = 0; s < 4; ++s) {
#pragma unroll
                for (int db = 0; db < 4; ++db) { const bf16x8 vf = *(const LAS bf16x8*)(vb + vaddr[s] + db * 4096); o[db] = __builtin_amdgcn_mfma_f32_32x32x16_bf16(vf, pf[s], o[db], 0, 0, 0); }
                __builtin_amdgcn_sched_barrier(0);
            }
        }
        asm volatile("s_waitcnt vmcnt(0)" ::: "memory");
        __syncthreads();
    }
#undef AT_DMA
}
__device__ __forceinline__ void attn_init(f32x16 (&o)[4], float& m, float& l) {
#pragma unroll
    for (int db = 0; db < 4; ++db)
#pragma unroll
        for (int i = 0; i < 16; ++i) o[db][i] = 0.f;
    m = -1e30f; l = 0.f;
}
__device__ __forceinline__ void load_q(const bf16_t* qrow, int hi, bf16x8 (&qf)[8]) {
#pragma unroll
    for (int ks = 0; ks < 8; ++ks) qf[ks] = *(const bf16x8*)(qrow + 16 * ks + 8 * hi);
}
__device__ __forceinline__ void store_o(const f32x16 (&o)[4], float sc, bf16_t* orow, int hi) {
#pragma unroll
    for (int db = 0; db < 4; ++db)
#pragma unroll
        for (int g = 0; g < 4; ++g) { u32x2 w; w.x = cvt_pk_bf16(o[db][4 * g] * sc, o[db][4 * g + 1] * sc); w.y = cvt_pk_bf16(o[db][4 * g + 2] * sc, o[db][4 * g + 3] * sc);
            *(u32x2*)(orow + 32 * db + 8 * g + 4 * hi) = w; }
}

__device__ __forceinline__ void phase_memattn(const Params& p, LAS unsigned char* lds, int bid, int nb) {
    const int tid = tid_(), lane = tid & 63, w = tid >> 6, c = lane & 31, hi = lane >> 5;
    for (int u = bid; u < BATCH * MH * 32; u += nb) {
        const int b = u >> 7, mh = (u >> 5) & 3, qb = u & 31;
        const int tok = b * SEQ + qb * 256 + 32 * w + c;
        bf16x8 qf[8]; load_q(WSP(bf16_t, WS_PMQ) + (size_t)tok * MEMW + mh * HD, hi, qf);
        f32x16 o[4]; float m, l; attn_init(o, m, l);
        AttnBias B{0.f, 0, nullptr, 0, 0};
        attn_tiles<0>(lds, WSP(bf16_t, WS_MEMK) + (size_t)b * MEMT * MEMW + mh * HD, MEMW, WSP(bf16_t, WS_MEMVT) + (size_t)mh * HD * 512 + b * MEMT, 512, 4, 4, qf, o, m, l, B);
        store_o(o, 1.0f / l, WSP(bf16_t, WS_MIX) + (size_t)tok * OUT_IN + DM + mh * HD, hi);
    }
}

__device__ __forceinline__ void phase_fox_logf(const Params& p, int layer, int bid, int nb) {
    const int tid = tid_(), lane = tid & 63, w = tid >> 6;
    const float* xin = (layer == 0) ? p.in[I_X] : WSP(float, WS_XF);
    const float* wf = p.in[I_FOX_W] + (size_t)(layer / 3) * DM * FOX_IN + 3072;
    const float* bf = p.in[I_FOX_BF] + (layer / 3) * NH;
    float wr[16][8];
#pragma unroll
    for (int j = 0; j < 4; ++j)
#pragma unroll
        for (int q = 0; q < 4; ++q) { const int k = 256 * j + 4 * lane + q;
#pragma unroll
            for (int h = 0; h < 8; ++h) wr[4 * j + q][h] = wf[(size_t)k * FOX_IN + h]; }
    for (int tok = bid * NWAVES + w; tok < T; tok += nb * NWAVES) {
        float acc[8];
#pragma unroll
        for (int h = 0; h < 8; ++h) acc[h] = 0.f;
#pragma unroll
        for (int j = 0; j < 4; ++j) { const f32x4 xv = *(const f32x4*)(xin + (size_t)tok * DM + 256 * j + 4 * lane);
#pragma unroll
            for (int q = 0; q < 4; ++q)
#pragma unroll
                for (int h = 0; h < 8; ++h) acc[h] = fmaf(xv[q], wr[4 * j + q][h], acc[h]); }
#pragma unroll
        for (int h = 0; h < 8; ++h) acc[h] = wave_sum(acc[h]);
        if (lane < 8) { float z = 0.f;
#pragma unroll
            for (int h = 0; h < 8; ++h) z = (lane == h) ? acc[h] : z;
            const int b = tok / SEQ, s = tok % SEQ;
            WSP(float, WS_LOGF)[((size_t)b * NH + lane) * SEQ + s] = logsigmoidf_(z + bf[lane]) * LOG2E; }
    }
}
__device__ __forceinline__ void phase_fox_prep(const Params& p, int bid, int nb) {
    const int tid = tid_(), lane = tid & 63, w = tid >> 6; const int gw = bid * NWAVES + w, ngw = nb * NWAVES;
    for (int it = gw; it < 16 + 2048; it += ngw) {
        if (it < 16) { const float* src = WSP(float, WS_LOGF) + (size_t)it * SEQ; float* dst = WSP(float, WS_C2) + (size_t)it * SEQ; float carry = 0.f;
            for (int c0 = 0; c0 < SEQ; c0 += 1024) { float v[16]; float run = 0.f;
#pragma unroll
                for (int j = 0; j < 4; ++j) { const f32x4 x = *(const f32x4*)(src + c0 + lane * 16 + 4 * j); v[4 * j] = x[0]; v[4 * j + 1] = x[1]; v[4 * j + 2] = x[2]; v[4 * j + 3] = x[3]; }
#pragma unroll
                for (int j = 0; j < 16; ++j) { run += v[j]; v[j] = run; }
                float inc = run;
#pragma unroll
                for (int o_ = 1; o_ < 64; o_ <<= 1) { const float y = __shfl_up(inc, o_); if (lane >= o_) inc += y; }
                const float base = carry + inc - run;
#pragma unroll
                for (int j = 0; j < 4; ++j) *(f32x4*)(dst + c0 + lane * 16 + 4 * j) = (f32x4){v[4 * j] + base, v[4 * j + 1] + base, v[4 * j + 2] + base, v[4 * j + 3] + base};
                carry += __shfl(inc, 63); }
        } else { const int u = it - 16, bh = u >> 7, t = u & 127, b = bh >> 3, h = bh & 7;
            const bf16_t* kp = WSP(bf16_t, WS_PB) + ((size_t)b * SEQ + t * 64 + lane) * DM + h * HD; float ss = 0.f;
#pragma unroll
            for (int j = 0; j < 16; ++j) { const u32x4 x = *(const u32x4*)(kp + 8 * j);
                ss += bflo(x.x) * bflo(x.x) + bfhi(x.x) * bfhi(x.x) + bflo(x.y) * bflo(x.y) + bfhi(x.y) * bfhi(x.y) + bflo(x.z) * bflo(x.z) + bfhi(x.z) * bfhi(x.z) + bflo(x.w) * bflo(x.w) + bfhi(x.w) * bfhi(x.w); }
#pragma unroll
            for (int o_ = 1; o_ < 64; o_ <<= 1) ss = fmaxf(ss, __shfl_xor(ss, o_));
            if (lane == 0) WSP(float, WS_KNT)[u] = sqrtf(ss) * 1.0001f; }
    }
}
constexpr float FOX_PRUNE = 40.0f;
__device__ __forceinline__ void phase_fox_attn(const Params& p, LAS unsigned char* lds, int layer, int bid, int nb) {
    const int tid = tid_(), lane = tid & 63, w = __builtin_amdgcn_readfirstlane(tid >> 6), c = lane & 31, r = c, hi = lane >> 5;
    LAS float* c2 = (LAS float*)(lds + AT_AUX);
    LAS float* kn = (LAS float*)(lds + AT_AUX + 32768);
    LAS int* sh = (LAS int*)(lds + AT_AUX + 32768 + 512);
    const float* bfp = p.in[I_FOX_BF] + (layer / 3) * NH;
    int koff[2], voff[2];
#pragma unroll
    for (int i = 0; i < 2; ++i) { const int pz = (w * 2 + i) * 64 + lane;
        { const int row = pz >> 4, chp = pz & 15, ch = chp ^ ((row & 3) | (((row >> 3) & 3) << 2)); koff[i] = row * DM + ch * 8; }
        { const int row = pz >> 3, chp = pz & 7, ch = chp ^ (((row >> 1) & 1) | (((row >> 3) & 3) << 1)); voff[i] = row * T + ch * 8; } }
    const int pr = (r & ~12) | ((r & 4) << 1) | ((r & 8) >> 1);
    int kaddr[8], vaddr[4];
#pragma unroll
    for (int ks = 0; ks < 8; ++ks) kaddr[ks] = kswz(pr, 2 * ks + hi);
#pragma unroll
    for (int s_ = 0; s_ < 4; ++s_) vaddr[s_] = vswz(r, 2 * s_ + hi);
    constexpr float C = QK_SCALE * LOG2E; const float NEG = -__builtin_inff();
    for (;;) {
        __syncthreads();
        if (tid == 0) sh[0] = (int)atomicAdd(ctl(p) + CW_FOXQ, 1u);
        __syncthreads();
        const int u = sh[0]; if (u >= 512) break;
        const int rk = u >> 6, b = (u >> 5) & 1, qb = 31 - (u & 31);
        int h = 0;
        for (int hc = 0; hc < NH; ++hc) { int rank = 0; for (int h2 = 0; h2 < NH; ++h2) rank += (bfp[h2] > bfp[hc] || (bfp[h2] == bfp[hc] && h2 < hc)) ? 1 : 0; if (rank == rk) h = hc; }
        const int bh = b * NH + h, n = (qb + 1) * 256, ntiles = (qb + 1) * 4;
        for (int i = tid * 4; i < n; i += NTHR * 4) *(LAS f32x4*)(c2 + i) = *(const f32x4*)(WSP(float, WS_C2) + (size_t)bh * SEQ + i);
        if (tid < 128) kn[tid] = WSP(float, WS_KNT)[bh * 128 + tid];
        const int qpos = qb * 256 + 32 * w + c, tok = b * SEQ + qpos, qmin = qb * 256 + 32 * w;
        bf16x8 qf[8]; load_q(WSP(bf16_t, WS_PA) + (size_t)tok * DM + h * HD, hi, qf);
        float qn2 = 0.f;
#pragma unroll
        for (int ks = 0; ks < 8; ++ks) { const u32x4 x = *reinterpret_cast<const u32x4*>(&qf[ks]);
            qn2 += bflo(x.x) * bflo(x.x) + bfhi(x.x) * bfhi(x.x) + bflo(x.y) * bflo(x.y) + bfhi(x.y) * bfhi(x.y) + bflo(x.z) * bflo(x.z) + bfhi(x.z) * bfhi(x.z) + bflo(x.w) * bflo(x.w) + bfhi(x.w) * bfhi(x.w); }
        qn2 = swap_sum(qn2);
#pragma unroll
        for (int o_ = 1; o_ < 32; o_ <<= 1) qn2 = fmaxf(qn2, __shfl_xor(qn2, o_));
        f32x16 o[4]; float m, l; attn_init(o, m, l);
        const bf16_t* kbase = WSP(bf16_t, WS_PB) + (size_t)b * SEQ * DM + h * HD; const bf16_t* vtbase = WSP(bf16_t, WS_PVT) + (size_t)h * HD * T + (size_t)b * SEQ;
        const int wave_nt = ((qb * 256 + 32 * w + 31) >> 6) + 1;
#define FX_DMA(t, buf) do { _Pragma("unroll") for (int _i = 0; _i < 2; ++_i) { \
        __builtin_amdgcn_global_load_lds((const unsigned*)(kbase + (size_t)(t) * 64 * DM + koff[_i]), (LAS unsigned*)(lds + AT_K0 + (buf) * 16384 + (w * 2 + _i) * 1024), 16, 0, 0); \
        __builtin_amdgcn_global_load_lds((const unsigned*)(vtbase + (t) * 64 + voff[_i]), (LAS unsigned*)(lds + AT_V0 + (buf) * 16384 + (w * 2 + _i) * 1024), 16, 0, 0); } } while (0)
        int t_lo = ntiles - 4, my_lo = 0; bool decided = false;
        FX_DMA(ntiles - 1, 0);
        asm volatile("s_waitcnt vmcnt(0)" ::: "memory");
        __syncthreads();
        const float cq = c2[qpos];
        for (int it = 0;; ++it) {
            const int t = ntiles - 1 - it, buf = it & 1;
            bool has_next = (t - 1 >= t_lo);
            if (has_next) FX_DMA(t - 1, buf ^ 1);
            if (t < wave_nt && t >= my_lo) {
                f32x16 s0, s1;
#pragma unroll
                for (int i = 0; i < 16; ++i) { s0[i] = 0.f; s1[i] = 0.f; }
                const LAS unsigned char* kb = lds + AT_K0 + buf * 16384;
#pragma unroll
                for (int kg = 0; kg < 4; ++kg) {
#pragma unroll
                    for (int k2 = 0; k2 < 2; ++k2) { const int ks = 2 * kg + k2;
                        const bf16x8 k0 = *(const LAS bf16x8*)(kb + kaddr[ks]), k1 = *(const LAS bf16x8*)(kb + kaddr[ks] + 8192);
                        s0 = __builtin_amdgcn_mfma_f32_32x32x16_bf16(k0, qf[ks], s0, 0, 0, 0);
                        s1 = __builtin_amdgcn_mfma_f32_32x32x16_bf16(k1, qf[ks], s1, 0, 0, 0); }
                    __builtin_amdgcn_sched_barrier(0);
                }
                float mx = NEG; const int tk = t * 64; const bool diag = (tk + 63 > qmin);
#pragma unroll
                for (int g = 0; g < 4; ++g) { const int kq = 16 * (g >> 1) + 8 * hi + 4 * (g & 1);
                    const f32x4 c0 = *(const LAS f32x4*)(c2 + tk + kq), c1 = *(const LAS f32x4*)(c2 + tk + 32 + kq);
#pragma unroll
                    for (int j = 0; j < 4; ++j) { const int i = 4 * g + j; float v0 = s0[i] * C + (cq - c0[j]), v1 = s1[i] * C + (cq - c1[j]);
                        if (diag) { const int ko = tk + kq + j; if (ko > qpos) v0 = NEG; if (ko + 32 > qpos) v1 = NEG; }
                        s0[i] = v0; s1[i] = v1; mx = fmaxf(mx, fmaxf(v0, v1)); }
                    __builtin_amdgcn_sched_barrier(0);
                }
                mx = swap_max(mx);
                const float mn = fmaxf(m, mx), alpha = fast_exp2(m - mn); m = mn;
                float ps = 0.f;
#pragma unroll
                for (int i = 0; i < 16; ++i) { s0[i] = fast_exp2(s0[i] - mn); s1[i] = fast_exp2(s1[i] - mn); ps += s0[i] + s1[i]; }
                ps = swap_sum(ps); l = l * alpha + ps;
                if (!__all(alpha == 1.0f)) {
#pragma unroll
                    for (int db = 0; db < 4; ++db)
#pragma unroll
                        for (int i = 0; i < 16; ++i) o[db][i] *= alpha;
                }
                bf16x8 pf[4];
#pragma unroll
                for (int s = 0; s < 4; ++s) { u32x4 wv;
                    if (s < 2) { wv.x = cvt_pk_bf16(s0[8 * s + 0], s0[8 * s + 1]); wv.y = cvt_pk_bf16(s0[8 * s + 2], s0[8 * s + 3]); wv.z = cvt_pk_bf16(s0[8 * s + 4], s0[8 * s + 5]); wv.w = cvt_pk_bf16(s0[8 * s + 6], s0[8 * s + 7]); }
                    else { const int q = s - 2; wv.x = cvt_pk_bf16(s1[8 * q + 0], s1[8 * q + 1]); wv.y = cvt_pk_bf16(s1[8 * q + 2], s1[8 * q + 3]); wv.z = cvt_pk_bf16(s1[8 * q + 4], s1[8 * q + 5]); wv.w = cvt_pk_bf16(s1[8 * q + 6], s1[8 * q + 7]); }
                    pf[s] = *reinterpret_cast<bf16x8*>(&wv); }
                const LAS unsigned char* vb = lds + AT_V0 + buf * 16384;
#pragma unroll
                for (int s = 0; s < 4; ++s) {
#pragma unroll
                    for (int db = 0; db < 4; ++db) { const bf16x8 vf = *(const LAS bf16x8*)(vb + vaddr[s] + db * 4096); o[db] = __builtin_amdgcn_mfma_f32_32x32x16_bf16(vf, pf[s], o[db], 0, 0, 0); }
                    __builtin_amdgcn_sched_barrier(0);
                }
            }
            asm volatile("s_waitcnt vmcnt(0)" ::: "memory");
            __syncthreads();
            if (!has_next) {
                if (decided || t == 0) break;
                decided = true;
                {
                    float mmin = m;
#pragma unroll
                    for (int o_ = 1; o_ < 64; o_ <<= 1) mmin = fminf(mmin, __shfl_xor(mmin, o_));
                    const float qmax = sqrtf(qn2) * 1.0001f, cq0 = c2[qmin], thr = mmin - FOX_PRUNE;
                    int first = t;
                    for (int tt = lane; tt < t; tt += 64) { const float ub = C * qmax * kn[tt] + (cq0 - c2[tt * 64 + 63]); if (ub >= thr) first = tt < first ? tt : first; }
#pragma unroll
                    for (int o_ = 1; o_ < 64; o_ <<= 1) { const int y = __shfl_xor(first, o_); first = y < first ? y : first; }
                    my_lo = first; if (lane == 0) sh[1 + w] = first;
                }
                __syncthreads();
                int lo = sh[1];
#pragma unroll
                for (int q = 1; q < 8; ++q) lo = sh[1 + q] < lo ? sh[1 + q] : lo;
                t_lo = lo;
                if (t - 1 < t_lo) break;
                FX_DMA(t - 1, buf ^ 1);
                asm volatile("s_waitcnt vmcnt(0)" ::: "memory");
                __syncthreads();
            }
        }
#undef FX_DMA
        store_o(o, 1.0f / l, WSP(bf16_t, WS_MIX) + (size_t)tok * OUT_IN + h * HD, hi);
    }
}

__device__ __forceinline__ int t5_bucket(int n) {
    if (n < 16) return n;
    const int v = 16 + (int)(__log2f((float)n * (1.0f / 16.0f)) * (16.0f / 3.0f));
    return v < 31 ? v : 31;
}
__device__ __forceinline__ void phase_moba_kmean(const Params& p, LAS unsigned char* lds, int bid, int nb) {
    const int tid = tid_(); LAS float* red = (LAS float*)lds;
    const int dp = tid & 63, kg = tid >> 6;
    for (int u = bid; u < 512; u += nb) {
        const int bh = u >> 5, j = u & 31, b = bh >> 3, h = bh & 7;
        const bf16_t* kp = WSP(bf16_t, WS_PB) + ((size_t)b * SEQ + j * 256 + kg * 32) * DM + h * HD + 2 * dp;
        float s0 = 0.f, s1 = 0.f;
#pragma unroll 8
        for (int k = 0; k < 32; ++k) { const unsigned wv = *(const unsigned*)(kp + (size_t)k * DM); s0 += bflo(wv); s1 += bfhi(wv); }
        __syncthreads();
        red[kg * 128 + 2 * dp] = s0; red[kg * 128 + 2 * dp + 1] = s1;
        __syncthreads();
        if (tid < 128) { float s = 0.f;
#pragma unroll
            for (int g = 0; g < 8; ++g) s += red[g * 128 + tid];
            WSP(float, WS_KMEAN)[(size_t)u * 128 + tid] = s * (1.0f / 256.0f); }
    }
}
__device__ __forceinline__ void phase_moba_gate(const Params& p, LAS unsigned char* lds, int bid, int nb) {
    const int tid = tid_(); LAS float* km = (LAS float*)lds;
    LAS int* lcnt = (LAS int*)(lds + 16384); LAS int* lbase = lcnt + 32;
    unsigned* gl = ctl(p) + CW_LCNT;
    for (int u = bid; u < 512; u += nb) {
        const int bh = u >> 5, own = u & 31, b = bh >> 3, h = bh & 7;
        __syncthreads();
        for (int i = tid; i < 32 * 128; i += NTHR) km[i] = WSP(float, WS_KMEAN)[(size_t)bh * 32 * 128 + i];
        if (tid < 32) lcnt[tid] = 0;
        __syncthreads();
        int sel[3] = {-1, -1, -1}, rank[3] = {0, 0, 0}; int nv = 0;
        const int q = own * 256 + (tid & 255);
        if (tid < 256) {
            const bf16_t* qp = WSP(bf16_t, WS_PA) + ((size_t)b * SEQ + q) * DM + h * HD;
            unsigned qw[64];
#pragma unroll
            for (int i = 0; i < 16; ++i) { const u32x4 x = *(const u32x4*)(qp + 8 * i); qw[4 * i] = x.x; qw[4 * i + 1] = x.y; qw[4 * i + 2] = x.z; qw[4 * i + 3] = x.w; }
            float best[3] = {-__builtin_inff(), -__builtin_inff(), -__builtin_inff()};
            for (int j = 0; j < own; ++j) { const LAS float* kr = km + j * 128; float g = 0.f;
#pragma unroll
                for (int i = 0; i < 64; ++i) { g = fmaf(bflo(qw[i]), kr[2 * i], g); g = fmaf(bfhi(qw[i]), kr[2 * i + 1], g); }
                if (g > best[0]) { best[2] = best[1]; sel[2] = sel[1]; best[1] = best[0]; sel[1] = sel[0]; best[0] = g; sel[0] = j; }
                else if (g > best[1]) { best[2] = best[1]; sel[2] = sel[1]; best[1] = g; sel[1] = j; }
                else if (g > best[2]) { best[2] = g; sel[2] = j; } }
            nv = own < 3 ? own : 3;
            for (int s = 0; s < 3; ++s) if (s < nv) rank[s] = atomicAdd((int*)&lcnt[sel[s]], 1);
            int* sp = WSP(int, WS_SEL) + (((size_t)b * SEQ + q) * NH + h) * 4; sp[0] = sel[0]; sp[1] = sel[1]; sp[2] = sel[2]; sp[3] = nv;
        }
        __syncthreads();
        if (tid < 32) lbase[tid] = lcnt[tid] ? (int)atomicAdd(gl + bh * 32 + tid, (unsigned)lcnt[tid]) : 0;
        __syncthreads();
        if (tid < 256) for (int s = 0; s < 3; ++s) if (s < nv) WSP(unsigned, WS_LISTS)[((size_t)bh * 32 + sel[s]) * 8192 + lbase[sel[s]] + rank[s]] = (unsigned)q | ((unsigned)s << 16);
    }
}
__device__ __forceinline__ void moba_bias_tab(const Params& p, LAS float* tab, int h) {
    const int tid = tid_();
    if (tid <= 128) tab[tid] = p.in[I_RELB][t5_bucket(tid) * NH + h] * LOG2E;
}
__device__ __forceinline__ void phase_moba_past(const Params& p, LAS unsigned char* lds, int bid, int nb) {
    const int tid = tid_(), lane = tid & 63, w = tid >> 6, c = lane & 31, hi = lane >> 5;
    LAS float* tab = (LAS float*)(lds + AT_AUX); LAS int* pre = (LAS int*)(lds + AT_AUX + 1024);
    LAS int* wsum = (LAS int*)(lds + AT_AUX + 1024 + 4096);
    const unsigned* gl = ctl(p) + CW_LCNT;
    {
        const int n = (int)__hip_atomic_load(gl + tid, __ATOMIC_RELAXED, __HIP_MEMORY_SCOPE_AGENT); const int nu = (n + 255) >> 8;
        int inc = nu;
#pragma unroll
        for (int o_ = 1; o_ < 64; o_ <<= 1) { const int y = __shfl_up(inc, o_); if (lane >= o_) inc += y; }
        if (lane == 63) wsum[w] = inc;
        __syncthreads();
        int base = inc - nu; for (int q = 0; q < w; ++q) base += wsum[q];
        pre[tid] = base; if (tid == 511) pre[512] = base + nu;
        __syncthreads();
    }
    const int total = pre[512];
    int cur_h = -1;
    for (int u = bid; u < total; u += nb) {
        int lo = 0, hiL = 511;
        while (lo < hiL) { const int mid = (lo + hiL + 1) >> 1; if (pre[mid] <= u) lo = mid; else hiL = mid - 1; }
        const int list = lo, chunk = u - pre[list], bh = list >> 5, j = list & 31, b = bh >> 3, h = bh & 7;
        const int n = (int)__hip_atomic_load(gl + list, __ATOMIC_RELAXED, __HIP_MEMORY_SCOPE_AGENT);
        if (h != cur_h) { __syncthreads(); moba_bias_tab(p, tab, h); cur_h = h; __syncthreads(); }
        const int e0 = chunk * 256 + 32 * w; const bool active = e0 < n;
        int ei = e0 + c; if (ei > n - 1) ei = n - 1;
        const unsigned ent = WSP(unsigned, WS_LISTS)[(size_t)list * 8192 + ei]; const int q = ent & 0xffff, slot = ent >> 16;
        const int tok = b * SEQ + q;
        bf16x8 qf[8]; load_q(WSP(bf16_t, WS_PA) + (size_t)tok * DM + h * HD, hi, qf);
        int qmin = q;
#pragma unroll
        for (int o_ = 1; o_ < 64; o_ <<= 1) { const int y = __shfl_xor(qmin, o_); qmin = y < qmin ? y : qmin; }
        f32x16 o[4]; float m, l; attn_init(o, m, l);
        AttnBias B{0.f, q, tab, j * 256, qmin};
        attn_tiles<2>(lds, WSP(bf16_t, WS_PB) + ((size_t)b * SEQ + j * 256) * DM + h * HD, DM, WSP(bf16_t, WS_PVT) + (size_t)h * HD * T + (size_t)b * SEQ + j * 256, T, 4, active ? 4 : 0, qf, o, m, l, B);
        if (active) { const size_t P = ((size_t)tok * NH + h) * 3 + slot;
            store_o(o, 1.0f / l, WSP(bf16_t, WS_PARTO) + P * HD, hi);
            if (hi == 0) WSP(float, WS_PARTL)[P] = m + __log2f(l); }
    }
}
__device__ __forceinline__ void phase_moba_own(const Params& p, LAS unsigned char* lds, int bid, int nb) {
    const int tid = tid_(), lane = tid & 63, w = tid >> 6, c = lane & 31, hi = lane >> 5;
    LAS float* tab = (LAS float*)(lds + AT_AUX);
    int cur_h = -1;
    for (int u = bid; u < 512; u += nb) {
        const int bh = u >> 5, blk = u & 31, b = bh >> 3, h = bh & 7;
        if (h != cur_h) { __syncthreads(); moba_bias_tab(p, tab, h); cur_h = h; __syncthreads(); }
        const int qrel = 32 * w + c, q = blk * 256 + qrel, tok = b * SEQ + q;
        bf16x8 qf[8]; load_q(WSP(bf16_t, WS_PA) + (size_t)tok * DM + h * HD, hi, qf);
        f32x16 o[4]; float m, l; attn_init(o, m, l);
        AttnBias B{0.f, qrel, tab, 0, 32 * w};
        attn_tiles<3>(lds, WSP(bf16_t, WS_PB) + ((size_t)b * SEQ + blk * 256) * DM + h * HD, DM, WSP(bf16_t, WS_PVT) + (size_t)h * HD * T + (size_t)b * SEQ + blk * 256, T, 4, (w >> 1) + 1, qf, o, m, l, B);
        const int* sp = WSP(int, WS_SEL) + ((size_t)tok * NH + h) * 4; const int nv = sp[3];
        const size_t P = ((size_t)tok * NH + h) * 3;
        float lse[3], M = m;
#pragma unroll
        for (int s = 0; s < 3; ++s) { lse[s] = (s < nv) ? WSP(float, WS_PARTL)[P + s] : -__builtin_inff(); M = fmaxf(M, lse[s]); }
        const float wo = fast_exp2(m - M); float den = l * wo;
#pragma unroll
        for (int db = 0; db < 4; ++db)
#pragma unroll
            for (int i = 0; i < 16; ++i) o[db][i] *= wo;
#pragma unroll
        for (int s = 0; s < 3; ++s) { if (s < nv) { const float ws_ = fast_exp2(lse[s] - M); den += ws_; const bf16_t* po = WSP(bf16_t, WS_PARTO) + (P + s) * HD;
#pragma unroll
                for (int db = 0; db < 4; ++db)
#pragma unroll
                    for (int g = 0; g < 4; ++g) { const u32x2 x = *(const u32x2*)(po + 32 * db + 8 * g + 4 * hi);
                        o[db][4 * g] += ws_ * bflo(x.x); o[db][4 * g + 1] += ws_ * bfhi(x.x); o[db][4 * g + 2] += ws_ * bflo(x.y); o[db][4 * g + 3] += ws_ * bfhi(x.y); } } }
        store_o(o, 1.0f / den, WSP(bf16_t, WS_MIX) + (size_t)tok * OUT_IN + h * HD, hi);
    }
}

__device__ __forceinline__ void phase_hgrn_pre(const Params& p, int layer, int bid, int nb) {
    const int jj = layer / 3; const int tid = tid_(), lane = tid & 63, w = tid >> 6;
    const float* lbp = p.in[I_HGRN_LB];
    for (int item = bid * NWAVES + w; item < 256 * 32; item += nb * NWAVES) {
        const int crow = item >> 5, cg = item & 31, ch0 = cg * 32;
        const int b = crow >> 7, cc = crow & 127; const size_t tok = (size_t)b * SEQ + cc * 64 + lane;
        f32x4 z[8]; u32x4 qw[4];
#pragma unroll
        for (int j = 0; j < 8; ++j) z[j] = *(const f32x4*)(WSP(float, WS_PZ) + tok * DM + ch0 + 4 * j);
#pragma unroll
        for (int j = 0; j < 4; ++j) qw[j] = *(const u32x4*)(WSP(bf16_t, WS_PA) + tok * DM + ch0 + 8 * j);
        unsigned oqb[16], oqr[16], okr[16]; float gsel = 0.f;
#pragma unroll
        for (int j = 0; j < 8; ++j) {
            float vqb[4], vqr[4], vkr[4];
#pragma unroll
            for (int q = 0; q < 4; ++q) { const int cl = 4 * j + q, ch = ch0 + cl; const float zz = z[j][q];
                const float lb = (jj == 0) ? 0.f : sigmoidf_(lbp[DM + ch] - lbp[ch]);
                const float e = __expf(-fabsf(zz)), r1 = fast_rcp(1.0f + e), l1 = __logf(1.0f + e);
                const float sg = (zz >= 0.f) ? r1 : e * r1, sgn = (zz >= 0.f) ? e * r1 : r1;
                const float ls = fminf(zz, 0.f) - l1;
                const float lf = (jj == 0) ? ls : __logf(lb + (1.f - lb) * sg);
                float bc = lf;
#pragma unroll
                for (int o_ = 1; o_ < 64; o_ <<= 1) { const float y = __shfl_up(bc, o_); if (lane >= o_) bc += y; }
                const float bmid = __shfl(bc, 31), blast = __shfl(bc, 63);
                const float kk = (1.f - lb) * sgn;
                const unsigned qword = (cl & 1) ? 0u : 0u; (void)qword;
                const unsigned qwv = ((const unsigned*)&qw[cl >> 3])[(cl & 7) >> 1]; const float qv = (cl & 1) ? bfhi(qwv) : bflo(qwv);
                vqb[q] = qv * __expf(bc); vqr[q] = qv * __expf(fminf(bc - bmid, 80.f)); vkr[q] = kk * __expf(fminf(bmid - bc, 80.f));
                WSP(bf16_t, WS_HKDT)[(size_t)ch * T + tok] = f2bf(kk * __expf(blast - bc));
                gsel = (lane == cl) ? __expf(blast) : gsel; }
            oqb[2 * j] = cvt_pk_bf16(vqb[0], vqb[1]); oqb[2 * j + 1] = cvt_pk_bf16(vqb[2], vqb[3]);
            oqr[2 * j] = cvt_pk_bf16(vqr[0], vqr[1]); oqr[2 * j + 1] = cvt_pk_bf16(vqr[2], vqr[3]);
            okr[2 * j] = cvt_pk_bf16(vkr[0], vkr[1]); okr[2 * j + 1] = cvt_pk_bf16(vkr[2], vkr[3]);
        }
#pragma unroll
        for (int j = 0; j < 4; ++j) {
            *(u32x4*)(WSP(bf16_t, WS_HQB) + tok * DM + ch0 + 8 * j) = (u32x4){oqb[4 * j], oqb[4 * j + 1], oqb[4 * j + 2], oqb[4 * j + 3]};
            *(u32x4*)(WSP(bf16_t, WS_HQR) + tok * DM + ch0 + 8 * j) = (u32x4){oqr[4 * j], oqr[4 * j + 1], oqr[4 * j + 2], oqr[4 * j + 3]};
            *(u32x4*)(WSP(bf16_t, WS_HKR) + tok * DM + ch0 + 8 * j) = (u32x4){okr[4 * j], okr[4 * j + 1], okr[4 * j + 2], okr[4 * j + 3]}; }
        if (lane < 32) { const int ch = ch0 + lane, hh = ch >> 7, d = ch & 127; WSP(float, WS_HG)[((size_t)(b * NH + hh) * 128 + cc) * 128 + d] = gsel; }
    }
}
__device__ __forceinline__ void phase_hgrn_a(const Params& p, int bid, int nb) {
    const int tid = tid_(), lane = tid & 63, w = tid >> 6, c = lane & 31, hi = lane >> 5, eb = w >> 1, dh = w & 1;
    for (int u = bid; u < 2048; u += nb) {
        const int bh = u >> 7, cc = u & 127, b = bh >> 3, hh = bh & 7; const size_t tok0 = (size_t)b * SEQ + cc * 64;
        const bf16_t* vt = WSP(bf16_t, WS_PVT) + (size_t)(hh * HD + 32 * eb + c) * T + tok0 + 8 * hi;
        const bf16_t* kd = WSP(bf16_t, WS_HKDT) + (size_t)(hh * HD + 64 * dh + c) * T + tok0 + 8 * hi;
        f32x16 a0, a1;
#pragma unroll
        for (int i = 0; i < 16; ++i) { a0[i] = 0.f; a1[i] = 0.f; }
#pragma unroll
        for (int ks = 0; ks < 4; ++ks) { const bf16x8 vf = *(const bf16x8*)(vt + 16 * ks), k0 = *(const bf16x8*)(kd + 16 * ks), k1 = *(const bf16x8*)(kd + (size_t)32 * T + 16 * ks);
            a0 = __builtin_amdgcn_mfma_f32_32x32x16_bf16(k0, vf, a0, 0, 0, 0); a1 = __builtin_amdgcn_mfma_f32_32x32x16_bf16(k1, vf, a1, 0, 0, 0); }
        bf16_t* st = WSP(bf16_t, WS_HST) + (size_t)u * 128 * 128 + (size_t)(32 * eb + c) * 128 + 64 * dh + 4 * hi;
#pragma unroll
        for (int g = 0; g < 4; ++g) { u32x2 x0, x1; x0.x = cvt_pk_bf16(a0[4 * g], a0[4 * g + 1]); x0.y = cvt_pk_bf16(a0[4 * g + 2], a0[4 * g + 3]); x1.x = cvt_pk_bf16(a1[4 * g], a1[4 * g + 1]); x1.y = cvt_pk_bf16(a1[4 * g + 2], a1[4 * g + 3]);
            *(u32x2*)(st + 8 * g) = x0; *(u32x2*)(st + 32 + 8 * g) = x1; }
    }
}
__device__ __forceinline__ void phase_hgrn_b(const Params& p, int bid, int nb) {
    for (int gid = bid * NTHR + tid_(); gid < 16 * 128 * 64; gid += nb * NTHR) {
        const int bh = gid >> 13, e = (gid >> 6) & 127, dp = gid & 63;
        unsigned* st = (unsigned*)(WSP(bf16_t, WS_HST) + (size_t)bh * 128 * 16384 + (size_t)e * 128 + 2 * dp); const float* gp = WSP(float, WS_HG) + (size_t)bh * 128 * 128 + 2 * dp;
        float S0 = 0.f, S1 = 0.f;
        for (int c8 = 0; c8 < 128; c8 += 8) { unsigned U[8]; f32x2 g[8];
#pragma unroll
            for (int q = 0; q < 8; ++q) { U[q] = st[(size_t)(c8 + q) * 8192]; g[q] = *(const f32x2*)(gp + (c8 + q) * 128); }
#pragma unroll
            for (int q = 0; q < 8; ++q) { st[(size_t)(c8 + q) * 8192] = cvt_pk_bf16(S0, S1); S0 = g[q][0] * S0 + bflo(U[q]); S1 = g[q][1] * S1 + bfhi(U[q]); } }
    }
}
__device__ __forceinline__ void phase_hgrn_c(const Params& p, int layer, int bid, int nb) {
    const int tid = tid_(), lane = tid & 63, w = tid >> 6, c = lane & 31, hi = lane >> 5;
    const float* ng = p.in[I_HGRN_NG] + (layer / 3) * DM;
    for (int wu = bid * NWAVES + w; wu < 4096; wu += nb * NWAVES) {
        const int u = wu >> 1, tb = wu & 1, bh = u >> 7, cc = u & 127, b = bh >> 3, hh = bh & 7; const size_t tok0 = (size_t)b * SEQ + cc * 64;
        const size_t tokq = tok0 + 32 * tb + c;
        f32x16 o[4];
#pragma unroll
        for (int db = 0; db < 4; ++db)
#pragma unroll
            for (int i = 0; i < 16; ++i) o[db][i] = 0.f;
        {
            bf16x8 qf[8]; load_q(WSP(bf16_t, WS_HQB) + tokq * DM + hh * HD, hi, qf);
            const bf16_t* st = WSP(bf16_t, WS_HST) + (size_t)u * 16384 + (size_t)c * 128 + 8 * hi;
#pragma unroll
            for (int db = 0; db < 4; ++db)
#pragma unroll
                for (int ks = 0; ks < 8; ++ks) o[db] = __builtin_amdgcn_mfma_f32_32x32x16_bf16(*(const bf16x8*)(st + (size_t)(32 * db) * 128 + 16 * ks), qf[ks], o[db], 0, 0, 0);
        }
        {
            bf16x8 qf[8]; load_q(WSP(bf16_t, WS_HQR) + tokq * DM + hh * HD, hi, qf);
            for (int kb = 0; kb <= tb; ++kb) {
                f32x16 s;
#pragma unroll
                for (int i = 0; i < 16; ++i) s[i] = 0.f;
                const bf16_t* kp = WSP(bf16_t, WS_HKR) + (tok0 + 32 * kb + c) * DM + hh * HD + 8 * hi;
#pragma unroll
                for (int ks = 0; ks < 8; ++ks) s = __builtin_amdgcn_mfma_f32_32x32x16_bf16(*(const bf16x8*)(kp + 16 * ks), qf[ks], s, 0, 0, 0);
                if (kb == tb) {
#pragma unroll
                    for (int i = 0; i < 16; ++i) { const int ko = (i & 3) + 8 * (i >> 2) + 4 * hi; if (ko > c) s[i] = 0.f; } }
#pragma unroll
                for (int sq = 0; sq < 2; ++sq) { u32x4 wv; wv.x = cvt_pk_bf16(s[8 * sq], s[8 * sq + 1]); wv.y = cvt_pk_bf16(s[8 * sq + 2], s[8 * sq + 3]); wv.z = cvt_pk_bf16(s[8 * sq + 4], s[8 * sq + 5]); wv.w = cvt_pk_bf16(s[8 * sq + 6], s[8 * sq + 7]);
                    const bf16x8 pf = *reinterpret_cast<bf16x8*>(&wv);
                    const bf16_t* vp = WSP(bf16_t, WS_PVT) + (size_t)(hh * HD + c) * T + tok0 + 32 * kb + 16 * sq + 4 * hi;
#pragma unroll
                    for (int db = 0; db < 4; ++db) { const u32x2 lo = *(const u32x2*)(vp + (size_t)(32 * db) * T), hi2 = *(const u32x2*)(vp + (size_t)(32 * db) * T + 8);
                        u32x4 vv; vv.x = lo.x; vv.y = lo.y; vv.z = hi2.x; vv.w = hi2.y;
                        o[db] = __builtin_amdgcn_mfma_f32_32x32x16_bf16(*reinterpret_cast<bf16x8*>(&vv), pf, o[db], 0, 0, 0); } }
            }
        }
        float ss = 0.f;
#pragma unroll
        for (int db = 0; db < 4; ++db)
#pragma unroll
            for (int i = 0; i < 16; ++i) ss += o[db][i] * o[db][i];
        ss = swap_sum(ss);
        const float rinv = rsqrtf(ss * (1.0f / 128.0f) + RMS_EPS);
        const bf16_t* gt = WSP(bf16_t, WS_PB) + tokq * DM + hh * HD; bf16_t* orow = WSP(bf16_t, WS_MIX) + tokq * OUT_IN + hh * HD;
#pragma unroll
        for (int db = 0; db < 4; ++db)
#pragma unroll
            for (int g = 0; g < 4; ++g) { const int d = 32 * db + 8 * g + 4 * hi; const u32x2 gw = *(const u32x2*)(gt + d); const f32x4 nv = *(const f32x4*)(ng + hh * HD + d);
                u32x2 wv; wv.x = cvt_pk_bf16(o[db][4 * g] * rinv * nv[0] * bflo(gw.x), o[db][4 * g + 1] * rinv * nv[1] * bfhi(gw.x));
                wv.y = cvt_pk_bf16(o[db][4 * g + 2] * rinv * nv[2] * bflo(gw.y), o[db][4 * g + 3] * rinv * nv[3] * bfhi(gw.y));
                *(u32x2*)(orow + d) = wv; }
    }
}

__device__ __forceinline__ void ln_row(f32x4 (&v)[4], const float* g, const float* bta, int lane) {
    float s = 0.f;
#pragma unroll
    for (int j = 0; j < 4; ++j) s += (v[j][0] + v[j][1]) + (v[j][2] + v[j][3]);
    const float mean = wave_sum(s) * (1.0f / DM); float s2 = 0.f;
#pragma unroll
    for (int j = 0; j < 4; ++j) { v[j] = v[j] - mean; s2 += (v[j][0] * v[j][0] + v[j][1] * v[j][1]) + (v[j][2] * v[j][2] + v[j][3] * v[j][3]); }
    const float rstd = rsqrtf(wave_sum(s2) * (1.0f / DM) + LN_EPS);
#pragma unroll
    for (int j = 0; j < 4; ++j) { const f32x4 gg = *(const f32x4*)(g + 256 * j + 4 * lane), bb = *(const f32x4*)(bta + 256 * j + 4 * lane); v[j] = v[j] * rstd * gg + bb; }
}
__device__ __forceinline__ void phase_ln1_router(const Params& p, LAS unsigned char* lds, int layer, int bid, int nb) {
    const int tid = tid_(), lane = tid & 63, w = tid >> 6;
    LAS float* part = (LAS float*)lds;
    LAS float* logit = (LAS float*)(lds + 32768);
    LAS int* asg_e = (LAS int*)(lds + 32768 + 8448 + 64); LAS unsigned* asg_v = (LAS unsigned*)(asg_e + 256);
    const float* g1 = p.in[I_LN1G] + layer * DM; const float* b1 = p.in[I_LN1B] + layer * DM;
    const float* rw = p.in[I_RW] + (size_t)layer * DM * NEXP; const float* rb = p.in[I_RB] + layer * NEXP;
    unsigned* ecnt = ctl(p) + CW_ECNT + layer * 32;
    for (int blk = bid; blk < T / 64; blk += nb) {
        const int row0 = blk * 64;
        for (int rr = 0; rr < 8; ++rr) { const size_t row = row0 + 8 * w + rr; const float* yp = WSP(float, WS_Y1) + row * DM;
            f32x4 v[4];
#pragma unroll
            for (int j = 0; j < 4; ++j) v[j] = *(const f32x4*)(yp + 256 * j + 4 * lane);
            ln_row(v, g1, b1, lane);
#pragma unroll
            for (int j = 0; j < 4; ++j) { *(f32x4*)(WSP(float, WS_X1F) + row * DM + 256 * j + 4 * lane) = v[j];
                u32x2 o; o.x = cvt_pk_bf16(v[j][0], v[j][1]); o.y = cvt_pk_bf16(v[j][2], v[j][3]); *(u32x2*)(WSP(bf16_t, WS_X1B) + row * DM + 256 * j + 4 * lane) = o; } }
        __syncthreads();
        {
            const int rt = w >> 2, kq = w & 3, i = lane & 31, kh = lane >> 5;
            const float* xp = WSP(float, WS_X1F) + (size_t)(row0 + 32 * rt + i) * DM + 256 * kq; const float* wp = rw + (size_t)(256 * kq + kh) * NEXP + i;
            f32x16 acc;
#pragma unroll
            for (int q = 0; q < 16; ++q) acc[q] = 0.f;
#pragma unroll 8
            for (int q = 0; q < 64; ++q) { const f32x4 xv = *(const f32x4*)(xp + 4 * q);
                acc = __builtin_amdgcn_mfma_f32_32x32x2f32(kh ? xv[1] : xv[0], wp[(size_t)(4 * q) * NEXP], acc, 0, 0, 0);
                acc = __builtin_amdgcn_mfma_f32_32x32x2f32(kh ? xv[3] : xv[2], wp[(size_t)(4 * q + 2) * NEXP], acc, 0, 0, 0); }
#pragma unroll
            for (int q = 0; q < 16; ++q) { const int r = (q & 3) + 8 * (q >> 2) + 4 * kh; part[(w * 32 + r) * 32 + i] = acc[q]; }
        }
        __syncthreads();
        for (int o_ = tid; o_ < 64 * 32; o_ += NTHR) { const int r = o_ >> 5, e = o_ & 31, rt = r >> 5, rl = r & 31; float s = rb[e];
#pragma unroll
            for (int kq = 0; kq < 4; ++kq) s += part[((rt * 4 + kq) * 32 + rl) * 32 + e];
            logit[r * 33 + e] = s; }
        __syncthreads();
        if (tid < 64) { const int tok = row0 + tid; float bv[4] = {-__builtin_inff(), -__builtin_inff(), -__builtin_inff(), -__builtin_inff()}; int bi[4] = {0, 0, 0, 0};
            for (int e = 0; e < 32; ++e) { const float x = logit[tid * 33 + e];
                if (x > bv[0]) { bv[3] = bv[2]; bi[3] = bi[2]; bv[2] = bv[1]; bi[2] = bi[1]; bv[1] = bv[0]; bi[1] = bi[0]; bv[0] = x; bi[0] = e; }
                else if (x > bv[1]) { bv[3] = bv[2]; bi[3] = bi[2]; bv[2] = bv[1]; bi[2] = bi[1]; bv[1] = x; bi[1] = e; }
                else if (x > bv[2]) { bv[3] = bv[2]; bi[3] = bi[2]; bv[2] = x; bi[2] = e; }
                else if (x > bv[3]) { bv[3] = x; bi[3] = e; } }
            float ex[4], se = 0.f;
#pragma unroll
            for (int k = 0; k < 4; ++k) { ex[k] = __expf(bv[k] - bv[0]); se += ex[k]; }
#pragma unroll
            for (int k = 0; k < 4; ++k) { WSP(float, WS_GATE)[(size_t)tok * 4 + k] = ex[k] / se; asg_e[tid * 4 + k] = bi[k]; asg_v[tid * 4 + k] = (unsigned)tok * 4u + k; } }
        __syncthreads();
        if (tid < 32) { int cnt = 0;
            for (int a = 0; a < 256; ++a) cnt += (asg_e[a] == tid) ? 1 : 0;
            if (cnt) { unsigned pos = atomicAdd(ecnt + tid, (unsigned)cnt); unsigned* et = WSP(unsigned, WS_ETOK) + (size_t)tid * T;
                for (int a = 0; a < 256; ++a) if (asg_e[a] == tid) et[pos++] = asg_v[a]; } }
        __syncthreads();
    }
}
__device__ __forceinline__ void phase_ln2(const Params& p, int layer, int bid, int nb) {
    const int tid = tid_(), lane = tid & 63, w = tid >> 6;
    const float* g2 = p.in[I_LN2G] + layer * DM; const float* b2 = p.in[I_LN2B] + layer * DM;
    float* dst = (layer == 3) ? p.out : WSP(float, WS_XF);
    for (size_t row = bid * NWAVES + w; row < T; row += (size_t)nb * NWAVES) {
        const float* xp = WSP(float, WS_X1F) + row * DM; const bf16_t* yp = WSP(bf16_t, WS_YE) + row * 4 * DM;
        float gk[4];
#pragma unroll
        for (int k = 0; k < 4; ++k) gk[k] = WSP(float, WS_GATE)[row * 4 + k];
        f32x4 v[4];
#pragma unroll
        for (int j = 0; j < 4; ++j) { v[j] = *(const f32x4*)(xp + 256 * j + 4 * lane) * DN_ALPHA;
#pragma unroll
            for (int k = 0; k < 4; ++k) { const u32x2 y = *(const u32x2*)(yp + (size_t)k * DM + 256 * j + 4 * lane);
                v[j][0] += gk[k] * bflo(y.x); v[j][1] += gk[k] * bfhi(y.x); v[j][2] += gk[k] * bflo(y.y); v[j][3] += gk[k] * bfhi(y.y); } }
        ln_row(v, g2, b2, lane);
#pragma unroll
        for (int j = 0; j < 4; ++j) { *(f32x4*)(dst + row * DM + 256 * j + 4 * lane) = v[j];
            u32x2 o; o.x = cvt_pk_bf16(v[j][0], v[j][1]); o.y = cvt_pk_bf16(v[j][2], v[j][3]); *(u32x2*)(WSP(bf16_t, WS_XB) + row * DM + 256 * j + 4 * lane) = o; }
    }
}

enum { PH_FOXPREP = 18 };
enum { PH_PROLOGUE = 0, PH_PROJ, PH_FOXLOGF, PH_HPRE, PH_HA, PH_HB, PH_HC, PH_FOXATTN, PH_KMEAN, PH_GATE, PH_PAST, PH_OWN, PH_MEMATTN, PH_OUTPROJ, PH_LN1, PH_UP, PH_DOWN, PH_LN2 };
template <int PH>
__device__ __forceinline__ void run_phase(const Params& p, LAS unsigned char* lds, int layer, int bid, int nb) {
    if constexpr (PH == PH_PROLOGUE) phase_prologue(p, lds, bid, nb);
    else if constexpr (PH == PH_PROJ) phase_proj(p, lds, layer, bid, nb);
    else if constexpr (PH == PH_FOXLOGF) phase_fox_logf(p, layer, bid, nb);
    else if constexpr (PH == PH_HPRE) phase_hgrn_pre(p, layer, bid, nb);
    else if constexpr (PH == PH_HA) phase_hgrn_a(p, bid, nb);
    else if constexpr (PH == PH_HB) phase_hgrn_b(p, bid, nb);
    else if constexpr (PH == PH_HC) phase_hgrn_c(p, layer, bid, nb);
    else if constexpr (PH == PH_FOXATTN) phase_fox_attn(p, lds, layer, bid, nb);
    else if constexpr (PH == PH_FOXPREP) phase_fox_prep(p, bid, nb);
    else if constexpr (PH == PH_KMEAN) phase_moba_kmean(p, lds, bid, nb);
    else if constexpr (PH == PH_GATE) phase_moba_gate(p, lds, bid, nb);
    else if constexpr (PH == PH_PAST) phase_moba_past(p, lds, bid, nb);
    else if constexpr (PH == PH_OWN) phase_moba_own(p, lds, bid, nb);
    else if constexpr (PH == PH_MEMATTN) phase_memattn(p, lds, bid, nb);
    else if constexpr (PH == PH_OUTPROJ) phase_outproj(p, lds, layer, bid, nb);
    else if constexpr (PH == PH_LN1) phase_ln1_router(p, lds, layer, bid, nb);
    else if constexpr (PH == PH_UP) phase_moe_up(p, lds, layer, bid, nb);
    else if constexpr (PH == PH_DOWN) phase_moe_down(p, lds, layer, bid, nb);
    else if constexpr (PH == PH_LN2) phase_ln2(p, layer, bid, nb);
}
template <int PH>
__global__ void __launch_bounds__(NTHR, 2) k_phase(Params p, int layer) {
    extern __shared__ __attribute__((aligned(16))) unsigned char lds_raw[];
    run_phase<PH>(p, (LAS unsigned char*)lds_raw, layer, (int)blockIdx.x, (int)gridDim.x);
}

#ifndef DEBUG_CHECKS
#define DEBUG_CHECKS 0
#endif
#if DEBUG_CHECKS
constexpr size_t WS_CHK = WS_END;
__device__ __forceinline__ float bfr(float x) { return bf2f(f2bf(x)); }
__device__ __forceinline__ unsigned hashu(unsigned x) { x ^= x >> 16; x *= 0x7feb352du; x ^= x >> 15; x *= 0x846ca68bu; x ^= x >> 16; return x; }
__device__ __forceinline__ void chk_report(const Params& p, int id, float err) { if (!(err == err)) err = 1e30f; atomicMax(ctl(p) + CW_CHK + id, __float_as_uint(fabsf(err))); }
__device__ __forceinline__ float blk_sum(float v, LAS float* red) {
    v = wave_sum(v); const int w = threadIdx.x >> 6, nw = blockDim.x >> 6; __syncthreads(); if ((threadIdx.x & 63) == 0) red[w] = v; __syncthreads(); float s = 0.f; for (int i = 0; i < nw; ++i) s += red[i]; return s; }
__device__ __forceinline__ float blk_max(float v, LAS float* red) {
#pragma unroll
    for (int o = 1; o < 64; o <<= 1) v = fmaxf(v, __shfl_xor(v, o));
    const int w = threadIdx.x >> 6, nw = blockDim.x >> 6; __syncthreads(); if ((threadIdx.x & 63) == 0) red[w] = v; __syncthreads(); float s = red[0]; for (int i = 1; i < nw; ++i) s = fmaxf(s, red[i]); return s; }

__global__ void chk_proj(Params p, int layer, int id) {
    const int kind = layer % 3, jj = layer / 3; const unsigned sidx = blockIdx.x * blockDim.x + threadIdx.x; const unsigned hsh = hashu(sidx * 2654435761u + layer * 977u + 12345u);
    const int nin = kind == 0 ? HGRN_IN : (kind == 1 ? FOX_IN : MOBA_IN);
    const float* W = kind == 0 ? p.in[I_HGRN_W] + (size_t)jj * DM * HGRN_IN : (kind == 1 ? p.in[I_FOX_W] : p.in[I_MOBA_W]);
    int tok = hsh % T; int col = (hsh >> 14) % (nin + 128);
    float exp_v, got;
    if (col >= nin) {
        const int c = (hashu(hsh) % 1024), row = tok % 512; const float* wk = p.in[I_WKV] + (size_t)layer * DM * 1024; float s = 0.f;
        for (int k = 0; k < DM; ++k) s += bfr(p.in[I_MEM][(size_t)row * DM + k]) * bfr(wk[(size_t)k * 1024 + c]);
        exp_v = s; got = c < 512 ? bf2f(WSP(bf16_t, WS_MEMK)[(size_t)row * 512 + c]) : bf2f(WSP(bf16_t, WS_MEMVT)[(size_t)(c - 512) * 512 + row]);
    } else {
        float s = 0.f, sf = 0.f;
        for (int k = 0; k < DM; ++k) { const float xv = (layer == 0) ? p.in[I_X][(size_t)tok * DM + k] : WSP(float, WS_XF)[(size_t)tok * DM + k]; const float xb = (layer == 0) ? bfr(xv) : bf2f(WSP(bf16_t, WS_XB)[(size_t)tok * DM + k]);
            const float wv = W[(size_t)k * nin + col]; s += xb * bfr(wv); sf += xv * wv; }
        const int sec = col >> 10, c = col & 1023; exp_v = s;
        if (kind == 0) { if (sec == 0) { exp_v = siluf_(s); got = bf2f(WSP(bf16_t, WS_PA)[(size_t)tok * DM + c]); } else if (sec == 1) got = WSP(float, WS_PZ)[(size_t)tok * DM + c];
            else if (sec == 2) got = bf2f(WSP(bf16_t, WS_PVT)[(size_t)c * T + tok]); else if (sec == 3) { exp_v = siluf_(s); got = bf2f(WSP(bf16_t, WS_PB)[(size_t)tok * DM + c]); } else got = bf2f(WSP(bf16_t, WS_PMQ)[(size_t)tok * MEMW + c]); }
        else { if (sec == 0) got = bf2f(WSP(bf16_t, WS_PA)[(size_t)tok * DM + c]); else if (sec == 1) got = bf2f(WSP(bf16_t, WS_PB)[(size_t)tok * DM + c]); else if (sec == 2) got = bf2f(WSP(bf16_t, WS_PVT)[(size_t)c * T + tok]);
            else if (kind == 1 && col < 3080) { exp_v = logsigmoidf_(sf + p.in[I_FOX_BF][jj * NH + (col - 3072)]) * LOG2E; got = WSP(float, WS_LOGF)[((size_t)(tok / SEQ) * NH + (col - 3072)) * SEQ + tok % SEQ]; }
            else got = bf2f(WSP(bf16_t, WS_PMQ)[(size_t)tok * MEMW + (col - (kind == 1 ? 3080 : 3072))]); }
    }
    chk_report(p, id, fabsf(got - exp_v) / (fabsf(exp_v) + 0.05f));
}
__global__ void chk_fox_prep(Params p) { const int bh = threadIdx.x; if (bh < 16) { float s = 0.f; for (int k = 0; k < SEQ; ++k) { s += WSP(float, WS_LOGF)[(size_t)bh * SEQ + k]; WSP(float, WS_CHK)[(size_t)bh * SEQ + k] = s; } } }
__device__ __forceinline__ float chk_softmax_out(const Params& p, LAS float* sc, const LAS int* kp, int n, int b, int h, int tok, LAS float* red) {
    float mx = -1e30f; for (int i = threadIdx.x; i < n; i += blockDim.x) mx = fmaxf(mx, sc[i]); mx = blk_max(mx, red);
    float sm = 0.f; for (int i = threadIdx.x; i < n; i += blockDim.x) { const float e = exp2f(sc[i] - mx); sc[i] = e; sm += e; } sm = blk_sum(sm, red);
    float err = 0.f, mag = 0.f;
    if (threadIdx.x < 128) { const int d = threadIdx.x; float o = 0.f; for (int i = 0; i < n; ++i) o += sc[i] * bf2f(WSP(bf16_t, WS_PVT)[(size_t)(h * HD + d) * T + (size_t)b * SEQ + (kp ? kp[i] : i)]);
        o /= sm; const float got = bf2f(WSP(bf16_t, WS_MIX)[(size_t)tok * OUT_IN + h * HD + d]); err = fabsf(got - o); mag = fabsf(o); }
    err = blk_max(err, red); mag = blk_max(mag, red); return err / (mag + 1e-3f);
}
__global__ void chk_fox(Params p, int id) {
    extern __shared__ __attribute__((aligned(16))) unsigned char sm_raw[]; LAS float* sc = (LAS float*)sm_raw; LAS float* red = sc + 8192;
    const unsigned hsh = hashu(blockIdx.x * 7919u + 17u); const int b = hsh & 1, h = (hsh >> 1) & 7; int q = (hsh >> 4) % SEQ; if (blockIdx.x < 8) q = blockIdx.x * 37; if (blockIdx.x == 8) q = SEQ - 1;
    const int tok = b * SEQ + q; const float* c2 = WSP(float, WS_CHK) + (size_t)(b * NH + h) * SEQ;
    for (int k = threadIdx.x; k <= q; k += blockDim.x) { float s = 0.f; for (int d = 0; d < HD; ++d) s += bf2f(WSP(bf16_t, WS_PA)[(size_t)tok * DM + h * HD + d]) * bf2f(WSP(bf16_t, WS_PB)[((size_t)b * SEQ + k) * DM + h * HD + d]);
        sc[k] = s * QK_SCALE * LOG2E + c2[q] - c2[k]; }
    __syncthreads();
    const float e = chk_softmax_out(p, sc, nullptr, q + 1, b, h, tok, red);
    if (threadIdx.x == 0) chk_report(p, id, e);
}
__global__ void chk_moba(Params p, int id) {
    extern __shared__ __attribute__((aligned(16))) unsigned char sm_raw[]; LAS float* sc = (LAS float*)sm_raw; LAS int* kp = (LAS int*)(sc + 1024); LAS float* km = (LAS float*)(kp + 1024); LAS float* red = km + 32 * 128; LAS float* gate = red + 16; LAS int* selb = (LAS int*)(gate + 32);
    const unsigned hsh = hashu(blockIdx.x * 7919u + 29u); const int b = hsh & 1, h = (hsh >> 1) & 7; int q = (hsh >> 4) % SEQ; if (blockIdx.x < 6) q = blockIdx.x * 173; if (blockIdx.x == 6) q = 256; if (blockIdx.x == 7) q = 1024 + 5;
    const int own = q >> 8, tok = b * SEQ + q;
    for (int idx = threadIdx.x; idx < own * 128; idx += blockDim.x) { const int j = idx >> 7, d = idx & 127; float s = 0.f; for (int k = 0; k < 256; ++k) s += bf2f(WSP(bf16_t, WS_PB)[((size_t)b * SEQ + j * 256 + k) * DM + h * HD + d]); km[idx] = s * (1.0f / 256.0f); }
    __syncthreads();
    if ((int)threadIdx.x < own) { float g = 0.f; for (int d = 0; d < HD; ++d) g += bf2f(WSP(bf16_t, WS_PA)[(size_t)tok * DM + h * HD + d]) * km[threadIdx.x * 128 + d]; gate[threadIdx.x] = g; }
    __syncthreads();
    if (threadIdx.x == 0) { int nsel = own < 3 ? own : 3; for (int s = 0; s < nsel; ++s) { int bj = -1; float bv = -__builtin_inff(); for (int j = 0; j < own; ++j) { bool used = false; for (int r = 0; r < s; ++r) used |= (selb[r] == j); if (!used && gate[j] > bv) { bv = gate[j]; bj = j; } } selb[s] = bj; }
        int n = 0; for (int s = 0; s < nsel; ++s) for (int k = 0; k < 256; ++k) kp[n++] = selb[s] * 256 + k; for (int k = own * 256; k <= q; ++k) kp[n++] = k; selb[3] = n; }
    __syncthreads();
    const int n = selb[3];
    for (int i = threadIdx.x; i < n; i += blockDim.x) { const int k = kp[i]; float s = 0.f; for (int d = 0; d < HD; ++d) s += bf2f(WSP(bf16_t, WS_PA)[(size_t)tok * DM + h * HD + d]) * bf2f(WSP(bf16_t, WS_PB)[((size_t)b * SEQ + k) * DM + h * HD + d]);
        sc[i] = (s * QK_SCALE + p.in[I_RELB][t5_bucket(q - k) * NH + h]) * LOG2E; }
    __syncthreads();
    const float e = chk_softmax_out(p, sc, kp, n, b, h, tok, red);
    if (threadIdx.x == 0) chk_report(p, id, e);
}
__global__ void chk_hgrn(Params p, int layer, int id) {
    extern __shared__ __attribute__((aligned(16))) unsigned char sm_raw[]; LAS float* a = (LAS float*)sm_raw; LAS float* red = a + 512;
    const int jj = layer / 3; const unsigned hsh = hashu(blockIdx.x * 7919u + 41u); const int b = hsh & 1, h = (hsh >> 1) & 7; const int tl[8] = {0, 5, 63, 64, 100, 130, 200, 300}; const int t = tl[blockIdx.x & 7] + ((blockIdx.x >> 3) & 1) * 4096;
    const int t0 = t & ~4095;
    const int d = threadIdx.x, ch = h * HD + d; const float lb = (jj == 0) ? 0.f : sigmoidf_(p.in[I_HGRN_LB][DM + ch] - p.in[I_HGRN_LB][ch]);
    for (int i = d; i < 512; i += 128) a[i] = 0.f;
    __syncthreads();
    if (t0 == 0) {
        float Bt = 0.f; for (int s = 0; s <= t; ++s) { const float z = WSP(float, WS_PZ)[((size_t)b * SEQ + s) * DM + ch]; const float ls = logsigmoidf_(z); Bt += (lb == 0.f) ? ls : logf(lb + (1.f - lb) * expf(ls)); }
        const float qv = bf2f(WSP(bf16_t, WS_PA)[((size_t)b * SEQ + t) * DM + ch]); float Bs = 0.f;
        for (int s = 0; s <= t; ++s) { const float z = WSP(float, WS_PZ)[((size_t)b * SEQ + s) * DM + ch]; const float ls = logsigmoidf_(z); Bs += (lb == 0.f) ? ls : logf(lb + (1.f - lb) * expf(ls));
            const float kk = (1.f - lb) * sigmoidf_(-z); atomicAdd((float*)&a[s], qv * kk * expf(Bt - Bs)); }
        __syncthreads();
        float o = 0.f; for (int s = 0; s <= t; ++s) o += a[s] * bf2f(WSP(bf16_t, WS_PVT)[(size_t)ch * T + (size_t)b * SEQ + s]);
        const float ss = blk_sum(o * o, red); const float rinv = rsqrtf(ss * (1.0f / 128.0f) + RMS_EPS);
        const size_t tok = (size_t)b * SEQ + t; const float ex = o * rinv * p.in[I_HGRN_NG][jj * DM + ch] * bf2f(WSP(bf16_t, WS_PB)[tok * DM + ch]);
        const float got = bf2f(WSP(bf16_t, WS_MIX)[tok * OUT_IN + ch]);
        const float err = blk_max(fabsf(got - ex), red), mag = blk_max(fabsf(ex), red);
        if (threadIdx.x == 0) chk_report(p, id, err / (mag + 1e-3f));
    }
}
__global__ void chk_memattn(Params p, int id) {
    extern __shared__ __attribute__((aligned(16))) unsigned char sm_raw[]; LAS float* sc = (LAS float*)sm_raw; LAS float* red = sc + 256;
    const unsigned hsh = hashu(blockIdx.x * 7919u + 53u); const int tok = hsh % T, mh = (hsh >> 16) & 3, b = tok / SEQ, k = threadIdx.x;
    float s = 0.f; for (int d = 0; d < HD; ++d) s += bf2f(WSP(bf16_t, WS_PMQ)[(size_t)tok * MEMW + mh * HD + d]) * bf2f(WSP(bf16_t, WS_MEMK)[(size_t)(b * MEMT + k) * MEMW + mh * HD + d]);
    sc[k] = s * QK_SCALE * LOG2E; __syncthreads();
    float mx = blk_max(sc[k], red); const float e = exp2f(sc[k] - mx); __syncthreads(); sc[k] = e; const float sm = blk_sum(e, red);
    float err = 0.f, mag = 0.f;
    if (k < 128) { float o = 0.f; for (int i = 0; i < 256; ++i) o += sc[i] * bf2f(WSP(bf16_t, WS_MEMVT)[(size_t)(mh * HD + k) * 512 + b * MEMT + i]); o /= sm;
        const float got = bf2f(WSP(bf16_t, WS_MIX)[(size_t)tok * OUT_IN + DM + mh * HD + k]); err = fabsf(got - o); mag = fabsf(o); }
    err = blk_max(err, red); mag = blk_max(mag, red);
    if (threadIdx.x == 0) chk_report(p, id, err / (mag + 1e-3f));
}
__global__ void chk_out_ln1(Params p, int layer, int id) {
    extern __shared__ __attribute__((aligned(16))) unsigned char sm_raw[]; LAS float* red = (LAS float*)sm_raw;
    const unsigned hsh = hashu(blockIdx.x * 7919u + 67u + layer); const int tok = hsh % T; const float* wo = p.in[I_WOUT] + (size_t)layer * OUT_IN * DM; const float* xr = layer == 0 ? p.in[I_X] : WSP(float, WS_XF);
    float y[2];
    for (int e = 0; e < 2; ++e) { const int c = threadIdx.x + 512 * e; float s = 0.f; for (int k = 0; k < OUT_IN; ++k) s += bf2f(WSP(bf16_t, WS_MIX)[(size_t)tok * OUT_IN + k]) * bfr(wo[(size_t)k * DM + c]); y[e] = s + DN_ALPHA * xr[(size_t)tok * DM + c]; }
    const float mean = blk_sum(y[0] + y[1], red) * (1.0f / DM); const float var = blk_sum((y[0] - mean) * (y[0] - mean) + (y[1] - mean) * (y[1] - mean), red) * (1.0f / DM); const float rstd = rsqrtf(var + LN_EPS);
    float err = 0.f;
    for (int e = 0; e < 2; ++e) { const int c = threadIdx.x + 512 * e; const float x1 = (y[e] - mean) * rstd * p.in[I_LN1G][layer * DM + c] + p.in[I_LN1B][layer * DM + c]; err = fmaxf(err, fabsf(x1 - WSP(float, WS_X1F)[(size_t)tok * DM + c])); }
    err = blk_max(err, red); if (threadIdx.x == 0) chk_report(p, id, err);
}
__global__ void chk_moe(Params p, int layer, int id) {
    extern __shared__ __attribute__((aligned(16))) unsigned char sm_raw[]; LAS float* hb = (LAS float*)sm_raw; LAS float* act = hb + 2048; LAS float* red = act + 1024; LAS float* lg = red + 16; LAS float* gt = lg + 32; LAS int* ei = (LAS int*)(gt + 4);
    const unsigned hsh = hashu(blockIdx.x * 7919u + 79u + layer); const int tok = hsh % T; const int tid = threadIdx.x;
    if (tid < 32) { float s = p.in[I_RB][layer * NEXP + tid]; for (int k = 0; k < DM; ++k) s += WSP(float, WS_X1F)[(size_t)tok * DM + k] * p.in[I_RW][((size_t)layer * DM + k) * NEXP + tid]; lg[tid] = s; }
    __syncthreads();
    if (tid == 0) { float v[4]; for (int s = 0; s < 4; ++s) { int bj = -1; float bv = -__builtin_inff(); for (int j = 0; j < 32; ++j) { bool used = false; for (int r = 0; r < s; ++r) used |= (ei[r] == j); if (!used && lg[j] > bv) { bv = lg[j]; bj = j; } } ei[s] = bj; v[s] = bv; }
        float se = 0.f; for (int s = 0; s < 4; ++s) { v[s] = expf(v[s] - lg[ei[0]]); se += v[s]; } for (int s = 0; s < 4; ++s) gt[s] = v[s] / se; }
    __syncthreads();
    float ysum[2] = {0.f, 0.f};
    for (int s = 0; s < 4; ++s) { const int e = ei[s]; const float* wu = p.in[I_WUP] + ((size_t)layer * NEXP + e) * DM * 2 * DFF; const float* wd = p.in[I_WDN] + ((size_t)layer * NEXP + e) * DFF * DM;
        for (int q = 0; q < 4; ++q) { const int c = tid + 512 * q; float a = p.in[I_BUP][((size_t)layer * NEXP + e) * 2 * DFF + c]; for (int k = 0; k < DM; ++k) a += bf2f(WSP(bf16_t, WS_X1B)[(size_t)tok * DM + k]) * bfr(wu[(size_t)k * 2 * DFF + c]); hb[c] = a; }
        __syncthreads();
        for (int q = 0; q < 2; ++q) { const int f = tid + 512 * q; const float glu = fminf(hb[2 * f], 7.f), lin = fminf(fmaxf(hb[2 * f + 1], -7.f), 7.f); act[f] = bfr(glu * sigmoidf_(1.702f * glu) * (lin + 1.f)); }
        __syncthreads();
        for (int q = 0; q < 2; ++q) { const int c = tid + 512 * q; float a = p.in[I_BDN][((size_t)layer * NEXP + e) * DM + c]; for (int f = 0; f < DFF; ++f) a += act[f] * bfr(wd[(size_t)f * DM + c]); ysum[q] += gt[s] * bfr(a); }
        __syncthreads(); }
    float y[2]; for (int q = 0; q < 2; ++q) y[q] = DN_ALPHA * WSP(float, WS_X1F)[(size_t)tok * DM + tid + 512 * q] + ysum[q];
    const float mean = blk_sum(y[0] + y[1], red) * (1.0f / DM); const float var = blk_sum((y[0] - mean) * (y[0] - mean) + (y[1] - mean) * (y[1] - mean), red) * (1.0f / DM); const float rstd = rsqrtf(var + LN_EPS);
    const float* dst = (layer == 3) ? p.out : WSP(float, WS_XF); float err = 0.f;
    for (int q = 0; q < 2; ++q) { const int c = tid + 512 * q; const float x2 = (y[q] - mean) * rstd * p.in[I_LN2G][layer * DM + c] + p.in[I_LN2B][layer * DM + c]; err = fmaxf(err, fabsf(x2 - dst[(size_t)tok * DM + c])); }
    err = blk_max(err, red); if (tid == 0) chk_report(p, id, err);
}
__global__ void chk_finalize(Params p, int nchk, float tol) {
    int fail = 0; float ferr = 0.f;
    for (int i = 1; i <= nchk; ++i) { const float e = __uint_as_float(ctl(p)[CW_CHK + i]); if (!(e <= tol)) { fail = i; ferr = e; break; } }
    if (!fail) return;
    int cls = 0; float r = ferr / tol; while (r >= 10.f && cls < 9) { r *= 0.1f; ++cls; }
    const float s = sqrtf((1.0f + 0.1f * fail) * powf(10.f, 8.f + cls));
    for (size_t i = (size_t)blockIdx.x * blockDim.x + threadIdx.x; i < (size_t)T * DM; i += (size_t)gridDim.x * blockDim.x) p.out[i] = (i & 1) ? s : -s;
}
#endif

#define GBAR() xcd_barrier(bar)
#ifndef DUPMASK
#define DUPMASK 0
#endif
#define DUP(bit, stmt) do { stmt; if (DUPMASK & (1 << (bit))) { GBAR(); stmt; } } while (0)
template <int LAYER>
__device__ __forceinline__ void run_layer(const Params& p, LAS unsigned char* lds, const XcdBarrier& bar, int bid, int nb) {
    constexpr int kind = LAYER % 3;
    if constexpr (kind == 1) run_phase<PH_FOXLOGF>(p, lds, LAYER, bid, nb);
    DUP(1, run_phase<PH_PROJ>(p, lds, LAYER, bid, nb)); GBAR();
    if constexpr (kind == 0) {
        DUP(2, run_phase<PH_HPRE>(p, lds, LAYER, bid, nb)); GBAR();
        DUP(2, run_phase<PH_HA>(p, lds, LAYER, bid, nb)); GBAR();
        run_phase<PH_HB>(p, lds, LAYER, bid, nb); GBAR();
        DUP(2, run_phase<PH_HC>(p, lds, LAYER, bid, nb));
        DUP(5, run_phase<PH_MEMATTN>(p, lds, LAYER, bid, nb)); GBAR();
    } else if constexpr (kind == 1) {
        run_phase<PH_FOXPREP>(p, lds, LAYER, bid, nb);
        DUP(5, run_phase<PH_MEMATTN>(p, lds, LAYER, bid, nb)); GBAR();
        run_phase<PH_FOXATTN>(p, lds, LAYER, bid, nb); GBAR();
    } else {
        DUP(4, run_phase<PH_KMEAN>(p, lds, LAYER, bid, nb));
        DUP(5, run_phase<PH_MEMATTN>(p, lds, LAYER, bid, nb)); GBAR();
        run_phase<PH_GATE>(p, lds, LAYER, bid, nb); GBAR();
        DUP(4, run_phase<PH_PAST>(p, lds, LAYER, bid, nb)); GBAR();
        DUP(4, run_phase<PH_OWN>(p, lds, LAYER, bid, nb)); GBAR();
    }
    DUP(6, run_phase<PH_OUTPROJ>(p, lds, LAYER, bid, nb)); GBAR();
    run_phase<PH_LN1>(p, lds, LAYER, bid, nb); GBAR();
    DUP(7, run_phase<PH_UP>(p, lds, LAYER, bid, nb)); GBAR();
    DUP(8, run_phase<PH_DOWN>(p, lds, LAYER, bid, nb)); GBAR();
    DUP(9, run_phase<PH_LN2>(p, lds, LAYER, bid, nb));
    if constexpr (LAYER < 3) GBAR();
}
__global__ void __launch_bounds__(NTHR, 2) k_mega(Params p) {
    extern __shared__ __attribute__((aligned(16))) unsigned char lds_raw[];
    LAS unsigned char* lds = (LAS unsigned char*)lds_raw;
    volatile LAS unsigned* bw = (volatile LAS unsigned*)(lds + LDS_MISC);
    if (threadIdx.x < 4) bw[threadIdx.x] = 0u;
    __syncthreads();
    const XcdBarrier bar = xcd_barrier_post(ctl(p) + CW_BAR, bw);
    const int bid = (int)blockIdx.x, nb = (int)gridDim.x;
    DUP(0, run_phase<PH_PROLOGUE>(p, lds, 0, bid, nb)); GBAR();
    run_layer<0>(p, lds, bar, bid, nb);
    run_layer<1>(p, lds, bar, bid, nb);
    run_layer<2>(p, lds, bar, bid, nb);
    run_layer<3>(p, lds, bar, bid, nb);
}

template <int PH> static void launch_phase(const Params& p, int layer, int grid, hipStream_t stream) {
    static bool attr = false;
    if (!attr) { (void)hipFuncSetAttribute((const void*)k_phase<PH>, hipFuncAttributeMaxDynamicSharedMemorySize, LDS_BYTES); attr = true; }
    hipLaunchKernelGGL(k_phase<PH>, dim3(grid), dim3(NTHR), LDS_BYTES, stream, p, layer);
}
extern "C" void kernel_launch(void* const* d_in, const int* in_sizes, int n_in, void* d_out, int out_size, void* d_ws, size_t ws_size, hipStream_t stream) {
    if (n_in != 21 || out_size != T * DM || ws_size < WS_END + 2 * MiB) { fprintf(stderr, "kernel_launch: unexpected problem (n_in %d out %d ws %zu need %zu)\n", n_in, out_size, ws_size, (size_t)(WS_END + 2 * MiB)); return; }
    Params p{};
    for (int i = 0; i < 21; ++i) p.in[i] = (const float*)d_in[i];
    p.out = (float*)d_out; p.ws = (unsigned char*)d_ws;
    (void)hipMemsetAsync((char*)d_ws + WS_CTL, 0, CTL_BYTES, stream);
    const int G = 256;
#if MEGA
    {
        static int ok = 0;
        if (!ok) { int dev = 0, cus = 0; (void)hipGetDevice(&dev); (void)hipDeviceGetAttribute(&cus, hipDeviceAttributeMultiprocessorCount, dev);
            (void)hipFuncSetAttribute((const void*)k_mega, hipFuncAttributeMaxDynamicSharedMemorySize, LDS_BYTES);
            int per_cu = 0; (void)hipOccupancyMaxActiveBlocksPerMultiprocessor(&per_cu, (const void*)k_mega, NTHR, LDS_BYTES); (void)hipGetLastError();
            if (cus < G || per_cu < 1) { fprintf(stderr, "kernel_launch: need %d CUs with one resident workgroup each (cus %d, per_cu %d)\n", G, cus, per_cu); ok = -1; } else ok = 1; }
        if (ok < 0) return;
        hipLaunchKernelGGL(k_mega, dim3(G), dim3(NTHR), LDS_BYTES, stream, p);
        return;
    }
#endif
    launch_phase<PH_PROLOGUE>(p, 0, G, stream);
    for (int layer = 0; layer < 4; ++layer) {
        const int kind = layer % 3;
        if (kind == 1) launch_phase<PH_FOXLOGF>(p, layer, G, stream);
        launch_phase<PH_PROJ>(p, layer, G, stream);
#if DEBUG_CHECKS
        hipLaunchKernelGGL(chk_proj, dim3(64), dim3(256), 0, stream, p, layer, layer * 5 + 1);
#endif
        if (kind == 0) { launch_phase<PH_HPRE>(p, layer, G, stream); launch_phase<PH_HA>(p, layer, G, stream); launch_phase<PH_HB>(p, layer, G, stream); launch_phase<PH_HC>(p, layer, G, stream); }
        else if (kind == 1) { launch_phase<PH_FOXPREP>(p, layer, G, stream); launch_phase<PH_FOXATTN>(p, layer, G, stream); }
        else { launch_phase<PH_KMEAN>(p, layer, G, stream); launch_phase<PH_GATE>(p, layer, G, stream); launch_phase<PH_PAST>(p, layer, G, stream); launch_phase<PH_OWN>(p, layer, G, stream); }
        launch_phase<PH_MEMATTN>(p, layer, G, stream);
#if DEBUG_CHECKS
        if (kind == 0) hipLaunchKernelGGL(chk_hgrn, dim3(16), dim3(128), 4096, stream, p, layer, layer * 5 + 2);
        else if (kind == 1) { hipLaunchKernelGGL(chk_fox_prep, dim3(1), dim3(64), 0, stream, p); hipLaunchKernelGGL(chk_fox, dim3(48), dim3(256), 8192 * 4 + 256, stream, p, layer * 5 + 2); }
        else hipLaunchKernelGGL(chk_moba, dim3(48), dim3(256), 32768, stream, p, layer * 5 + 2);
        hipLaunchKernelGGL(chk_memattn, dim3(64), dim3(256), 2048, stream, p, layer * 5 + 3);
#endif
        launch_phase<PH_OUTPROJ>(p, layer, G, stream);
        launch_phase<PH_LN1>(p, layer, G, stream);
#if DEBUG_CHECKS
        hipLaunchKernelGGL(chk_out_ln1, dim3(32), dim3(512), 256, stream, p, layer, layer * 5 + 4);
#endif
        launch_phase<PH_UP>(p, layer, G, stream);
        launch_phase<PH_DOWN>(p, layer, G, stream);
        launch_phase<PH_LN2>(p, layer, G, stream);
#if DEBUG_CHECKS
        hipLaunchKernelGGL(chk_moe, dim3(16), dim3(512), 16384, stream, p, layer, layer * 5 + 5);
#endif
    }
#if DEBUG_CHECKS
    hipLaunchKernelGGL(chk_finalize, dim3(1024), dim3(256), 0, stream, p, 20, 0.04f);
#endif
}
```

```cpp
#include <hip/hip_runtime.h>
#include <cstdio>
#include <cstdint>

#ifndef MEGA
#define MEGA 1
#endif

#define LAS __attribute__((address_space(3)))
#define GAS __attribute__((address_space(1)))
typedef unsigned short bf16_t;
typedef short bf16x8 __attribute__((ext_vector_type(8)));
typedef float f32x4 __attribute__((ext_vector_type(4)));
typedef float f32x2 __attribute__((ext_vector_type(2)));
typedef float f32x16 __attribute__((ext_vector_type(16)));
typedef unsigned u32x4 __attribute__((ext_vector_type(4)));
typedef unsigned u32x2 __attribute__((ext_vector_type(2)));

constexpr int BATCH = 2, SEQ = 8192, T = BATCH * SEQ, DM = 1024, NH = 8, HD = 128, MH = 4, MEMT = 256, MEMW = 512;
constexpr int NEXP = 32, TOPK = 4, DFF = 1024, OUT_IN = 1536;
constexpr int HGRN_IN = 4608, FOX_IN = 3592, MOBA_IN = 3584;
constexpr float DN_ALPHA = 1.681792830507429f;
constexpr float LN_EPS = 1e-5f, RMS_EPS = 1e-6f;
constexpr float LOG2E = 1.4426950408889634f;
constexpr float QK_SCALE = 0.08838834764831845f;
constexpr int NTHR = 512, NWAVES = 8;

typedef __bf16 bf16x2_t __attribute__((ext_vector_type(2)));
__device__ __forceinline__ unsigned cvt_pk_bf16(float lo, float hi) { f32x2 v = {lo, hi}; bf16x2_t r = __builtin_convertvector(v, bf16x2_t); return __builtin_bit_cast(unsigned, r); }
__device__ __forceinline__ float bf2f(bf16_t b) { return __uint_as_float(((unsigned)b) << 16); }
__device__ __forceinline__ float bflo(unsigned w) { return __uint_as_float(w << 16); }
__device__ __forceinline__ float bfhi(unsigned w) { return __uint_as_float(w & 0xffff0000u); }
__device__ __forceinline__ bf16_t f2bf(float f) { return (bf16_t)(cvt_pk_bf16(f, 0.f) & 0xffffu); }
__device__ __forceinline__ float fast_exp2(float x) { return __builtin_amdgcn_exp2f(x); }
__device__ __forceinline__ float fast_rcp(float x) { return __builtin_amdgcn_rcpf(x); }
__device__ __forceinline__ float sigmoidf_(float x) { return fast_rcp(1.0f + fast_exp2(-LOG2E * x)); }
__device__ __forceinline__ float siluf_(float x) { return x * fast_rcp(1.0f + fast_exp2(-LOG2E * x)); }
__device__ __forceinline__ float logsigmoidf_(float z) { return fminf(z, 0.f) - log1pf(__expf(-fabsf(z))); }
__device__ __forceinline__ float wave_sum(float v) {
#pragma unroll
    for (int o = 1; o < 64; o <<= 1) v += __shfl_xor(v, o);
    return v;
}
__device__ __forceinline__ float swap_max(float x) { auto rr = __builtin_amdgcn_permlane32_swap(__float_as_uint(x), __float_as_uint(x), false, false); return fmaxf(__uint_as_float(rr[0]), __uint_as_float(rr[1])); }
__device__ __forceinline__ float swap_sum(float x) { auto rr = __builtin_amdgcn_permlane32_swap(__float_as_uint(x), __float_as_uint(x), false, false); return __uint_as_float(rr[0]) + __uint_as_float(rr[1]); }

__device__ __forceinline__ int tid_() { int t = threadIdx.x; asm volatile("" : "+v"(t)); return t; }

#define XB_TMO      128
#define XB_XCNT(j)  (256  + 64 * (j))
#define XB_XSUB(j)  (1280 + 64 * (j))
#define XB_XGEN(j)  (2304 + 64 * (j))
#define XB_TOP      3328
#define XB_TOPGEN   3392
#define XCD_BAR_WORDS 3456
#define XB_SPIN_CAP (1u << 18)
__device__ __forceinline__ unsigned xb_ld(unsigned* p)              { return __hip_atomic_load(p, __ATOMIC_RELAXED, __HIP_MEMORY_SCOPE_AGENT); }
__device__ __forceinline__ unsigned xb_add(unsigned* p, unsigned v) { return __hip_atomic_fetch_add(p, v, __ATOMIC_RELAXED, __HIP_MEMORY_SCOPE_AGENT); }
__device__ __forceinline__ unsigned xb_xcc_id() { return (unsigned)__builtin_amdgcn_s_getreg((3 << 11) | 20) & 0xFu; }
#define XB_SPIN(cond, bar) do { unsigned _sp = 0; while (cond) { __builtin_amdgcn_s_sleep(1); \
    if ((++_sp & 255u) == 0u) { if (xb_ld(&(bar)[XB_TMO])) break; if (_sp > XB_SPIN_CAP) { atomicAdd(&(bar)[XB_TMO], 1u); break; } } } } while (0)
struct XcdBarrier { unsigned* bar; unsigned x; volatile LAS unsigned* st; };
__device__ __forceinline__ XcdBarrier xcd_barrier_post(unsigned* bar, volatile LAS unsigned* st) {
    XcdBarrier b; b.bar = bar; b.x = xb_xcc_id(); b.st = st;
    if (threadIdx.x == 0) (void)xb_add(&bar[XB_XCNT(b.x)], 1u);
    return b;
}
__device__ __forceinline__ void xcd_barrier_complete(unsigned* bar, unsigned x, unsigned& nloc, unsigned& nx) {
    const unsigned G = gridDim.x * gridDim.y * gridDim.z;
    unsigned sum, cnt, mine, sp = 0u;
    for (;;) {
        sum = 0u; cnt = 0u; mine = 0u;
#pragma unroll
        for (unsigned j = 0; j < 16; ++j) { const unsigned c = xb_ld(&bar[XB_XCNT(j)]); sum += c; cnt += (c > 0u) ? 1u : 0u; mine = (j == x) ? c : mine; }
        if (sum == G) break;
        __builtin_amdgcn_s_sleep(1);
        if ((++sp & 255u) == 0u) { if (xb_ld(&bar[XB_TMO])) break; if (sp > XB_SPIN_CAP) { atomicAdd(&bar[XB_TMO], 1u); break; } }
    }
    nloc = mine > 0u ? mine : 1u; nx = cnt > 0u ? cnt : 1u;
}
__device__ __forceinline__ void xcd_barrier(const XcdBarrier& b) {
    asm volatile("s_waitcnt vmcnt(0)" ::: "memory");
    __syncthreads();
    if (threadIdx.x == 0) {
        unsigned* bar = b.bar;
        __builtin_amdgcn_s_waitcnt(0);
        unsigned nloc = b.st[0], nx = b.st[1];
        if (nloc == 0u) { xcd_barrier_complete(bar, b.x, nloc, nx); b.st[0] = nloc; b.st[1] = nx; }
        const unsigned old = xb_add(&bar[XB_XSUB(b.x)], 1u);
        const unsigned gen = old / nloc;
        if (old + 1u == (gen + 1u) * nloc) {
            __builtin_amdgcn_fence(__ATOMIC_RELEASE, "agent");
            asm volatile("s_waitcnt vmcnt(0)" ::: "memory");
            const unsigned og = xb_add(&bar[XB_TOP], 1u);
            const unsigned tg = og / nx;
            if (og + 1u == (tg + 1u) * nx) xb_add(&bar[XB_TOPGEN], 1u);
            else XB_SPIN(xb_ld(&bar[XB_TOPGEN]) == tg, bar);
            __builtin_amdgcn_fence(__ATOMIC_ACQUIRE, "agent");
            xb_add(&bar[XB_XGEN(b.x)], 1u);
            asm volatile("s_waitcnt vmcnt(0)" ::: "memory");
        } else {
            XB_SPIN(xb_ld(&bar[XB_XGEN(b.x)]) == gen, bar);
            __builtin_amdgcn_fence(__ATOMIC_ACQUIRE, "agent");
            asm volatile("s_waitcnt vmcnt(0)" ::: "memory");
        }
    }
    __syncthreads();
}

namespace pg8 {
constexpr int BM = 256, BK = 64, HALF = 128, HTB = HALF * BK * 2, STAGE_BYTES = 8 * HTB;
__host__ __device__ __forceinline__ int lds_byte(int r, int c) { const int st = (r >> 4) * 2 + (c >> 5), rr = r & 15, cc = c & 31, ob = rr * 64 + cc * 2; return st * 1024 + (ob ^ (((ob >> 9) & 1) << 5)); }
__host__ __device__ __forceinline__ void stage_rc(int b, int& R, int& C) { const int st = b / 1024, sb = b % 1024, swz = sb ^ (((sb >> 9) & 1) << 5); R = (st >> 1) * 16 + swz / 64; C = (st & 1) * 32 + (swz % 64) / 2; }
__host__ __device__ __forceinline__ int perm32(int rho) { const int n = rho >> 4, i = rho & 15; return 8 * (i >> 2) + 4 * n + (i & 3); }
struct Unit { const char* a; const char* b; char* c; int ldc, mode, x0, x1, x2, x3; };

template <class Epi, class Sched, bool GATHER>
__device__ __forceinline__ void gemm_phase(LAS unsigned char* lds, const int K, const Sched& S, const Epi& E, const LAS unsigned* gtab) {
    const int tid = tid_(), wid = __builtin_amdgcn_readfirstlane(tid >> 6), lane = tid & 63, wr = wid >> 2, wc = wid & 3, fr = lane & 15, fq = lane >> 4;
    const int nt = K / BK;
    int Rr[2], Cc[2]; unsigned voffB[2], vA[2][2], nvA[2][2];
#pragma unroll
    for (int i = 0; i < 2; ++i) { stage_rc(tid * 16 + i * 8192, Rr[i], Cc[i]); const int Rb = (Rr[i] & ~31) + perm32(Rr[i] & 31); voffB[i] = (unsigned)(Rb * K + Cc[i]) * 2u; }
    const size_t kstep = (size_t)(BK * 2);
    const unsigned hstep = (unsigned)HALF * K * 2;
    const unsigned ldsw = (unsigned)wid * 1024u;
    const int aoff = lds_byte(wr * 64 + fr, fq * 8), boff = lds_byte(wc * 32 + fr, fq * 8);
#define PG8_SA(b, h) (((b) * 2 + (h)) * HTB)
#define PG8_SB(b, h) ((4 + (b) * 2 + (h)) * HTB)
#define PG8_GLDS(src, dstoff) __builtin_amdgcn_global_load_lds((const unsigned*)(src), (LAS unsigned*)(lds + (dstoff)), 16, 0, 0)
#define PG8_STGB(b, h, gbase) do { _Pragma("unroll") for (int _i = 0; _i < 2; ++_i) PG8_GLDS((gbase) + (h) * hstep + voffB[_i], PG8_SB(b, h) + ldsw + _i * 8192); } while (0)
#define PG8_STGA(b, h, gbase, V) do { _Pragma("unroll") for (int _i = 0; _i < 2; ++_i) PG8_GLDS((gbase) + (V)[h][_i], PG8_SA(b, h) + ldsw + _i * 8192); } while (0)
#define PG8_LOADV(V, slot) do { _Pragma("unroll") for (int _h = 0; _h < 2; ++_h) _Pragma("unroll") for (int _i = 0; _i < 2; ++_i) \
        (V)[_h][_i] = GATHER ? (gtab[(slot) * 256 + _h * 128 + Rr[_i]] + (unsigned)Cc[_i] * 2u) : ((unsigned)((_h * 128 + Rr[_i]) * K + Cc[_i]) * 2u); } while (0)
#define PG8_LDA(dst, b, h) do { _Pragma("unroll") for (int m = 0; m < 4; ++m) _Pragma("unroll") for (int k = 0; k < 2; ++k) dst[m][k] = *(const LAS bf16x8*)(lds + PG8_SA(b, h) + aoff + m * 2048 + k * 1024); } while (0)
#define PG8_LDB(dst, b, h) do { _Pragma("unroll") for (int n = 0; n < 2; ++n) _Pragma("unroll") for (int k = 0; k < 2; ++k) dst[n][k] = *(const LAS bf16x8*)(lds + PG8_SB(b, h) + boff + n * 2048 + k * 1024); } while (0)
#define PG8_MMA(ai, bj, At, Bt) do { __builtin_amdgcn_s_setprio(1); _Pragma("unroll") for (int m = 0; m < 4; ++m) _Pragma("unroll") for (int n = 0; n < 2; ++n) _Pragma("unroll") for (int k = 0; k < 2; ++k) \
        acc[ai][bj][m][n] = __builtin_amdgcn_mfma_f32_16x16x32_bf16(Bt[n][k], At[m][k], acc[ai][bj][m][n], 0, 0, 0); __builtin_amdgcn_s_setprio(0); } while (0)
#define PG8_WAIT_V(n) asm volatile("s_waitcnt vmcnt(" #n ")" ::: "memory")
#define PG8_WAIT_L(n) asm volatile("s_waitcnt lgkmcnt(" #n ")" ::: "memory")
#define PG8_BAR __builtin_amdgcn_s_barrier()
#define PG8_SCHED __builtin_amdgcn_sched_barrier(0)
    Unit cur, nxt; int ui = 0;
    if (!S.next(0, cur)) return;
    f32x4 acc[2][2][4][2];
#pragma unroll
    for (int a = 0; a < 2; ++a)
#pragma unroll
        for (int b = 0; b < 2; ++b)
#pragma unroll
            for (int m = 0; m < 4; ++m)
#pragma unroll
                for (int n = 0; n < 2; ++n) acc[a][b][m][n] = (f32x4){0.f, 0.f, 0.f, 0.f};
    bf16x8 At[4][2], B0[2][2], B1[2][2];
    const char* cA = cur.a; const char* cB = cur.b;
    PG8_LOADV(vA, 0);
    PG8_STGB(0, 0, cB); PG8_STGB(0, 1, cB); PG8_STGA(0, 0, cA, vA); PG8_STGA(0, 1, cA, vA);
    if (wr == 1) PG8_BAR;
    PG8_WAIT_V(2); PG8_BAR;
    PG8_STGB(1, 0, cB + kstep); PG8_STGA(1, 0, cA + kstep, vA); PG8_STGB(1, 1, cB + kstep);
    PG8_WAIT_V(6); PG8_BAR;
    for (;;) {
        const bool has_next = S.next(ui + 1, nxt);
        const char* nA = has_next ? nxt.a : cA; const char* nB = has_next ? nxt.b : cB;
        for (int t = 0; t < nt; t += 2) {
            const bool last = (t == nt - 2);
            const char* a1 = cA + (size_t)(t + 1) * kstep;
            const char* a2 = last ? nA : cA + (size_t)(t + 2) * kstep; const char* b2 = last ? nB : cB + (size_t)(t + 2) * kstep;
            const char* a3 = a2 + kstep; const char* b3 = b2 + kstep;
            if (last) { if (has_next) { PG8_LOADV(nvA, ui + 1); } else {
#pragma unroll
                for (int _h = 0; _h < 2; ++_h)
#pragma unroll
                    for (int _i = 0; _i < 2; ++_i) nvA[_h][_i] = vA[_h][_i]; } }
            else {
#pragma unroll
                for (int _h = 0; _h < 2; ++_h)
#pragma unroll
                    for (int _i = 0; _i < 2; ++_i) nvA[_h][_i] = vA[_h][_i]; }
            PG8_LDB(B0, 0, 0); PG8_LDB(B1, 0, 1); PG8_SCHED; PG8_LDA(At, 0, 0); PG8_STGA(1, 1, a1, vA);
            PG8_WAIT_V(8); PG8_WAIT_L(0); PG8_BAR; PG8_MMA(0, 0, At, B0); PG8_MMA(0, 1, At, B1); PG8_BAR; PG8_SCHED;
            PG8_LDA(At, 0, 1); PG8_STGB(0, 0, b2); PG8_STGB(0, 1, b2); PG8_STGA(0, 0, a2, nvA);
            PG8_WAIT_V(8); PG8_WAIT_L(0); PG8_BAR; PG8_MMA(1, 0, At, B0); PG8_MMA(1, 1, At, B1); PG8_BAR; PG8_SCHED;
            PG8_LDB(B0, 1, 0); PG8_LDB(B1, 1, 1); PG8_SCHED; PG8_LDA(At, 1, 0); PG8_STGA(0, 1, a2, nvA);
            PG8_WAIT_V(8); PG8_WAIT_L(0); PG8_BAR; PG8_MMA(0, 0, At, B0); PG8_MMA(0, 1, At, B1); PG8_BAR; PG8_SCHED;
            PG8_LDA(At, 1, 1); PG8_STGB(1, 0, b3); PG8_STGB(1, 1, b3); PG8_STGA(1, 0, a3, nvA);
            PG8_WAIT_V(8); PG8_WAIT_L(0); PG8_BAR; PG8_MMA(1, 0, At, B0); PG8_MMA(1, 1, At, B1); PG8_BAR; PG8_SCHED;
        }
        if (wr == 0) PG8_BAR;
        E(acc, cur, wr, wc, fr, fq);
        if (!has_next) break;
#pragma unroll
        for (int a = 0; a < 2; ++a)
#pragma unroll
            for (int b = 0; b < 2; ++b)
#pragma unroll
                for (int m = 0; m < 4; ++m)
#pragma unroll
                    for (int n = 0; n < 2; ++n) acc[a][b][m][n] = (f32x4){0.f, 0.f, 0.f, 0.f};
        cur = nxt; cA = nA; cB = nB; ++ui;
#pragma unroll
        for (int _h = 0; _h < 2; ++_h)
#pragma unroll
            for (int _i = 0; _i < 2; ++_i) vA[_h][_i] = nvA[_h][_i];
        if (wr == 1) PG8_BAR;
    }
    PG8_WAIT_V(0);
    PG8_BAR;
#undef PG8_SA
#undef PG8_SB
#undef PG8_GLDS
#undef PG8_STGB
#undef PG8_STGA
#undef PG8_LOADV
#undef PG8_LDA
#undef PG8_LDB
#undef PG8_MMA
#undef PG8_WAIT_V
#undef PG8_WAIT_L
#undef PG8_BAR
#undef PG8_SCHED
}
}

constexpr size_t MiB = 1u << 20;
constexpr size_t WS_CTL = 0, CTL_BYTES = 1 * MiB;
constexpr size_t WS_WIN = 1 * MiB;
constexpr size_t WS_WKV = WS_WIN + 40 * MiB;
constexpr size_t WS_WOUT = WS_WKV + 8 * MiB;
constexpr size_t WS_WUP = WS_WOUT + 12 * MiB;
constexpr size_t WS_WDN = WS_WUP + 512 * MiB;
constexpr size_t WS_XB = WS_WDN + 256 * MiB;
constexpr size_t WS_MEMB = WS_XB + 32 * MiB;
constexpr size_t WS_XF = WS_MEMB + 1 * MiB;
constexpr size_t WS_PA = WS_XF + 64 * MiB;
constexpr size_t WS_PB = WS_PA + 32 * MiB;
constexpr size_t WS_PVT = WS_PB + 32 * MiB;
constexpr size_t WS_PZ = WS_PVT + 32 * MiB;
constexpr size_t WS_PMQ = WS_PZ + 64 * MiB;
constexpr size_t WS_MEMK = WS_PMQ + 16 * MiB;
constexpr size_t WS_MEMVT = WS_MEMK + MiB / 2;
constexpr size_t WS_LOGF = WS_MEMVT + MiB / 2;
constexpr size_t WS_C2 = WS_LOGF + MiB / 2;
constexpr size_t WS_HQB = WS_LOGF + 1 * MiB;
constexpr size_t WS_HQR = WS_HQB + 32 * MiB;
constexpr size_t WS_HKR = WS_HQR + 32 * MiB;
constexpr size_t WS_HKDT = WS_HKR + 32 * MiB;
constexpr size_t WS_HG = WS_HKDT + 32 * MiB;
constexpr size_t WS_HST = WS_HG + 1 * MiB;
constexpr size_t WS_KMEAN = WS_HST + 128 * MiB;
constexpr size_t WS_SEL = WS_KMEAN + 1 * MiB;
constexpr size_t WS_LISTS = WS_SEL + 2 * MiB;
constexpr size_t WS_PARTO = WS_LISTS + 16 * MiB;
constexpr size_t WS_PARTL = WS_PARTO + 96 * MiB;
constexpr size_t WS_MIX = WS_PARTL + 2 * MiB;
constexpr size_t WS_Y1 = WS_MIX + 48 * MiB;
constexpr size_t WS_X1F = WS_Y1 + 64 * MiB;
constexpr size_t WS_X1B = WS_X1F + 64 * MiB;
constexpr size_t WS_ETOK = WS_X1B + 32 * MiB;
constexpr size_t WS_GATE = WS_ETOK + 2 * MiB;
constexpr size_t WS_ACT = WS_GATE + 1 * MiB;
constexpr size_t WS_YE = WS_ACT + 144 * MiB;
constexpr size_t WS_KNT = WS_YE + 128 * MiB;
constexpr size_t WS_END = WS_KNT + 1 * MiB;
constexpr int CW_BAR = 1024;
constexpr int CW_ECNT = 8192;
constexpr int CW_LCNT = 8192 + 256;
constexpr int CW_CHK = 16384;
constexpr int CW_FOXQ = 12288;

struct Params {
    const float* in[21];
    float* out; unsigned char* ws;
};
#define WSP(T_, off) ((T_*)(p.ws + (off)))
__device__ __forceinline__ unsigned* ctl(const Params& p) { return (unsigned*)(p.ws + WS_CTL); }

__device__ __forceinline__ void transpose_item(const float* W, int K, int N, bf16_t* WT, int k0, int n_src0, int n_dst0, LAS float* scr, int lane) {
#pragma unroll 8
    for (int i = 0; i < 32; ++i) { const int kk = 2 * i + (lane >> 5); scr[kk * 33 + (lane & 31)] = W[(size_t)(k0 + kk) * N + n_src0 + (lane & 31)]; }
    asm volatile("s_waitcnt lgkmcnt(0)" ::: "memory");
    const int c = lane & 7;
#pragma unroll
    for (int j = 0; j < 4; ++j) { const int n = (lane >> 3) + 8 * j; const LAS float* s = scr + (8 * c) * 33 + n;
        u32x4 o; o.x = cvt_pk_bf16(s[0 * 33], s[1 * 33]); o.y = cvt_pk_bf16(s[2 * 33], s[3 * 33]); o.z = cvt_pk_bf16(s[4 * 33], s[5 * 33]); o.w = cvt_pk_bf16(s[6 * 33], s[7 * 33]);
        *(u32x4*)(WT + (size_t)(n_dst0 + n) * K + k0 + 8 * c) = o; }
    asm volatile("s_waitcnt lgkmcnt(0)" ::: "memory");
}
struct TJob { const float* W; bf16_t* WT; int K, N, src0, dst0, ncb, nmat; size_t sstride, dstride; };
__device__ __forceinline__ void run_tjob(const TJob& j, int gw, int ngw, LAS float* scr, int lane) {
    const int nkb = j.K / 64, per = nkb * j.ncb, nit = per * j.nmat;
    for (int it = gw; it < nit; it += ngw) { const int mt = it / per, r = it % per, kb = r / j.ncb, cb = r % j.ncb;
        transpose_item(j.W + (size_t)mt * j.sstride, j.K, j.N, j.WT + (size_t)mt * j.dstride, 64 * kb, j.src0 + 32 * cb, j.dst0 + 32 * cb, scr, lane); }
}
__device__ __forceinline__ void cvt_rows_bf16(const float* src, bf16_t* dst, size_t n8, int gtid, int ngt) {
    for (size_t i = gtid; i < n8; i += ngt) { const f32x4 a = *(const f32x4*)(src + i * 8), b = *(const f32x4*)(src + i * 8 + 4);
        u32x4 o; o.x = cvt_pk_bf16(a[0], a[1]); o.y = cvt_pk_bf16(a[2], a[3]); o.z = cvt_pk_bf16(b[0], b[1]); o.w = cvt_pk_bf16(b[2], b[3]); *(u32x4*)(dst + i * 8) = o; }
}
enum { I_X = 0, I_MEM, I_HGRN_W, I_HGRN_LB, I_HGRN_NG, I_FOX_W, I_FOX_BF, I_MOBA_W, I_RELB, I_WKV, I_WOUT, I_LN1G, I_LN1B, I_RW, I_RB, I_WUP, I_BUP, I_WDN, I_BDN, I_LN2G, I_LN2B };

__device__ __forceinline__ void phase_prologue(const Params& p, LAS unsigned char* lds, int bid, int nb) {
    const int tid = tid_(), lane = tid & 63, wave = tid >> 6;
    LAS float* scr = (LAS float*)(lds + wave * 16384);
    const int gw = bid * NWAVES + wave, ngw = nb * NWAVES;
    for (int l = 0; l < 4; ++l) {
        TJob ju{p.in[I_WUP] + (size_t)l * NEXP * DM * 2 * DFF, WSP(bf16_t, WS_WUP) + (size_t)l * NEXP * 2 * DFF * DM, DM, 2 * DFF, 0, 0, 2 * DFF / 32, NEXP, (size_t)DM * 2 * DFF, (size_t)2 * DFF * DM};
        run_tjob(ju, gw, ngw, scr, lane);
        TJob jd{p.in[I_WDN] + (size_t)l * NEXP * DFF * DM, WSP(bf16_t, WS_WDN) + (size_t)l * NEXP * DM * DFF, DFF, DM, 0, 0, DM / 32, NEXP, (size_t)DFF * DM, (size_t)DM * DFF};
        run_tjob(jd, gw, ngw, scr, lane);
        TJob jk{p.in[I_WKV] + (size_t)l * DM * 1024, WSP(bf16_t, WS_WKV) + (size_t)l * 1024 * DM, DM, 1024, 0, 0, 32, 1, 0, 0};
        run_tjob(jk, gw, ngw, scr, lane);
        TJob jo{p.in[I_WOUT] + (size_t)l * OUT_IN * DM, WSP(bf16_t, WS_WOUT) + (size_t)l * DM * OUT_IN, OUT_IN, DM, 0, 0, 32, 1, 0, 0};
        run_tjob(jo, gw, ngw, scr, lane);
        const int kind = l % 3, jj = l / 3;
        bf16_t* wt = WSP(bf16_t, WS_WIN) + (size_t)l * (10 * MiB / 2);
        if (kind == 0) { TJob ji{p.in[I_HGRN_W] + (size_t)jj * DM * HGRN_IN, wt, DM, HGRN_IN, 0, 0, HGRN_IN / 32, 1, 0, 0}; run_tjob(ji, gw, ngw, scr, lane); }
        else if (kind == 1) { TJob ja{p.in[I_FOX_W], wt, DM, FOX_IN, 0, 0, 3072 / 32, 1, 0, 0}; run_tjob(ja, gw, ngw, scr, lane);
                              TJob jb{p.in[I_FOX_W], wt, DM, FOX_IN, 3080, 3072, 512 / 32, 1, 0, 0}; run_tjob(jb, gw, ngw, scr, lane); }
        else { TJob ji{p.in[I_MOBA_W], wt, DM, MOBA_IN, 0, 0, MOBA_IN / 32, 1, 0, 0}; run_tjob(ji, gw, ngw, scr, lane); }
    }
    const int gtid = bid * NTHR + tid, ngt = nb * NTHR;
    cvt_rows_bf16(p.in[I_X], WSP(bf16_t, WS_XB), (size_t)T * DM / 8, gtid, ngt);
    cvt_rows_bf16(p.in[I_MEM], WSP(bf16_t, WS_MEMB), (size_t)BATCH * MEMT * DM / 8, gtid, ngt);
}

constexpr int LDS_STAGE = 0, LDS_GTAB = 131072, LDS_MISC = 147456, LDS_BYTES = 153600;

__device__ __forceinline__ void static_order(int L, int nM, int nN, int& pm, int& pn) {
    const int nwg = nM * nN; int wgid = L; { const int q = nwg / 8, r = nwg % 8, xcd = wgid % 8, off = wgid / 8; wgid = (xcd < r ? xcd * (q + 1) : r * (q + 1) + (xcd - r) * q) + off; }
    const int nig = 8 * nN, gid = wgid / nig, fm = gid * 8, gsz = (nM - fm) < 8 ? (nM - fm) : 8;
    pm = fm + ((wgid % nig) % gsz); pn = (wgid % nig) / gsz;
}
struct ProjSched {
    int G, c, kind; const char *xb, *win, *memb, *wkv; char *pa, *pb, *pvt, *pz, *pmq, *memk, *memvt;
    __device__ __forceinline__ bool next(int i, pg8::Unit& u) const {
        const int nmc = (kind == 0) ? 14 : 10, nmain = 64 * nmc; const int L = i * G + c;
        u.x0 = 0; u.x1 = 0; u.x2 = 0; u.x3 = 0;
        if (L < nmain) { int pm, j; static_order(L, 64, nmc, pm, j);
            int pn, dc; char* dst; int ldc = DM, mode = 0, esz = 2;
            if (kind == 0) { if (j < 4) { pn = j; dst = pa; dc = j; mode = 1; } else if (j < 8) { pn = j; dst = pz; dc = j - 4; mode = 2; esz = 4; } else if (j < 12) { pn = j + 4; dst = pb; dc = j - 8; mode = 1; } else { pn = j + 4; dst = pmq; dc = j - 12; ldc = MEMW; } }
            else { if (j < 4) { pn = j; dst = pa; dc = j; } else if (j < 8) { pn = j; dst = pb; dc = j - 4; } else { pn = j + 4; dst = pmq; dc = j - 8; ldc = MEMW; } }
            u.a = xb + (size_t)pm * 256 * DM * 2; u.b = win + (size_t)pn * 256 * DM * 2; u.c = dst + ((size_t)pm * 256 * ldc + dc * 256) * esz; u.ldc = ldc; u.mode = mode; return true; }
        int idx = L - nmain;
        if (idx < 256) { const int x = idx & 7, off = idx >> 3, tn = 8 * x + (off & 7), vm = off >> 3;
            u.a = win + (size_t)(2048 + 256 * vm) * DM * 2; u.b = xb + (size_t)tn * 256 * DM * 2; u.c = pvt + ((size_t)256 * vm * T + 256 * tn) * 2; u.ldc = T; u.mode = 0; return true; }
        idx -= 256;
        if (idx < 4) { const int mm = idx & 1, kn = idx >> 1;
            u.a = memb + (size_t)mm * 256 * DM * 2; u.b = wkv + (size_t)kn * 256 * DM * 2; u.c = memk + ((size_t)256 * mm * MEMW + 256 * kn) * 2; u.ldc = MEMW; u.mode = 0; return true; }
        idx -= 4;
        if (idx < 4) { const int mm = idx & 1, vn = idx >> 1;
            u.a = wkv + (size_t)(512 + 256 * vn) * DM * 2; u.b = memb + (size_t)mm * 256 * DM * 2; u.c = memvt + ((size_t)256 * vn * 512 + 256 * mm) * 2; u.ldc = 512; u.mode = 0; return true; }
        return false;
    }
};
struct EpiStore {
    __device__ __forceinline__ void operator()(const f32x4 (&acc)[2][2][4][2], const pg8::Unit& u, int wr, int wc, int fr, int fq) const {
        const int r0 = wr * 64 + fr, c0 = wc * 32 + 8 * fq;
#pragma unroll
        for (int ai = 0; ai < 2; ++ai)
#pragma unroll
            for (int m = 0; m < 4; ++m) { const size_t ro = (size_t)(r0 + ai * 128 + m * 16) * u.ldc + c0;
#pragma unroll
                for (int bj = 0; bj < 2; ++bj) { f32x4 v0 = acc[ai][bj][m][0], v1 = acc[ai][bj][m][1];
                    if (u.mode == 2) { float* o = (float*)u.c + ro + bj * 128; *(f32x4*)o = v0; *(f32x4*)(o + 4) = v1; }
                    else { if (u.mode == 1) {
#pragma unroll
                            for (int j = 0; j < 4; ++j) { v0[j] = siluf_(v0[j]); v1[j] = siluf_(v1[j]); } }
                        u32x4 w; w.x = cvt_pk_bf16(v0[0], v0[1]); w.y = cvt_pk_bf16(v0[2], v0[3]); w.z = cvt_pk_bf16(v1[0], v1[1]); w.w = cvt_pk_bf16(v1[2], v1[3]);
                        *(u32x4*)((bf16_t*)u.c + ro + bj * 128) = w; } } }
    }
};
struct OutSched { int G, c; const char *mix, *wout;
    __device__ __forceinline__ bool next(int i, pg8::Unit& u) const { const int L = i * G + c; if (L >= 256) return false; int pm, pn; static_order(L, 64, 4, pm, pn);
        u.a = mix + (size_t)pm * 256 * OUT_IN * 2; u.b = wout + (size_t)pn * 256 * OUT_IN * 2; u.c = nullptr; u.ldc = DM; u.mode = 0; u.x0 = pm; u.x1 = pn; u.x2 = 0; u.x3 = 0; return true; }
};
struct EpiResid {
    const float* res; float* out;
    __device__ __forceinline__ void operator()(const f32x4 (&acc)[2][2][4][2], const pg8::Unit& u, int wr, int wc, int fr, int fq) const {
        const int r0 = u.x0 * 256 + wr * 64 + fr, c0 = u.x1 * 256 + wc * 32 + 8 * fq;
#pragma unroll
        for (int ai = 0; ai < 2; ++ai)
#pragma unroll
            for (int m = 0; m < 4; ++m) { const size_t ro = (size_t)(r0 + ai * 128 + m * 16) * DM + c0;
#pragma unroll
                for (int bj = 0; bj < 2; ++bj) { const float* rp = res + ro + bj * 128; float* o = out + ro + bj * 128;
                    const f32x4 a = *(const f32x4*)rp, b = *(const f32x4*)(rp + 4);
                    *(f32x4*)o = a * DN_ALPHA + acc[ai][bj][m][0]; *(f32x4*)(o + 4) = b * DN_ALPHA + acc[ai][bj][m][1]; } }
    }
};
struct MoeSched { const LAS int* ut; const char *abase, *wbase; int up;
    __device__ __forceinline__ bool next(int i, pg8::Unit& u) const {
        if (i >= 16) return false; const LAS int* t = ut + i * 8; if (!t[0]) return false;
        const int e = t[1], rbl = t[2], rbc = t[3], pn = t[4], cnt = t[5];
        if (up) { u.a = abase; u.b = wbase + ((size_t)e * 2 * DFF + pn * 256) * DM * 2; }
        else { u.a = abase + (size_t)rbc * 256 * DFF * 2; u.b = wbase + ((size_t)e * DM + pn * 256) * DFF * 2; }
        u.c = nullptr; u.ldc = pn; u.mode = e; u.x0 = rbl; u.x1 = rbc; u.x2 = cnt; u.x3 = 0; return true; }
};
struct EpiUp {
    const float* bup; bf16_t* act;
    __device__ __forceinline__ void operator()(const f32x4 (&acc)[2][2][4][2], const pg8::Unit& u, int wr, int wc, int fr, int fq) const {
        const int e = u.mode, pn = u.ldc, r0 = u.x1 * 256 + wr * 64 + fr, c0 = pn * 256 + wc * 32 + 8 * fq;
        f32x4 bv[2][2];
#pragma unroll
        for (int bj = 0; bj < 2; ++bj) { const float* bp = bup + (size_t)e * 2 * DFF + c0 + bj * 128; bv[bj][0] = *(const f32x4*)bp; bv[bj][1] = *(const f32x4*)(bp + 4); }
#pragma unroll
        for (int ai = 0; ai < 2; ++ai)
#pragma unroll
            for (int m = 0; m < 4; ++m) { bf16_t* rowp = act + (size_t)(r0 + ai * 128 + m * 16) * DFF + (c0 >> 1);
#pragma unroll
                for (int bj = 0; bj < 2; ++bj) { const f32x4 v0 = acc[ai][bj][m][0] + bv[bj][0], v1 = acc[ai][bj][m][1] + bv[bj][1];
                    float o[4];
#pragma unroll
                    for (int j = 0; j < 4; ++j) { const float hg = (j < 2) ? v0[2 * j] : v1[2 * j - 4], hl = (j < 2) ? v0[2 * j + 1] : v1[2 * j - 3];
                        const float glu = fminf(hg, 7.0f), lin = fminf(fmaxf(hl, -7.0f), 7.0f); o[j] = glu * sigmoidf_(1.702f * glu) * (lin + 1.0f); }
                    u32x2 w; w.x = cvt_pk_bf16(o[0], o[1]); w.y = cvt_pk_bf16(o[2], o[3]); *(u32x2*)(rowp + bj * 64) = w; } }
    }
};
struct EpiDown {
    const float* bdn; const unsigned* etok; bf16_t* ye;
    __device__ __forceinline__ void operator()(const f32x4 (&acc)[2][2][4][2], const pg8::Unit& u, int wr, int wc, int fr, int fq) const {
        const int e = u.mode, pn = u.ldc, rl0 = u.x0 * 256 + wr * 64 + fr, cnt = u.x2, c0 = pn * 256 + wc * 32 + 8 * fq;
        f32x4 bv[2][2];
#pragma unroll
        for (int bj = 0; bj < 2; ++bj) { const float* bp = bdn + (size_t)e * DM + c0 + bj * 128; bv[bj][0] = *(const f32x4*)bp; bv[bj][1] = *(const f32x4*)(bp + 4); }
        unsigned dest[2][4];
#pragma unroll
        for (int ai = 0; ai < 2; ++ai)
#pragma unroll
            for (int m = 0; m < 4; ++m) { const int rl = rl0 + ai * 128 + m * 16; dest[ai][m] = (rl < cnt) ? etok[(size_t)e * T + rl] : 0xffffffffu; }
#pragma unroll
        for (int ai = 0; ai < 2; ++ai)
#pragma unroll
            for (int m = 0; m < 4; ++m) { if (dest[ai][m] != 0xffffffffu) { bf16_t* rowp = ye + (size_t)dest[ai][m] * DM + c0;
#pragma unroll
                for (int bj = 0; bj < 2; ++bj) { const f32x4 v0 = acc[ai][bj][m][0] + bv[bj][0], v1 = acc[ai][bj][m][1] + bv[bj][1];
                    u32x4 w; w.x = cvt_pk_bf16(v0[0], v0[1]); w.y = cvt_pk_bf16(v0[2], v0[3]); w.z = cvt_pk_bf16(v1[0], v1[1]); w.w = cvt_pk_bf16(v1[2], v1[3]);
                    *(u32x4*)(rowp + bj * 128) = w; } } }
    }
};

__device__ __forceinline__ void phase_proj(const Params& p, LAS unsigned char* lds, int layer, int bid, int nb) {
    ProjSched S; S.G = nb; S.c = bid; S.kind = layer % 3;
    S.xb = (const char*)WSP(bf16_t, WS_XB); S.win = (const char*)(WSP(bf16_t, WS_WIN) + (size_t)layer * (10 * MiB / 2)); S.memb = (const char*)WSP(bf16_t, WS_MEMB);
    S.wkv = (const char*)(WSP(bf16_t, WS_WKV) + (size_t)layer * 1024 * DM);
    S.pa = (char*)WSP(bf16_t, WS_PA); S.pb = (char*)WSP(bf16_t, WS_PB); S.pvt = (char*)WSP(bf16_t, WS_PVT); S.pz = (char*)WSP(float, WS_PZ); S.pmq = (char*)WSP(bf16_t, WS_PMQ);
    S.memk = (char*)WSP(bf16_t, WS_MEMK); S.memvt = (char*)WSP(bf16_t, WS_MEMVT);
    EpiStore E;
    pg8::gemm_phase<EpiStore, ProjSched, false>(lds + LDS_STAGE, DM, S, E, nullptr);
}
__device__ __forceinline__ void phase_outproj(const Params& p, LAS unsigned char* lds, int layer, int bid, int nb) {
    OutSched S{nb, bid, (const char*)WSP(bf16_t, WS_MIX), (const char*)(WSP(bf16_t, WS_WOUT) + (size_t)layer * DM * OUT_IN)};
    EpiResid E{layer == 0 ? p.in[I_X] : WSP(float, WS_XF), WSP(float, WS_Y1)};
    pg8::gemm_phase<EpiResid, OutSched, false>(lds + LDS_STAGE, OUT_IN, S, E, nullptr);
}
__device__ __forceinline__ void moe_build_units(const Params& p, LAS unsigned char* lds, int layer, int bid, int nb, int npn, bool up) {
    LAS int* misc = (LAS int*)(lds + LDS_MISC); LAS int* ut = misc + 16; LAS int* pre = misc + 160; LAS int* cnts = misc + 200;
    LAS unsigned* gtab = (LAS unsigned*)(lds + LDS_GTAB);
    const int tid = tid_();
    const unsigned* ecnt = ctl(p) + CW_ECNT + layer * 32;
    if (tid < 32) cnts[tid] = (int)__hip_atomic_load(ecnt + tid, __ATOMIC_RELAXED, __HIP_MEMORY_SCOPE_AGENT);
    __syncthreads();
    if (tid == 0) { int s = 0; for (int e = 0; e < 32; ++e) { pre[e] = s; s += (cnts[e] + 255) >> 8; } pre[32] = s; }
    __syncthreads();
    if (tid < 16) { const int i = tid, nblk = pre[32]; int rbg, pn;
        if (nb == 256) { const int x = bid & 7, slot = bid >> 3, rpr = 32 / npn; rbg = i * (8 * rpr) + x * rpr + slot / npn; pn = slot % npn; }
        else { const int L = i * nb + bid; rbg = L / npn; pn = L % npn; }
        LAS int* t = ut + i * 8;
        if (rbg < nblk) { int e = 0; while (pre[e + 1] <= rbg) ++e; t[0] = 1; t[1] = e; t[2] = rbg - pre[e]; t[3] = rbg; t[4] = pn; t[5] = cnts[e]; }
        else { t[0] = 0; t[1] = 0; t[2] = 0; t[3] = 0; t[4] = 0; t[5] = 0; } }
    __syncthreads();
    if (up) { const unsigned* etok = WSP(unsigned, WS_ETOK);
        for (int idx = tid; idx < 16 * 256; idx += NTHR) { const int i = idx >> 8, r = idx & 255; const LAS int* t = ut + i * 8; unsigned off = 0;
            if (t[0]) { const int rl = t[2] * 256 + r; if (rl < t[5]) off = (etok[(size_t)t[1] * T + rl] >> 2) * (unsigned)(DM * 2); }
            gtab[idx] = off; }
        __syncthreads(); }
}
__device__ __forceinline__ void phase_moe_up(const Params& p, LAS unsigned char* lds, int layer, int bid, int nb) {
    moe_build_units(p, lds, layer, bid, nb, 8, true);
    MoeSched S{(const LAS int*)(lds + LDS_MISC) + 16, (const char*)WSP(bf16_t, WS_X1B), (const char*)(WSP(bf16_t, WS_WUP) + (size_t)layer * NEXP * 2 * DFF * DM), 1};
    EpiUp E{p.in[I_BUP] + (size_t)layer * NEXP * 2 * DFF, WSP(bf16_t, WS_ACT)};
    pg8::gemm_phase<EpiUp, MoeSched, true>(lds + LDS_STAGE, DM, S, E, (const LAS unsigned*)(lds + LDS_GTAB));
}
__device__ __forceinline__ void phase_moe_down(const Params& p, LAS unsigned char* lds, int layer, int bid, int nb) {
    moe_build_units(p, lds, layer, bid, nb, 4, false);
    MoeSched S{(const LAS int*)(lds + LDS_MISC) + 16, (const char*)WSP(bf16_t, WS_ACT), (const char*)(WSP(bf16_t, WS_WDN) + (size_t)layer * NEXP * DM * DFF), 0};
    EpiDown E{p.in[I_BDN] + (size_t)layer * NEXP * DM, WSP(unsigned, WS_ETOK), WSP(bf16_t, WS_YE)};
    pg8::gemm_phase<EpiDown, MoeSched, false>(lds + LDS_STAGE, DFF, S, E, nullptr);
}

constexpr int AT_K0 = 0, AT_V0 = 32768, AT_AUX = 65536;
__device__ __forceinline__ int kswz(int row, int ch) { return row * 256 + ((ch ^ ((row & 3) | (((row >> 3) & 3) << 2))) << 4); }
__device__ __forceinline__ int vswz(int row, int ch) { return row * 128 + ((ch ^ (((row >> 1) & 1) | (((row >> 3) & 3) << 1))) << 4); }
struct AttnBias { float cq; int qpos; const LAS float* tab; int kpos0; int qmin; };
template <int MODE>
__device__ __forceinline__ void attn_tiles(LAS unsigned char* lds, const bf16_t* kbase, int ldk, const bf16_t* vtbase, int ldv, int ntiles, int wave_nt,
                                           const bf16x8 (&qf)[8], f32x16 (&o)[4], float& m, float& l, const AttnBias& B) {
    const int tid = tid_(), lane = tid & 63, w = __builtin_amdgcn_readfirstlane(tid >> 6), r = lane & 31, hi = lane >> 5;
    int koff[2], voff[2];
#pragma unroll
    for (int i = 0; i < 2; ++i) { const int pz = (w * 2 + i) * 64 + lane;
        { const int row = pz >> 4, chp = pz & 15, ch = chp ^ ((row & 3) | (((row >> 3) & 3) << 2)); koff[i] = row * ldk + ch * 8; }
        { const int row = pz >> 3, chp = pz & 7, ch = chp ^ (((row >> 1) & 1) | (((row >> 3) & 3) << 1)); voff[i] = row * ldv + ch * 8; } }
    const int pr = (r & ~12) | ((r & 4) << 1) | ((r & 8) >> 1);
    int kaddr[8], vaddr[4];
#pragma unroll
    for (int ks = 0; ks < 8; ++ks) kaddr[ks] = kswz(pr, 2 * ks + hi);
#pragma unroll
    for (int s_ = 0; s_ < 4; ++s_) vaddr[s_] = vswz(r, 2 * s_ + hi);
#define AT_DMA(t, buf) do { _Pragma("unroll") for (int _i = 0; _i < 2; ++_i) { \
        __builtin_amdgcn_global_load_lds((const unsigned*)(kbase + (size_t)(t) * 64 * ldk + koff[_i]), (LAS unsigned*)(lds + AT_K0 + (buf) * 16384 + (w * 2 + _i) * 1024), 16, 0, 0); \
        __builtin_amdgcn_global_load_lds((const unsigned*)(vtbase + (t) * 64 + voff[_i]), (LAS unsigned*)(lds + AT_V0 + (buf) * 16384 + (w * 2 + _i) * 1024), 16, 0, 0); } } while (0)
    AT_DMA(0, 0);
    asm volatile("s_waitcnt vmcnt(0)" ::: "memory");
    __syncthreads();
    constexpr float C = QK_SCALE * LOG2E;
    const float NEG = -__builtin_inff();
    for (int t = 0; t < ntiles; ++t) {
        const int buf = t & 1;
        if (t + 1 < ntiles) AT_DMA(t + 1, buf ^ 1);
        if (t < wave_nt) {
            f32x16 s0, s1;
#pragma unroll
            for (int i = 0; i < 16; ++i) { s0[i] = 0.f; s1[i] = 0.f; }
            const LAS unsigned char* kb = lds + AT_K0 + buf * 16384;
#pragma unroll
            for (int kg = 0; kg < 4; ++kg) {
#pragma unroll
                for (int k2 = 0; k2 < 2; ++k2) { const int ks = 2 * kg + k2;
                    const bf16x8 k0 = *(const LAS bf16x8*)(kb + kaddr[ks]), k1 = *(const LAS bf16x8*)(kb + kaddr[ks] + 8192);
                    s0 = __builtin_amdgcn_mfma_f32_32x32x16_bf16(k0, qf[ks], s0, 0, 0, 0);
                    s1 = __builtin_amdgcn_mfma_f32_32x32x16_bf16(k1, qf[ks], s1, 0, 0, 0); }
                __builtin_amdgcn_sched_barrier(0);
            }
            float mx = NEG;
            if (MODE == 0) {
#pragma unroll
                for (int i = 0; i < 16; ++i) { s0[i] *= C; s1[i] *= C; mx = fmaxf(mx, fmaxf(s0[i], s1[i])); }
            } else if (MODE == 1) {
                const int tk = t * 64;
                const bool diag = (tk + 63 > B.qmin);
#pragma unroll
                for (int g = 0; g < 4; ++g) {
                    const int kq = 16 * (g >> 1) + 8 * hi + 4 * (g & 1);
                    const f32x4 c0 = *(const LAS f32x4*)(B.tab + tk + kq), c1 = *(const LAS f32x4*)(B.tab + tk + 32 + kq);
#pragma unroll
                    for (int j = 0; j < 4; ++j) { const int i = 4 * g + j; float v0 = s0[i] * C + (B.cq - c0[j]), v1 = s1[i] * C + (B.cq - c1[j]);
                        if (diag) { const int ko = tk + kq + j; if (ko > B.qpos) v0 = NEG; if (ko + 32 > B.qpos) v1 = NEG; }
                        s0[i] = v0; s1[i] = v1; mx = fmaxf(mx, fmaxf(v0, v1)); }
                    __builtin_amdgcn_sched_barrier(0);
                }
            } else {
                const int tk = B.kpos0 + t * 64;
                const bool far = (MODE == 2) && (B.qmin - (tk + 63) >= 128);
                if (far) { const float bb = B.tab[128];
#pragma unroll
                    for (int i = 0; i < 16; ++i) { s0[i] = s0[i] * C + bb; s1[i] = s1[i] * C + bb; mx = fmaxf(mx, fmaxf(s0[i], s1[i])); }
                } else {
#pragma unroll
                    for (int i = 0; i < 16; ++i) { const int ko = 16 * (i >> 3) + 8 * hi + (i & 7); const int d0 = B.qpos - (tk + ko), d1 = d0 - 32;
                        float v0 = s0[i] * C + B.tab[d0 < 0 ? 0 : (d0 > 128 ? 128 : d0)], v1 = s1[i] * C + B.tab[d1 < 0 ? 0 : (d1 > 128 ? 128 : d1)];
                        if (MODE == 3) { if (d0 < 0) v0 = NEG; if (d1 < 0) v1 = NEG; }
                        s0[i] = v0; s1[i] = v1; mx = fmaxf(mx, fmaxf(v0, v1)); }
                }
            }
            mx = swap_max(mx);
            const float mn = fmaxf(m, mx), alpha = fast_exp2(m - mn); m = mn;
            float ps = 0.f;
#pragma unroll
            for (int i = 0; i < 16; ++i) { s0[i] = fast_exp2(s0[i] - mn); s1[i] = fast_exp2(s1[i] - mn); ps += s0[i] + s1[i]; }
            ps = swap_sum(ps); l = l * alpha + ps;
            if (!__all(alpha == 1.0f)) {
#pragma unroll
                for (int db = 0; db < 4; ++db)
#pragma unroll
                    for (int i = 0; i < 16; ++i) o[db][i] *= alpha;
            }
            bf16x8 pf[4];
#pragma unroll
            for (int s = 0; s < 4; ++s) { u32x4 wv;
                if (s < 2) { wv.x = cvt_pk_bf16(s0[8 * s + 0], s0[8 * s + 1]); wv.y = cvt_pk_bf16(s0[8 * s + 2], s0[8 * s + 3]); wv.z = cvt_pk_bf16(s0[8 * s + 4], s0[8 * s + 5]); wv.w = cvt_pk_bf16(s0[8 * s + 6], s0[8 * s + 7]); }
                else { const int q = s - 2; wv.x = cvt_pk_bf16(s1[8 * q + 0], s1[8 * q + 1]); wv.y = cvt_pk_bf16(s1[8 * q + 2], s1[8 * q + 3]); wv.z = cvt_pk_bf16(s1[8 * q + 4], s1[8 * q + 5]); wv.w = cvt_pk_bf16(s1[8 * q + 6], s1[8 * q + 7]); }
                pf[s] = *reinterpret_cast<bf16x8*>(&wv); }
            const LAS unsigned char* vb = lds + AT_V0 + buf * 16384;
#pragma unroll
            for (int s = 0; s < 4; ++s) {
#pragma unroll
                for (int db = 0; db < 4; ++db) { const bf16x8 vf = *(const LAS bf16x8*)(vb + vaddr[s] + db * 4096); o[db] = __builtin_amdgcn_mfma_f32_32x32x16_bf16(vf, pf[s], o[db], 0, 0, 0); }
                __builtin_amdgcn_sched_barrier(0);
            }
        }
        asm volatile("s_waitcnt vmcnt(0)" ::: "memory");
        __syncthreads();
    }
#undef AT_DMA
}
__device__ __forceinline__ void attn_init(f32x16 (&o)[4], float& m, float& l) {
#pragma unroll
    for (int db = 0; db < 4; ++db)
#pragma unroll
        for (int i = 0; i < 16; ++i) o[db][i] = 0.f;
    m = -1e30f; l = 0.f;
}
__device__ __forceinline__ void load_q(const bf16_t* qrow, int hi, bf16x8 (&qf)[8]) {
#pragma unroll
    for (int ks = 0; ks < 8; ++ks) qf[ks] = *(const bf16x8*)(qrow + 16 * ks + 8 * hi);
}
__device__ __forceinline__ void store_o(const f32x16 (&o)[4], float sc, bf16_t* orow, int hi) {
#pragma unroll
    for (int db = 0; db < 4; ++db)
#pragma unroll
        for (int g = 0; g < 4; ++g) { u32x2 w; w.x = cvt_pk_bf16(o[db][4 * g] * sc, o[db][4 * g + 1] * sc); w.y = cvt_pk_bf16(o[db][4 * g + 2] * sc, o[db][4 * g + 3] * sc);
            *(u32x2*)(orow + 32 * db + 8 * g + 4 * hi) = w; }
}

__device__ __forceinline__ void phase_memattn(const Params& p, LAS unsigned char* lds, int bid, int nb) {
    const int tid = tid_(), lane = tid & 63, w = tid >> 6, c = lane & 31, hi = lane >> 5;
    for (int u = bid; u < BATCH * MH * 32; u += nb) {
        const int b = u >> 7, mh = (u >> 5) & 3, qb = u & 31;
        const int tok = b * SEQ + qb * 256 + 32 * w + c;
        bf16x8 qf[8]; load_q(WSP(bf16_t, WS_PMQ) + (size_t)tok * MEMW + mh * HD, hi, qf);
        f32x16 o[4]; float m, l; attn_init(o, m, l);
        AttnBias B{0.f, 0, nullptr, 0, 0};
        attn_tiles<0>(lds, WSP(bf16_t, WS_MEMK) + (size_t)b * MEMT * MEMW + mh * HD, MEMW, WSP(bf16_t, WS_MEMVT) + (size_t)mh * HD * 512 + b * MEMT, 512, 4, 4, qf, o, m, l, B);
        store_o(o, 1.0f / l, WSP(bf16_t, WS_MIX) + (size_t)tok * OUT_IN + DM + mh * HD, hi);
    }
}

__device__ __forceinline__ void phase_fox_logf(const Params& p, int layer, int bid, int nb) {
    const int tid = tid_(), lane = tid & 63, w = tid >> 6;
    const float* xin = (layer == 0) ? p.in[I_X] : WSP(float, WS_XF);
    const float* wf = p.in[I_FOX_W] + (size_t)(layer / 3) * DM * FOX_IN + 3072;
    const float* bf = p.in[I_FOX_BF] + (layer / 3) * NH;
    float wr[16][8];
#pragma unroll
    for (int j = 0; j < 4; ++j)
#pragma unroll
        for (int q = 0; q < 4; ++q) { const int k = 256 * j + 4 * lane + q;
#pragma unroll
            for (int h = 0; h < 8; ++h) wr[4 * j + q][h] = wf[(size_t)k * FOX_IN + h]; }
    for (int tok = bid * NWAVES + w; tok < T; tok += nb * NWAVES) {
        float acc[8];
#pragma unroll
        for (int h = 0; h < 8; ++h) acc[h] = 0.f;
#pragma unroll
        for (int j = 0; j < 4; ++j) { const f32x4 xv = *(const f32x4*)(xin + (size_t)tok * DM + 256 * j + 4 * lane);
#pragma unroll
            for (int q = 0; q < 4; ++q)
#pragma unroll
                for (int h = 0; h < 8; ++h) acc[h] = fmaf(xv[q], wr[4 * j + q][h], acc[h]); }
#pragma unroll
        for (int h = 0; h < 8; ++h) acc[h] = wave_sum(acc[h]);
        if (lane < 8) { float z = 0.f;
#pragma unroll
            for (int h = 0; h < 8; ++h) z = (lane == h) ? acc[h] : z;
            const int b = tok / SEQ, s = tok % SEQ;
            WSP(float, WS_LOGF)[((size_t)b * NH + lane) * SEQ + s] = logsigmoidf_(z + bf[lane]) * LOG2E; }
    }
}
__device__ __forceinline__ void phase_fox_prep(const Params& p, int bid, int nb) {
    const int tid = tid_(), lane = tid & 63, w = tid >> 6; const int gw = bid * NWAVES + w, ngw = nb * NWAVES;
    for (int it = gw; it < 16 + 2048; it += ngw) {
        if (it < 16) { const float* src = WSP(float, WS_LOGF) + (size_t)it * SEQ; float* dst = WSP(float, WS_C2) + (size_t)it * SEQ; float carry = 0.f;
            for (int c0 = 0; c0 < SEQ; c0 += 1024) { float v[16]; float run = 0.f;
#pragma unroll
                for (int j = 0; j < 4; ++j) { const f32x4 x = *(const f32x4*)(src + c0 + lane * 16 + 4 * j); v[4 * j] = x[0]; v[4 * j + 1] = x[1]; v[4 * j + 2] = x[2]; v[4 * j + 3] = x[3]; }
#pragma unroll
                for (int j = 0; j < 16; ++j) { run += v[j]; v[j] = run; }
                float inc = run;
#pragma unroll
                for (int o_ = 1; o_ < 64; o_ <<= 1) { const float y = __shfl_up(inc, o_); if (lane >= o_) inc += y; }
                const float base = carry + inc - run;
#pragma unroll
                for (int j = 0; j < 4; ++j) *(f32x4*)(dst + c0 + lane * 16 + 4 * j) = (f32x4){v[4 * j] + base, v[4 * j + 1] + base, v[4 * j + 2] + base, v[4 * j + 3] + base};
                carry += __shfl(inc, 63); }
        } else { const int u = it - 16, bh = u >> 7, t = u & 127, b = bh >> 3, h = bh & 7;
            const bf16_t* kp = WSP(bf16_t, WS_PB) + ((size_t)b * SEQ + t * 64 + lane) * DM + h * HD; float ss = 0.f;
#pragma unroll
            for (int j = 0; j < 16; ++j) { const u32x4 x = *(const u32x4*)(kp + 8 * j);
                ss += bflo(x.x) * bflo(x.x) + bfhi(x.x) * bfhi(x.x) + bflo(x.y) * bflo(x.y) + bfhi(x.y) * bfhi(x.y) + bflo(x.z) * bflo(x.z) + bfhi(x.z) * bfhi(x.z) + bflo(x.w) * bflo(x.w) + bfhi(x.w) * bfhi(x.w); }
#pragma unroll
            for (int o_ = 1; o_ < 64; o_ <<= 1) ss = fmaxf(ss, __shfl_xor(ss, o_));
            if (lane == 0) WSP(float, WS_KNT)[u] = sqrtf(ss) * 1.0001f; }
    }
}
constexpr float FOX_PRUNE = 40.0f;
__device__ __forceinline__ void phase_fox_attn(const Params& p, LAS unsigned char* lds, int layer, int bid, int nb) {
    const int tid = tid_(), lane = tid & 63, w = __builtin_amdgcn_readfirstlane(tid >> 6), c = lane & 31, r = c, hi = lane >> 5;
    LAS float* c2 = (LAS float*)(lds + AT_AUX);
    LAS float* kn = (LAS float*)(lds + AT_AUX + 32768);
    LAS int* sh = (LAS int*)(lds + AT_AUX + 32768 + 512);
    const float* bfp = p.in[I_FOX_BF] + (layer / 3) * NH;
    int koff[2], voff[2];
#pragma unroll
    for (int i = 0; i < 2; ++i) { const int pz = (w * 2 + i) * 64 + lane;
        { const int row = pz >> 4, chp = pz & 15, ch = chp ^ ((row & 3) | (((row >> 3) & 3) << 2)); koff[i] = row * DM + ch * 8; }
        { const int row = pz >> 3, chp = pz & 7, ch = chp ^ (((row >> 1) & 1) | (((row >> 3) & 3) << 1)); voff[i] = row * T + ch * 8; } }
    const int pr = (r & ~12) | ((r & 4) << 1) | ((r & 8) >> 1);
    int kaddr[8], vaddr[4];
#pragma unroll
    for (int ks = 0; ks < 8; ++ks) kaddr[ks] = kswz(pr, 2 * ks + hi);
#pragma unroll
    for (int s_ = 0; s_ < 4; ++s_) vaddr[s_] = vswz(r, 2 * s_ + hi);
    constexpr float C = QK_SCALE * LOG2E; const float NEG = -__builtin_inff();
    for (;;) {
        __syncthreads();
        if (tid == 0) sh[0] = (int)atomicAdd(ctl(p) + CW_FOXQ, 1u);
        __syncthreads();
        const int u = sh[0]; if (u >= 512) break;
        const int rk = u >> 6, b = (u >> 5) & 1, qb = 31 - (u & 31);
        int h = 0;
        for (int hc = 0; hc < NH; ++hc) { int rank = 0; for (int h2 = 0; h2 < NH; ++h2) rank += (bfp[h2] > bfp[hc] || (bfp[h2] == bfp[hc] && h2 < hc)) ? 1 : 0; if (rank == rk) h = hc; }
        const int bh = b * NH + h, n = (qb + 1) * 256, ntiles = (qb + 1) * 4;
        for (int i = tid * 4; i < n; i += NTHR * 4) *(LAS f32x4*)(c2 + i) = *(const f32x4*)(WSP(float, WS_C2) + (size_t)bh * SEQ + i);
        if (tid < 128) kn[tid] = WSP(float, WS_KNT)[bh * 128 + tid];
        const int qpos = qb * 256 + 32 * w + c, tok = b * SEQ + qpos, qmin = qb * 256 + 32 * w;
        bf16x8 qf[8]; load_q(WSP(bf16_t, WS_PA) + (size_t)tok * DM + h * HD, hi, qf);
        float qn2 = 0.f;
#pragma unroll
        for (int ks = 0; ks < 8; ++ks) { const u32x4 x = *reinterpret_cast<const u32x4*>(&qf[ks]);
            qn2 += bflo(x.x) * bflo(x.x) + bfhi(x.x) * bfhi(x.x) + bflo(x.y) * bflo(x.y) + bfhi(x.y) * bfhi(x.y) + bflo(x.z) * bflo(x.z) + bfhi(x.z) * bfhi(x.z) + bflo(x.w) * bflo(x.w) + bfhi(x.w) * bfhi(x.w); }
        qn2 = swap_sum(qn2);
#pragma unroll
        for (int o_ = 1; o_ < 32; o_ <<= 1) qn2 = fmaxf(qn2, __shfl_xor(qn2, o_));
        f32x16 o[4]; float m, l; attn_init(o, m, l);
        const bf16_t* kbase = WSP(bf16_t, WS_PB) + (size_t)b * SEQ * DM + h * HD; const bf16_t* vtbase = WSP(bf16_t, WS_PVT) + (size_t)h * HD * T + (size_t)b * SEQ;
        const int wave_nt = ((qb * 256 + 32 * w + 31) >> 6) + 1;
#define FX_DMA(t, buf) do { _Pragma("unroll") for (int _i = 0; _i < 2; ++_i) { \
        __builtin_amdgcn_global_load_lds((const unsigned*)(kbase + (size_t)(t) * 64 * DM + koff[_i]), (LAS unsigned*)(lds + AT_K0 + (buf) * 16384 + (w * 2 + _i) * 1024), 16, 0, 0); \
        __builtin_amdgcn_global_load_lds((const unsigned*)(vtbase + (t) * 64 + voff[_i]), (LAS unsigned*)(lds + AT_V0 + (buf) * 16384 + (w * 2 + _i) * 1024), 16, 0, 0); } } while (0)
        int t_lo = ntiles - 4, my_lo = 0; bool decided = false;
        FX_DMA(ntiles - 1, 0);
        asm volatile("s_waitcnt vmcnt(0)" ::: "memory");
        __syncthreads();
        const float cq = c2[qpos];
        for (int it = 0;; ++it) {
            const int t = ntiles - 1 - it, buf = it & 1;
            bool has_next = (t - 1 >= t_lo);
            if (has_next) FX_DMA(t - 1, buf ^ 1);
            if (t < wave_nt && t >= my_lo) {
                f32x16 s0, s1;
#pragma unroll
                for (int i = 0; i < 16; ++i) { s0[i] = 0.f; s1[i] = 0.f; }
                const LAS unsigned char* kb = lds + AT_K0 + buf * 16384;
#pragma unroll
                for (int kg = 0; kg < 4; ++kg) {
#pragma unroll
                    for (int k2 = 0; k2 < 2; ++k2) { const int ks = 2 * kg + k2;
                        const bf16x8 k0 = *(const LAS bf16x8*)(kb + kaddr[ks]), k1 = *(const LAS bf16x8*)(kb + kaddr[ks] + 8192);
                        s0 = __builtin_amdgcn_mfma_f32_32x32x16_bf16(k0, qf[ks], s0, 0, 0, 0);
                        s1 = __builtin_amdgcn_mfma_f32_32x32x16_bf16(k1, qf[ks], s1, 0, 0, 0); }
                    __builtin_amdgcn_sched_barrier(0);
                }
                float mx = NEG; const int tk = t * 64; const bool diag = (tk + 63 > qmin);
#pragma unroll
                for (int g = 0; g < 4; ++g) { const int kq = 16 * (g >> 1) + 8 * hi + 4 * (g & 1);
                    const f32x4 c0 = *(const LAS f32x4*)(c2 + tk + kq), c1 = *(const LAS f32x4*)(c2 + tk + 32 + kq);
#pragma unroll
                    for (int j = 0; j < 4; ++j) { const int i = 4 * g + j; float v0 = s0[i] * C + (cq - c0[j]), v1 = s1[i] * C + (cq - c1[j]);
                        if (diag) { const int ko = tk + kq + j; if (ko > qpos) v0 = NEG; if (ko + 32 > qpos) v1 = NEG; }
                        s0[i] = v0; s1[i] = v1; mx = fmaxf(mx, fmaxf(v0, v1)); }
                    __builtin_amdgcn_sched_barrier(0);
                }
                mx = swap_max(mx);
                const float mn = fmaxf(m, mx), alpha = fast_exp2(m - mn); m = mn;
                float ps = 0.f;
#pragma unroll
                for (int i = 0; i < 16; ++i) { s0[i] = fast_exp2(s0[i] - mn); s1[i] = fast_exp2(s1[i] - mn); ps += s0[i] + s1[i]; }
                ps = swap_sum(ps); l = l * alpha + ps;
                if (!__all(alpha == 1.0f)) {
#pragma unroll
                    for (int db = 0; db < 4; ++db)
#pragma unroll
                        for (int i = 0; i < 16; ++i) o[db][i] *= alpha;
                }
                bf16x8 pf[4];
#pragma unroll
                for (int s = 0; s < 4; ++s) { u32x4 wv;
                    if (s < 2) { wv.x = cvt_pk_bf16(s0[8 * s + 0], s0[8 * s + 1]); wv.y = cvt_pk_bf16(s0[8 * s + 2], s0[8 * s + 3]); wv.z = cvt_pk_bf16(s0[8 * s + 4], s0[8 * s + 5]); wv.w = cvt_pk_bf16(s0[8 * s + 6], s0[8 * s + 7]); }
                    else { const int q = s - 2; wv.x = cvt_pk_bf16(s1[8 * q + 0], s1[8 * q + 1]); wv.y = cvt_pk_bf16(s1[8 * q + 2], s1[8 * q + 3]); wv.z = cvt_pk_bf16(s1[8 * q + 4], s1[8 * q + 5]); wv.w = cvt_pk_bf16(s1[8 * q + 6], s1[8 * q + 7]); }
                    pf[s] = *reinterpret_cast<bf16x8*>(&wv); }
                const LAS unsigned char* vb = lds + AT_V0 + buf * 16384;
#pragma unroll
                for (int s = 0; s < 4; ++s) {
#pragma unroll
                    for (int db = 0; db < 4; ++db) { const bf16x8 vf = *(const LAS bf16x8*)(vb + vaddr[s] + db * 4096); o[db] = __builtin_amdgcn_mfma_f32_32x32x16_bf16(vf, pf[s], o[db], 0, 0, 0); }
                    __builtin_amdgcn_sched_barrier(0);
                }
            }
            asm volatile("s_waitcnt vmcnt(0)" ::: "memory");
            __syncthreads();
            if (!has_next) {
                if (decided || t == 0) break;
                decided = true;
                {
                    float mmin = m;
#pragma unroll
                    for (int o_ = 1; o_ < 64; o_ <<= 1) mmin = fminf(mmin, __shfl_xor(mmin, o_));
                    const float qmax = sqrtf(qn2) * 1.0001f, cq0 = c2[qmin], thr = mmin - FOX_PRUNE;
                    int first = t;
                    for (int tt = lane; tt < t; tt += 64) { const float ub = C * qmax * kn[tt] + (cq0 - c2[tt * 64 + 63]); if (ub >= thr) first = tt < first ? tt : first; }
#pragma unroll
                    for (int o_ = 1; o_ < 64; o_ <<= 1) { const int y = __shfl_xor(first, o_); first = y < first ? y : first; }
                    my_lo = first; if (lane == 0) sh[1 + w] = first;
                }
                __syncthreads();
                int lo = sh[1];
#pragma unroll
                for (int q = 1; q < 8; ++q) lo = sh[1 + q] < lo ? sh[1 + q] : lo;
                t_lo = lo;
                if (t - 1 < t_lo) break;
                FX_DMA(t - 1, buf ^ 1);
                asm volatile("s_waitcnt vmcnt(0)" ::: "memory");
                __syncthreads();
            }
        }
#undef FX_DMA
        store_o(o, 1.0f / l, WSP(bf16_t, WS_MIX) + (size_t)tok * OUT_IN + h * HD, hi);
    }
}

__device__ __forceinline__ int t5_bucket(int n) {
    if (n < 16) return n;
    const int v = 16 + (int)(__log2f((float)n * (1.0f / 16.0f)) * (16.0f / 3.0f));
    return v < 31 ? v : 31;
}
__device__ __forceinline__ void phase_moba_kmean(const Params& p, LAS unsigned char* lds, int bid, int nb) {
    const int tid = tid_(); LAS float* red = (LAS float*)lds;
    const int dp = tid & 63, kg = tid >> 6;
    for (int u = bid; u < 512; u += nb) {
        const int bh = u >> 5, j = u & 31, b = bh >> 3, h = bh & 7;
        const bf16_t* kp = WSP(bf16_t, WS_PB) + ((size_t)b * SEQ + j * 256 + kg * 32) * DM + h * HD + 2 * dp;
        float s0 = 0.f, s1 = 0.f;
#pragma unroll 8
        for (int k = 0; k < 32; ++k) { const unsigned wv = *(const unsigned*)(kp + (size_t)k * DM); s0 += bflo(wv); s1 += bfhi(wv); }
        __syncthreads();
        red[kg * 128 + 2 * dp] = s0; red[kg * 128 + 2 * dp + 1] = s1;
        __syncthreads();
        if (tid < 128) { float s = 0.f;
#pragma unroll
            for (int g = 0; g < 8; ++g) s += red[g * 128 + tid];
            WSP(float, WS_KMEAN)[(size_t)u * 128 + tid] = s * (1.0f / 256.0f); }
    }
}
__device__ __forceinline__ void phase_moba_gate(const Params& p, LAS unsigned char* lds, int bid, int nb) {
    const int tid = tid_(); LAS float* km = (LAS float*)lds;
    LAS int* lcnt = (LAS int*)(lds + 16384); LAS int* lbase = lcnt + 32;
    unsigned* gl = ctl(p) + CW_LCNT;
    for (int u = bid; u < 512; u += nb) {
        const int bh = u >> 5, own = u & 31, b = bh >> 3, h = bh & 7;
        __syncthreads();
        for (int i = tid; i < 32 * 128; i += NTHR) km[i] = WSP(float, WS_KMEAN)[(size_t)bh * 32 * 128 + i];
        if (tid < 32) lcnt[tid] = 0;
        __syncthreads();
        int sel[3] = {-1, -1, -1}, rank[3] = {0, 0, 0}; int nv = 0;
        const int q = own * 256 + (tid & 255);
        if (tid < 256) {
            const bf16_t* qp = WSP(bf16_t, WS_PA) + ((size_t)b * SEQ + q) * DM + h * HD;
            unsigned qw[64];
#pragma unroll
            for (int i = 0; i < 16; ++i) { const u32x4 x = *(const u32x4*)(qp + 8 * i); qw[4 * i] = x.x; qw[4 * i + 1] = x.y; qw[4 * i + 2] = x.z; qw[4 * i + 3] = x.w; }
            float best[3] = {-__builtin_inff(), -__builtin_inff(), -__builtin_inff()};
            for (int j = 0; j < own; ++j) { const LAS float* kr = km + j * 128; float g = 0.f;
#pragma unroll
                for (int i = 0; i < 64; ++i) { g = fmaf(bflo(qw[i]), kr[2 * i], g); g = fmaf(bfhi(qw[i]), kr[2 * i + 1], g); }
                if (g > best[0]) { best[2] = best[1]; sel[2] = sel[1]; best[1] = best[0]; sel[1] = sel[0]; best[0] = g; sel[0] = j; }
                else if (g > best[1]) { best[2] = best[1]; sel[2] = sel[1]; best[1] = g; sel[1] = j; }
                else if (g > best[2]) { best[2] = g; sel[2] = j; } }
            nv = own < 3 ? own : 3;
            for (int s = 0; s < 3; ++s) if (s < nv) rank[s] = atomicAdd((int*)&lcnt[sel[s]], 1);
            int* sp = WSP(int, WS_SEL) + (((size_t)b * SEQ + q) * NH + h) * 4; sp[0] = sel[0]; sp[1] = sel[1]; sp[2] = sel[2]; sp[3] = nv;
        }
        __syncthreads();
        if (tid < 32) lbase[tid] = lcnt[tid] ? (int)atomicAdd(gl + bh * 32 + tid, (unsigned)lcnt[tid]) : 0;
        __syncthreads();
        if (tid < 256) for (int s = 0; s < 3; ++s) if (s < nv) WSP(unsigned, WS_LISTS)[((size_t)bh * 32 + sel[s]) * 8192 + lbase[sel[s]] + rank[s]] = (unsigned)q | ((unsigned)s << 16);
    }
}
__device__ __forceinline__ void moba_bias_tab(const Params& p, LAS float* tab, int h) {
    const int tid = tid_();
    if (tid <= 128) tab[tid] = p.in[I_RELB][t5_bucket(tid) * NH + h] * LOG2E;
}
__device__ __forceinline__ void phase_moba_past(const Params& p, LAS unsigned char* lds, int bid, int nb) {
    const int tid = tid_(), lane = tid & 63, w = tid >> 6, c = lane & 31, hi = lane >> 5;
    LAS float* tab = (LAS float*)(lds + AT_AUX); LAS int* pre = (LAS int*)(lds + AT_AUX + 1024);
    LAS int* wsum = (LAS int*)(lds + AT_AUX + 1024 + 4096);
    const unsigned* gl = ctl(p) + CW_LCNT;
    {
        const int n = (int)__hip_atomic_load(gl + tid, __ATOMIC_RELAXED, __HIP_MEMORY_SCOPE_AGENT); const int nu = (n + 255) >> 8;
        int inc = nu;
#pragma unroll
        for (int o_ = 1; o_ < 64; o_ <<= 1) { const int y = __shfl_up(inc, o_); if (lane >= o_) inc += y; }
        if (lane == 63) wsum[w] = inc;
        __syncthreads();
        int base = inc - nu; for (int q = 0; q < w; ++q) base += wsum[q];
        pre[tid] = base; if (tid == 511) pre[512] = base + nu;
        __syncthreads();
    }
    const int total = pre[512];
    int cur_h = -1;
    for (int u = bid; u < total; u += nb) {
        int lo = 0, hiL = 511;
        while (lo < hiL) { const int mid = (lo + hiL + 1) >> 1; if (pre[mid] <= u) lo = mid; else hiL = mid - 1; }
        const int list = lo, chunk = u - pre[list], bh = list >> 5, j = list & 31, b = bh >> 3, h = bh & 7;
        const int n = (int)__hip_atomic_load(gl + list, __ATOMIC_RELAXED, __HIP_MEMORY_SCOPE_AGENT);
        if (h != cur_h) { __syncthreads(); moba_bias_tab(p, tab, h); cur_h = h; __syncthreads(); }
        const int e0 = chunk * 256 + 32 * w; const bool active = e0 < n;
        int ei = e0 + c; if (ei > n - 1) ei = n - 1;
        const unsigned ent = WSP(unsigned, WS_LISTS)[(size_t)list * 8192 + ei]; const int q = ent & 0xffff, slot = ent >> 16;
        const int tok = b * SEQ + q;
        bf16x8 qf[8]; load_q(WSP(bf16_t, WS_PA) + (size_t)tok * DM + h * HD, hi, qf);
        int qmin = q;
#pragma unroll
        for (int o_ = 1; o_ < 64; o_ <<= 1) { const int y = __shfl_xor(qmin, o_); qmin = y < qmin ? y : qmin; }
        f32x16 o[4]; float m, l; attn_init(o, m, l);
        AttnBias B{0.f, q, tab, j * 256, qmin};
        attn_tiles<2>(lds, WSP(bf16_t, WS_PB) + ((size_t)b * SEQ + j * 256) * DM + h * HD, DM, WSP(bf16_t, WS_PVT) + (size_t)h * HD * T + (size_t)b * SEQ + j * 256, T, 4, active ? 4 : 0, qf, o, m, l, B);
        if (active) { const size_t P = ((size_t)tok * NH + h) * 3 + slot;
            store_o(o, 1.0f / l, WSP(bf16_t, WS_PARTO) + P * HD, hi);
            if (hi == 0) WSP(float, WS_PARTL)[P] = m + __log2f(l); }
    }
}
__device__ __forceinline__ void phase_moba_own(const Params& p, LAS unsigned char* lds, int bid, int nb) {
    const int tid = tid_(), lane = tid & 63, w = tid >> 6, c = lane & 31, hi = lane >> 5;
    LAS float* tab = (LAS float*)(lds + AT_AUX);
    int cur_h = -1;
    for (int u = bid; u < 512; u += nb) {
        const int bh = u >> 5, blk = u & 31, b = bh >> 3, h = bh & 7;
        if (h != cur_h) { __syncthreads(); moba_bias_tab(p, tab, h); cur_h = h; __syncthreads(); }
        const int qrel = 32 * w + c, q = blk * 256 + qrel, tok = b * SEQ + q;
        bf16x8 qf[8]; load_q(WSP(bf16_t, WS_PA) + (size_t)tok * DM + h * HD, hi, qf);
        f32x16 o[4]; float m, l; attn_init(o, m, l);
        AttnBias B{0.f, qrel, tab, 0, 32 * w};
        attn_tiles<3>(lds, WSP(bf16_t, WS_PB) + ((size_t)b * SEQ + blk * 256) * DM + h * HD, DM, WSP(bf16_t, WS_PVT) + (size_t)h * HD * T + (size_t)b * SEQ + blk * 256, T, 4, (w >> 1) + 1, qf, o, m, l, B);
        const int* sp = WSP(int, WS_SEL) + ((size_t)tok * NH + h) * 4; const int nv = sp[3];
        const size_t P = ((size_t)tok * NH + h) * 3;
        float lse[3], M = m;
#pragma unroll
        for (int s = 0; s < 3; ++s) { lse[s] = (s < nv) ? WSP(float, WS_PARTL)[P + s] : -__builtin_inff(); M = fmaxf(M, lse[s]); }
        const float wo = fast_exp2(m - M); float den = l * wo;
#pragma unroll
        for (int db = 0; db < 4; ++db)
#pragma unroll
            for (int i = 0; i < 16; ++i) o[db][i] *= wo;
#pragma unroll
        for (int s = 0; s < 3; ++s) { if (s < nv) { const float ws_ = fast_exp2(lse[s] - M); den += ws_; const bf16_t* po = WSP(bf16_t, WS_PARTO) + (P + s) * HD;
#pragma unroll
                for (int db = 0; db < 4; ++db)
#pragma unroll
                    for (int g = 0; g < 4; ++g) { const u32x2 x = *(const u32x2*)(po + 32 * db + 8 * g + 4 * hi);
                        o[db][4 * g] += ws_ * bflo(x.x); o[db][4 * g + 1] += ws_ * bfhi(x.x); o[db][4 * g + 2] += ws_ * bflo(x.y); o[db][4 * g + 3] += ws_ * bfhi(x.y); } } }
        store_o(o, 1.0f / den, WSP(bf16_t, WS_MIX) + (size_t)tok * OUT_IN + h * HD, hi);
    }
}

__device__ __forceinline__ void phase_hgrn_pre(const Params& p, int layer, int bid, int nb) {
    const int jj = layer / 3; const int tid = tid_(), lane = tid & 63, w = tid >> 6;
    const float* lbp = p.in[I_HGRN_LB];
    for (int item = bid * NWAVES + w; item < 256 * 32; item += nb * NWAVES) {
        const int crow = item >> 5, cg = item & 31, ch0 = cg * 32;
        const int b = crow >> 7, cc = crow & 127; const size_t tok = (size_t)b * SEQ + cc * 64 + lane;
        f32x4 z[8]; u32x4 qw[4];
#pragma unroll
        for (int j = 0; j < 8; ++j) z[j] = *(const f32x4*)(WSP(float, WS_PZ) + tok * DM + ch0 + 4 * j);
#pragma unroll
        for (int j = 0; j < 4; ++j) qw[j] = *(const u32x4*)(WSP(bf16_t, WS_PA) + tok * DM + ch0 + 8 * j);
        unsigned oqb[16], oqr[16], okr[16]; float gsel = 0.f;
#pragma unroll
        for (int j = 0; j < 8; ++j) {
            float vqb[4], vqr[4], vkr[4];
#pragma unroll
            for (int q = 0; q < 4; ++q) { const int cl = 4 * j + q, ch = ch0 + cl; const float zz = z[j][q];
                const float lb = (jj == 0) ? 0.f : sigmoidf_(lbp[DM + ch] - lbp[ch]);
                const float e = __expf(-fabsf(zz)), r1 = fast_rcp(1.0f + e), l1 = __logf(1.0f + e);
                const float sg = (zz >= 0.f) ? r1 : e * r1, sgn = (zz >= 0.f) ? e * r1 : r1;
                const float ls = fminf(zz, 0.f) - l1;
                const float lf = (jj == 0) ? ls : __logf(lb + (1.f - lb) * sg);
                float bc = lf;
#pragma unroll
                for (int o_ = 1; o_ < 64; o_ <<= 1) { const float y = __shfl_up(bc, o_); if (lane >= o_) bc += y; }
                const float bmid = __shfl(bc, 31), blast = __shfl(bc, 63);
                const float kk = (1.f - lb) * sgn;
                const unsigned qword = (cl & 1) ? 0u : 0u; (void)qword;
                const unsigned qwv = ((const unsigned*)&qw[cl >> 3])[(cl & 7) >> 1]; const float qv = (cl & 1) ? bfhi(qwv) : bflo(qwv);
                vqb[q] = qv * __expf(bc); vqr[q] = qv * __expf(fminf(bc - bmid, 80.f)); vkr[q] = kk * __expf(fminf(bmid - bc, 80.f));
                WSP(bf16_t, WS_HKDT)[(size_t)ch * T + tok] = f2bf(kk * __expf(blast - bc));
                gsel = (lane == cl) ? __expf(blast) : gsel; }
            oqb[2 * j] = cvt_pk_bf16(vqb[0], vqb[1]); oqb[2 * j + 1] = cvt_pk_bf16(vqb[2], vqb[3]);
            oqr[2 * j] = cvt_pk_bf16(vqr[0], vqr[1]); oqr[2 * j + 1] = cvt_pk_bf16(vqr[2], vqr[3]);
            okr[2 * j] = cvt_pk_bf16(vkr[0], vkr[1]); okr[2 * j + 1] = cvt_pk_bf16(vkr[2], vkr[3]);
        }
#pragma unroll
        for (int j = 0; j < 4; ++j) {
            *(u32x4*)(WSP(bf16_t, WS_HQB) + tok * DM + ch0 + 8 * j) = (u32x4){oqb[4 * j], oqb[4 * j + 1], oqb[4 * j + 2], oqb[4 * j + 3]};
            *(u32x4*)(WSP(bf16_t, WS_HQR) + tok * DM + ch0 + 8 * j) = (u32x4){oqr[4 * j], oqr[4 * j + 1], oqr[4 * j + 2], oqr[4 * j + 3]};
            *(u32x4*)(WSP(bf16_t, WS_HKR) + tok * DM + ch0 + 8 * j) = (u32x4){okr[4 * j], okr[4 * j + 1], okr[4 * j + 2], okr[4 * j + 3]}; }
        if (lane < 32) { const int ch = ch0 + lane, hh = ch >> 7, d = ch & 127; WSP(float, WS_HG)[((size_t)(b * NH + hh) * 128 + cc) * 128 + d] = gsel; }
    }
}
__device__ __forceinline__ void phase_hgrn_a(const Params& p, int bid, int nb) {
    const int tid = tid_(), lane = tid & 63, w = tid >> 6, c = lane & 31, hi = lane >> 5, eb = w >> 1, dh = w & 1;
    for (int u = bid; u < 2048; u += nb) {
        const int bh = u >> 7, cc = u & 127, b = bh >> 3, hh = bh & 7; const size_t tok0 = (size_t)b * SEQ + cc * 64;
        const bf16_t* vt = WSP(bf16_t, WS_PVT) + (size_t)(hh * HD + 32 * eb + c) * T + tok0 + 8 * hi;
        const bf16_t* kd = WSP(bf16_t, WS_HKDT) + (size_t)(hh * HD + 64 * dh + c) * T + tok0 + 8 * hi;
        f32x16 a0, a1;
#pragma unroll
        for (int i = 0; i < 16; ++i) { a0[i] = 0.f; a1[i] = 0.f; }
#pragma unroll
        for (int ks = 0; ks < 4; ++ks) { const bf16x8 vf = *(const bf16x8*)(vt + 16 * ks), k0 = *(const bf16x8*)(kd + 16 * ks), k1 = *(const bf16x8*)(kd + (size_t)32 * T + 16 * ks);
            a0 = __builtin_amdgcn_mfma_f32_32x32x16_bf16(k0, vf, a0, 0, 0, 0); a1 = __builtin_amdgcn_mfma_f32_32x32x16_bf16(k1, vf, a1, 0, 0, 0); }
        bf16_t* st = WSP(bf16_t, WS_HST) + (size_t)u * 128 * 128 + (size_t)(32 * eb + c) * 128 + 64 * dh + 4 * hi;
#pragma unroll
        for (int g = 0; g < 4; ++g) { u32x2 x0, x1; x0.x = cvt_pk_bf16(a0[4 * g], a0[4 * g + 1]); x0.y = cvt_pk_bf16(a0[4 * g + 2], a0[4 * g + 3]); x1.x = cvt_pk_bf16(a1[4 * g], a1[4 * g + 1]); x1.y = cvt_pk_bf16(a1[4 * g + 2], a1[4 * g + 3]);
            *(u32x2*)(st + 8 * g) = x0; *(u32x2*)(st + 32 + 8 * g) = x1; }
    }
}
__device__ __forceinline__ void phase_hgrn_b(const Params& p, int bid, int nb) {
    for (int gid = bid * NTHR + tid_(); gid < 16 * 128 * 64; gid += nb * NTHR) {
        const int bh = gid >> 13, e = (gid >> 6) & 127, dp = gid & 63;
        unsigned* st = (unsigned*)(WSP(bf16_t, WS_HST) + (size_t)bh * 128 * 16384 + (size_t)e * 128 + 2 * dp); const float* gp = WSP(float, WS_HG) + (size_t)bh * 128 * 128 + 2 * dp;
        float S0 = 0.f, S1 = 0.f;
        for (int c8 = 0; c8 < 128; c8 += 8) { unsigned U[8]; f32x2 g[8];
#pragma unroll
            for (int q = 0; q < 8; ++q) { U[q] = st[(size_t)(c8 + q) * 8192]; g[q] = *(const f32x2*)(gp + (c8 + q) * 128); }
#pragma unroll
            for (int q = 0; q < 8; ++q) { st[(size_t)(c8 + q) * 8192] = cvt_pk_bf16(S0, S1); S0 = g[q][0] * S0 + bflo(U[q]); S1 = g[q][1] * S1 + bfhi(U[q]); } }
    }
}
__device__ __forceinline__ void phase_hgrn_c(const Params& p, int layer, int bid, int nb) {
    const int tid = tid_(), lane = tid & 63, w = tid >> 6, c = lane & 31, hi = lane >> 5;
    const float* ng = p.in[I_HGRN_NG] + (layer / 3) * DM;
    for (int wu = bid * NWAVES + w; wu < 4096; wu += nb * NWAVES) {
        const int u = wu >> 1, tb = wu & 1, bh = u >> 7, cc = u & 127, b = bh >> 3, hh = bh & 7; const size_t tok0 = (size_t)b * SEQ + cc * 64;
        const size_t tokq = tok0 + 32 * tb + c;
        f32x16 o[4];
#pragma unroll
        for (int db = 0; db < 4; ++db)
#pragma unroll
            for (int i = 0; i < 16; ++i) o[db][i] = 0.f;
        {
            bf16x8 qf[8]; load_q(WSP(bf16_t, WS_HQB) + tokq * DM + hh * HD, hi, qf);
            const bf16_t* st = WSP(bf16_t, WS_HST) + (size_t)u * 16384 + (size_t)c * 128 + 8 * hi;
#pragma unroll
            for (int db = 0; db < 4; ++db)
#pragma unroll
                for (int ks = 0; ks < 8; ++ks) o[db] = __builtin_amdgcn_mfma_f32_32x32x16_bf16(*(const bf16x8*)(st + (size_t)(32 * db) * 128 + 16 * ks), qf[ks], o[db], 0, 0, 0);
        }
        {
            bf16x8 qf[8]; load_q(WSP(bf16_t, WS_HQR) + tokq * DM + hh * HD, hi, qf);
            for (int kb = 0; kb <= tb; ++kb) {
                f32x16 s;
#pragma unroll
                for (int i = 0; i < 16; ++i) s[i] = 0.f;
                const bf16_t* kp = WSP(bf16_t, WS_HKR) + (tok0 + 32 * kb + c) * DM + hh * HD + 8 * hi;
#pragma unroll
                for (int ks = 0; ks < 8; ++ks) s = __builtin_amdgcn_mfma_f32_32x32x16_bf16(*(const bf16x8*)(kp + 16 * ks), qf[ks], s, 0, 0, 0);
                if (kb == tb) {
#pragma unroll
                    for (int i = 0; i < 16; ++i) { const int ko = (i & 3) + 8 * (i >> 2) + 4 * hi; if (ko > c) s[i] = 0.f; } }
#pragma unroll
                for (int sq = 0; sq < 2; ++sq) { u32x4 wv; wv.x = cvt_pk_bf16(s[8 * sq], s[8 * sq + 1]); wv.y = cvt_pk_bf16(s[8 * sq + 2], s[8 * sq + 3]); wv.z = cvt_pk_bf16(s[8 * sq + 4], s[8 * sq + 5]); wv.w = cvt_pk_bf16(s[8 * sq + 6], s[8 * sq + 7]);
                    const bf16x8 pf = *reinterpret_cast<bf16x8*>(&wv);
                    const bf16_t* vp = WSP(bf16_t, WS_PVT) + (size_t)(hh * HD + c) * T + tok0 + 32 * kb + 16 * sq + 4 * hi;
#pragma unroll
                    for (int db = 0; db < 4; ++db) { const u32x2 lo = *(const u32x2*)(vp + (size_t)(32 * db) * T), hi2 = *(const u32x2*)(vp + (size_t)(32 * db) * T + 8);
                        u32x4 vv; vv.x = lo.x; vv.y = lo.y; vv.z = hi2.x; vv.w = hi2.y;
                        o[db] = __builtin_amdgcn_mfma_f32_32x32x16_bf16(*reinterpret_cast<bf16x8*>(&vv), pf, o[db], 0, 0, 0); } }
            }
        }
        float ss = 0.f;
#pragma unroll
        for (int db = 0; db < 4; ++db)
#pragma unroll
            for (int i = 0; i < 16; ++i) ss += o[db][i] * o[db][i];
        ss = swap_sum(ss);
        const float rinv = rsqrtf(ss * (1.0f / 128.0f) + RMS_EPS);
        const bf16_t* gt = WSP(bf16_t, WS_PB) + tokq * DM + hh * HD; bf16_t* orow = WSP(bf16_t, WS_MIX) + tokq * OUT_IN + hh * HD;
#pragma unroll
        for (int db = 0; db < 4; ++db)
#pragma unroll
            for (int g = 0; g < 4; ++g) { const int d = 32 * db + 8 * g + 4 * hi; const u32x2 gw = *(const u32x2*)(gt + d); const f32x4 nv = *(const f32x4*)(ng + hh * HD + d);
                u32x2 wv; wv.x = cvt_pk_bf16(o[db][4 * g] * rinv * nv[0] * bflo(gw.x), o[db][4 * g + 1] * rinv * nv[1] * bfhi(gw.x));
                wv.y = cvt_pk_bf16(o[db][4 * g + 2] * rinv * nv[2] * bflo(gw.y), o[db][4 * g + 3] * rinv * nv[3] * bfhi(gw.y));
                *(u32x2*)(orow + d) = wv; }
    }
}

__device__ __forceinline__ void ln_row(f32x4 (&v)[4], const float* g, const float* bta, int lane) {
    float s = 0.f;
#pragma unroll
    for (int j = 0; j < 4; ++j) s += (v[j][0] + v[j][1]) + (v[j][2] + v[j][3]);
    const float mean = wave_sum(s) * (1.0f / DM); float s2 = 0.f;
#pragma unroll
    for (int j = 0; j < 4; ++j) { v[j] = v[j] - mean; s2 += (v[j][0] * v[j][0] + v[j][1] * v[j][1]) + (v[j][2] * v[j][2] + v[j][3] * v[j][3]); }
    const float rstd = rsqrtf(wave_sum(s2) * (1.0f / DM) + LN_EPS);
#pragma unroll
    for (int j = 0; j < 4; ++j) { const f32x4 gg = *(const f32x4*)(g + 256 * j + 4 * lane), bb = *(const f32x4*)(bta + 256 * j + 4 * lane); v[j] = v[j] * rstd * gg + bb; }
}
__device__ __forceinline__ void phase_ln1_router(const Params& p, LAS unsigned char* lds, int layer, int bid, int nb) {
    const int tid = tid_(), lane = tid & 63, w = tid >> 6;
    LAS float* part = (LAS float*)lds;
    LAS float* logit = (LAS float*)(lds + 32768);
    LAS int* asg_e = (LAS int*)(lds + 32768 + 8448 + 64); LAS unsigned* asg_v = (LAS unsigned*)(asg_e + 256);
    const float* g1 = p.in[I_LN1G] + layer * DM; const float* b1 = p.in[I_LN1B] + layer * DM;
    const float* rw = p.in[I_RW] + (size_t)layer * DM * NEXP; const float* rb = p.in[I_RB] + layer * NEXP;
    unsigned* ecnt = ctl(p) + CW_ECNT + layer * 32;
    for (int blk = bid; blk < T / 64; blk += nb) {
        const int row0 = blk * 64;
        for (int rr = 0; rr < 8; ++rr) { const size_t row = row0 + 8 * w + rr; const float* yp = WSP(float, WS_Y1) + row * DM;
            f32x4 v[4];
#pragma unroll
            for (int j = 0; j < 4; ++j) v[j] = *(const f32x4*)(yp + 256 * j + 4 * lane);
            ln_row(v, g1, b1, lane);
#pragma unroll
            for (int j = 0; j < 4; ++j) { *(f32x4*)(WSP(float, WS_X1F) + row * DM + 256 * j + 4 * lane) = v[j];
                u32x2 o; o.x = cvt_pk_bf16(v[j][0], v[j][1]); o.y = cvt_pk_bf16(v[j][2], v[j][3]); *(u32x2*)(WSP(bf16_t, WS_X1B) + row * DM + 256 * j + 4 * lane) = o; } }
        __syncthreads();
        {
            const int rt = w >> 2, kq = w & 3, i = lane & 31, kh = lane >> 5;
            const float* xp = WSP(float, WS_X1F) + (size_t)(row0 + 32 * rt + i) * DM + 256 * kq; const float* wp = rw + (size_t)(256 * kq + kh) * NEXP + i;
            f32x16 acc;
#pragma unroll
            for (int q = 0; q < 16; ++q) acc[q] = 0.f;
#pragma unroll 8
            for (int q = 0; q < 64; ++q) { const f32x4 xv = *(const f32x4*)(xp + 4 * q);
                acc = __builtin_amdgcn_mfma_f32_32x32x2f32(kh ? xv[1] : xv[0], wp[(size_t)(4 * q) * NEXP], acc, 0, 0, 0);
                acc = __builtin_amdgcn_mfma_f32_32x32x2f32(kh ? xv[3] : xv[2], wp[(size_t)(4 * q + 2) * NEXP], acc, 0, 0, 0); }
#pragma unroll
            for (int q = 0; q < 16; ++q) { const int r = (q & 3) + 8 * (q >> 2) + 4 * kh; part[(w * 32 + r) * 32 + i] = acc[q]; }
        }
        __syncthreads();
        for (int o_ = tid; o_ < 64 * 32; o_ += NTHR) { const int r = o_ >> 5, e = o_ & 31, rt = r >> 5, rl = r & 31; float s = rb[e];
#pragma unroll
            for (int kq = 0; kq < 4; ++kq) s += part[((rt * 4 + kq) * 32 + rl) * 32 + e];
            logit[r * 33 + e] = s; }
        __syncthreads();
        if (tid < 64) { const int tok = row0 + tid; float bv[4] = {-__builtin_inff(), -__builtin_inff(), -__builtin_inff(), -__builtin_inff()}; int bi[4] = {0, 0, 0, 0};
            for (int e = 0; e < 32; ++e) { const float x = logit[tid * 33 + e];
                if (x > bv[0]) { bv[3] = bv[2]; bi[3] = bi[2]; bv[2] = bv[1]; bi[2] = bi[1]; bv[1] = bv[0]; bi[1] = bi[0]; bv[0] = x; bi[0] = e; }
                else if (x > bv[1]) { bv[3] = bv[2]; bi[3] = bi[2]; bv[2] = bv[1]; bi[2] = bi[1]; bv[1] = x; bi[1] = e; }
                else if (x > bv[2]) { bv[3] = bv[2]; bi[3] = bi[2]; bv[2] = x; bi[2] = e; }
                else if (x > bv[3]) { bv[3] = x; bi[3] = e; } }
            float ex[4], se = 0.f;
#pragma unroll
            for (int k = 0; k < 4; ++k) { ex[k] = __expf(bv[k] - bv[0]); se += ex[k]; }
#pragma unroll
            for (int k = 0; k < 4; ++k) { WSP(float, WS_GATE)[(size_t)tok * 4 + k] = ex[k] / se; asg_e[tid * 4 + k] = bi[k]; asg_v[tid * 4 + k] = (unsigned)tok * 4u + k; } }
        __syncthreads();
        if (tid < 32) { int cnt = 0;
            for (int a = 0; a < 256; ++a) cnt += (asg_e[a] == tid) ? 1 : 0;
            if (cnt) { unsigned pos = atomicAdd(ecnt + tid, (unsigned)cnt); unsigned* et = WSP(unsigned, WS_ETOK) + (size_t)tid * T;
                for (int a = 0; a < 256; ++a) if (asg_e[a] == tid) et[pos++] = asg_v[a]; } }
        __syncthreads();
    }
}
__device__ __forceinline__ void phase_ln2(const Params& p, int layer, int bid, int nb) {
    const int tid = tid_(), lane = tid & 63, w = tid >> 6;
    const float* g2 = p.in[I_LN2G] + layer * DM; const float* b2 = p.in[I_LN2B] + layer * DM;
    float* dst = (layer == 3) ? p.out : WSP(float, WS_XF);
    for (size_t row = bid * NWAVES + w; row < T; row += (size_t)nb * NWAVES) {
        const float* xp = WSP(float, WS_X1F) + row * DM; const bf16_t* yp = WSP(bf16_t, WS_YE) + row * 4 * DM;
        float gk[4];
#pragma unroll
        for (int k = 0; k < 4; ++k) gk[k] = WSP(float, WS_GATE)[row * 4 + k];
        f32x4 v[4];
#pragma unroll
        for (int j = 0; j < 4; ++j) { v[j] = *(const f32x4*)(xp + 256 * j + 4 * lane) * DN_ALPHA;
#pragma unroll
            for (int k = 0; k < 4; ++k) { const u32x2 y = *(const u32x2*)(yp + (size_t)k * DM + 256 * j + 4 * lane);
                v[j][0] += gk[k] * bflo(y.x); v[j][1] += gk[k] * bfhi(y.x); v[j][2] += gk[k] * bflo(y.y); v[j][3] += gk[k] * bfhi(y.y); } }
        ln_row(v, g2, b2, lane);
#pragma unroll
        for (int j = 0; j < 4; ++j) { *(f32x4*)(dst + row * DM + 256 * j + 4 * lane) = v[j];
            u32x2 o; o.x = cvt_pk_bf16(v[j][0], v[j][1]); o.y = cvt_pk_bf16(v[j][2], v[j][3]); *(u32x2*)(WSP(bf16_t, WS_XB) + row * DM + 256 * j + 4 * lane) = o; }
    }
}

enum { PH_FOXPREP = 18 };
enum { PH_PROLOGUE = 0, PH_PROJ, PH_FOXLOGF, PH_HPRE, PH_HA, PH_HB, PH_HC, PH_FOXATTN, PH_KMEAN, PH_GATE, PH_PAST, PH_OWN, PH_MEMATTN, PH_OUTPROJ, PH_LN1, PH_UP, PH_DOWN, PH_LN2 };
template <int PH>
__device__ __forceinline__ void run_phase(const Params& p, LAS unsigned char* lds, int layer, int bid, int nb) {
    if constexpr (PH == PH_PROLOGUE) phase_prologue(p, lds, bid, nb);
    else if constexpr (PH == PH_PROJ) phase_proj(p, lds, layer, bid, nb);
    else if constexpr (PH == PH_FOXLOGF) phase_fox_logf(p, layer, bid, nb);
    else if constexpr (PH == PH_HPRE) phase_hgrn_pre(p, layer, bid, nb);
    else if constexpr (PH == PH_HA) phase_hgrn_a(p, bid, nb);
    else if constexpr (PH == PH_HB) phase_hgrn_b(p, bid, nb);
    else if constexpr (PH == PH_HC) phase_hgrn_c(p, layer, bid, nb);
    else if constexpr (PH == PH_FOXATTN) phase_fox_attn(p, lds, layer, bid, nb);
    else if constexpr (PH == PH_FOXPREP) phase_fox_prep(p, bid, nb);
    else if constexpr (PH == PH_KMEAN) phase_moba_kmean(p, lds, bid, nb);
    else if constexpr (PH == PH_GATE) phase_moba_gate(p, lds, bid, nb);
    else if constexpr (PH == PH_PAST) phase_moba_past(p, lds, bid, nb);
    else if constexpr (PH == PH_OWN) phase_moba_own(p, lds, bid, nb);
    else if constexpr (PH == PH_MEMATTN) phase_memattn(p, lds, bid, nb);
    else if constexpr (PH == PH_OUTPROJ) phase_outproj(p, lds, layer, bid, nb);
    else if constexpr (PH == PH_LN1) phase_ln1_router(p, lds, layer, bid, nb);
    else if constexpr (PH == PH_UP) phase_moe_up(p, lds, layer, bid, nb);
    else if constexpr (PH == PH_DOWN) phase_moe_down(p, lds, layer, bid, nb);
    else if constexpr (PH == PH_LN2) phase_ln2(p, layer, bid, nb);
}
template <int PH>
__global__ void __launch_bounds__(NTHR, 2) k_phase(Params p, int layer) {
    extern __shared__ __attribute__((aligned(16))) unsigned char lds_raw[];
    run_phase<PH>(p, (LAS unsigned char*)lds_raw, layer, (int)blockIdx.x, (int)gridDim.x);
}

#ifndef DEBUG_CHECKS
#define DEBUG_CHECKS 0
#endif
#if DEBUG_CHECKS
constexpr size_t WS_CHK = WS_END;
__device__ __forceinline__ float bfr(float x) { return bf2f(f2bf(x)); }
__device__ __forceinline__ unsigned hashu(unsigned x) { x ^= x >> 16; x *= 0x7feb352du; x ^= x >> 15; x *= 0x846ca68bu; x ^= x >> 16; return x; }
__device__ __forceinline__ void chk_report(const Params& p, int id, float err) { if (!(err == err)) err = 1e30f; atomicMax(ctl(p) + CW_CHK + id, __float_as_uint(fabsf(err))); }
__device__ __forceinline__ float blk_sum(float v, LAS float* red) {
    v = wave_sum(v); const int w = threadIdx.x >> 6, nw = blockDim.x >> 6; __syncthreads(); if ((threadIdx.x & 63) == 0) red[w] = v; __syncthreads(); float s = 0.f; for (int i = 0; i < nw; ++i) s += red[i]; return s; }
__device__ __forceinline__ float blk_max(float v, LAS float* red) {
#pragma unroll
    for (int o = 1; o < 64; o <<= 1) v = fmaxf(v, __shfl_xor(v, o));
    const int w = threadIdx.x >> 6, nw = blockDim.x >> 6; __syncthreads(); if ((threadIdx.x & 63) == 0) red[w] = v; __syncthreads(); float s = red[0]; for (int i = 1; i < nw; ++i) s = fmaxf(s, red[i]); return s; }

__global__ void chk_proj(Params p, int layer, int id) {
    const int kind = layer % 3, jj = layer / 3; const unsigned sidx = blockIdx.x * blockDim.x + threadIdx.x; const unsigned hsh = hashu(sidx * 2654435761u + layer * 977u + 12345u);
    const int nin = kind == 0 ? HGRN_IN : (kind == 1 ? FOX_IN : MOBA_IN);
    const float* W = kind == 0 ? p.in[I_HGRN_W] + (size_t)jj * DM * HGRN_IN : (kind == 1 ? p.in[I_FOX_W] : p.in[I_MOBA_W]);
    int tok = hsh % T; int col = (hsh >> 14) % (nin + 128);
    float exp_v, got;
    if (col >= nin) {
        const int c = (hashu(hsh) % 1024), row = tok % 512; const float* wk = p.in[I_WKV] + (size_t)layer * DM * 1024; float s = 0.f;
        for (int k = 0; k < DM; ++k) s += bfr(p.in[I_MEM][(size_t)row * DM + k]) * bfr(wk[(size_t)k * 1024 + c]);
        exp_v = s; got = c < 512 ? bf2f(WSP(bf16_t, WS_MEMK)[(size_t)row * 512 + c]) : bf2f(WSP(bf16_t, WS_MEMVT)[(size_t)(c - 512) * 512 + row]);
    } else {
        float s = 0.f, sf = 0.f;
        for (int k = 0; k < DM; ++k) { const float xv = (layer == 0) ? p.in[I_X][(size_t)tok * DM + k] : WSP(float, WS_XF)[(size_t)tok * DM + k]; const float xb = (layer == 0) ? bfr(xv) : bf2f(WSP(bf16_t, WS_XB)[(size_t)tok * DM + k]);
            const float wv = W[(size_t)k * nin + col]; s += xb * bfr(wv); sf += xv * wv; }
        const int sec = col >> 10, c = col & 1023; exp_v = s;
        if (kind == 0) { if (sec == 0) { exp_v = siluf_(s); got = bf2f(WSP(bf16_t, WS_PA)[(size_t)tok * DM + c]); } else if (sec == 1) got = WSP(float, WS_PZ)[(size_t)tok * DM + c];
            else if (sec == 2) got = bf2f(WSP(bf16_t, WS_PVT)[(size_t)c * T + tok]); else if (sec == 3) { exp_v = siluf_(s); got = bf2f(WSP(bf16_t, WS_PB)[(size_t)tok * DM + c]); } else got = bf2f(WSP(bf16_t, WS_PMQ)[(size_t)tok * MEMW + c]); }
        else { if (sec == 0) got = bf2f(WSP(bf16_t, WS_PA)[(size_t)tok * DM + c]); else if (sec == 1) got = bf2f(WSP(bf16_t, WS_PB)[(size_t)tok * DM + c]); else if (sec == 2) got = bf2f(WSP(bf16_t, WS_PVT)[(size_t)c * T + tok]);
            else if (kind == 1 && col < 3080) { exp_v = logsigmoidf_(sf + p.in[I_FOX_BF][jj * NH + (col - 3072)]) * LOG2E; got = WSP(float, WS_LOGF)[((size_t)(tok / SEQ) * NH + (col - 3072)) * SEQ + tok % SEQ]; }
            else got = bf2f(WSP(bf16_t, WS_PMQ)[(size_t)tok * MEMW + (col - (kind == 1 ? 3080 : 3072))]); }
    }
    chk_report(p, id, fabsf(got - exp_v) / (fabsf(exp_v) + 0.05f));
}
__global__ void chk_fox_prep(Params p) { const int bh = threadIdx.x; if (bh < 16) { float s = 0.f; for (int k = 0; k < SEQ; ++k) { s += WSP(float, WS_LOGF)[(size_t)bh * SEQ + k]; WSP(float, WS_CHK)[(size_t)bh * SEQ + k] = s; } } }
__device__ __forceinline__ float chk_softmax_out(const Params& p, LAS float* sc, const LAS int* kp, int n, int b, int h, int tok, LAS float* red) {
    float mx = -1e30f; for (int i = threadIdx.x; i < n; i += blockDim.x) mx = fmaxf(mx, sc[i]); mx = blk_max(mx, red);
    float sm = 0.f; for (int i = threadIdx.x; i < n; i += blockDim.x) { const float e = exp2f(sc[i] - mx); sc[i] = e; sm += e; } sm = blk_sum(sm, red);
    float err = 0.f, mag = 0.f;
    if (threadIdx.x < 128) { const int d = threadIdx.x; float o = 0.f; for (int i = 0; i < n; ++i) o += sc[i] * bf2f(WSP(bf16_t, WS_PVT)[(size_t)(h * HD + d) * T + (size_t)b * SEQ + (kp ? kp[i] : i)]);
        o /= sm; const float got = bf2f(WSP(bf16_t, WS_MIX)[(size_t)tok * OUT_IN + h * HD + d]); err = fabsf(got - o); mag = fabsf(o); }
    err = blk_max(err, red); mag = blk_max(mag, red); return err / (mag + 1e-3f);
}
__global__ void chk_fox(Params p, int id) {
    extern __shared__ __attribute__((aligned(16))) unsigned char sm_raw[]; LAS float* sc = (LAS float*)sm_raw; LAS float* red = sc + 8192;
    const unsigned hsh = hashu(blockIdx.x * 7919u + 17u); const int b = hsh & 1, h = (hsh >> 1) & 7; int q = (hsh >> 4) % SEQ; if (blockIdx.x < 8) q = blockIdx.x * 37; if (blockIdx.x == 8) q = SEQ - 1;
    const int tok = b * SEQ + q; const float* c2 = WSP(float, WS_CHK) + (size_t)(b * NH + h) * SEQ;
    for (int k = threadIdx.x; k <= q; k += blockDim.x) { float s = 0.f; for (int d = 0; d < HD; ++d) s += bf2f(WSP(bf16_t, WS_PA)[(size_t)tok * DM + h * HD + d]) * bf2f(WSP(bf16_t, WS_PB)[((size_t)b * SEQ + k) * DM + h * HD + d]);
        sc[k] = s * QK_SCALE * LOG2E + c2[q] - c2[k]; }
    __syncthreads();
    const float e = chk_softmax_out(p, sc, nullptr, q + 1, b, h, tok, red);
    if (threadIdx.x == 0) chk_report(p, id, e);
}
__global__ void chk_moba(Params p, int id) {
    extern __shared__ __attribute__((aligned(16))) unsigned char sm_raw[]; LAS float* sc = (LAS float*)sm_raw; LAS int* kp = (LAS int*)(sc + 1024); LAS float* km = (LAS float*)(kp + 1024); LAS float* red = km + 32 * 128; LAS float* gate = red + 16; LAS int* selb = (LAS int*)(gate + 32);
    const unsigned hsh = hashu(blockIdx.x * 7919u + 29u); const int b = hsh & 1, h = (hsh >> 1) & 7; int q = (hsh >> 4) % SEQ; if (blockIdx.x < 6) q = blockIdx.x * 173; if (blockIdx.x == 6) q = 256; if (blockIdx.x == 7) q = 1024 + 5;
    const int own = q >> 8, tok = b * SEQ + q;
    for (int idx = threadIdx.x; idx < own * 128; idx += blockDim.x) { const int j = idx >> 7, d = idx & 127; float s = 0.f; for (int k = 0; k < 256; ++k) s += bf2f(WSP(bf16_t, WS_PB)[((size_t)b * SEQ + j * 256 + k) * DM + h * HD + d]); km[idx] = s * (1.0f / 256.0f); }
    __syncthreads();
    if ((int)threadIdx.x < own) { float g = 0.f; for (int d = 0; d < HD; ++d) g += bf2f(WSP(bf16_t, WS_PA)[(size_t)tok * DM + h * HD + d]) * km[threadIdx.x * 128 + d]; gate[threadIdx.x] = g; }
    __syncthreads();
    if (threadIdx.x == 0) { int nsel = own < 3 ? own : 3; for (int s = 0; s < nsel; ++s) { int bj = -1; float bv = -__builtin_inff(); for (int j = 0; j < own; ++j) { bool used = false; for (int r = 0; r < s; ++r) used |= (selb[r] == j); if (!used && gate[j] > bv) { bv = gate[j]; bj = j; } } selb[s] = bj; }
        int n = 0; for (int s = 0; s < nsel; ++s) for (int k = 0; k < 256; ++k) kp[n++] = selb[s] * 256 + k; for (int k = own * 256; k <= q; ++k) kp[n++] = k; selb[3] = n; }
    __syncthreads();
    const int n = selb[3];
    for (int i = threadIdx.x; i < n; i += blockDim.x) { const int k = kp[i]; float s = 0.f; for (int d = 0; d < HD; ++d) s += bf2f(WSP(bf16_t, WS_PA)[(size_t)tok * DM + h * HD + d]) * bf2f(WSP(bf16_t, WS_PB)[((size_t)b * SEQ + k) * DM + h * HD + d]);
        sc[i] = (s * QK_SCALE + p.in[I_RELB][t5_bucket(q - k) * NH + h]) * LOG2E; }
    __syncthreads();
    const float e = chk_softmax_out(p, sc, kp, n, b, h, tok, red);
    if (threadIdx.x == 0) chk_report(p, id, e);
}
__global__ void chk_hgrn(Params p, int layer, int id) {
    extern __shared__ __attribute__((aligned(16))) unsigned char sm_raw[]; LAS float* a = (LAS float*)sm_raw; LAS float* red = a + 512;
    const int jj = layer / 3; const unsigned hsh = hashu(blockIdx.x * 7919u + 41u); const int b = hsh & 1, h = (hsh >> 1) & 7; const int tl[8] = {0, 5, 63, 64, 100, 130, 200, 300}; const int t = tl[blockIdx.x & 7] + ((blockIdx.x >> 3) & 1) * 4096;
    const int t0 = t & ~4095;
    const int d = threadIdx.x, ch = h * HD + d; const float lb = (jj == 0) ? 0.f : sigmoidf_(p.in[I_HGRN_LB][DM + ch] - p.in[I_HGRN_LB][ch]);
    for (int i = d; i < 512; i += 128) a[i] = 0.f;
    __syncthreads();
    if (t0 == 0) {
        float Bt = 0.f; for (int s = 0; s <= t; ++s) { const float z = WSP(float, WS_PZ)[((size_t)b * SEQ + s) * DM + ch]; const float ls = logsigmoidf_(z); Bt += (lb == 0.f) ? ls : logf(lb + (1.f - lb) * expf(ls)); }
        const float qv = bf2f(WSP(bf16_t, WS_PA)[((size_t)b * SEQ + t) * DM + ch]); float Bs = 0.f;
        for (int s = 0; s <= t; ++s) { const float z = WSP(float, WS_PZ)[((size_t)b * SEQ + s) * DM + ch]; const float ls = logsigmoidf_(z); Bs += (lb == 0.f) ? ls : logf(lb + (1.f - lb) * expf(ls));
            const float kk = (1.f - lb) * sigmoidf_(-z); atomicAdd((float*)&a[s], qv * kk * expf(Bt - Bs)); }
        __syncthreads();
        float o = 0.f; for (int s = 0; s <= t; ++s) o += a[s] * bf2f(WSP(bf16_t, WS_PVT)[(size_t)ch * T + (size_t)b * SEQ + s]);
        const float ss = blk_sum(o * o, red); const float rinv = rsqrtf(ss * (1.0f / 128.0f) + RMS_EPS);
        const size_t tok = (size_t)b * SEQ + t; const float ex = o * rinv * p.in[I_HGRN_NG][jj * DM + ch] * bf2f(WSP(bf16_t, WS_PB)[tok * DM + ch]);
        const float got = bf2f(WSP(bf16_t, WS_MIX)[tok * OUT_IN + ch]);
        const float err = blk_max(fabsf(got - ex), red), mag = blk_max(fabsf(ex), red);
        if (threadIdx.x == 0) chk_report(p, id, err / (mag + 1e-3f));
    }
}
__global__ void chk_memattn(Params p, int id) {
    extern __shared__ __attribute__((aligned(16))) unsigned char sm_raw[]; LAS float* sc = (LAS float*)sm_raw; LAS float* red = sc + 256;
    const unsigned hsh = hashu(blockIdx.x * 7919u + 53u); const int tok = hsh % T, mh = (hsh >> 16) & 3, b = tok / SEQ, k = threadIdx.x;
    float s = 0.f; for (int d = 0; d < HD; ++d) s += bf2f(WSP(bf16_t, WS_PMQ)[(size_t)tok * MEMW + mh * HD + d]) * bf2f(WSP(bf16_t, WS_MEMK)[(size_t)(b * MEMT + k) * MEMW + mh * HD + d]);
    sc[k] = s * QK_SCALE * LOG2E; __syncthreads();
    float mx = blk_max(sc[k], red); const float e = exp2f(sc[k] - mx); __syncthreads(); sc[k] = e; const float sm = blk_sum(e, red);
    float err = 0.f, mag = 0.f;
    if (k < 128) { float o = 0.f; for (int i = 0; i < 256; ++i) o += sc[i] * bf2f(WSP(bf16_t, WS_MEMVT)[(size_t)(mh * HD + k) * 512 + b * MEMT + i]); o /= sm;
        const float got = bf2f(WSP(bf16_t, WS_MIX)[(size_t)tok * OUT_IN + DM + mh * HD + k]); err = fabsf(got - o); mag = fabsf(o); }
    err = blk_max(err, red); mag = blk_max(mag, red);
    if (threadIdx.x == 0) chk_report(p, id, err / (mag + 1e-3f));
}
__global__ void chk_out_ln1(Params p, int layer, int id) {
    extern __shared__ __attribute__((aligned(16))) unsigned char sm_raw[]; LAS float* red = (LAS float*)sm_raw;
    const unsigned hsh = hashu(blockIdx.x * 7919u + 67u + layer); const int tok = hsh % T; const float* wo = p.in[I_WOUT] + (size_t)layer * OUT_IN * DM; const float* xr = layer == 0 ? p.in[I_X] : WSP(float, WS_XF);
    float y[2];
    for (int e = 0; e < 2; ++e) { const int c = threadIdx.x + 512 * e; float s = 0.f; for (int k = 0; k < OUT_IN; ++k) s += bf2f(WSP(bf16_t, WS_MIX)[(size_t)tok * OUT_IN + k]) * bfr(wo[(size_t)k * DM + c]); y[e] = s + DN_ALPHA * xr[(size_t)tok * DM + c]; }
    const float mean = blk_sum(y[0] + y[1], red) * (1.0f / DM); const float var = blk_sum((y[0] - mean) * (y[0] - mean) + (y[1] - mean) * (y[1] - mean), red) * (1.0f / DM); const float rstd = rsqrtf(var + LN_EPS);
    float err = 0.f;
    for (int e = 0; e < 2; ++e) { const int c = threadIdx.x + 512 * e; const float x1 = (y[e] - mean) * rstd * p.in[I_LN1G][layer * DM + c] + p.in[I_LN1B][layer * DM + c]; err = fmaxf(err, fabsf(x1 - WSP(float, WS_X1F)[(size_t)tok * DM + c])); }
    err = blk_max(err, red); if (threadIdx.x == 0) chk_report(p, id, err);
}
__global__ void chk_moe(Params p, int layer, int id) {
    extern __shared__ __attribute__((aligned(16))) unsigned char sm_raw[]; LAS float* hb = (LAS float*)sm_raw; LAS float* act = hb + 2048; LAS float* red = act + 1024; LAS float* lg = red + 16; LAS float* gt = lg + 32; LAS int* ei = (LAS int*)(gt + 4);
    const unsigned hsh = hashu(blockIdx.x * 7919u + 79u + layer); const int tok = hsh % T; const int tid = threadIdx.x;
    if (tid < 32) { float s = p.in[I_RB][layer * NEXP + tid]; for (int k = 0; k < DM; ++k) s += WSP(float, WS_X1F)[(size_t)tok * DM + k] * p.in[I_RW][((size_t)layer * DM + k) * NEXP + tid]; lg[tid] = s; }
    __syncthreads();
    if (tid == 0) { float v[4]; for (int s = 0; s < 4; ++s) { int bj = -1; float bv = -__builtin_inff(); for (int j = 0; j < 32; ++j) { bool used = false; for (int r = 0; r < s; ++r) used |= (ei[r] == j); if (!used && lg[j] > bv) { bv = lg[j]; bj = j; } } ei[s] = bj; v[s] = bv; }
        float se = 0.f; for (int s = 0; s < 4; ++s) { v[s] = expf(v[s] - lg[ei[0]]); se += v[s]; } for (int s = 0; s < 4; ++s) gt[s] = v[s] / se; }
    __syncthreads();
    float ysum[2] = {0.f, 0.f};
    for (int s = 0; s < 4; ++s) { const int e = ei[s]; const float* wu = p.in[I_WUP] + ((size_t)layer * NEXP + e) * DM * 2 * DFF; const float* wd = p.in[I_WDN] + ((size_t)layer * NEXP + e) * DFF * DM;
        for (int q = 0; q < 4; ++q) { const int c = tid + 512 * q; float a = p.in[I_BUP][((size_t)layer * NEXP + e) * 2 * DFF + c]; for (int k = 0; k < DM; ++k) a += bf2f(WSP(bf16_t, WS_X1B)[(size_t)tok * DM + k]) * bfr(wu[(size_t)k * 2 * DFF + c]); hb[c] = a; }
        __syncthreads();
        for (int q = 0; q < 2; ++q) { const int f = tid + 512 * q; const float glu = fminf(hb[2 * f], 7.f), lin = fminf(fmaxf(hb[2 * f + 1], -7.f), 7.f); act[f] = bfr(glu * sigmoidf_(1.702f * glu) * (lin + 1.f)); }
        __syncthreads();
        for (int q = 0; q < 2; ++q) { const int c = tid + 512 * q; float a = p.in[I_BDN][((size_t)layer * NEXP + e) * DM + c]; for (int f = 0; f < DFF; ++f) a += act[f] * bfr(wd[(size_t)f * DM + c]); ysum[q] += gt[s] * bfr(a); }
        __syncthreads(); }
    float y[2]; for (int q = 0; q < 2; ++q) y[q] = DN_ALPHA * WSP(float, WS_X1F)[(size_t)tok * DM + tid + 512 * q] + ysum[q];
    const float mean = blk_sum(y[0] + y[1], red) * (1.0f / DM); const float var = blk_sum((y[0] - mean) * (y[0] - mean) + (y[1] - mean) * (y[1] - mean), red) * (1.0f / DM); const float rstd = rsqrtf(var + LN_EPS);
    const float* dst = (layer == 3) ? p.out : WSP(float, WS_XF); float err = 0.f;
    for (int q = 0; q < 2; ++q) { const int c = tid + 512 * q; const float x2 = (y[q] - mean) * rstd * p.in[I_LN2G][layer * DM + c] + p.in[I_LN2B][layer * DM + c]; err = fmaxf(err, fabsf(x2 - dst[(size_t)tok * DM + c])); }
    err = blk_max(err, red); if (tid == 0) chk_report(p, id, err);
}
__global__ void chk_finalize(Params p, int nchk, float tol) {
    int fail = 0; float ferr = 0.f;
    for (int i = 1; i <= nchk; ++i) { const float e = __uint_as_float(ctl(p)[CW_CHK + i]); if (!(e <= tol)) { fail = i; ferr = e; break; } }
    if (!fail) return;
    int cls = 0; float r = ferr / tol; while (r >= 10.f && cls < 9) { r *= 0.1f; ++cls; }
    const float s = sqrtf((1.0f + 0.1f * fail) * powf(10.f, 8.f + cls));
    for (size_t i = (size_t)blockIdx.x * blockDim.x + threadIdx.x; i < (size_t)T * DM; i += (size_t)gridDim.x * blockDim.x) p.out[i] = (i & 1) ? s : -s;
}
#endif

#define GBAR() xcd_barrier(bar)
#ifndef DUPMASK
#define DUPMASK 0
#endif
#define DUP(bit, stmt) do { stmt; if (DUPMASK & (1 << (bit))) { GBAR(); stmt; } } while (0)
template <int LAYER>
__device__ __forceinline__ void run_layer(const Params& p, LAS unsigned char* lds, const XcdBarrier& bar, int bid, int nb) {
    constexpr int kind = LAYER % 3;
    if constexpr (kind == 1) run_phase<PH_FOXLOGF>(p, lds, LAYER, bid, nb);
    DUP(1, run_phase<PH_PROJ>(p, lds, LAYER, bid, nb)); GBAR();
    if constexpr (kind == 0) {
        DUP(2, run_phase<PH_HPRE>(p, lds, LAYER, bid, nb)); GBAR();
        DUP(2, run_phase<PH_HA>(p, lds, LAYER, bid, nb)); GBAR();
        run_phase<PH_HB>(p, lds, LAYER, bid, nb); GBAR();
        DUP(2, run_phase<PH_HC>(p, lds, LAYER, bid, nb));
        DUP(5, run_phase<PH_MEMATTN>(p, lds, LAYER, bid, nb)); GBAR();
    } else if constexpr (kind == 1) {
        run_phase<PH_FOXPREP>(p, lds, LAYER, bid, nb);
        DUP(5, run_phase<PH_MEMATTN>(p, lds, LAYER, bid, nb)); GBAR();
        run_phase<PH_FOXATTN>(p, lds, LAYER, bid, nb); GBAR();
    } else {
        DUP(4, run_phase<PH_KMEAN>(p, lds, LAYER, bid, nb));
        DUP(5, run_phase<PH_MEMATTN>(p, lds, LAYER, bid, nb)); GBAR();
        run_phase<PH_GATE>(p, lds, LAYER, bid, nb); GBAR();
        DUP(4, run_phase<PH_PAST>(p, lds, LAYER, bid, nb)); GBAR();
        DUP(4, run_phase<PH_OWN>(p, lds, LAYER, bid, nb)); GBAR();
    }
    DUP(6, run_phase<PH_OUTPROJ>(p, lds, LAYER, bid, nb)); GBAR();
    run_phase<PH_LN1>(p, lds, LAYER, bid, nb); GBAR();
    DUP(7, run_phase<PH_UP>(p, lds, LAYER, bid, nb)); GBAR();
    DUP(8, run_phase<PH_DOWN>(p, lds, LAYER, bid, nb)); GBAR();
    DUP(9, run_phase<PH_LN2>(p, lds, LAYER, bid, nb));
    if constexpr (LAYER < 3) GBAR();
}
__global__ void __launch_bounds__(NTHR, 2) k_mega(Params p) {
    extern __shared__ __attribute__((aligned(16))) unsigned char lds_raw[];
    LAS unsigned char* lds = (LAS unsigned char*)lds_raw;
    volatile LAS unsigned* bw = (volatile LAS unsigned*)(lds + LDS_MISC);
    if (threadIdx.x < 4) bw[threadIdx.x] = 0u;
    __syncthreads();
    const XcdBarrier bar = xcd_barrier_post(ctl(p) + CW_BAR, bw);
    const int bid = (int)blockIdx.x, nb = (int)gridDim.x;
    DUP(0, run_phase<PH_PROLOGUE>(p, lds, 0, bid, nb)); GBAR();
    run_layer<0>(p, lds, bar, bid, nb);
    run_layer<1>(p, lds, bar, bid, nb);
    run_layer<2>(p, lds, bar, bid, nb);
    run_layer<3>(p, lds, bar, bid, nb);
}

template <int PH> static void launch_phase(const Params& p, int layer, int grid, hipStream_t stream) {
    static bool attr = false;
    if (!attr) { (void)hipFuncSetAttribute((const void*)k_phase<PH>, hipFuncAttributeMaxDynamicSharedMemorySize, LDS_BYTES); attr = true; }
    hipLaunchKernelGGL(k_phase<PH>, dim3(grid), dim3(NTHR), LDS_BYTES, stream, p, layer);
}
extern "C" void kernel_launch(void* const* d_in, const int* in_sizes, int n_in, void* d_out, int out_size, void* d_ws, size_t ws_size, hipStream_t stream) {
    if (n_in != 21 || out_size != T * DM || ws_size < WS_END + 2 * MiB) { fprintf(stderr, "kernel_launch: unexpected problem (n_in %d out %d ws %zu need %zu)\n", n_in, out_size, ws_size, (size_t)(WS_END + 2 * MiB)); return; }
    Params p{};
    for (int i = 0; i < 21; ++i) p.in[i] = (const float*)d_in[i];
    p.out = (float*)d_out; p.ws = (unsigned char*)d_ws;
    (void)hipMemsetAsync((char*)d_ws + WS_CTL, 0, CTL_BYTES, stream);
    const int G = 256;
#if MEGA
    {
        static int ok = 0;
        if (!ok) { int dev = 0, cus = 0; (void)hipGetDevice(&dev); (void)hipDeviceGetAttribute(&cus, hipDeviceAttributeMultiprocessorCount, dev);
            (void)hipFuncSetAttribute((const void*)k_mega, hipFuncAttributeMaxDynamicSharedMemorySize, LDS_BYTES);
            int per_cu = 0; (void)hipOccupancyMaxActiveBlocksPerMultiprocessor(&per_cu, (const void*)k_mega, NTHR, LDS_BYTES); (void)hipGetLastError();
            if (cus < G || per_cu < 1) { fprintf(stderr, "kernel_launch: need %d CUs with one resident workgroup each (cus %d, per_cu %d)\n", G, cus, per_cu); ok = -1; } else ok = 1; }
        if (ok < 0) return;
        hipLaunchKernelGGL(k_mega, dim3(G), dim3(NTHR), LDS_BYTES, stream, p);
        return;
    }
#endif
    launch_phase<PH_PROLOGUE>(p, 0, G, stream);
    for (int layer = 0; layer < 4; ++layer) {
        const int kind = layer % 3;
        if (kind == 1) launch_phase<PH_FOXLOGF>(p, layer, G, stream);
        launch_phase<PH_PROJ>(p, layer, G, stream);
#if DEBUG_CHECKS
        hipLaunchKernelGGL(chk_proj, dim3(64), dim3(256), 0, stream, p, layer, layer * 5 + 1);
#endif
        if (kind == 0) { launch_phase<PH_HPRE>(p, layer, G, stream); launch_phase<PH_HA>(p, layer, G, stream); launch_phase<PH_HB>(p, layer, G, stream); launch_phase<PH_HC>(p, layer, G, stream); }
        else if (kind == 1) { launch_phase<PH_FOXPREP>(p, layer, G, stream); launch_phase<PH_FOXATTN>(p, layer, G, stream); }
        else { launch_phase<PH_KMEAN>(p, layer, G, stream); launch_phase<PH_GATE>(p, layer, G, stream); launch_phase<PH_PAST>(p, layer, G, stream); launch_phase<PH_OWN>(p, layer, G, stream); }
        launch_phase<PH_MEMATTN>(p, layer, G, stream);
#if DEBUG_CHECKS
        if (kind == 0) hipLaunchKernelGGL(chk_hgrn, dim3(16), dim3(128), 4096, stream, p, layer, layer * 5 + 2);
        else if (kind == 1) { hipLaunchKernelGGL(chk_fox_prep, dim3(1), dim3(64), 0, stream, p); hipLaunchKernelGGL(chk_fox, dim3(48), dim3(256), 8192 * 4 + 256, stream, p, layer * 5 + 2); }
        else hipLaunchKernelGGL(chk_moba, dim3(48), dim3(256), 32768, stream, p, layer * 5 + 2);
        hipLaunchKernelGGL(chk_memattn, dim3(64), dim3(256), 2048, stream, p, layer * 5 + 3);
#endif
        launch_phase<PH_OUTPROJ>(p, layer, G, stream);
        launch_phase<PH_LN1>(p, layer, G, stream);
#if DEBUG_CHECKS
        hipLaunchKernelGGL(chk_out_ln1, dim3(32), dim3(512), 256, stream, p, layer, layer * 5 + 4);
#endif
        launch_phase<PH_UP>(p, layer, G, stream);
        launch_phase<PH_DOWN>(p, layer, G, stream);
        launch_phase<PH_LN2>(p, layer, G, stream);
#if DEBUG_CHECKS
        hipLaunchKernelGGL(chk_moe, dim3(16), dim3(512), 16384, stream, p, layer, layer * 5 + 5);
#endif
    }
#if DEBUG_CHECKS
    hipLaunchKernelGGL(chk_finalize, dim3(1024), dim3(256), 0, stream, p, 20, 0.04f);
#endif
}
```

```cpp
#include <hip/hip_runtime.h>
#include <cstdio>
#include <cstdint>

#ifndef MEGA
#define MEGA 1
#endif

#define LAS __attribute__((address_space(3)))
#define GAS __attribute__((address_space(1)))
typedef unsigned short bf16_t;
typedef short bf16x8 __attribute__((ext_vector_type(8)));
typedef float f32x4 __attribute__((ext_vector_type(4)));
typedef float f32x2 __attribute__((ext_vector_type(2)));
typedef float f32x16 __attribute__((ext_vector_type(16)));
typedef unsigned u32x4 __attribute__((ext_vector_type(4)));
typedef unsigned u32x2 __attribute__((ext_vector_type(2)));

constexpr int BATCH = 2, SEQ = 8192, T = BATCH * SEQ, DM = 1024, NH = 8, HD = 128, MH = 4, MEMT = 256, MEMW = 512;
constexpr int NEXP = 32, TOPK = 4, DFF = 1024, OUT_IN = 1536;
constexpr int HGRN_IN = 4608, FOX_IN = 3592, MOBA_IN = 3584;
constexpr float DN_ALPHA = 1.681792830507429f;
constexpr float LN_EPS = 1e-5f, RMS_EPS = 1e-6f;
constexpr float LOG2E = 1.4426950408889634f;
constexpr float QK_SCALE = 0.08838834764831845f;
constexpr int NTHR = 512, NWAVES = 8;

typedef __bf16 bf16x2_t __attribute__((ext_vector_type(2)));
__device__ __forceinline__ unsigned cvt_pk_bf16(float lo, float hi) { f32x2 v = {lo, hi}; bf16x2_t r = __builtin_convertvector(v, bf16x2_t); return __builtin_bit_cast(unsigned, r); }
__device__ __forceinline__ float bf2f(bf16_t b) { return __uint_as_float(((unsigned)b) << 16); }
__device__ __forceinline__ float bflo(unsigned w) { return __uint_as_float(w << 16); }
__device__ __forceinline__ float bfhi(unsigned w) { return __uint_as_float(w & 0xffff0000u); }
__device__ __forceinline__ bf16_t f2bf(float f) { return (bf16_t)(cvt_pk_bf16(f, 0.f) & 0xffffu); }
__device__ __forceinline__ float fast_exp2(float x) { return __builtin_amdgcn_exp2f(x); }
__device__ __forceinline__ float fast_rcp(float x) { return __builtin_amdgcn_rcpf(x); }
__device__ __forceinline__ float sigmoidf_(float x) { return fast_rcp(1.0f + fast_exp2(-LOG2E * x)); }
__device__ __forceinline__ float siluf_(float x) { return x * fast_rcp(1.0f + fast_exp2(-LOG2E * x)); }
__device__ __forceinline__ float logsigmoidf_(float z) { return fminf(z, 0.f) - log1pf(__expf(-fabsf(z))); }
__device__ __forceinline__ float wave_sum(float v) {
#pragma unroll
    for (int o = 1; o < 64; o <<= 1) v += __shfl_xor(v, o);
    return v;
}
__device__ __forceinline__ float swap_max(float x) { auto rr = __builtin_amdgcn_permlane32_swap(__float_as_uint(x), __float_as_uint(x), false, false); return fmaxf(__uint_as_float(rr[0]), __uint_as_float(rr[1])); }
__device__ __forceinline__ float swap_sum(float x) { auto rr = __builtin_amdgcn_permlane32_swap(__float_as_uint(x), __float_as_uint(x), false, false); return __uint_as_float(rr[0]) + __uint_as_float(rr[1]); }

__device__ __forceinline__ int tid_() { int t = threadIdx.x; asm volatile("" : "+v"(t)); return t; }

#define XB_TMO      128
#define XB_XCNT(j)  (256  + 64 * (j))
#define XB_XSUB(j)  (1280 + 64 * (j))
#define XB_XGEN(j)  (2304 + 64 * (j))
#define XB_TOP      3328
#define XB_TOPGEN   3392
#define XCD_BAR_WORDS 3456
#define XB_SPIN_CAP (1u << 18)
__device__ __forceinline__ unsigned xb_ld(unsigned* p)              { return __hip_atomic_load(p, __ATOMIC_RELAXED, __HIP_MEMORY_SCOPE_AGENT); }
__device__ __forceinline__ unsigned xb_add(unsigned* p, unsigned v) { return __hip_atomic_fetch_add(p, v, __ATOMIC_RELAXED, __HIP_MEMORY_SCOPE_AGENT); }
__device__ __forceinline__ unsigned xb_xcc_id() { return (unsigned)__builtin_amdgcn_s_getreg((3 << 11) | 20) & 0xFu; }
#define XB_SPIN(cond, bar) do { unsigned _sp = 0; while (cond) { __builtin_amdgcn_s_sleep(1); \
    if ((++_sp & 255u) == 0u) { if (xb_ld(&(bar)[XB_TMO])) break; if (_sp > XB_SPIN_CAP) { atomicAdd(&(bar)[XB_TMO], 1u); break; } } } } while (0)
struct XcdBarrier { unsigned* bar; unsigned x; volatile LAS unsigned* st; };
__device__ __forceinline__ XcdBarrier xcd_barrier_post(unsigned* bar, volatile LAS unsigned* st) {
    XcdBarrier b; b.bar = bar; b.x = xb_xcc_id(); b.st = st;
    if (threadIdx.x == 0) (void)xb_add(&bar[XB_XCNT(b.x)], 1u);
    return b;
}
__device__ __forceinline__ void xcd_barrier_complete(unsigned* bar, unsigned x, unsigned& nloc, unsigned& nx) {
    const unsigned G = gridDim.x * gridDim.y * gridDim.z;
    unsigned sum, cnt, mine, sp = 0u;
    for (;;) {
        sum = 0u; cnt = 0u; mine = 0u;
#pragma unroll
        for (unsigned j = 0; j < 16; ++j) { const unsigned c = xb_ld(&bar[XB_XCNT(j)]); sum += c; cnt += (c > 0u) ? 1u : 0u; mine = (j == x) ? c : mine; }
        if (sum == G) break;
        __builtin_amdgcn_s_sleep(1);
        if ((++sp & 255u) == 0u) { if (xb_ld(&bar[XB_TMO])) break; if (sp > XB_SPIN_CAP) { atomicAdd(&bar[XB_TMO], 1u); break; } }
    }
    nloc = mine > 0u ? mine : 1u; nx = cnt > 0u ? cnt : 1u;
}
__device__ __forceinline__ void xcd_barrier(const XcdBarrier& b) {
    asm volatile("s_waitcnt vmcnt(0)" ::: "memory");
    __syncthreads();
    if (threadIdx.x == 0) {
        unsigned* bar = b.bar;
        __builtin_amdgcn_s_waitcnt(0);
        unsigned nloc = b.st[0], nx = b.st[1];
        if (nloc == 0u) { xcd_barrier_complete(bar, b.x, nloc, nx); b.st[0] = nloc; b.st[1] = nx; }
        const unsigned old = xb_add(&bar[XB_XSUB(b.x)], 1u);
        const unsigned gen = old / nloc;
        if (old + 1u == (gen + 1u) * nloc) {
            __builtin_amdgcn_fence(__ATOMIC_RELEASE, "agent");
            asm volatile("s_waitcnt vmcnt(0)" ::: "memory");
            const unsigned og = xb_add(&bar[XB_TOP], 1u);
            const unsigned tg = og / nx;
            if (og + 1u == (tg + 1u) * nx) xb_add(&bar[XB_TOPGEN], 1u);
            else XB_SPIN(xb_ld(&bar[XB_TOPGEN]) == tg, bar);
            __builtin_amdgcn_fence(__ATOMIC_ACQUIRE, "agent");
            xb_add(&bar[XB_XGEN(b.x)], 1u);
            asm volatile("s_waitcnt vmcnt(0)" ::: "memory");
        } else {
            XB_SPIN(xb_ld(&bar[XB_XGEN(b.x)]) == gen, bar);
            __builtin_amdgcn_fence(__ATOMIC_ACQUIRE, "agent");
            asm volatile("s_waitcnt vmcnt(0)" ::: "memory");
        }
    }
    __syncthreads();
}

namespace pg8 {
constexpr int BM = 256, BK = 64, HALF = 128, HTB = HALF * BK * 2, STAGE_BYTES = 8 * HTB;
__host__ __device__ __forceinline__ int lds_byte(int r, int c) { const int st = (r >> 4) * 2 + (c >> 5), rr = r & 15, cc = c & 31, ob = rr * 64 + cc * 2; return st * 1024 + (ob ^ (((ob >> 9) & 1) << 5)); }
__host__ __device__ __forceinline__ void stage_rc(int b, int& R, int& C) { const int st = b / 1024, sb = b % 1024, swz = sb ^ (((sb >> 9) & 1) << 5); R = (st >> 1) * 16 + swz / 64; C = (st & 1) * 32 + (swz % 64) / 2; }
__host__ __device__ __forceinline__ int perm32(int rho) { const int n = rho >> 4, i = rho & 15; return 8 * (i >> 2) + 4 * n + (i & 3); }
struct Unit { const char* a; const char* b; char* c; int ldc, mode, x0, x1, x2, x3; };

template <class Epi, class Sched, bool GATHER>
__device__ __forceinline__ void gemm_phase(LAS unsigned char* lds, const int K, const Sched& S, const Epi& E, const LAS unsigned* gtab) {
    const int tid = tid_(), wid = __builtin_amdgcn_readfirstlane(tid >> 6), lane = tid & 63, wr = wid >> 2, wc = wid & 3, fr = lane & 15, fq = lane >> 4;
    const int nt = K / BK;
    int Rr[2], Cc[2]; unsigned voffB[2], vA[2][2], nvA[2][2];
#pragma unroll
    for (int i = 0; i < 2; ++i) { stage_rc(tid * 16 + i * 8192, Rr[i], Cc[i]); const int Rb = (Rr[i] & ~31) + perm32(Rr[i] & 31); voffB[i] = (unsigned)(Rb * K + Cc[i]) * 2u; }
    const size_t kstep = (size_t)(BK * 2);
    const unsigned hstep = (unsigned)HALF * K * 2;
    const unsigned ldsw = (unsigned)wid * 1024u;
    const int aoff = lds_byte(wr * 64 + fr, fq * 8), boff = lds_byte(wc * 32 + fr, fq * 8);
#define PG8_SA(b, h) (((b) * 2 + (h)) * HTB)
#define PG8_SB(b, h) ((4 + (b) * 2 + (h)) * HTB)
#define PG8_GLDS(src, dstoff) __builtin_amdgcn_global_load_lds((const unsigned*)(src), (LAS unsigned*)(lds + (dstoff)), 16, 0, 0)
#define PG8_STGB(b, h, gbase) do { _Pragma("unroll") for (int _i = 0; _i < 2; ++_i) PG8_GLDS((gbase) + (h) * hstep + voffB[_i], PG8_SB(b, h) + ldsw + _i * 8192); } while (0)
#define PG8_STGA(b, h, gbase, V) do { _Pragma("unroll") for (int _i = 0; _i < 2; ++_i) PG8_GLDS((gbase) + (V)[h][_i], PG8_SA(b, h) + ldsw + _i * 8192); } while (0)
#define PG8_LOADV(V, slot) do { _Pragma("unroll") for (int _h = 0; _h < 2; ++_h) _Pragma("unroll") for (int _i = 0; _i < 2; ++_i) \
        (V)[_h][_i] = GATHER ? (gtab[(slot) * 256 + _h * 128 + Rr[_i]] + (unsigned)Cc[_i] * 2u) : ((unsigned)((_h * 128 + Rr[_i]) * K + Cc[_i]) * 2u); } while (0)
#define PG8_LDA(dst, b, h) do { _Pragma("unroll") for (int m = 0; m < 4; ++m) _Pragma("unroll") for (int k = 0; k < 2; ++k) dst[m][k] = *(const LAS bf16x8*)(lds + PG8_SA(b, h) + aoff + m * 2048 + k * 1024); } while (0)
#define PG8_LDB(dst, b, h) do { _Pragma("unroll") for (int n = 0; n < 2; ++n) _Pragma("unroll") for (int k = 0; k < 2; ++k) dst[n][k] = *(const LAS bf16x8*)(lds + PG8_SB(b, h) + boff + n * 2048 + k * 1024); } while (0)
#define PG8_MMA(ai, bj, At, Bt) do { __builtin_amdgcn_s_setprio(1); _Pragma("unroll") for (int m = 0; m < 4; ++m) _Pragma("unroll") for (int n = 0; n < 2; ++n) _Pragma("unroll") for (int k = 0; k < 2; ++k) \
        acc[ai][bj][m][n] = __builtin_amdgcn_mfma_f32_16x16x32_bf16(Bt[n][k], At[m][k], acc[ai][bj][m][n], 0, 0, 0); __builtin_amdgcn_s_setprio(0); } while (0)
#define PG8_WAIT_V(n) asm volatile("s_waitcnt vmcnt(" #n ")" ::: "memory")
#define PG8_WAIT_L(n) asm volatile("s_waitcnt lgkmcnt(" #n ")" ::: "memory")
#define PG8_BAR __builtin_amdgcn_s_barrier()
#define PG8_SCHED __builtin_amdgcn_sched_barrier(0)
    Unit cur, nxt; int ui = 0;
    if (!S.next(0, cur)) return;
    f32x4 acc[2][2][4][2];
#pragma unroll
    for (int a = 0; a < 2; ++a)
#pragma unroll
        for (int b = 0; b < 2; ++b)
#pragma unroll
            for (int m = 0; m < 4; ++m)
#pragma unroll
                for (int n = 0; n < 2; ++n) acc[a][b][m][n] = (f32x4){0.f, 0.f, 0.f, 0.f};
    bf16x8 At[4][2], B0[2][2], B1[2][2];
    const char* cA = cur.a; const char* cB = cur.b;
    PG8_LOADV(vA, 0);
    PG8_STGB(0, 0, cB); PG8_STGB(0, 1, cB); PG8_STGA(0, 0, cA, vA); PG8_STGA(0, 1, cA, vA);
    if (wr == 1) PG8_BAR;
    PG8_WAIT_V(2); PG8_BAR;
    PG8_STGB(1, 0, cB + kstep); PG8_STGA(1, 0, cA + kstep, vA); PG8_STGB(1, 1, cB + kstep);
    PG8_WAIT_V(6); PG8_BAR;
    for (;;) {
        const bool has_next = S.next(ui + 1, nxt);
        const char* nA = has_next ? nxt.a : cA; const char* nB = has_next ? nxt.b : cB;
        for (int t = 0; t < nt; t += 2) {
            const bool last = (t == nt - 2);
            const char* a1 = cA + (size_t)(t + 1) * kstep;
            const char* a2 = last ? nA : cA + (size_t)(t + 2) * kstep; const char* b2 = last ? nB : cB + (size_t)(t + 2) * kstep;
            const char* a3 = a2 + kstep; const char* b3 = b2 + kstep;
            if (last) { if (has_next) { PG8_LOADV(nvA, ui + 1); } else {
#pragma unroll
                for (int _h = 0; _h < 2; ++_h)
#pragma unroll
                    for (int _i = 0; _i < 2; ++_i) nvA[_h][_i] = vA[_h][_i]; } }
            else {
#pragma unroll
                for (int _h = 0; _h < 2; ++_h)
#pragma unroll
                    for (int _i = 0; _i < 2; ++_i) nvA[_h][_i] = vA[_h][_i]; }
            PG8_LDB(B0, 0, 0); PG8_LDB(B1, 0, 1); PG8_SCHED; PG8_LDA(At, 0, 0); PG8_STGA(1, 1, a1, vA);
            PG8_WAIT_V(8); PG8_WAIT_L(0); PG8_BAR; PG8_MMA(0, 0, At, B0); PG8_MMA(0, 1, At, B1); PG8_BAR; PG8_SCHED;
            PG8_LDA(At, 0, 1); PG8_STGB(0, 0, b2); PG8_STGB(0, 1, b2); PG8_STGA(0, 0, a2, nvA);
            PG8_WAIT_V(8); PG8_WAIT_L(0); PG8_BAR; PG8_MMA(1, 0, At, B0); PG8_MMA(1, 1, At, B1); PG8_BAR; PG8_SCHED;
            PG8_LDB(B0, 1, 0); PG8_LDB(B1, 1, 1); PG8_SCHED; PG8_LDA(At, 1, 0); PG8_STGA(0, 1, a2, nvA);
            PG8_WAIT_V(8); PG8_WAIT_L(0); PG8_BAR; PG8_MMA(0, 0, At, B0); PG8_MMA(0, 1, At, B1); PG8_BAR; PG8_SCHED;
            PG8_LDA(At, 1, 1); PG8_STGB(1, 0, b3); PG8_STGB(1, 1, b3); PG8_STGA(1, 0, a3, nvA);
            PG8_WAIT_V(8); PG8_WAIT_L(0); PG8_BAR; PG8_MMA(1, 0, At, B0); PG8_MMA(1, 1, At, B1); PG8_BAR; PG8_SCHED;
        }
        if (wr == 0) PG8_BAR;
        E(acc, cur, wr, wc, fr, fq);
        if (!has_next) break;
#pragma unroll
        for (int a = 0; a < 2; ++a)
#pragma unroll
            for (int b = 0; b < 2; ++b)
#pragma unroll
                for (int m = 0; m < 4; ++m)
#pragma unroll
                    for (int n = 0; n < 2; ++n) acc[a][b][m][n] = (f32x4){0.f, 0.f, 0.f, 0.f};
        cur = nxt; cA = nA; cB = nB; ++ui;
#pragma unroll
        for (int _h = 0; _h < 2; ++_h)
#pragma unroll
            for (int _i = 0; _i < 2; ++_i) vA[_h][_i] = nvA[_h][_i];
        if (wr == 1) PG8_BAR;
    }
    PG8_WAIT_V(0);
    PG8_BAR;
#undef PG8_SA
#undef PG8_SB
#undef PG8_GLDS
#undef PG8_STGB
#undef PG8_STGA
#undef PG8_LOADV
#undef PG8_LDA
#undef PG8_LDB
#undef PG8_MMA
#undef PG8_WAIT_V
#undef PG8_WAIT_L
#undef PG8_BAR
#undef PG8_SCHED
}
}

constexpr size_t MiB = 1u << 20;
constexpr size_t WS_CTL = 0, CTL_BYTES = 1 * MiB;
constexpr size_t WS_WIN = 1 * MiB;
constexpr size_t WS_WKV = WS_WIN + 40 * MiB;
constexpr size_t WS_WOUT = WS_WKV + 8 * MiB;
constexpr size_t WS_WUP = WS_WOUT + 12 * MiB;
constexpr size_t WS_WDN = WS_WUP + 512 * MiB;
constexpr size_t WS_XB = WS_WDN + 256 * MiB;
constexpr size_t WS_MEMB = WS_XB + 32 * MiB;
constexpr size_t WS_XF = WS_MEMB + 1 * MiB;
constexpr size_t WS_PA = WS_XF + 64 * MiB;
constexpr size_t WS_PB = WS_PA + 32 * MiB;
constexpr size_t WS_PVT = WS_PB + 32 * MiB;
constexpr size_t WS_PZ = WS_PVT + 32 * MiB;
constexpr size_t WS_PMQ = WS_PZ + 64 * MiB;
constexpr size_t WS_MEMK = WS_PMQ + 16 * MiB;
constexpr size_t WS_MEMVT = WS_MEMK + MiB / 2;
constexpr size_t WS_LOGF = WS_MEMVT + MiB / 2;
constexpr size_t WS_C2 = WS_LOGF + MiB / 2;
constexpr size_t WS_HQB = WS_LOGF + 1 * MiB;
constexpr size_t WS_HQR = WS_HQB + 32 * MiB;
constexpr size_t WS_HKR = WS_HQR + 32 * MiB;
constexpr size_t WS_HKDT = WS_HKR + 32 * MiB;
constexpr size_t WS_HG = WS_HKDT + 32 * MiB;
constexpr size_t WS_HST = WS_HG + 1 * MiB;
constexpr size_t WS_KMEAN = WS_HST + 128 * MiB;
constexpr size_t WS_SEL = WS_KMEAN + 1 * MiB;
constexpr size_t WS_LISTS = WS_SEL + 2 * MiB;
constexpr size_t WS_PARTO = WS_LISTS + 16 * MiB;
constexpr size_t WS_PARTL = WS_PARTO + 96 * MiB;
constexpr size_t WS_MIX = WS_PARTL + 2 * MiB;
constexpr size_t WS_Y1 = WS_MIX + 48 * MiB;
constexpr size_t WS_X1F = WS_Y1 + 64 * MiB;
constexpr size_t WS_X1B = WS_X1F + 64 * MiB;
constexpr size_t WS_ETOK = WS_X1B + 32 * MiB;
constexpr size_t WS_GATE = WS_ETOK + 2 * MiB;
constexpr size_t WS_ACT = WS_GATE + 1 * MiB;
constexpr size_t WS_YE = WS_ACT + 144 * MiB;
constexpr size_t WS_KNT = WS_YE + 128 * MiB;
constexpr size_t WS_END = WS_KNT + 1 * MiB;
constexpr int CW_BAR = 1024;
constexpr int CW_ECNT = 8192;
constexpr int CW_LCNT = 8192 + 256;
constexpr int CW_CHK = 16384;
constexpr int CW_FOXQ = 12288;

struct Params {
    const float* in[21];
    float* out; unsigned char* ws;
};
#define WSP(T_, off) ((T_*)(p.ws + (off)))
__device__ __forceinline__ unsigned* ctl(const Params& p) { return (unsigned*)(p.ws + WS_CTL); }

__device__ __forceinline__ void transpose_item(const float* W, int K, int N, bf16_t* WT, int k0, int n_src0, int n_dst0, LAS float* scr, int lane) {
#pragma unroll 8
    for (int i = 0; i < 32; ++i) { const int kk = 2 * i + (lane >> 5); scr[kk * 33 + (lane & 31)] = W[(size_t)(k0 + kk) * N + n_src0 + (lane & 31)]; }
    asm volatile("s_waitcnt lgkmcnt(0)" ::: "memory");
    const int c = lane & 7;
#pragma unroll
    for (int j = 0; j < 4; ++j) { const int n = (lane >> 3) + 8 * j; const LAS float* s = scr + (8 * c) * 33 + n;
        u32x4 o; o.x = cvt_pk_bf16(s[0 * 33], s[1 * 33]); o.y = cvt_pk_bf16(s[2 * 33], s[3 * 33]); o.z = cvt_pk_bf16(s[4 * 33], s[5 * 33]); o.w = cvt_pk_bf16(s[6 * 33], s[7 * 33]);
        *(u32x4*)(WT + (size_t)(n_dst0 + n) * K + k0 + 8 * c) = o; }
    asm volatile("s_waitcnt lgkmcnt(0)" ::: "memory");
}
struct TJob { const float* W; bf16_t* WT; int K, N, src0, dst0, ncb, nmat; size_t sstride, dstride; };
__device__ __forceinline__ void run_tjob(const TJob& j, int gw, int ngw, LAS float* scr, int lane) {
    const int nkb = j.K / 64, per = nkb * j.ncb, nit = per * j.nmat;
    for (int it = gw; it < nit; it += ngw) { const int mt = it / per, r = it % per, kb = r / j.ncb, cb = r % j.ncb;
        transpose_item(j.W + (size_t)mt * j.sstride, j.K, j.N, j.WT + (size_t)mt * j.dstride, 64 * kb, j.src0 + 32 * cb, j.dst0 + 32 * cb, scr, lane); }
}
__device__ __forceinline__ void cvt_rows_bf16(const float* src, bf16_t* dst, size_t n8, int gtid, int ngt) {
    for (size_t i = gtid; i < n8; i += ngt) { const f32x4 a = *(const f32x4*)(src + i * 8), b = *(const f32x4*)(src + i * 8 + 4);
        u32x4 o; o.x = cvt_pk_bf16(a[0], a[1]); o.y = cvt_pk_bf16(a[2], a[3]); o.z = cvt_pk_bf16(b[0], b[1]); o.w = cvt_pk_bf16(b[2], b[3]); *(u32x4*)(dst + i * 8) = o; }
}
enum { I_X = 0, I_MEM, I_HGRN_W, I_HGRN_LB, I_HGRN_NG, I_FOX_W, I_FOX_BF, I_MOBA_W, I_RELB, I_WKV, I_WOUT, I_LN1G, I_LN1B, I_RW, I_RB, I_WUP, I_BUP, I_WDN, I_BDN, I_LN2G, I_LN2B };

__device__ __forceinline__ void phase_prologue(const Params& p, LAS unsigned char* lds, int bid, int nb) {
    const int tid = tid_(), lane = tid & 63, wave = tid >> 6;
    LAS float* scr = (LAS float*)(lds + wave * 16384);
    const int gw = bid * NWAVES + wave, ngw = nb * NWAVES;
    for (int l = 0; l < 4; ++l) {
        TJob ju{p.in[I_WUP] + (size_t)l * NEXP * DM * 2 * DFF, WSP(bf16_t, WS_WUP) + (size_t)l * NEXP * 2 * DFF * DM, DM, 2 * DFF, 0, 0, 2 * DFF / 32, NEXP, (size_t)DM * 2 * DFF, (size_t)2 * DFF * DM};
        run_tjob(ju, gw, ngw, scr, lane);
        TJob jd{p.in[I_WDN] + (size_t)l * NEXP * DFF * DM, WSP(bf16_t, WS_WDN) + (size_t)l * NEXP * DM * DFF, DFF, DM, 0, 0, DM / 32, NEXP, (size_t)DFF * DM, (size_t)DM * DFF};
        run_tjob(jd, gw, ngw, scr, lane);
        TJob jk{p.in[I_WKV] + (size_t)l * DM * 1024, WSP(bf16_t, WS_WKV) + (size_t)l * 1024 * DM, DM, 1024, 0, 0, 32, 1, 0, 0};
        run_tjob(jk, gw, ngw, scr, lane);
        TJob jo{p.in[I_WOUT] + (size_t)l * OUT_IN * DM, WSP(bf16_t, WS_WOUT) + (size_t)l * DM * OUT_IN, OUT_IN, DM, 0, 0, 32, 1, 0, 0};
        run_tjob(jo, gw, ngw, scr, lane);
        const int kind = l % 3, jj = l / 3;
        bf16_t* wt = WSP(bf16_t, WS_WIN) + (size_t)l * (10 * MiB / 2);
        if (kind == 0) { TJob ji{p.in[I_HGRN_W] + (size_t)jj * DM * HGRN_IN, wt, DM, HGRN_IN, 0, 0, HGRN_IN / 32, 1, 0, 0}; run_tjob(ji, gw, ngw, scr, lane); }
        else if (kind == 1) { TJob ja{p.in[I_FOX_W], wt, DM, FOX_IN, 0, 0, 3072 / 32, 1, 0, 0}; run_tjob(ja, gw, ngw, scr, lane);
                              TJob jb{p.in[I_FOX_W], wt, DM, FOX_IN, 3080, 3072, 512 / 32, 1, 0, 0}; run_tjob(jb, gw, ngw, scr, lane); }
        else { TJob ji{p.in[I_MOBA_W], wt, DM, MOBA_IN, 0, 0, MOBA_IN / 32, 1, 0, 0}; run_tjob(ji, gw, ngw, scr, lane); }
    }
    const int gtid = bid * NTHR + tid, ngt = nb * NTHR;
    cvt_rows_bf16(p.in[I_X], WSP(bf16_t, WS_XB), (size_t)T * DM / 8, gtid, ngt);
    cvt_rows_bf16(p.in[I_MEM], WSP(bf16_t, WS_MEMB), (size_t)BATCH * MEMT * DM / 8, gtid, ngt);
}

constexpr int LDS_STAGE = 0, LDS_GTAB = 131072, LDS_MISC = 147456, LDS_BYTES = 153600;

__device__ __forceinline__ void static_order(int L, int nM, int nN, int& pm, int& pn) {
    const int nwg = nM * nN; int wgid = L; { const int q = nwg / 8, r = nwg % 8, xcd = wgid % 8, off = wgid / 8; wgid = (xcd < r ? xcd * (q + 1) : r * (q + 1) + (xcd - r) * q) + off; }
    const int nig = 8 * nN, gid = wgid / nig, fm = gid * 8, gsz = (nM - fm) < 8 ? (nM - fm) : 8;
    pm = fm + ((wgid % nig) % gsz); pn = (wgid % nig) / gsz;
}
struct ProjSched {
    int G, c, kind; const char *xb, *win, *memb, *wkv; char *pa, *pb, *pvt, *pz, *pmq, *memk, *memvt;
    __device__ __forceinline__ bool next(int i, pg8::Unit& u) const {
        const int nmc = (kind == 0) ? 14 : 10, nmain = 64 * nmc; const int L = i * G + c;
        u.x0 = 0; u.x1 = 0; u.x2 = 0; u.x3 = 0;
        if (L < nmain) { int pm, j; static_order(L, 64, nmc, pm, j);
            int pn, dc; char* dst; int ldc = DM, mode = 0, esz = 2;
            if (kind == 0) { if (j < 4) { pn = j; dst = pa; dc = j; mode = 1; } else if (j < 8) { pn = j; dst = pz; dc = j - 4; mode = 2; esz = 4; } else if (j < 12) { pn = j + 4; dst = pb; dc = j - 8; mode = 1; } else { pn = j + 4; dst = pmq; dc = j - 12; ldc = MEMW; } }
            else { if (j < 4) { pn = j; dst = pa; dc = j; } else if (j < 8) { pn = j; dst = pb; dc = j - 4; } else { pn = j + 4; dst = pmq; dc = j - 8; ldc = MEMW; } }
            u.a = xb + (size_t)pm * 256 * DM * 2; u.b = win + (size_t)pn * 256 * DM * 2; u.c = dst + ((size_t)pm * 256 * ldc + dc * 256) * esz; u.ldc = ldc; u.mode = mode; return true; }
        int idx = L - nmain;
        if (idx < 256) { const int x = idx & 7, off = idx >> 3, tn = 8 * x + (off & 7), vm = off >> 3;
            u.a = win + (size_t)(2048 + 256 * vm) * DM * 2; u.b = xb + (size_t)tn * 256 * DM * 2;
            if (kind == 0) { u.c = pvt; u.ldc = T; u.mode = 3; u.x0 = vm; u.x1 = tn; } else { u.c = pvt + ((size_t)256 * vm * T + 256 * tn) * 2; u.ldc = T; u.mode = 0; }
            return true; }
        idx -= 256;
        if (idx < 4) { const int mm = idx & 1, kn = idx >> 1;
            u.a = memb + (size_t)mm * 256 * DM * 2; u.b = wkv + (size_t)kn * 256 * DM * 2; u.c = memk + ((size_t)256 * mm * MEMW + 256 * kn) * 2; u.ldc = MEMW; u.mode = 0; return true; }
        idx -= 4;
        if (idx < 4) { const int mm = idx & 1, vn = idx >> 1;
            u.a = wkv + (size_t)(512 + 256 * vn) * DM * 2; u.b = memb + (size_t)mm * 256 * DM * 2; u.c = memvt + ((size_t)256 * vn * 512 + 256 * mm) * 2; u.ldc = 512; u.mode = 0; return true; }
        return false;
    }
};
struct EpiStore {
    __device__ __forceinline__ void operator()(const f32x4 (&acc)[2][2][4][2], const pg8::Unit& u, int wr, int wc, int fr, int fq) const {
        const int r0 = wr * 64 + fr, c0 = wc * 32 + 8 * fq;
        if (u.mode == 3) {
            const int lane_off = (((2 * (wc & 1) + (fq >> 1)) * 64) + fr + 32 * (fq & 1)) * 8;
            const int b_ = u.x1 >> 5, tq = 4 * (u.x1 & 31) + (wc >> 1);
#pragma unroll
            for (int ai = 0; ai < 2; ++ai)
#pragma unroll
                for (int bj = 0; bj < 2; ++bj) { const int chunk = ((b_ * NH + 2 * u.x0 + ai) * 128 + tq + 2 * bj);
#pragma unroll
                    for (int m = 0; m < 4; ++m) { const f32x4 v0 = acc[ai][bj][m][0], v1 = acc[ai][bj][m][1];
                        u32x4 w; w.x = cvt_pk_bf16(v0[0], v0[1]); w.y = cvt_pk_bf16(v0[2], v0[3]); w.z = cvt_pk_bf16(v1[0], v1[1]); w.w = cvt_pk_bf16(v1[2], v1[3]);
                        *(u32x4*)((bf16_t*)u.c + ((size_t)(chunk * 4 + 2 * wr + (m >> 1)) * 4) * 512 + (m & 1) * 128 + lane_off) = w; } }
            return;
        }
#pragma unroll
        for (int ai = 0; ai < 2; ++ai)
#pragma unroll
            for (int m = 0; m < 4; ++m) { const size_t ro = (size_t)(r0 + ai * 128 + m * 16) * u.ldc + c0;
#pragma unroll
                for (int bj = 0; bj < 2; ++bj) { f32x4 v0 = acc[ai][bj][m][0], v1 = acc[ai][bj][m][1];
                    if (u.mode == 2) { float* o = (float*)u.c + ro + bj * 128; *(f32x4*)o = v0; *(f32x4*)(o + 4) = v1; }
                    else { if (u.mode == 1) {
#pragma unroll
                            for (int j = 0; j < 4; ++j) { v0[j] = siluf_(v0[j]); v1[j] = siluf_(v1[j]); } }
                        u32x4 w; w.x = cvt_pk_bf16(v0[0], v0[1]); w.y = cvt_pk_bf16(v0[2], v0[3]); w.z = cvt_pk_bf16(v1[0], v1[1]); w.w = cvt_pk_bf16(v1[2], v1[3]);
                        *(u32x4*)((bf16_t*)u.c + ro + bj * 128) = w; } } }
    }
};
struct OutSched { int G, c; const char *mix, *wout;
    __device__ __forceinline__ bool next(int i, pg8::Unit& u) const { const int L = i * G + c; if (L >= 256) return false; int pm, pn; static_order(L, 64, 4, pm, pn);
        u.a = mix + (size_t)pm * 256 * OUT_IN * 2; u.b = wout + (size_t)pn * 256 * OUT_IN * 2; u.c = nullptr; u.ldc = DM; u.mode = 0; u.x0 = pm; u.x1 = pn; u.x2 = 0; u.x3 = 0; return true; }
};
struct EpiResid {
    const float* res; float* out;
    __device__ __forceinline__ void operator()(const f32x4 (&acc)[2][2][4][2], const pg8::Unit& u, int wr, int wc, int fr, int fq) const {
        const int r0 = u.x0 * 256 + wr * 64 + fr, c0 = u.x1 * 256 + wc * 32 + 8 * fq;
#pragma unroll
        for (int ai = 0; ai < 2; ++ai)
#pragma unroll
            for (int m = 0; m < 4; ++m) { const size_t ro = (size_t)(r0 + ai * 128 + m * 16) * DM + c0;
#pragma unroll
                for (int bj = 0; bj < 2; ++bj) { const float* rp = res + ro + bj * 128; float* o = out + ro + bj * 128;
                    const f32x4 a = *(const f32x4*)rp, b = *(const f32x4*)(rp + 4);
                    *(f32x4*)o = a * DN_ALPHA + acc[ai][bj][m][0]; *(f32x4*)(o + 4) = b * DN_ALPHA + acc[ai][bj][m][1]; } }
    }
};
struct MoeSched { const LAS int* ut; const char *abase, *wbase; int up;
    __device__ __forceinline__ bool next(int i, pg8::Unit& u) const {
        if (i >= 16) return false; const LAS int* t = ut + i * 8; if (!t[0]) return false;
        const int e = t[1], rbl = t[2], rbc = t[3], pn = t[4], cnt = t[5];
        if (up) { u.a = abase; u.b = wbase + ((size_t)e * 2 * DFF + pn * 256) * DM * 2; }
        else { u.a = abase + (size_t)rbc * 256 * DFF * 2; u.b = wbase + ((size_t)e * DM + pn * 256) * DFF * 2; }
        u.c = nullptr; u.ldc = pn; u.mode = e; u.x0 = rbl; u.x1 = rbc; u.x2 = cnt; u.x3 = 0; return true; }
};
struct EpiUp {
    const float* bup; bf16_t* act;
    __device__ __forceinline__ void operator()(const f32x4 (&acc)[2][2][4][2], const pg8::Unit& u, int wr, int wc, int fr, int fq) const {
        const int e = u.mode, pn = u.ldc, r0 = u.x1 * 256 + wr * 64 + fr, c0 = pn * 256 + wc * 32 + 8 * fq;
        f32x4 bv[2][2];
#pragma unroll
        for (int bj = 0; bj < 2; ++bj) { const float* bp = bup + (size_t)e * 2 * DFF + c0 + bj * 128; bv[bj][0] = *(const f32x4*)bp; bv[bj][1] = *(const f32x4*)(bp + 4); }
#pragma unroll
        for (int ai = 0; ai < 2; ++ai)
#pragma unroll
            for (int m = 0; m < 4; ++m) { bf16_t* rowp = act + (size_t)(r0 + ai * 128 + m * 16) * DFF + (c0 >> 1);
#pragma unroll
                for (int bj = 0; bj < 2; ++bj) { const f32x4 v0 = acc[ai][bj][m][0] + bv[bj][0], v1 = acc[ai][bj][m][1] + bv[bj][1];
                    float o[4];
#pragma unroll
                    for (int j = 0; j < 4; ++j) { const float hg = (j < 2) ? v0[2 * j] : v1[2 * j - 4], hl = (j < 2) ? v0[2 * j + 1] : v1[2 * j - 3];
                        const float glu = fminf(hg, 7.0f), lin = fminf(fmaxf(hl, -7.0f), 7.0f); o[j] = glu * sigmoidf_(1.702f * glu) * (lin + 1.0f); }
                    u32x2 w; w.x = cvt_pk_bf16(o[0], o[1]); w.y = cvt_pk_bf16(o[2], o[3]); *(u32x2*)(rowp + bj * 64) = w; } }
    }
};
struct EpiDown {
    const float* bdn; const unsigned* etok; bf16_t* ye;
    __device__ __forceinline__ void operator()(const f32x4 (&acc)[2][2][4][2], const pg8::Unit& u, int wr, int wc, int fr, int fq) const {
        const int e = u.mode, pn = u.ldc, rl0 = u.x0 * 256 + wr * 64 + fr, cnt = u.x2, c0 = pn * 256 + wc * 32 + 8 * fq;
        f32x4 bv[2][2];
#pragma unroll
        for (int bj = 0; bj < 2; ++bj) { const float* bp = bdn + (size_t)e * DM + c0 + bj * 128; bv[bj][0] = *(const f32x4*)bp; bv[bj][1] = *(const f32x4*)(bp + 4); }
        unsigned dest[2][4];
#pragma unroll
        for (int ai = 0; ai < 2; ++ai)
#pragma unroll
            for (int m = 0; m < 4; ++m) { const int rl = rl0 + ai * 128 + m * 16; dest[ai][m] = (rl < cnt) ? etok[(size_t)e * T + rl] : 0xffffffffu; }
#pragma unroll
        for (int ai = 0; ai < 2; ++ai)
#pragma unroll
            for (int m = 0; m < 4; ++m) { if (dest[ai][m] != 0xffffffffu) { bf16_t* rowp = ye + (size_t)dest[ai][m] * DM + c0;
#pragma unroll
                for (int bj = 0; bj < 2; ++bj) { const f32x4 v0 = acc[ai][bj][m][0] + bv[bj][0], v1 = acc[ai][bj][m][1] + bv[bj][1];
                    u32x4 w; w.x = cvt_pk_bf16(v0[0], v0[1]); w.y = cvt_pk_bf16(v0[2], v0[3]); w.z = cvt_pk_bf16(v1[0], v1[1]); w.w = cvt_pk_bf16(v1[2], v1[3]);
                    *(u32x4*)(rowp + bj * 128) = w; } } }
    }
};

__device__ __forceinline__ void phase_proj(const Params& p, LAS unsigned char* lds, int layer, int bid, int nb) {
    ProjSched S; S.G = nb; S.c = bid; S.kind = layer % 3;
    S.xb = (const char*)WSP(bf16_t, WS_XB); S.win = (const char*)(WSP(bf16_t, WS_WIN) + (size_t)layer * (10 * MiB / 2)); S.memb = (const char*)WSP(bf16_t, WS_MEMB);
    S.wkv = (const char*)(WSP(bf16_t, WS_WKV) + (size_t)layer * 1024 * DM);
    S.pa = (char*)WSP(bf16_t, WS_PA); S.pb = (char*)WSP(bf16_t, WS_PB); S.pvt = (char*)WSP(bf16_t, WS_PVT); S.pz = (char*)WSP(float, WS_PZ); S.pmq = (char*)WSP(bf16_t, WS_PMQ);
    S.memk = (char*)WSP(bf16_t, WS_MEMK); S.memvt = (char*)WSP(bf16_t, WS_MEMVT);
    EpiStore E;
    pg8::gemm_phase<EpiStore, ProjSched, false>(lds + LDS_STAGE, DM, S, E, nullptr);
}
__device__ __forceinline__ void phase_outproj(const Params& p, LAS unsigned char* lds, int layer, int bid, int nb) {
    OutSched S{nb, bid, (const char*)WSP(bf16_t, WS_MIX), (const char*)(WSP(bf16_t, WS_WOUT) + (size_t)layer * DM * OUT_IN)};
    EpiResid E{layer == 0 ? p.in[I_X] : WSP(float, WS_XF), WSP(float, WS_Y1)};
    pg8::gemm_phase<EpiResid, OutSched, false>(lds + LDS_STAGE, OUT_IN, S, E, nullptr);
}
__device__ __forceinline__ void moe_build_units(const Params& p, LAS unsigned char* lds, int layer, int bid, int nb, int npn, bool up) {
    LAS int* misc = (LAS int*)(lds + LDS_MISC); LAS int* ut = misc + 16; LAS int* pre = misc + 160; LAS int* cnts = misc + 200;
    LAS unsigned* gtab = (LAS unsigned*)(lds + LDS_GTAB);
    const int tid = tid_();
    const unsigned* ecnt = ctl(p) + CW_ECNT + layer * 32;
    if (tid < 32) cnts[tid] = (int)__hip_atomic_load(ecnt + tid, __ATOMIC_RELAXED, __HIP_MEMORY_SCOPE_AGENT);
    __syncthreads();
    if (tid == 0) { int s = 0; for (int e = 0; e < 32; ++e) { pre[e] = s; s += (cnts[e] + 255) >> 8; } pre[32] = s; }
    __syncthreads();
    if (tid < 16) { const int i = tid, nblk = pre[32]; int rbg, pn;
        if (nb == 256) { const int x = bid & 7, slot = bid >> 3, rpr = 32 / npn; rbg = i * (8 * rpr) + x * rpr + slot / npn; pn = slot % npn; }
        else { const int L = i * nb + bid; rbg = L / npn; pn = L % npn; }
        LAS int* t = ut + i * 8;
        if (rbg < nblk) { int e = 0; while (pre[e + 1] <= rbg) ++e; t[0] = 1; t[1] = e; t[2] = rbg - pre[e]; t[3] = rbg; t[4] = pn; t[5] = cnts[e]; }
        else { t[0] = 0; t[1] = 0; t[2] = 0; t[3] = 0; t[4] = 0; t[5] = 0; } }
    __syncthreads();
    if (up) { const unsigned* etok = WSP(unsigned, WS_ETOK);
        for (int idx = tid; idx < 16 * 256; idx += NTHR) { const int i = idx >> 8, r = idx & 255; const LAS int* t = ut + i * 8; unsigned off = 0;
            if (t[0]) { const int rl = t[2] * 256 + r; if (rl < t[5]) off = (etok[(size_t)t[1] * T + rl] >> 2) * (unsigned)(DM * 2); }
            gtab[idx] = off; }
        __syncthreads(); }
}
__device__ __forceinline__ void phase_moe_up(const Params& p, LAS unsigned char* lds, int layer, int bid, int nb) {
    moe_build_units(p, lds, layer, bid, nb, 8, true);
    MoeSched S{(const LAS int*)(lds + LDS_MISC) + 16, (const char*)WSP(bf16_t, WS_X1B), (const char*)(WSP(bf16_t, WS_WUP) + (size_t)layer * NEXP * 2 * DFF * DM), 1};
    EpiUp E{p.in[I_BUP] + (size_t)layer * NEXP * 2 * DFF, WSP(bf16_t, WS_ACT)};
    pg8::gemm_phase<EpiUp, MoeSched, true>(lds + LDS_STAGE, DM, S, E, (const LAS unsigned*)(lds + LDS_GTAB));
}
__device__ __forceinline__ void phase_moe_down(const Params& p, LAS unsigned char* lds, int layer, int bid, int nb) {
    moe_build_units(p, lds, layer, bid, nb, 4, false);
    MoeSched S{(const LAS int*)(lds + LDS_MISC) + 16, (const char*)WSP(bf16_t, WS_ACT), (const char*)(WSP(bf16_t, WS_WDN) + (size_t)layer * NEXP * DM * DFF), 0};
    EpiDown E{p.in[I_BDN] + (size_t)layer * NEXP * DM, WSP(unsigned, WS_ETOK), WSP(bf16_t, WS_YE)};
    pg8::gemm_phase<EpiDown, MoeSched, false>(lds + LDS_STAGE, DFF, S, E, nullptr);
}

constexpr int AT_K0 = 0, AT_V0 = 32768, AT_AUX = 65536;
__device__ __forceinline__ int kswz(int row, int ch) { return row * 256 + ((ch ^ ((row & 3) | (((row >> 3) & 3) << 2))) << 4); }
__device__ __forceinline__ int vswz(int row, int ch) { return row * 128 + ((ch ^ (((row >> 1) & 1) | (((row >> 3) & 3) << 1))) << 4); }
struct AttnBias { float cq; int qpos; const LAS float* tab; int kpos0; int qmin; };
template <int MODE>
__device__ __forceinline__ void attn_tiles(LAS unsigned char* lds, const bf16_t* kbase, int ldk, const bf16_t* vtbase, int ldv, int ntiles, int wave_nt,
                                           const bf16x8 (&qf)[8], f32x16 (&o)[4], float& m, float& l, const AttnBias& B) {
    const int tid = tid_(), lane = tid & 63, w = __builtin_amdgcn_readfirstlane(tid >> 6), r = lane & 31, hi = lane >> 5;
    int koff[2], voff[2];
#pragma unroll
    for (int i = 0; i < 2; ++i) { const int pz = (w * 2 + i) * 64 + lane;
        { const int row = pz >> 4, chp = pz & 15, ch = chp ^ ((row & 3) | (((row >> 3) & 3) << 2)); koff[i] = row * ldk + ch * 8; }
        { const int row = pz >> 3, chp = pz & 7, ch = chp ^ (((row >> 1) & 1) | (((row >> 3) & 3) << 1)); voff[i] = row * ldv + ch * 8; } }
    const int pr = (r & ~12) | ((r & 4) << 1) | ((r & 8) >> 1);
    int kaddr[8], vaddr[4];
#pragma unroll
    for (int ks = 0; ks < 8; ++ks) kaddr[ks] = kswz(pr, 2 * ks + hi);
#pragma unroll
    for (int s_ = 0; s_ < 4; ++s_) vaddr[s_] = vswz(r, 2 * s_ + hi);
#define AT_DMA(t, buf) do { _Pragma("unroll") for (int _i = 0; _i < 2; ++_i) { \
        __builtin_amdgcn_global_load_lds((const unsigned*)(kbase + (size_t)(t) * 64 * ldk + koff[_i]), (LAS unsigned*)(lds + AT_K0 + (buf) * 16384 + (w * 2 + _i) * 1024), 16, 0, 0); \
        __builtin_amdgcn_global_load_lds((const unsigned*)(vtbase + (t) * 64 + voff[_i]), (LAS unsigned*)(lds + AT_V0 + (buf) * 16384 + (w * 2 + _i) * 1024), 16, 0, 0); } } while (0)
    AT_DMA(0, 0);
    asm volatile("s_waitcnt vmcnt(0)" ::: "memory");
    __syncthreads();
    constexpr float C = QK_SCALE * LOG2E;
    const float NEG = -__builtin_inff();
    for (int t = 0; t < ntiles; ++t) {
        const int buf = t & 1;
        if (t + 1 < ntiles) AT_DMA(t + 1, buf ^ 1);
        if (t < wave_nt) {
            f32x16 s0, s1;
#pragma unroll
            for (int i = 0; i < 16; ++i) { s0[i] = 0.f; s1[i] = 0.f; }
            const LAS unsigned char* kb = lds + AT_K0 + buf * 16384;
#pragma unroll
            for (int kg = 0; kg < 4; ++kg) {
#pragma unroll
                for (int k2 = 0; k2 < 2; ++k2) { const int ks = 2 * kg + k2;
                    const bf16x8 k0 = *(const LAS bf16x8*)(kb + kaddr[ks]), k1 = *(const LAS bf16x8*)(kb + kaddr[ks] + 8192);
                    s0 = __builtin_amdgcn_mfma_f32_32x32x16_bf16(k0, qf[ks], s0, 0, 0, 0);
                    s1 = __builtin_amdgcn_mfma_f32_32x32x16_bf16(k1, qf[ks], s1, 0, 0, 0); }
                __builtin_amdgcn_sched_barrier(0);
            }
            float mx = NEG;
            if (MODE == 0) {
#pragma unroll
                for (int i = 0; i < 16; ++i) { s0[i] *= C; s1[i] *= C; mx = fmaxf(mx, fmaxf(s0[i], s1[i])); }
            } else if (MODE == 1) {
                const int tk = t * 64;
                const bool diag = (tk + 63 > B.qmin);
#pragma unroll
                for (int g = 0; g < 4; ++g) {
                    const int kq = 16 * (g >> 1) + 8 * hi + 4 * (g & 1);
                    const f32x4 c0 = *(const LAS f32x4*)(B.tab + tk + kq), c1 = *(const LAS f32x4*)(B.tab + tk + 32 + kq);
#pragma unroll
                    for (int j = 0; j < 4; ++j) { const int i = 4 * g + j; float v0 = s0[i] * C + (B.cq - c0[j]), v1 = s1[i] * C + (B.cq - c1[j]);
                        if (diag) { const int ko = tk + kq + j; if (ko > B.qpos) v0 = NEG; if (ko + 32 > B.qpos) v1 = NEG; }
                        s0[i] = v0; s1[i] = v1; mx = fmaxf(mx, fmaxf(v0, v1)); }
                    __builtin_amdgcn_sched_barrier(0);
                }
            } else {
                const int tk = B.kpos0 + t * 64;
                const bool far = (MODE == 2) && (B.qmin - (tk + 63) >= 128);
                if (far) { const float bb = B.tab[128];
#pragma unroll
                    for (int i = 0; i < 16; ++i) { s0[i] = s0[i] * C + bb; s1[i] = s1[i] * C + bb; mx = fmaxf(mx, fmaxf(s0[i], s1[i])); }
                } else {
#pragma unroll
                    for (int i = 0; i < 16; ++i) { const int ko = 16 * (i >> 3) + 8 * hi + (i & 7); const int d0 = B.qpos - (tk + ko), d1 = d0 - 32;
                        float v0 = s0[i] * C + B.tab[d0 < 0 ? 0 : (d0 > 128 ? 128 : d0)], v1 = s1[i] * C + B.tab[d1 < 0 ? 0 : (d1 > 128 ? 128 : d1)];
                        if (MODE == 3) { if (d0 < 0) v0 = NEG; if (d1 < 0) v1 = NEG; }
                        s0[i] = v0; s1[i] = v1; mx = fmaxf(mx, fmaxf(v0, v1)); }
                }
            }
            mx = swap_max(mx);
            const float mn = fmaxf(m, mx), alpha = fast_exp2(m - mn); m = mn;
            float ps = 0.f;
#pragma unroll
            for (int i = 0; i < 16; ++i) { s0[i] = fast_exp2(s0[i] - mn); s1[i] = fast_exp2(s1[i] - mn); ps += s0[i] + s1[i]; }
            ps = swap_sum(ps); l = l * alpha + ps;
            if (!__all(alpha == 1.0f)) {
#pragma unroll
                for (int db = 0; db < 4; ++db)
#pragma unroll
                    for (int i = 0; i < 16; ++i) o[db][i] *= alpha;
            }
            bf16x8 pf[4];
#pragma unroll
            for (int s = 0; s < 4; ++s) { u32x4 wv;
                if (s < 2) { wv.x = cvt_pk_bf16(s0[8 * s + 0], s0[8 * s + 1]); wv.y = cvt_pk_bf16(s0[8 * s + 2], s0[8 * s + 3]); wv.z = cvt_pk_bf16(s0[8 * s + 4], s0[8 * s + 5]); wv.w = cvt_pk_bf16(s0[8 * s + 6], s0[8 * s + 7]); }
                else { const int q = s - 2; wv.x = cvt_pk_bf16(s1[8 * q + 0], s1[8 * q + 1]); wv.y = cvt_pk_bf16(s1[8 * q + 2], s1[8 * q + 3]); wv.z = cvt_pk_bf16(s1[8 * q + 4], s1[8 * q + 5]); wv.w = cvt_pk_bf16(s1[8 * q + 6], s1[8 * q + 7]); }
                pf[s] = *reinterpret_cast<bf16x8*>(&wv); }
            const LAS unsigned char* vb = lds + AT_V0 + buf * 16384;
#pragma unroll
            for (int s = 0; s < 4; ++s) {
#pragma unroll
                for (int db = 0; db < 4; ++db) { const bf16x8 vf = *(const LAS bf16x8*)(vb + vaddr[s] + db * 4096); o[db] = __builtin_amdgcn_mfma_f32_32x32x16_bf16(vf, pf[s], o[db], 0, 0, 0); }
                __builtin_amdgcn_sched_barrier(0);
            }
        }
        asm volatile("s_waitcnt vmcnt(0)" ::: "memory");
        __syncthreads();
    }
#undef AT_DMA
}
__device__ __forceinline__ void attn_init(f32x16 (&o)[4], float& m, float& l) {
#pragma unroll
    for (int db = 0; db < 4; ++db)
#pragma unroll
        for (int i = 0; i < 16; ++i) o[db][i] = 0.f;
    m = -1e30f; l = 0.f;
}
__device__ __forceinline__ void load_q(const bf16_t* qrow, int hi, bf16x8 (&qf)[8]) {
#pragma unroll
    for (int ks = 0; ks < 8; ++ks) qf[ks] = *(const bf16x8*)(qrow + 16 * ks + 8 * hi);
}
__device__ __forceinline__ void store_o(const f32x16 (&o)[4], float sc, bf16_t* orow, int hi) {
#pragma unroll
    for (int db = 0; db < 4; ++db)
#pragma unroll
        for (int g = 0; g < 4; ++g) { u32x2 w; w.x = cvt_pk_bf16(o[db][4 * g] * sc, o[db][4 * g + 1] * sc); w.y = cvt_pk_bf16(o[db][4 * g + 2] * sc, o[db][4 * g + 3] * sc);
            *(u32x2*)(orow + 32 * db + 8 * g + 4 * hi) = w; }
}

__device__ __forceinline__ void phase_memattn(const Params& p, LAS unsigned char* lds, int bid, int nb) {
    const int tid = tid_(), lane = tid & 63, w = tid >> 6, c = lane & 31, hi = lane >> 5;
    for (int u = bid; u < BATCH * MH * 32; u += nb) {
        const int b = u >> 7, mh = (u >> 5) & 3, qb = u & 31;
        const int tok = b * SEQ + qb * 256 + 32 * w + c;
        bf16x8 qf[8]; load_q(WSP(bf16_t, WS_PMQ) + (size_t)tok * MEMW + mh * HD, hi, qf);
        f32x16 o[4]; float m, l; attn_init(o, m, l);
        AttnBias B{0.f, 0, nullptr, 0, 0};
        attn_tiles<0>(lds, WSP(bf16_t, WS_MEMK) + (size_t)b * MEMT * MEMW + mh * HD, MEMW, WSP(bf16_t, WS_MEMVT) + (size_t)mh * HD * 512 + b * MEMT, 512, 4, 4, qf, o, m, l, B);
        store_o(o, 1.0f / l, WSP(bf16_t, WS_MIX) + (size_t)tok * OUT_IN + DM + mh * HD, hi);
    }
}

__device__ __forceinline__ void phase_fox_logf(const Params& p, int layer, int bid, int nb) {
    const int tid = tid_(), lane = tid & 63, w = tid >> 6;
    const float* xin = (layer == 0) ? p.in[I_X] : WSP(float, WS_XF);
    const float* wf = p.in[I_FOX_W] + (size_t)(layer / 3) * DM * FOX_IN + 3072;
    const float* bf = p.in[I_FOX_BF] + (layer / 3) * NH;
    float wr[16][8];
#pragma unroll
    for (int j = 0; j < 4; ++j)
#pragma unroll
        for (int q = 0; q < 4; ++q) { const int k = 256 * j + 4 * lane + q;
#pragma unroll
            for (int h = 0; h < 8; ++h) wr[4 * j + q][h] = wf[(size_t)k * FOX_IN + h]; }
    for (int tok = bid * NWAVES + w; tok < T; tok += nb * NWAVES) {
        float acc[8];
#pragma unroll
        for (int h = 0; h < 8; ++h) acc[h] = 0.f;
#pragma unroll
        for (int j = 0; j < 4; ++j) { const f32x4 xv = *(const f32x4*)(xin + (size_t)tok * DM + 256 * j + 4 * lane);
#pragma unroll
            for (int q = 0; q < 4; ++q)
#pragma unroll
                for (int h = 0; h < 8; ++h) acc[h] = fmaf(xv[q], wr[4 * j + q][h], acc[h]); }
#pragma unroll
        for (int h = 0; h < 8; ++h) acc[h] = wave_sum(acc[h]);
        if (lane < 8) { float z = 0.f;
#pragma unroll
            for (int h = 0; h < 8; ++h) z = (lane == h) ? acc[h] : z;
            const int b = tok / SEQ, s = tok % SEQ;
            WSP(float, WS_LOGF)[((size_t)b * NH + lane) * SEQ + s] = logsigmoidf_(z + bf[lane]) * LOG2E; }
    }
}
__device__ __forceinline__ void phase_fox_prep(const Params& p, int bid, int nb) {
    const int tid = tid_(), lane = tid & 63, w = tid >> 6; const int gw = bid * NWAVES + w, ngw = nb * NWAVES;
    for (int it = gw; it < 16 + 2048; it += ngw) {
        if (it < 16) { const float* src = WSP(float, WS_LOGF) + (size_t)it * SEQ; float* dst = WSP(float, WS_C2) + (size_t)it * SEQ; float carry = 0.f;
            for (int c0 = 0; c0 < SEQ; c0 += 1024) { float v[16]; float run = 0.f;
#pragma unroll
                for (int j = 0; j < 4; ++j) { const f32x4 x = *(const f32x4*)(src + c0 + lane * 16 + 4 * j); v[4 * j] = x[0]; v[4 * j + 1] = x[1]; v[4 * j + 2] = x[2]; v[4 * j + 3] = x[3]; }
#pragma unroll
                for (int j = 0; j < 16; ++j) { run += v[j]; v[j] = run; }
                float inc = run;
#pragma unroll
                for (int o_ = 1; o_ < 64; o_ <<= 1) { const float y = __shfl_up(inc, o_); if (lane >= o_) inc += y; }
                const float base = carry + inc - run;
#pragma unroll
                for (int j = 0; j < 4; ++j) *(f32x4*)(dst + c0 + lane * 16 + 4 * j) = (f32x4){v[4 * j] + base, v[4 * j + 1] + base, v[4 * j + 2] + base, v[4 * j + 3] + base};
                carry += __shfl(inc, 63); }
        } else { const int u = it - 16, bh = u >> 7, t = u & 127, b = bh >> 3, h = bh & 7;
            const bf16_t* kp = WSP(bf16_t, WS_PB) + ((size_t)b * SEQ + t * 64 + lane) * DM + h * HD; float ss = 0.f;
#pragma unroll
            for (int j = 0; j < 16; ++j) { const u32x4 x = *(const u32x4*)(kp + 8 * j);
                ss += bflo(x.x) * bflo(x.x) + bfhi(x.x) * bfhi(x.x) + bflo(x.y) * bflo(x.y) + bfhi(x.y) * bfhi(x.y) + bflo(x.z) * bflo(x.z) + bfhi(x.z) * bfhi(x.z) + bflo(x.w) * bflo(x.w) + bfhi(x.w) * bfhi(x.w); }
#pragma unroll
            for (int o_ = 1; o_ < 64; o_ <<= 1) ss = fmaxf(ss, __shfl_xor(ss, o_));
            if (lane == 0) WSP(float, WS_KNT)[u] = sqrtf(ss) * 1.0001f; }
    }
}
constexpr float FOX_PRUNE = 40.0f;
__device__ __forceinline__ void phase_fox_attn(const Params& p, LAS unsigned char* lds, int layer, int bid, int nb) {
    const int tid = tid_(), lane = tid & 63, w = __builtin_amdgcn_readfirstlane(tid >> 6), c = lane & 31, r = c, hi = lane >> 5;
    LAS float* c2 = (LAS float*)(lds + AT_AUX);
    LAS float* kn = (LAS float*)(lds + AT_AUX + 32768);
    LAS int* sh = (LAS int*)(lds + AT_AUX + 32768 + 512);
    const float* bfp = p.in[I_FOX_BF] + (layer / 3) * NH;
    int koff[2], voff[2];
#pragma unroll
    for (int i = 0; i < 2; ++i) { const int pz = (w * 2 + i) * 64 + lane;
        { const int row = pz >> 4, chp = pz & 15, ch = chp ^ ((row & 3) | (((row >> 3) & 3) << 2)); koff[i] = row * DM + ch * 8; }
        { const int row = pz >> 3, chp = pz & 7, ch = chp ^ (((row >> 1) & 1) | (((row >> 3) & 3) << 1)); voff[i] = row * T + ch * 8; } }
    const int pr = (r & ~12) | ((r & 4) << 1) | ((r & 8) >> 1);
    int kaddr[8], vaddr[4];
#pragma unroll
    for (int ks = 0; ks < 8; ++ks) kaddr[ks] = kswz(pr, 2 * ks + hi);
#pragma unroll
    for (int s_ = 0; s_ < 4; ++s_) vaddr[s_] = vswz(r, 2 * s_ + hi);
    constexpr float C = QK_SCALE * LOG2E; const float NEG = -__builtin_inff();
    for (;;) {
        __syncthreads();
        if (tid == 0) sh[0] = (int)atomicAdd(ctl(p) + CW_FOXQ, 1u);
        __syncthreads();
        const int u = sh[0]; if (u >= 512) break;
        const int rk = u >> 6, b = (u >> 5) & 1, qb = 31 - (u & 31);
        int h = 0;
        for (int hc = 0; hc < NH; ++hc) { int rank = 0; for (int h2 = 0; h2 < NH; ++h2) rank += (bfp[h2] > bfp[hc] || (bfp[h2] == bfp[hc] && h2 < hc)) ? 1 : 0; if (rank == rk) h = hc; }
        const int bh = b * NH + h, n = (qb + 1) * 256, ntiles = (qb + 1) * 4;
        for (int i = tid * 4; i < n; i += NTHR * 4) *(LAS f32x4*)(c2 + i) = *(const f32x4*)(WSP(float, WS_C2) + (size_t)bh * SEQ + i);
        if (tid < 128) kn[tid] = WSP(float, WS_KNT)[bh * 128 + tid];
        const int qpos = qb * 256 + 32 * w + c, tok = b * SEQ + qpos, qmin = qb * 256 + 32 * w;
        bf16x8 qf[8]; load_q(WSP(bf16_t, WS_PA) + (size_t)tok * DM + h * HD, hi, qf);
        float qn2 = 0.f;
#pragma unroll
        for (int ks = 0; ks < 8; ++ks) { const u32x4 x = *reinterpret_cast<const u32x4*>(&qf[ks]);
            qn2 += bflo(x.x) * bflo(x.x) + bfhi(x.x) * bfhi(x.x) + bflo(x.y) * bflo(x.y) + bfhi(x.y) * bfhi(x.y) + bflo(x.z) * bflo(x.z) + bfhi(x.z) * bfhi(x.z) + bflo(x.w) * bflo(x.w) + bfhi(x.w) * bfhi(x.w); }
        qn2 = swap_sum(qn2);
#pragma unroll
        for (int o_ = 1; o_ < 32; o_ <<= 1) qn2 = fmaxf(qn2, __shfl_xor(qn2, o_));
        f32x16 o[4]; float m, l; attn_init(o, m, l);
        const bf16_t* kbase = WSP(bf16_t, WS_PB) + (size_t)b * SEQ * DM + h * HD; const bf16_t* vtbase = WSP(bf16_t, WS_PVT) + (size_t)h * HD * T + (size_t)b * SEQ;
        const int wave_nt = ((qb * 256 + 32 * w + 31) >> 6) + 1;
#define FX_DMA(t, buf) do { _Pragma("unroll") for (int _i = 0; _i < 2; ++_i) { \
        __builtin_amdgcn_global_load_lds((const unsigned*)(kbase + (size_t)(t) * 64 * DM + koff[_i]), (LAS unsigned*)(lds + AT_K0 + (buf) * 16384 + (w * 2 + _i) * 1024), 16, 0, 0); \
        __builtin_amdgcn_global_load_lds((const unsigned*)(vtbase + (t) * 64 + voff[_i]), (LAS unsigned*)(lds + AT_V0 + (buf) * 16384 + (w * 2 + _i) * 1024), 16, 0, 0); } } while (0)
        int t_lo = ntiles - 4, my_lo = 0; bool decided = false;
        FX_DMA(ntiles - 1, 0);
        asm volatile("s_waitcnt vmcnt(0)" ::: "memory");
        __syncthreads();
        const float cq = c2[qpos];
        for (int it = 0;; ++it) {
            const int t = ntiles - 1 - it, buf = it & 1;
            bool has_next = (t - 1 >= t_lo);
            if (has_next) FX_DMA(t - 1, buf ^ 1);
            if (t < wave_nt && t >= my_lo) {
                f32x16 s0, s1;
#pragma unroll
                for (int i = 0; i < 16; ++i) { s0[i] = 0.f; s1[i] = 0.f; }
                const LAS unsigned char* kb = lds + AT_K0 + buf * 16384;
#pragma unroll
                for (int kg = 0; kg < 4; ++kg) {
#pragma unroll
                    for (int k2 = 0; k2 < 2; ++k2) { const int ks = 2 * kg + k2;
                        const bf16x8 k0 = *(const LAS bf16x8*)(kb + kaddr[ks]), k1 = *(const LAS bf16x8*)(kb + kaddr[ks] + 8192);
                        s0 = __builtin_amdgcn_mfma_f32_32x32x16_bf16(k0, qf[ks], s0, 0, 0, 0);
                        s1 = __builtin_amdgcn_mfma_f32_32x32x16_bf16(k1, qf[ks], s1, 0, 0, 0); }
                    __builtin_amdgcn_sched_barrier(0);
                }
                float mx = NEG; const int tk = t * 64; const bool diag = (tk + 63 > qmin);
#pragma unroll
                for (int g = 0; g < 4; ++g) { const int kq = 16 * (g >> 1) + 8 * hi + 4 * (g & 1);
                    const f32x4 c0 = *(const LAS f32x4*)(c2 + tk + kq), c1 = *(const LAS f32x4*)(c2 + tk + 32 + kq);
#pragma unroll
                    for (int j = 0; j < 4; ++j) { const int i = 4 * g + j; float v0 = s0[i] * C + (cq - c0[j]), v1 = s1[i] * C + (cq - c1[j]);
                        if (diag) { const int ko = tk + kq + j; if (ko > qpos) v0 = NEG; if (ko + 32 > qpos) v1 = NEG; }
                        s0[i] = v0; s1[i] = v1; mx = fmaxf(mx, fmaxf(v0, v1)); }
                    __builtin_amdgcn_sched_barrier(0);
                }
                mx = swap_max(mx);
                const float mn = fmaxf(m, mx), alpha = fast_exp2(m - mn); m = mn;
                float ps = 0.f;
#pragma unroll
                for (int i = 0; i < 16; ++i) { s0[i] = fast_exp2(s0[i] - mn); s1[i] = fast_exp2(s1[i] - mn); ps += s0[i] + s1[i]; }
                ps = swap_sum(ps); l = l * alpha + ps;
                if (!__all(alpha == 1.0f)) {
#pragma unroll
                    for (int db = 0; db < 4; ++db)
#pragma unroll
                        for (int i = 0; i < 16; ++i) o[db][i] *= alpha;
                }
                bf16x8 pf[4];
#pragma unroll
                for (int s = 0; s < 4; ++s) { u32x4 wv;
                    if (s < 2) { wv.x = cvt_pk_bf16(s0[8 * s + 0], s0[8 * s + 1]); wv.y = cvt_pk_bf16(s0[8 * s + 2], s0[8 * s + 3]); wv.z = cvt_pk_bf16(s0[8 * s + 4], s0[8 * s + 5]); wv.w = cvt_pk_bf16(s0[8 * s + 6], s0[8 * s + 7]); }
                    else { const int q = s - 2; wv.x = cvt_pk_bf16(s1[8 * q + 0], s1[8 * q + 1]); wv.y = cvt_pk_bf16(s1[8 * q + 2], s1[8 * q + 3]); wv.z = cvt_pk_bf16(s1[8 * q + 4], s1[8 * q + 5]); wv.w = cvt_pk_bf16(s1[8 * q + 6], s1[8 * q + 7]); }
                    pf[s] = *reinterpret_cast<bf16x8*>(&wv); }
                const LAS unsigned char* vb = lds + AT_V0 + buf * 16384;
#pragma unroll
                for (int s = 0; s < 4; ++s) {
#pragma unroll
                    for (int db = 0; db < 4; ++db) { const bf16x8 vf = *(const LAS bf16x8*)(vb + vaddr[s] + db * 4096); o[db] = __builtin_amdgcn_mfma_f32_32x32x16_bf16(vf, pf[s], o[db], 0, 0, 0); }
                    __builtin_amdgcn_sched_barrier(0);
                }
            }
            asm volatile("s_waitcnt vmcnt(0)" ::: "memory");
            __syncthreads();
            if (!has_next) {
                if (decided || t == 0) break;
                decided = true;
                {
                    float mmin = m;
#pragma unroll
                    for (int o_ = 1; o_ < 64; o_ <<= 1) mmin = fminf(mmin, __shfl_xor(mmin, o_));
                    const float qmax = sqrtf(qn2) * 1.0001f, cq0 = c2[qmin], thr = mmin - FOX_PRUNE;
                    int first = t;
                    for (int tt = lane; tt < t; tt += 64) { const float ub = C * qmax * kn[tt] + (cq0 - c2[tt * 64 + 63]); if (ub >= thr) first = tt < first ? tt : first; }
#pragma unroll
                    for (int o_ = 1; o_ < 64; o_ <<= 1) { const int y = __shfl_xor(first, o_); first = y < first ? y : first; }
                    my_lo = first; if (lane == 0) sh[1 + w] = first;
                }
                __syncthreads();
                int lo = sh[1];
#pragma unroll
                for (int q = 1; q < 8; ++q) lo = sh[1 + q] < lo ? sh[1 + q] : lo;
                t_lo = lo;
                if (t - 1 < t_lo) break;
                FX_DMA(t - 1, buf ^ 1);
                asm volatile("s_waitcnt vmcnt(0)" ::: "memory");
                __syncthreads();
            }
        }
#undef FX_DMA
        store_o(o, 1.0f / l, WSP(bf16_t, WS_MIX) + (size_t)tok * OUT_IN + h * HD, hi);
    }
}

__device__ __forceinline__ int t5_bucket(int n) {
    if (n < 16) return n;
    const int v = 16 + (int)(__log2f((float)n * (1.0f / 16.0f)) * (16.0f / 3.0f));
    return v < 31 ? v : 31;
}
__device__ __forceinline__ void phase_moba_kmean(const Params& p, LAS unsigned char* lds, int bid, int nb) {
    const int tid = tid_(); LAS float* red = (LAS float*)lds;
    const int dp = tid & 63, kg = tid >> 6;
    for (int u = bid; u < 512; u += nb) {
        const int bh = u >> 5, j = u & 31, b = bh >> 3, h = bh & 7;
        const bf16_t* kp = WSP(bf16_t, WS_PB) + ((size_t)b * SEQ + j * 256 + kg * 32) * DM + h * HD + 2 * dp;
        float s0 = 0.f, s1 = 0.f;
#pragma unroll 8
        for (int k = 0; k < 32; ++k) { const unsigned wv = *(const unsigned*)(kp + (size_t)k * DM); s0 += bflo(wv); s1 += bfhi(wv); }
        __syncthreads();
        red[kg * 128 + 2 * dp] = s0; red[kg * 128 + 2 * dp + 1] = s1;
        __syncthreads();
        if (tid < 128) { float s = 0.f;
#pragma unroll
            for (int g = 0; g < 8; ++g) s += red[g * 128 + tid];
            WSP(float, WS_KMEAN)[(size_t)u * 128 + tid] = s * (1.0f / 256.0f); }
    }
}
__device__ __forceinline__ void phase_moba_gate(const Params& p, LAS unsigned char* lds, int bid, int nb) {
    const int tid = tid_(); LAS float* km = (LAS float*)lds;
    LAS int* lcnt = (LAS int*)(lds + 16384); LAS int* lbase = lcnt + 32;
    unsigned* gl = ctl(p) + CW_LCNT;
    for (int u = bid; u < 512; u += nb) {
        const int bh = u >> 5, own = u & 31, b = bh >> 3, h = bh & 7;
        __syncthreads();
        for (int i = tid; i < 32 * 128; i += NTHR) km[i] = WSP(float, WS_KMEAN)[(size_t)bh * 32 * 128 + i];
        if (tid < 32) lcnt[tid] = 0;
        __syncthreads();
        int sel[3] = {-1, -1, -1}, rank[3] = {0, 0, 0}; int nv = 0;
        const int q = own * 256 + (tid & 255);
        if (tid < 256) {
            const bf16_t* qp = WSP(bf16_t, WS_PA) + ((size_t)b * SEQ + q) * DM + h * HD;
            unsigned qw[64];
#pragma unroll
            for (int i = 0; i < 16; ++i) { const u32x4 x = *(const u32x4*)(qp + 8 * i); qw[4 * i] = x.x; qw[4 * i + 1] = x.y; qw[4 * i + 2] = x.z; qw[4 * i + 3] = x.w; }
            float best[3] = {-__builtin_inff(), -__builtin_inff(), -__builtin_inff()};
            for (int j = 0; j < own; ++j) { const LAS float* kr = km + j * 128; float g = 0.f;
#pragma unroll
                for (int i = 0; i < 64; ++i) { g = fmaf(bflo(qw[i]), kr[2 * i], g); g = fmaf(bfhi(qw[i]), kr[2 * i + 1], g); }
                if (g > best[0]) { best[2] = best[1]; sel[2] = sel[1]; best[1] = best[0]; sel[1] = sel[0]; best[0] = g; sel[0] = j; }
                else if (g > best[1]) { best[2] = best[1]; sel[2] = sel[1]; best[1] = g; sel[1] = j; }
                else if (g > best[2]) { best[2] = g; sel[2] = j; } }
            nv = own < 3 ? own : 3;
            for (int s = 0; s < 3; ++s) if (s < nv) rank[s] = atomicAdd((int*)&lcnt[sel[s]], 1);
            int* sp = WSP(int, WS_SEL) + (((size_t)b * SEQ + q) * NH + h) * 4; sp[0] = sel[0]; sp[1] = sel[1]; sp[2] = sel[2]; sp[3] = nv;
        }
        __syncthreads();
        if (tid < 32) lbase[tid] = lcnt[tid] ? (int)atomicAdd(gl + bh * 32 + tid, (unsigned)lcnt[tid]) : 0;
        __syncthreads();
        if (tid < 256) for (int s = 0; s < 3; ++s) if (s < nv) WSP(unsigned, WS_LISTS)[((size_t)bh * 32 + sel[s]) * 8192 + lbase[sel[s]] + rank[s]] = (unsigned)q | ((unsigned)s << 16);
    }
}
__device__ __forceinline__ void moba_bias_tab(const Params& p, LAS float* tab, int h) {
    const int tid = tid_();
    if (tid <= 128) tab[tid] = p.in[I_RELB][t5_bucket(tid) * NH + h] * LOG2E;
}
__device__ __forceinline__ void phase_moba_past(const Params& p, LAS unsigned char* lds, int bid, int nb) {
    const int tid = tid_(), lane = tid & 63, w = tid >> 6, c = lane & 31, hi = lane >> 5;
    LAS float* tab = (LAS float*)(lds + AT_AUX); LAS int* pre = (LAS int*)(lds + AT_AUX + 1024);
    LAS int* wsum = (LAS int*)(lds + AT_AUX + 1024 + 4096);
    const unsigned* gl = ctl(p) + CW_LCNT;
    {
        const int n = (int)__hip_atomic_load(gl + tid, __ATOMIC_RELAXED, __HIP_MEMORY_SCOPE_AGENT); const int nu = (n + 255) >> 8;
        int inc = nu;
#pragma unroll
        for (int o_ = 1; o_ < 64; o_ <<= 1) { const int y = __shfl_up(inc, o_); if (lane >= o_) inc += y; }
        if (lane == 63) wsum[w] = inc;
        __syncthreads();
        int base = inc - nu; for (int q = 0; q < w; ++q) base += wsum[q];
        pre[tid] = base; if (tid == 511) pre[512] = base + nu;
        __syncthreads();
    }
    const int total = pre[512];
    int cur_h = -1;
    for (int u = bid; u < total; u += nb) {
        int lo = 0, hiL = 511;
        while (lo < hiL) { const int mid = (lo + hiL + 1) >> 1; if (pre[mid] <= u) lo = mid; else hiL = mid - 1; }
        const int list = lo, chunk = u - pre[list], bh = list >> 5, j = list & 31, b = bh >> 3, h = bh & 7;
        const int n = (int)__hip_atomic_load(gl + list, __ATOMIC_RELAXED, __HIP_MEMORY_SCOPE_AGENT);
        if (h != cur_h) { __syncthreads(); moba_bias_tab(p, tab, h); cur_h = h; __syncthreads(); }
        const int e0 = chunk * 256 + 32 * w; const bool active = e0 < n;
        int ei = e0 + c; if (ei > n - 1) ei = n - 1;
        const unsigned ent = WSP(unsigned, WS_LISTS)[(size_t)list * 8192 + ei]; const int q = ent & 0xffff, slot = ent >> 16;
        const int tok = b * SEQ + q;
        bf16x8 qf[8]; load_q(WSP(bf16_t, WS_PA) + (size_t)tok * DM + h * HD, hi, qf);
        int qmin = q;
#pragma unroll
        for (int o_ = 1; o_ < 64; o_ <<= 1) { const int y = __shfl_xor(qmin, o_); qmin = y < qmin ? y : qmin; }
        f32x16 o[4]; float m, l; attn_init(o, m, l);
        AttnBias B{0.f, q, tab, j * 256, qmin};
        attn_tiles<2>(lds, WSP(bf16_t, WS_PB) + ((size_t)b * SEQ + j * 256) * DM + h * HD, DM, WSP(bf16_t, WS_PVT) + (size_t)h * HD * T + (size_t)b * SEQ + j * 256, T, 4, active ? 4 : 0, qf, o, m, l, B);
        if (active) { const size_t P = ((size_t)tok * NH + h) * 3 + slot;
            store_o(o, 1.0f / l, WSP(bf16_t, WS_PARTO) + P * HD, hi);
            if (hi == 0) WSP(float, WS_PARTL)[P] = m + __log2f(l); }
    }
}
__device__ __forceinline__ void phase_moba_own(const Params& p, LAS unsigned char* lds, int bid, int nb) {
    const int tid = tid_(), lane = tid & 63, w = tid >> 6, c = lane & 31, hi = lane >> 5;
    LAS float* tab = (LAS float*)(lds + AT_AUX);
    int cur_h = -1;
    for (int u = bid; u < 512; u += nb) {
        const int bh = u >> 5, blk = u & 31, b = bh >> 3, h = bh & 7;
        if (h != cur_h) { __syncthreads(); moba_bias_tab(p, tab, h); cur_h = h; __syncthreads(); }
        const int qrel = 32 * w + c, q = blk * 256 + qrel, tok = b * SEQ + q;
        bf16x8 qf[8]; load_q(WSP(bf16_t, WS_PA) + (size_t)tok * DM + h * HD, hi, qf);
        f32x16 o[4]; float m, l; attn_init(o, m, l);
        AttnBias B{0.f, qrel, tab, 0, 32 * w};
        attn_tiles<3>(lds, WSP(bf16_t, WS_PB) + ((size_t)b * SEQ + blk * 256) * DM + h * HD, DM, WSP(bf16_t, WS_PVT) + (size_t)h * HD * T + (size_t)b * SEQ + blk * 256, T, 4, (w >> 1) + 1, qf, o, m, l, B);
        const int* sp = WSP(int, WS_SEL) + ((size_t)tok * NH + h) * 4; const int nv = sp[3];
        const size_t P = ((size_t)tok * NH + h) * 3;
        float lse[3], M = m;
#pragma unroll
        for (int s = 0; s < 3; ++s) { lse[s] = (s < nv) ? WSP(float, WS_PARTL)[P + s] : -__builtin_inff(); M = fmaxf(M, lse[s]); }
        const float wo = fast_exp2(m - M); float den = l * wo;
#pragma unroll
        for (int db = 0; db < 4; ++db)
#pragma unroll
            for (int i = 0; i < 16; ++i) o[db][i] *= wo;
#pragma unroll
        for (int s = 0; s < 3; ++s) { if (s < nv) { const float ws_ = fast_exp2(lse[s] - M); den += ws_; const bf16_t* po = WSP(bf16_t, WS_PARTO) + (P + s) * HD;
#pragma unroll
                for (int db = 0; db < 4; ++db)
#pragma unroll
                    for (int g = 0; g < 4; ++g) { const u32x2 x = *(const u32x2*)(po + 32 * db + 8 * g + 4 * hi);
                        o[db][4 * g] += ws_ * bflo(x.x); o[db][4 * g + 1] += ws_ * bfhi(x.x); o[db][4 * g + 2] += ws_ * bflo(x.y); o[db][4 * g + 3] += ws_ * bfhi(x.y); } } }
        store_o(o, 1.0f / den, WSP(bf16_t, WS_MIX) + (size_t)tok * OUT_IN + h * HD, hi);
    }
}

__device__ __forceinline__ void phase_hgrn_pre(const Params& p, int layer, int bid, int nb) {
    const int jj = layer / 3; const int tid = tid_(), lane = tid & 63, w = tid >> 6;
    const float* lbp = p.in[I_HGRN_LB];
    for (int item = bid * NWAVES + w; item < 256 * 32; item += nb * NWAVES) {
        const int crow = item >> 5, cg = item & 31, ch0 = cg * 32;
        const int b = crow >> 7, cc = crow & 127; const size_t tok = (size_t)b * SEQ + cc * 64 + lane;
        f32x4 z[8]; u32x4 qw[4];
#pragma unroll
        for (int j = 0; j < 8; ++j) z[j] = *(const f32x4*)(WSP(float, WS_PZ) + tok * DM + ch0 + 4 * j);
#pragma unroll
        for (int j = 0; j < 4; ++j) qw[j] = *(const u32x4*)(WSP(bf16_t, WS_PA) + tok * DM + ch0 + 8 * j);
        unsigned oqb[16], oqr[16], okr[16]; float gsel = 0.f;
#pragma unroll
        for (int j = 0; j < 8; ++j) {
            float vqb[4], vqr[4], vkr[4];
#pragma unroll
            for (int q = 0; q < 4; ++q) { const int cl = 4 * j + q, ch = ch0 + cl; const float zz = z[j][q];
                const float lb = (jj == 0) ? 0.f : sigmoidf_(lbp[DM + ch] - lbp[ch]);
                const float e = __expf(-fabsf(zz)), r1 = fast_rcp(1.0f + e), l1 = __logf(1.0f + e);
                const float sg = (zz >= 0.f) ? r1 : e * r1, sgn = (zz >= 0.f) ? e * r1 : r1;
                const float ls = fminf(zz, 0.f) - l1;
                const float lf = (jj == 0) ? ls : __logf(lb + (1.f - lb) * sg);
                float bc = lf;
#pragma unroll
                for (int o_ = 1; o_ < 64; o_ <<= 1) { const float y = __shfl_up(bc, o_); if (lane >= o_) bc += y; }
                const float bmid = __shfl(bc, 31), blast = __shfl(bc, 63);
                const float kk = (1.f - lb) * sgn;
                const unsigned qword = (cl & 1) ? 0u : 0u; (void)qword;
                const unsigned qwv = ((const unsigned*)&qw[cl >> 3])[(cl & 7) >> 1]; const float qv = (cl & 1) ? bfhi(qwv) : bflo(qwv);
                vqb[q] = qv * __expf(bc); vqr[q] = qv * __expf(fminf(bc - bmid, 80.f)); vkr[q] = kk * __expf(fminf(bmid - bc, 80.f));
                WSP(bf16_t, WS_HKDT)[(size_t)ch * T + tok] = f2bf(kk * __expf(blast - bc));
                gsel = (lane == cl) ? __expf(blast) : gsel; }
            oqb[2 * j] = cvt_pk_bf16(vqb[0], vqb[1]); oqb[2 * j + 1] = cvt_pk_bf16(vqb[2], vqb[3]);
            oqr[2 * j] = cvt_pk_bf16(vqr[0], vqr[1]); oqr[2 * j + 1] = cvt_pk_bf16(vqr[2], vqr[3]);
            okr[2 * j] = cvt_pk_bf16(vkr[0], vkr[1]); okr[2 * j + 1] = cvt_pk_bf16(vkr[2], vkr[3]);
        }
        {
            const int hh_ = cg >> 2, uu = (b * NH + hh_) * 128 + cc, tb_ = lane >> 5, c_ = lane & 31, pc_ = (c_ & ~12) | ((c_ & 4) << 1) | ((c_ & 8) >> 1);
#pragma unroll
            for (int j = 0; j < 4; ++j) { const int ks_ = (cg & 3) * 2 + (j >> 1), h_ = j & 1; const size_t fb = ((size_t)(uu * 2 + tb_) * 8 + ks_) * 512;
                *(u32x4*)(WSP(bf16_t, WS_HQB) + fb + (c_ + 32 * h_) * 8) = (u32x4){oqb[4 * j], oqb[4 * j + 1], oqb[4 * j + 2], oqb[4 * j + 3]};
                *(u32x4*)(WSP(bf16_t, WS_HQR) + fb + (c_ + 32 * h_) * 8) = (u32x4){oqr[4 * j], oqr[4 * j + 1], oqr[4 * j + 2], oqr[4 * j + 3]};
                *(u32x4*)(WSP(bf16_t, WS_HKR) + fb + (pc_ + 32 * h_) * 8) = (u32x4){okr[4 * j], okr[4 * j + 1], okr[4 * j + 2], okr[4 * j + 3]}; }
        }
        if (lane < 32) { const int ch = ch0 + lane, hh = ch >> 7, d = ch & 127; WSP(float, WS_HG)[((size_t)(b * NH + hh) * 128 + cc) * 128 + d] = gsel; }
    }
}
__device__ __forceinline__ void phase_hgrn_a(const Params& p, int bid, int nb) {
    const int tid = tid_(), lane = tid & 63, w = tid >> 6, c = lane & 31, hi = lane >> 5, eb = w >> 1, dh = w & 1;
    for (int u = bid; u < 2048; u += nb) {
        const int bh = u >> 7, cc = u & 127, b = bh >> 3, hh = bh & 7; const size_t tok0 = (size_t)b * SEQ + cc * 64;
        const bf16_t* vt = WSP(bf16_t, WS_PVT) + ((size_t)(u * 4 + eb) * 4) * 512 + lane * 8;
        const bf16_t* kd = WSP(bf16_t, WS_HKDT) + (size_t)(hh * HD + 64 * dh + c) * T + tok0 + 8 * hi;
        f32x16 a0, a1;
#pragma unroll
        for (int i = 0; i < 16; ++i) { a0[i] = 0.f; a1[i] = 0.f; }
#pragma unroll
        for (int ks = 0; ks < 4; ++ks) { const bf16x8 vf = *(const bf16x8*)(vt + ks * 512), k0 = *(const bf16x8*)(kd + 16 * ks), k1 = *(const bf16x8*)(kd + (size_t)32 * T + 16 * ks);
            a0 = __builtin_amdgcn_mfma_f32_32x32x16_bf16(k0, vf, a0, 0, 0, 0); a1 = __builtin_amdgcn_mfma_f32_32x32x16_bf16(k1, vf, a1, 0, 0, 0); }
        bf16_t* st = WSP(bf16_t, WS_HST) + (size_t)u * 128 * 128;
#pragma unroll
        for (int g = 0; g < 4; ++g) { u32x2 x0, x1; x0.x = cvt_pk_bf16(a0[4 * g], a0[4 * g + 1]); x0.y = cvt_pk_bf16(a0[4 * g + 2], a0[4 * g + 3]); x1.x = cvt_pk_bf16(a1[4 * g], a1[4 * g + 1]); x1.y = cvt_pk_bf16(a1[4 * g + 2], a1[4 * g + 3]);
            const int o0 = ((eb * 8 + 4 * dh + (g >> 1)) * 64 + c + 32 * (g & 1)) * 8 + 4 * hi;
            *(u32x2*)(st + o0) = x0; *(u32x2*)(st + o0 + 2 * 512) = x1; }
    }
}
__device__ __forceinline__ void phase_hgrn_b(const Params& p, int bid, int nb) {
    for (int gid = bid * NTHR + tid_(); gid < 16 * 128 * 64; gid += nb * NTHR) {
        const int bh = gid >> 13, f2 = gid & 8191, f = 2 * f2, dd = 16 * ((f >> 9) & 7) + 8 * ((f >> 8) & 1) + (f & 7);
        unsigned* st = (unsigned*)(WSP(bf16_t, WS_HST) + (size_t)bh * 128 * 16384) + f2; const float* gp = WSP(float, WS_HG) + (size_t)bh * 128 * 128 + dd;
        float S0 = 0.f, S1 = 0.f;
        for (int c8 = 0; c8 < 128; c8 += 8) { unsigned U[8]; f32x2 g[8];
#pragma unroll
            for (int q = 0; q < 8; ++q) { U[q] = st[(size_t)(c8 + q) * 8192]; g[q] = *(const f32x2*)(gp + (c8 + q) * 128); }
#pragma unroll
            for (int q = 0; q < 8; ++q) { st[(size_t)(c8 + q) * 8192] = cvt_pk_bf16(S0, S1); S0 = g[q][0] * S0 + bflo(U[q]); S1 = g[q][1] * S1 + bfhi(U[q]); } }
    }
}
__device__ __forceinline__ void phase_hgrn_c(const Params& p, int layer, int bid, int nb) {
    const int tid = tid_(), lane = tid & 63, w = tid >> 6, c = lane & 31, hi = lane >> 5;
    const float* ng = p.in[I_HGRN_NG] + (layer / 3) * DM;
    for (int wu = bid * NWAVES + w; wu < 4096; wu += nb * NWAVES) {
        const int u = wu >> 1, tb = wu & 1, bh = u >> 7, cc = u & 127, b = bh >> 3, hh = bh & 7; const size_t tok0 = (size_t)b * SEQ + cc * 64;
        const size_t tokq = tok0 + 32 * tb + c;
        f32x16 o[4];
#pragma unroll
        for (int db = 0; db < 4; ++db)
#pragma unroll
            for (int i = 0; i < 16; ++i) o[db][i] = 0.f;
        {
            bf16x8 qf[8];
#pragma unroll
            for (int ks = 0; ks < 8; ++ks) qf[ks] = *(const bf16x8*)(WSP(bf16_t, WS_HQB) + ((size_t)(u * 2 + tb) * 8 + ks) * 512 + lane * 8);
            const bf16_t* st = WSP(bf16_t, WS_HST) + (size_t)u * 16384 + lane * 8;
#pragma unroll
            for (int db = 0; db < 4; ++db)
#pragma unroll
                for (int ks = 0; ks < 8; ++ks) o[db] = __builtin_amdgcn_mfma_f32_32x32x16_bf16(*(const bf16x8*)(st + (db * 8 + ks) * 512), qf[ks], o[db], 0, 0, 0);
        }
        {
            bf16x8 qf[8];
#pragma unroll
            for (int ks = 0; ks < 8; ++ks) qf[ks] = *(const bf16x8*)(WSP(bf16_t, WS_HQR) + ((size_t)(u * 2 + tb) * 8 + ks) * 512 + lane * 8);
            for (int kb = 0; kb <= tb; ++kb) {
                f32x16 s;
#pragma unroll
                for (int i = 0; i < 16; ++i) s[i] = 0.f;
                const bf16_t* kp = WSP(bf16_t, WS_HKR) + ((size_t)(u * 2 + kb) * 8) * 512 + lane * 8;
#pragma unroll
                for (int ks = 0; ks < 8; ++ks) s = __builtin_amdgcn_mfma_f32_32x32x16_bf16(*(const bf16x8*)(kp + ks * 512), qf[ks], s, 0, 0, 0);
                if (kb == tb) {
#pragma unroll
                    for (int i = 0; i < 16; ++i) { const int ko = 16 * (i >> 3) + 8 * hi + (i & 7); if (ko > c) s[i] = 0.f; } }
#pragma unroll
                for (int sq = 0; sq < 2; ++sq) { u32x4 wv; wv.x = cvt_pk_bf16(s[8 * sq], s[8 * sq + 1]); wv.y = cvt_pk_bf16(s[8 * sq + 2], s[8 * sq + 3]); wv.z = cvt_pk_bf16(s[8 * sq + 4], s[8 * sq + 5]); wv.w = cvt_pk_bf16(s[8 * sq + 6], s[8 * sq + 7]);
                    const bf16x8 pf = *reinterpret_cast<bf16x8*>(&wv);
                    const bf16_t* vp = WSP(bf16_t, WS_PVT) + ((size_t)(u * 4) * 4 + 2 * kb + sq) * 512 + lane * 8;
#pragma unroll
                    for (int db = 0; db < 4; ++db) o[db] = __builtin_amdgcn_mfma_f32_32x32x16_bf16(*(const bf16x8*)(vp + db * 4 * 512), pf, o[db], 0, 0, 0); }
            }
        }
        float ss = 0.f;
#pragma unroll
        for (int db = 0; db < 4; ++db)
#pragma unroll
            for (int i = 0; i < 16; ++i) ss += o[db][i] * o[db][i];
        ss = swap_sum(ss);
        const float rinv = rsqrtf(ss * (1.0f / 128.0f) + RMS_EPS);
        const bf16_t* gt = WSP(bf16_t, WS_PB) + tokq * DM + hh * HD; bf16_t* orow = WSP(bf16_t, WS_MIX) + tokq * OUT_IN + hh * HD;
#pragma unroll
        for (int db = 0; db < 4; ++db)
#pragma unroll
            for (int g = 0; g < 4; ++g) { const int d = 32 * db + 8 * g + 4 * hi; const u32x2 gw = *(const u32x2*)(gt + d); const f32x4 nv = *(const f32x4*)(ng + hh * HD + d);
                u32x2 wv; wv.x = cvt_pk_bf16(o[db][4 * g] * rinv * nv[0] * bflo(gw.x), o[db][4 * g + 1] * rinv * nv[1] * bfhi(gw.x));
                wv.y = cvt_pk_bf16(o[db][4 * g + 2] * rinv * nv[2] * bflo(gw.y), o[db][4 * g + 3] * rinv * nv[3] * bfhi(gw.y));
                *(u32x2*)(orow + d) = wv; }
    }
}

__device__ __forceinline__ void ln_row(f32x4 (&v)[4], const float* g, const float* bta, int lane) {
    float s = 0.f;
#pragma unroll
    for (int j = 0; j < 4; ++j) s += (v[j][0] + v[j][1]) + (v[j][2] + v[j][3]);
    const float mean = wave_sum(s) * (1.0f / DM); float s2 = 0.f;
#pragma unroll
    for (int j = 0; j < 4; ++j) { v[j] = v[j] - mean; s2 += (v[j][0] * v[j][0] + v[j][1] * v[j][1]) + (v[j][2] * v[j][2] + v[j][3] * v[j][3]); }
    const float rstd = rsqrtf(wave_sum(s2) * (1.0f / DM) + LN_EPS);
#pragma unroll
    for (int j = 0; j < 4; ++j) { const f32x4 gg = *(const f32x4*)(g + 256 * j + 4 * lane), bb = *(const f32x4*)(bta + 256 * j + 4 * lane); v[j] = v[j] * rstd * gg + bb; }
}
__device__ __forceinline__ void phase_ln1_router(const Params& p, LAS unsigned char* lds, int layer, int bid, int nb) {
    const int tid = tid_(), lane = tid & 63, w = tid >> 6;
    LAS float* part = (LAS float*)lds;
    LAS float* logit = (LAS float*)(lds + 32768);
    LAS int* asg_e = (LAS int*)(lds + 32768 + 8448 + 64); LAS unsigned* asg_v = (LAS unsigned*)(asg_e + 256);
    const float* g1 = p.in[I_LN1G] + layer * DM; const float* b1 = p.in[I_LN1B] + layer * DM;
    const float* rw = p.in[I_RW] + (size_t)layer * DM * NEXP; const float* rb = p.in[I_RB] + layer * NEXP;
    unsigned* ecnt = ctl(p) + CW_ECNT + layer * 32;
    for (int blk = bid; blk < T / 64; blk += nb) {
        const int row0 = blk * 64;
        for (int rr = 0; rr < 8; ++rr) { const size_t row = row0 + 8 * w + rr; const float* yp = WSP(float, WS_Y1) + row * DM;
            f32x4 v[4];
#pragma unroll
            for (int j = 0; j < 4; ++j) v[j] = *(const f32x4*)(yp + 256 * j + 4 * lane);
            ln_row(v, g1, b1, lane);
#pragma unroll
            for (int j = 0; j < 4; ++j) { *(f32x4*)(WSP(float, WS_X1F) + row * DM + 256 * j + 4 * lane) = v[j];
                u32x2 o; o.x = cvt_pk_bf16(v[j][0], v[j][1]); o.y = cvt_pk_bf16(v[j][2], v[j][3]); *(u32x2*)(WSP(bf16_t, WS_X1B) + row * DM + 256 * j + 4 * lane) = o; } }
        __syncthreads();
        {
            const int rt = w >> 2, kq = w & 3, i = lane & 31, kh = lane >> 5;
            const float* xp = WSP(float, WS_X1F) + (size_t)(row0 + 32 * rt + i) * DM + 256 * kq; const float* wp = rw + (size_t)(256 * kq + kh) * NEXP + i;
            f32x16 acc;
#pragma unroll
            for (int q = 0; q < 16; ++q) acc[q] = 0.f;
#pragma unroll 8
            for (int q = 0; q < 64; ++q) { const f32x4 xv = *(const f32x4*)(xp + 4 * q);
                acc = __builtin_amdgcn_mfma_f32_32x32x2f32(kh ? xv[1] : xv[0], wp[(size_t)(4 * q) * NEXP], acc, 0, 0, 0);
                acc = __builtin_amdgcn_mfma_f32_32x32x2f32(kh ? xv[3] : xv[2], wp[(size_t)(4 * q + 2) * NEXP], acc, 0, 0, 0); }
#pragma unroll
            for (int q = 0; q < 16; ++q) { const int r = (q & 3) + 8 * (q >> 2) + 4 * kh; part[(w * 32 + r) * 32 + i] = acc[q]; }
        }
        __syncthreads();
        for (int o_ = tid; o_ < 64 * 32; o_ += NTHR) { const int r = o_ >> 5, e = o_ & 31, rt = r >> 5, rl = r & 31; float s = rb[e];
#pragma unroll
            for (int kq = 0; kq < 4; ++kq) s += part[((rt * 4 + kq) * 32 + rl) * 32 + e];
            logit[r * 33 + e] = s; }
        __syncthreads();
        if (tid < 64) { const int tok = row0 + tid; float bv[4] = {-__builtin_inff(), -__builtin_inff(), -__builtin_inff(), -__builtin_inff()}; int bi[4] = {0, 0, 0, 0};
            for (int e = 0; e < 32; ++e) { const float x = logit[tid * 33 + e];
                if (x > bv[0]) { bv[3] = bv[2]; bi[3] = bi[2]; bv[2] = bv[1]; bi[2] = bi[1]; bv[1] = bv[0]; bi[1] = bi[0]; bv[0] = x; bi[0] = e; }
                else if (x > bv[1]) { bv[3] = bv[2]; bi[3] = bi[2]; bv[2] = bv[1]; bi[2] = bi[1]; bv[1] = x; bi[1] = e; }
                else if (x > bv[2]) { bv[3] = bv[2]; bi[3] = bi[2]; bv[2] = x; bi[2] = e; }
                else if (x > bv[3]) { bv[3] = x; bi[3] = e; } }
            float ex[4], se = 0.f;
#pragma unroll
            for (int k = 0; k < 4; ++k) { ex[k] = __expf(bv[k] - bv[0]); se += ex[k]; }
#pragma unroll
            for (int k = 0; k < 4; ++k) { WSP(float, WS_GATE)[(size_t)tok * 4 + k] = ex[k] / se; asg_e[tid * 4 + k] = bi[k]; asg_v[tid * 4 + k] = (unsigned)tok * 4u + k; } }
        __syncthreads();
        LAS int* ecl = asg_e + 512; LAS int* ebase = ecl + 32;
        if (tid < 32) ecl[tid] = 0;
        __syncthreads();
        int my_e = 0, my_rank = 0;
        if (tid < 256) { my_e = asg_e[tid]; my_rank = atomicAdd((int*)&ecl[my_e], 1); }
        __syncthreads();
        if (tid < 32) ebase[tid] = ecl[tid] ? (int)atomicAdd(ecnt + tid, (unsigned)ecl[tid]) : 0;
        __syncthreads();
        if (tid < 256) WSP(unsigned, WS_ETOK)[(size_t)my_e * T + ebase[my_e] + my_rank] = asg_v[tid];
        __syncthreads();
    }
}
__device__ __forceinline__ void phase_ln2(const Params& p, int layer, int bid, int nb) {
    const int tid = tid_(), lane = tid & 63, w = tid >> 6;
    const float* g2 = p.in[I_LN2G] + layer * DM; const float* b2 = p.in[I_LN2B] + layer * DM;
    float* dst = (layer == 3) ? p.out : WSP(float, WS_XF);
    for (size_t row = bid * NWAVES + w; row < T; row += (size_t)nb * NWAVES) {
        const float* xp = WSP(float, WS_X1F) + row * DM; const bf16_t* yp = WSP(bf16_t, WS_YE) + row * 4 * DM;
        float gk[4];
#pragma unroll
        for (int k = 0; k < 4; ++k) gk[k] = WSP(float, WS_GATE)[row * 4 + k];
        f32x4 v[4];
#pragma unroll
        for (int j = 0; j < 4; ++j) { v[j] = *(const f32x4*)(xp + 256 * j + 4 * lane) * DN_ALPHA;
#pragma unroll
            for (int k = 0; k < 4; ++k) { const u32x2 y = *(const u32x2*)(yp + (size_t)k * DM + 256 * j + 4 * lane);
                v[j][0] += gk[k] * bflo(y.x); v[j][1] += gk[k] * bfhi(y.x); v[j][2] += gk[k] * bflo(y.y); v[j][3] += gk[k] * bfhi(y.y); } }
        ln_row(v, g2, b2, lane);
#pragma unroll
        for (int j = 0; j < 4; ++j) { *(f32x4*)(dst + row * DM + 256 * j + 4 * lane) = v[j];
            u32x2 o; o.x = cvt_pk_bf16(v[j][0], v[j][1]); o.y = cvt_pk_bf16(v[j][2], v[j][3]); *(u32x2*)(WSP(bf16_t, WS_XB) + row * DM + 256 * j + 4 * lane) = o; }
    }
}

enum { PH_FOXPREP = 18 };
enum { PH_PROLOGUE = 0, PH_PROJ, PH_FOXLOGF, PH_HPRE, PH_HA, PH_HB, PH_HC, PH_FOXATTN, PH_KMEAN, PH_GATE, PH_PAST, PH_OWN, PH_MEMATTN, PH_OUTPROJ, PH_LN1, PH_UP, PH_DOWN, PH_LN2 };
template <int PH>
__device__ __forceinline__ void run_phase(const Params& p, LAS unsigned char* lds, int layer, int bid, int nb) {
    if constexpr (PH == PH_PROLOGUE) phase_prologue(p, lds, bid, nb);
    else if constexpr (PH == PH_PROJ) phase_proj(p, lds, layer, bid, nb);
    else if constexpr (PH == PH_FOXLOGF) phase_fox_logf(p, layer, bid, nb);
    else if constexpr (PH == PH_HPRE) phase_hgrn_pre(p, layer, bid, nb);
    else if constexpr (PH == PH_HA) phase_hgrn_a(p, bid, nb);
    else if constexpr (PH == PH_HB) phase_hgrn_b(p, bid, nb);
    else if constexpr (PH == PH_HC) phase_hgrn_c(p, layer, bid, nb);
    else if constexpr (PH == PH_FOXATTN) phase_fox_attn(p, lds, layer, bid, nb);
    else if constexpr (PH == PH_FOXPREP) phase_fox_prep(p, bid, nb);
    else if constexpr (PH == PH_KMEAN) phase_moba_kmean(p, lds, bid, nb);
    else if constexpr (PH == PH_GATE) phase_moba_gate(p, lds, bid, nb);
    else if constexpr (PH == PH_PAST) phase_moba_past(p, lds, bid, nb);
    else if constexpr (PH == PH_OWN) phase_moba_own(p, lds, bid, nb);
    else if constexpr (PH == PH_MEMATTN) phase_memattn(p, lds, bid, nb);
    else if constexpr (PH == PH_OUTPROJ) phase_outproj(p, lds, layer, bid, nb);
    else if constexpr (PH == PH_LN1) phase_ln1_router(p, lds, layer, bid, nb);
    else if constexpr (PH == PH_UP) phase_moe_up(p, lds, layer, bid, nb);
    else if constexpr (PH == PH_DOWN) phase_moe_down(p, lds, layer, bid, nb);
    else if constexpr (PH == PH_LN2) phase_ln2(p, layer, bid, nb);
}
template <int PH>
__global__ void __launch_bounds__(NTHR, 2) k_phase(Params p, int layer) {
    extern __shared__ __attribute__((aligned(16))) unsigned char lds_raw[];
    run_phase<PH>(p, (LAS unsigned char*)lds_raw, layer, (int)blockIdx.x, (int)gridDim.x);
}

#ifndef DEBUG_CHECKS
#define DEBUG_CHECKS 0
#endif
#if DEBUG_CHECKS
constexpr size_t WS_CHK = WS_END;
__device__ __forceinline__ float bfr(float x) { return bf2f(f2bf(x)); }
__device__ __forceinline__ unsigned hashu(unsigned x) { x ^= x >> 16; x *= 0x7feb352du; x ^= x >> 15; x *= 0x846ca68bu; x ^= x >> 16; return x; }
__device__ __forceinline__ void chk_report(const Params& p, int id, float err) { if (!(err == err)) err = 1e30f; atomicMax(ctl(p) + CW_CHK + id, __float_as_uint(fabsf(err))); }
__device__ __forceinline__ float blk_sum(float v, LAS float* red) {
    v = wave_sum(v); const int w = threadIdx.x >> 6, nw = blockDim.x >> 6; __syncthreads(); if ((threadIdx.x & 63) == 0) red[w] = v; __syncthreads(); float s = 0.f; for (int i = 0; i < nw; ++i) s += red[i]; return s; }
__device__ __forceinline__ float blk_max(float v, LAS float* red) {
#pragma unroll
    for (int o = 1; o < 64; o <<= 1) v = fmaxf(v, __shfl_xor(v, o));
    const int w = threadIdx.x >> 6, nw = blockDim.x >> 6; __syncthreads(); if ((threadIdx.x & 63) == 0) red[w] = v; __syncthreads(); float s = red[0]; for (int i = 1; i < nw; ++i) s = fmaxf(s, red[i]); return s; }

__global__ void chk_proj(Params p, int layer, int id) {
    const int kind = layer % 3, jj = layer / 3; const unsigned sidx = blockIdx.x * blockDim.x + threadIdx.x; const unsigned hsh = hashu(sidx * 2654435761u + layer * 977u + 12345u);
    const int nin = kind == 0 ? HGRN_IN : (kind == 1 ? FOX_IN : MOBA_IN);
    const float* W = kind == 0 ? p.in[I_HGRN_W] + (size_t)jj * DM * HGRN_IN : (kind == 1 ? p.in[I_FOX_W] : p.in[I_MOBA_W]);
    int tok = hsh % T; int col = (hsh >> 14) % (nin + 128);
    float exp_v, got;
    if (col >= nin) {
        const int c = (hashu(hsh) % 1024), row = tok % 512; const float* wk = p.in[I_WKV] + (size_t)layer * DM * 1024; float s = 0.f;
        for (int k = 0; k < DM; ++k) s += bfr(p.in[I_MEM][(size_t)row * DM + k]) * bfr(wk[(size_t)k * 1024 + c]);
        exp_v = s; got = c < 512 ? bf2f(WSP(bf16_t, WS_MEMK)[(size_t)row * 512 + c]) : bf2f(WSP(bf16_t, WS_MEMVT)[(size_t)(c - 512) * 512 + row]);
    } else {
        float s = 0.f, sf = 0.f;
        for (int k = 0; k < DM; ++k) { const float xv = (layer == 0) ? p.in[I_X][(size_t)tok * DM + k] : WSP(float, WS_XF)[(size_t)tok * DM + k]; const float xb = (layer == 0) ? bfr(xv) : bf2f(WSP(bf16_t, WS_XB)[(size_t)tok * DM + k]);
            const float wv = W[(size_t)k * nin + col]; s += xb * bfr(wv); sf += xv * wv; }
        const int sec = col >> 10, c = col & 1023; exp_v = s;
        if (kind == 0) { if (sec == 0) { exp_v = siluf_(s); got = bf2f(WSP(bf16_t, WS_PA)[(size_t)tok * DM + c]); } else if (sec == 1) got = WSP(float, WS_PZ)[(size_t)tok * DM + c];
            else if (sec == 2) got = bf2f(WSP(bf16_t, WS_PVT)[(size_t)c * T + tok]); else if (sec == 3) { exp_v = siluf_(s); got = bf2f(WSP(bf16_t, WS_PB)[(size_t)tok * DM + c]); } else got = bf2f(WSP(bf16_t, WS_PMQ)[(size_t)tok * MEMW + c]); }
        else { if (sec == 0) got = bf2f(WSP(bf16_t, WS_PA)[(size_t)tok * DM + c]); else if (sec == 1) got = bf2f(WSP(bf16_t, WS_PB)[(size_t)tok * DM + c]); else if (sec == 2) got = bf2f(WSP(bf16_t, WS_PVT)[(size_t)c * T + tok]);
            else if (kind == 1 && col < 3080) { exp_v = logsigmoidf_(sf + p.in[I_FOX_BF][jj * NH + (col - 3072)]) * LOG2E; got = WSP(float, WS_LOGF)[((size_t)(tok / SEQ) * NH + (col - 3072)) * SEQ + tok % SEQ]; }
            else got = bf2f(WSP(bf16_t, WS_PMQ)[(size_t)tok * MEMW + (col - (kind == 1 ? 3080 : 3072))]); }
    }
    chk_report(p, id, fabsf(got - exp_v) / (fabsf(exp_v) + 0.05f));
}
__global__ void chk_fox_prep(Params p) { const int bh = threadIdx.x; if (bh < 16) { float s = 0.f; for (int k = 0; k < SEQ; ++k) { s += WSP(float, WS_LOGF)[(size_t)bh * SEQ + k]; WSP(float, WS_CHK)[(size_t)bh * SEQ + k] = s; } } }
__device__ __forceinline__ float chk_softmax_out(const Params& p, LAS float* sc, const LAS int* kp, int n, int b, int h, int tok, LAS float* red) {
    float mx = -1e30f; for (int i = threadIdx.x; i < n; i += blockDim.x) mx = fmaxf(mx, sc[i]); mx = blk_max(mx, red);
    float sm = 0.f; for (int i = threadIdx.x; i < n; i += blockDim.x) { const float e = exp2f(sc[i] - mx); sc[i] = e; sm += e; } sm = blk_sum(sm, red);
    float err = 0.f, mag = 0.f;
    if (threadIdx.x < 128) { const int d = threadIdx.x; float o = 0.f; for (int i = 0; i < n; ++i) o += sc[i] * bf2f(WSP(bf16_t, WS_PVT)[(size_t)(h * HD + d) * T + (size_t)b * SEQ + (kp ? kp[i] : i)]);
        o /= sm; const float got = bf2f(WSP(bf16_t, WS_MIX)[(size_t)tok * OUT_IN + h * HD + d]); err = fabsf(got - o); mag = fabsf(o); }
    err = blk_max(err, red); mag = blk_max(mag, red); return err / (mag + 1e-3f);
}
__global__ void chk_fox(Params p, int id) {
    extern __shared__ __attribute__((aligned(16))) unsigned char sm_raw[]; LAS float* sc = (LAS float*)sm_raw; LAS float* red = sc + 8192;
    const unsigned hsh = hashu(blockIdx.x * 7919u + 17u); const int b = hsh & 1, h = (hsh >> 1) & 7; int q = (hsh >> 4) % SEQ; if (blockIdx.x < 8) q = blockIdx.x * 37; if (blockIdx.x == 8) q = SEQ - 1;
    const int tok = b * SEQ + q; const float* c2 = WSP(float, WS_CHK) + (size_t)(b * NH + h) * SEQ;
    for (int k = threadIdx.x; k <= q; k += blockDim.x) { float s = 0.f; for (int d = 0; d < HD; ++d) s += bf2f(WSP(bf16_t, WS_PA)[(size_t)tok * DM + h * HD + d]) * bf2f(WSP(bf16_t, WS_PB)[((size_t)b * SEQ + k) * DM + h * HD + d]);
        sc[k] = s * QK_SCALE * LOG2E + c2[q] - c2[k]; }
    __syncthreads();
    const float e = chk_softmax_out(p, sc, nullptr, q + 1, b, h, tok, red);
    if (threadIdx.x == 0) chk_report(p, id, e);
}
__global__ void chk_moba(Params p, int id) {
    extern __shared__ __attribute__((aligned(16))) unsigned char sm_raw[]; LAS float* sc = (LAS float*)sm_raw; LAS int* kp = (LAS int*)(sc + 1024); LAS float* km = (LAS float*)(kp + 1024); LAS float* red = km + 32 * 128; LAS float* gate = red + 16; LAS int* selb = (LAS int*)(gate + 32);
    const unsigned hsh = hashu(blockIdx.x * 7919u + 29u); const int b = hsh & 1, h = (hsh >> 1) & 7; int q = (hsh >> 4) % SEQ; if (blockIdx.x < 6) q = blockIdx.x * 173; if (blockIdx.x == 6) q = 256; if (blockIdx.x == 7) q = 1024 + 5;
    const int own = q >> 8, tok = b * SEQ + q;
    for (int idx = threadIdx.x; idx < own * 128; idx += blockDim.x) { const int j = idx >> 7, d = idx & 127; float s = 0.f; for (int k = 0; k < 256; ++k) s += bf2f(WSP(bf16_t, WS_PB)[((size_t)b * SEQ + j * 256 + k) * DM + h * HD + d]); km[idx] = s * (1.0f / 256.0f); }
    __syncthreads();
    if ((int)threadIdx.x < own) { float g = 0.f; for (int d = 0; d < HD; ++d) g += bf2f(WSP(bf16_t, WS_PA)[(size_t)tok * DM + h * HD + d]) * km[threadIdx.x * 128 + d]; gate[threadIdx.x] = g; }
    __syncthreads();
    if (threadIdx.x == 0) { int nsel = own < 3 ? own : 3; for (int s = 0; s < nsel; ++s) { int bj = -1; float bv = -__builtin_inff(); for (int j = 0; j < own; ++j) { bool used = false; for (int r = 0; r < s; ++r) used |= (selb[r] == j); if (!used && gate[j] > bv) { bv = gate[j]; bj = j; } } selb[s] = bj; }
        int n = 0; for (int s = 0; s < nsel; ++s) for (int k = 0; k < 256; ++k) kp[n++] = selb[s] * 256 + k; for (int k = own * 256; k <= q; ++k) kp[n++] = k; selb[3] = n; }
    __syncthreads();
    const int n = selb[3];
    for (int i = threadIdx.x; i < n; i += blockDim.x) { const int k = kp[i]; float s = 0.f; for (int d = 0; d < HD; ++d) s += bf2f(WSP(bf16_t, WS_PA)[(size_t)tok * DM + h * HD + d]) * bf2f(WSP(bf16_t, WS_PB)[((size_t)b * SEQ + k) * DM + h * HD + d]);
        sc[i] = (s * QK_SCALE + p.in[I_RELB][t5_bucket(q - k) * NH + h]) * LOG2E; }
    __syncthreads();
    const float e = chk_softmax_out(p, sc, kp, n, b, h, tok, red);
    if (threadIdx.x == 0) chk_report(p, id, e);
}
__global__ void chk_hgrn(Params p, int layer, int id) {
    extern __shared__ __attribute__((aligned(16))) unsigned char sm_raw[]; LAS float* a = (LAS float*)sm_raw; LAS float* red = a + 512;
    const int jj = layer / 3; const unsigned hsh = hashu(blockIdx.x * 7919u + 41u); const int b = hsh & 1, h = (hsh >> 1) & 7; const int tl[8] = {0, 5, 63, 64, 100, 130, 200, 300}; const int t = tl[blockIdx.x & 7] + ((blockIdx.x >> 3) & 1) * 4096;
    const int t0 = t & ~4095;
    const int d = threadIdx.x, ch = h * HD + d; const float lb = (jj == 0) ? 0.f : sigmoidf_(p.in[I_HGRN_LB][DM + ch] - p.in[I_HGRN_LB][ch]);
    for (int i = d; i < 512; i += 128) a[i] = 0.f;
    __syncthreads();
    if (t0 == 0) {
        float Bt = 0.f; for (int s = 0; s <= t; ++s) { const float z = WSP(float, WS_PZ)[((size_t)b * SEQ + s) * DM + ch]; const float ls = logsigmoidf_(z); Bt += (lb == 0.f) ? ls : logf(lb + (1.f - lb) * expf(ls)); }
        const float qv = bf2f(WSP(bf16_t, WS_PA)[((size_t)b * SEQ + t) * DM + ch]); float Bs = 0.f;
        for (int s = 0; s <= t; ++s) { const float z = WSP(float, WS_PZ)[((size_t)b * SEQ + s) * DM + ch]; const float ls = logsigmoidf_(z); Bs += (lb == 0.f) ? ls : logf(lb + (1.f - lb) * expf(ls));
            const float kk = (1.f - lb) * sigmoidf_(-z); atomicAdd((float*)&a[s], qv * kk * expf(Bt - Bs)); }
        __syncthreads();
        float o = 0.f; for (int s = 0; s <= t; ++s) o += a[s] * bf2f(WSP(bf16_t, WS_PVT)[(size_t)ch * T + (size_t)b * SEQ + s]);
        const float ss = blk_sum(o * o, red); const float rinv = rsqrtf(ss * (1.0f / 128.0f) + RMS_EPS);
        const size_t tok = (size_t)b * SEQ + t; const float ex = o * rinv * p.in[I_HGRN_NG][jj * DM + ch] * bf2f(WSP(bf16_t, WS_PB)[tok * DM + ch]);
        const float got = bf2f(WSP(bf16_t, WS_MIX)[tok * OUT_IN + ch]);
        const float err = blk_max(fabsf(got - ex), red), mag = blk_max(fabsf(ex), red);
        if (threadIdx.x == 0) chk_report(p, id, err / (mag + 1e-3f));
    }
}
__global__ void chk_memattn(Params p, int id) {
    extern __shared__ __attribute__((aligned(16))) unsigned char sm_raw[]; LAS float* sc = (LAS float*)sm_raw; LAS float* red = sc + 256;
    const unsigned hsh = hashu(blockIdx.x * 7919u + 53u); const int tok = hsh % T, mh = (hsh >> 16) & 3, b = tok / SEQ, k = threadIdx.x;
    float s = 0.f; for (int d = 0; d < HD; ++d) s += bf2f(WSP(bf16_t, WS_PMQ)[(size_t)tok * MEMW + mh * HD + d]) * bf2f(WSP(bf16_t, WS_MEMK)[(size_t)(b * MEMT + k) * MEMW + mh * HD + d]);
    sc[k] = s * QK_SCALE * LOG2E; __syncthreads();
    float mx = blk_max(sc[k], red); const float e = exp2f(sc[k] - mx); __syncthreads(); sc[k] = e; const float sm = blk_sum(e, red);
    float err = 0.f, mag = 0.f;
    if (k < 128) { float o = 0.f; for (int i = 0; i < 256; ++i) o += sc[i] * bf2f(WSP(bf16_t, WS_MEMVT)[(size_t)(mh * HD + k) * 512 + b * MEMT + i]); o /= sm;
        const float got = bf2f(WSP(bf16_t, WS_MIX)[(size_t)tok * OUT_IN + DM + mh * HD + k]); err = fabsf(got - o); mag = fabsf(o); }
    err = blk_max(err, red); mag = blk_max(mag, red);
    if (threadIdx.x == 0) chk_report(p, id, err / (mag + 1e-3f));
}
__global__ void chk_out_ln1(Params p, int layer, int id) {
    extern __shared__ __attribute__((aligned(16))) unsigned char sm_raw[]; LAS float* red = (LAS float*)sm_raw;
    const unsigned hsh = hashu(blockIdx.x * 7919u + 67u + layer); const int tok = hsh % T; const float* wo = p.in[I_WOUT] + (size_t)layer * OUT_IN * DM; const float* xr = layer == 0 ? p.in[I_X] : WSP(float, WS_XF);
    float y[2];
    for (int e = 0; e < 2; ++e) { const int c = threadIdx.x + 512 * e; float s = 0.f; for (int k = 0; k < OUT_IN; ++k) s += bf2f(WSP(bf16_t, WS_MIX)[(size_t)tok * OUT_IN + k]) * bfr(wo[(size_t)k * DM + c]); y[e] = s + DN_ALPHA * xr[(size_t)tok * DM + c]; }
    const float mean = blk_sum(y[0] + y[1], red) * (1.0f / DM); const float var = blk_sum((y[0] - mean) * (y[0] - mean) + (y[1] - mean) * (y[1] - mean), red) * (1.0f / DM); const float rstd = rsqrtf(var + LN_EPS);
    float err = 0.f;
    for (int e = 0; e < 2; ++e) { const int c = threadIdx.x + 512 * e; const float x1 = (y[e] - mean) * rstd * p.in[I_LN1G][layer * DM + c] + p.in[I_LN1B][layer * DM + c]; err = fmaxf(err, fabsf(x1 - WSP(float, WS_X1F)[(size_t)tok * DM + c])); }
    err = blk_max(err, red); if (threadIdx.x == 0) chk_report(p, id, err);
}
__global__ void chk_moe(Params p, int layer, int id) {
    extern __shared__ __attribute__((aligned(16))) unsigned char sm_raw[]; LAS float* hb = (LAS float*)sm_raw; LAS float* act = hb + 2048; LAS float* red = act + 1024; LAS float* lg = red + 16; LAS float* gt = lg + 32; LAS int* ei = (LAS int*)(gt + 4);
    const unsigned hsh = hashu(blockIdx.x * 7919u + 79u + layer); const int tok = hsh % T; const int tid = threadIdx.x;
    if (tid < 32) { float s = p.in[I_RB][layer * NEXP + tid]; for (int k = 0; k < DM; ++k) s += WSP(float, WS_X1F)[(size_t)tok * DM + k] * p.in[I_RW][((size_t)layer * DM + k) * NEXP + tid]; lg[tid] = s; }
    __syncthreads();
    if (tid == 0) { float v[4]; for (int s = 0; s < 4; ++s) { int bj = -1; float bv = -__builtin_inff(); for (int j = 0; j < 32; ++j) { bool used = false; for (int r = 0; r < s; ++r) used |= (ei[r] == j); if (!used && lg[j] > bv) { bv = lg[j]; bj = j; } } ei[s] = bj; v[s] = bv; }
        float se = 0.f; for (int s = 0; s < 4; ++s) { v[s] = expf(v[s] - lg[ei[0]]); se += v[s]; } for (int s = 0; s < 4; ++s) gt[s] = v[s] / se; }
    __syncthreads();
    float ysum[2] = {0.f, 0.f};
    for (int s = 0; s < 4; ++s) { const int e = ei[s]; const float* wu = p.in[I_WUP] + ((size_t)layer * NEXP + e) * DM * 2 * DFF; const float* wd = p.in[I_WDN] + ((size_t)layer * NEXP + e) * DFF * DM;
        for (int q = 0; q < 4; ++q) { const int c = tid + 512 * q; float a = p.in[I_BUP][((size_t)layer * NEXP + e) * 2 * DFF + c]; for (int k = 0; k < DM; ++k) a += bf2f(WSP(bf16_t, WS_X1B)[(size_t)tok * DM + k]) * bfr(wu[(size_t)k * 2 * DFF + c]); hb[c] = a; }
        __syncthreads();
        for (int q = 0; q < 2; ++q) { const int f = tid + 512 * q; const float glu = fminf(hb[2 * f], 7.f), lin = fminf(fmaxf(hb[2 * f + 1], -7.f), 7.f); act[f] = bfr(glu * sigmoidf_(1.702f * glu) * (lin + 1.f)); }
        __syncthreads();
        for (int q = 0; q < 2; ++q) { const int c = tid + 512 * q; float a = p.in[I_BDN][((size_t)layer * NEXP + e) * DM + c]; for (int f = 0; f < DFF; ++f) a += act[f] * bfr(wd[(size_t)f * DM + c]); ysum[q] += gt[s] * bfr(a); }
        __syncthreads(); }
    float y[2]; for (int q = 0; q < 2; ++q) y[q] = DN_ALPHA * WSP(float, WS_X1F)[(size_t)tok * DM + tid + 512 * q] + ysum[q];
    const float mean = blk_sum(y[0] + y[1], red) * (1.0f / DM); const float var = blk_sum((y[0] - mean) * (y[0] - mean) + (y[1] - mean) * (y[1] - mean), red) * (1.0f / DM); const float rstd = rsqrtf(var + LN_EPS);
    const float* dst = (layer == 3) ? p.out : WSP(float, WS_XF); float err = 0.f;
    for (int q = 0; q < 2; ++q) { const int c = tid + 512 * q; const float x2 = (y[q] - mean) * rstd * p.in[I_LN2G][layer * DM + c] + p.in[I_LN2B][layer * DM + c]; err = fmaxf(err, fabsf(x2 - dst[(size_t)tok * DM + c])); }
    err = blk_max(err, red); if (tid == 0) chk_report(p, id, err);
}
__global__ void chk_finalize(Params p, int nchk, float tol) {
    int fail = 0; float ferr = 0.f;
    for (int i = 1; i <= nchk; ++i) { const float e = __uint_as_float(ctl(p)[CW_CHK + i]); if (!(e <= tol)) { fail = i; ferr = e; break; } }
    if (!fail) return;
    int cls = 0; float r = ferr / tol; while (r >= 10.f && cls < 9) { r *= 0.1f; ++cls; }
    const float s = sqrtf((1.0f + 0.1f * fail) * powf(10.f, 8.f + cls));
    for (size_t i = (size_t)blockIdx.x * blockDim.x + threadIdx.x; i < (size_t)T * DM; i += (size_t)gridDim.x * blockDim.x) p.out[i] = (i & 1) ? s : -s;
}
#endif

#define GBAR() xcd_barrier(bar)
#ifndef DUPMASK
#define DUPMASK 0
#endif
#define DUP(bit, stmt) do { stmt; if (DUPMASK & (1 << (bit))) { GBAR(); stmt; } } while (0)
template <int LAYER>
__device__ __forceinline__ void run_layer(const Params& p, LAS unsigned char* lds, const XcdBarrier& bar, int bid, int nb) {
    constexpr int kind = LAYER % 3;
    if constexpr (kind == 1) run_phase<PH_FOXLOGF>(p, lds, LAYER, bid, nb);
    DUP(1, run_phase<PH_PROJ>(p, lds, LAYER, bid, nb)); GBAR();
    if constexpr (kind == 0) {
        DUP(2, run_phase<PH_HPRE>(p, lds, LAYER, bid, nb)); GBAR();
        DUP(2, run_phase<PH_HA>(p, lds, LAYER, bid, nb)); GBAR();
        run_phase<PH_HB>(p, lds, LAYER, bid, nb); GBAR();
        DUP(2, run_phase<PH_HC>(p, lds, LAYER, bid, nb));
        DUP(5, run_phase<PH_MEMATTN>(p, lds, LAYER, bid, nb)); GBAR();
    } else if constexpr (kind == 1) {
        run_phase<PH_FOXPREP>(p, lds, LAYER, bid, nb);
        DUP(5, run_phase<PH_MEMATTN>(p, lds, LAYER, bid, nb)); GBAR();
        run_phase<PH_FOXATTN>(p, lds, LAYER, bid, nb); GBAR();
    } else {
        DUP(4, run_phase<PH_KMEAN>(p, lds, LAYER, bid, nb));
        DUP(5, run_phase<PH_MEMATTN>(p, lds, LAYER, bid, nb)); GBAR();
        run_phase<PH_GATE>(p, lds, LAYER, bid, nb); GBAR();
        DUP(4, run_phase<PH_PAST>(p, lds, LAYER, bid, nb)); GBAR();
        DUP(4, run_phase<PH_OWN>(p, lds, LAYER, bid, nb)); GBAR();
    }
    DUP(6, run_phase<PH_OUTPROJ>(p, lds, LAYER, bid, nb)); GBAR();
    run_phase<PH_LN1>(p, lds, LAYER, bid, nb); GBAR();
    DUP(7, run_phase<PH_UP>(p, lds, LAYER, bid, nb)); GBAR();
    DUP(8, run_phase<PH_DOWN>(p, lds, LAYER, bid, nb)); GBAR();
    DUP(9, run_phase<PH_LN2>(p, lds, LAYER, bid, nb));
    if constexpr (LAYER < 3) GBAR();
}
__global__ void __launch_bounds__(NTHR, 2) k_mega(Params p) {
    extern __shared__ __attribute__((aligned(16))) unsigned char lds_raw[];
    LAS unsigned char* lds = (LAS unsigned char*)lds_raw;
    volatile LAS unsigned* bw = (volatile LAS unsigned*)(lds + LDS_MISC);
    if (threadIdx.x < 4) bw[threadIdx.x] = 0u;
    __syncthreads();
    const XcdBarrier bar = xcd_barrier_post(ctl(p) + CW_BAR, bw);
    const int bid = (int)blockIdx.x, nb = (int)gridDim.x;
    DUP(0, run_phase<PH_PROLOGUE>(p, lds, 0, bid, nb)); GBAR();
    run_layer<0>(p, lds, bar, bid, nb);
    run_layer<1>(p, lds, bar, bid, nb);
    run_layer<2>(p, lds, bar, bid, nb);
    run_layer<3>(p, lds, bar, bid, nb);
}

template <int PH> static void launch_phase(const Params& p, int layer, int grid, hipStream_t stream) {
    static bool attr = false;
    if (!attr) { (void)hipFuncSetAttribute((const void*)k_phase<PH>, hipFuncAttributeMaxDynamicSharedMemorySize, LDS_BYTES); attr = true; }
    hipLaunchKernelGGL(k_phase<PH>, dim3(grid), dim3(NTHR), LDS_BYTES, stream, p, layer);
}
extern "C" void kernel_launch(void* const* d_in, const int* in_sizes, int n_in, void* d_out, int out_size, void* d_ws, size_t ws_size, hipStream_t stream) {
    if (n_in != 21 || out_size != T * DM || ws_size < WS_END + 2 * MiB) { fprintf(stderr, "kernel_launch: unexpected problem (n_in %d out %d ws %zu need %zu)\n", n_in, out_size, ws_size, (size_t)(WS_END + 2 * MiB)); return; }
    Params p{};
    for (int i = 0; i < 21; ++i) p.in[i] = (const float*)d_in[i];
    p.out = (float*)d_out; p.ws = (unsigned char*)d_ws;
    (void)hipMemsetAsync((char*)d_ws + WS_CTL, 0, CTL_BYTES, stream);
    const int G = 256;
#if MEGA
    {
        static int ok = 0;
        if (!ok) { int dev = 0, cus = 0; (void)hipGetDevice(&dev); (void)hipDeviceGetAttribute(&cus, hipDeviceAttributeMultiprocessorCount, dev);
            (void)hipFuncSetAttribute((const void*)k_mega, hipFuncAttributeMaxDynamicSharedMemorySize, LDS_BYTES);
            int per_cu = 0; (void)hipOccupancyMaxActiveBlocksPerMultiprocessor(&per_cu, (const void*)k_mega, NTHR, LDS_BYTES); (void)hipGetLastError();
            if (cus < G || per_cu < 1) { fprintf(stderr, "kernel_launch: need %d CUs with one resident workgroup each (cus %d, per_cu %d)\n", G, cus, per_cu); ok = -1; } else ok = 1; }
        if (ok < 0) return;
        hipLaunchKernelGGL(k_mega, dim3(G), dim3(NTHR), LDS_BYTES, stream, p);
        return;
    }
#endif
    launch_phase<PH_PROLOGUE>(p, 0, G, stream);
    for (int layer = 0; layer < 4; ++layer) {
        const int kind = layer % 3;
        if (kind == 1) launch_phase<PH_FOXLOGF>(p, layer, G, stream);
        launch_phase<PH_PROJ>(p, layer, G, stream);
#if DEBUG_CHECKS
        hipLaunchKernelGGL(chk_proj, dim3(64), dim3(256), 0, stream, p, layer, layer * 5 + 1);
#endif
        if (kind == 0) { launch_phase<PH_HPRE>(p, layer, G, stream); launch_phase<PH_HA>(p, layer, G, stream); launch_phase<PH_HB>(p, layer, G, stream); launch_phase<PH_HC>(p, layer, G, stream); }
        else if (kind == 1) { launch_phase<PH_FOXPREP>(p, layer, G, stream); launch_phase<PH_FOXATTN>(p, layer, G, stream); }
        else { launch_phase<PH_KMEAN>(p, layer, G, stream); launch_phase<PH_GATE>(p, layer, G, stream); launch_phase<PH_PAST>(p, layer, G, stream); launch_phase<PH_OWN>(p, layer, G, stream); }
        launch_phase<PH_MEMATTN>(p, layer, G, stream);
#if DEBUG_CHECKS
        if (kind == 0) hipLaunchKernelGGL(chk_hgrn, dim3(16), dim3(128), 4096, stream, p, layer, layer * 5 + 2);
        else if (kind == 1) { hipLaunchKernelGGL(chk_fox_prep, dim3(1), dim3(64), 0, stream, p); hipLaunchKernelGGL(chk_fox, dim3(48), dim3(256), 8192 * 4 + 256, stream, p, layer * 5 + 2); }
        else hipLaunchKernelGGL(chk_moba, dim3(48), dim3(256), 32768, stream, p, layer * 5 + 2);
        hipLaunchKernelGGL(chk_memattn, dim3(64), dim3(256), 2048, stream, p, layer * 5 + 3);
#endif
        launch_phase<PH_OUTPROJ>(p, layer, G, stream);
        launch_phase<PH_LN1>(p, layer, G, stream);
#if DEBUG_CHECKS
        hipLaunchKernelGGL(chk_out_ln1, dim3(32), dim3(512), 256, stream, p, layer, layer * 5 + 4);
#endif
        launch_phase<PH_UP>(p, layer, G, stream);
        launch_phase<PH_DOWN>(p, layer, G, stream);
        launch_phase<PH_LN2>(p, layer, G, stream);
#if DEBUG_CHECKS
        hipLaunchKernelGGL(chk_moe, dim3(16), dim3(512), 16384, stream, p, layer, layer * 5 + 5);
#endif
    }
#if DEBUG_CHECKS
    hipLaunchKernelGGL(chk_finalize, dim3(1024), dim3(256), 0, stream, p, 20, 0.04f);
#endif
}
```
